# Optimizing an MI355X kernel written in HIP

```python
import math
import jax, jax.numpy as jnp
from jax import lax
import numpy as np

D_MODEL = 1024
BATCH = 8
SEQ = 2048
DEPTH = 2

CHUNK = 64
Q_BLOCK = 128
MEM_LEN = 256

GLA_HEADS = 4
GLA_DK = 64
GLA_DV = 64
GLA_GATE_RANK = 16
GLA_TAU = 16.0
MLSTM_HEADS = 4
MLSTM_DK = 64
MLSTM_DV = 64
MLSTM_CONV = 4
MLA_HEADS = 8
MLA_NOPE = 64
MLA_ROPE = 32
MLA_V = 64
MLA_Q_RANK = 256
MLA_KV_RANK = 128
ROPE_BASE = 10000.0
XA_HEADS = 4
XA_DH = D_MODEL // XA_HEADS
N_GROUPS = 4
EXPERTS_PER_GROUP = 8
N_EXPERTS = N_GROUPS * EXPERTS_PER_GROUP
EXPERT_TOP_K = 2
D_EXPERT = 256

ALPHA = (2 * DEPTH) ** 0.25
BETA = (8 * DEPTH) ** -0.25
LN_EPS = 1e-5

GLA_QK = GLA_HEADS * GLA_DK
GLA_VW = GLA_HEADS * GLA_DV
ML_QK = MLSTM_HEADS * MLSTM_DK
ML_VW = MLSTM_HEADS * MLSTM_DV
MLA_OUT = MLA_HEADS * MLA_V
MIX_WIDTH = GLA_VW + ML_VW + MLA_OUT
IN_SIZES = (GLA_QK, GLA_QK, GLA_VW, GLA_VW, GLA_GATE_RANK,
            2 * ML_QK, ML_VW, ML_VW, MLSTM_HEADS, MLSTM_HEADS,
            MLA_Q_RANK, MLA_KV_RANK, MLA_ROPE)
IN_WIDTH = sum(IN_SIZES)

kernel_name = "hybrid_gla_mlstm_mla_hmoe_block"


def layer_norm(x, g, b):
    xf = x.astype(jnp.float32)
    mu = jnp.mean(xf, -1, keepdims=True)
    var = jnp.mean(jnp.square(xf - mu), -1, keepdims=True)
    return ((xf - mu) * lax.rsqrt(var + LN_EPS) * g + b).astype(x.dtype)


def rms_norm(x, g):
    xf = x.astype(jnp.float32)
    return (xf * lax.rsqrt(jnp.mean(jnp.square(xf), -1, keepdims=True) + LN_EPS) * g).astype(x.dtype)


def head_norm(x, g):
    mu = jnp.mean(x, -1, keepdims=True)
    var = jnp.mean(jnp.square(x - mu), -1, keepdims=True)
    return (x - mu) * lax.rsqrt(var + LN_EPS) * g.reshape(x.shape[-2:])


def rope(x, pos):
    half = x.shape[-1] // 2
    inv = ROPE_BASE ** (-jnp.arange(half, dtype=jnp.float32) / half)
    ang = pos.astype(jnp.float32)[..., None] * inv
    cos = jnp.cos(ang)[:, :, None, :]
    sin = jnp.sin(ang)[:, :, None, :]
    xf = x.astype(jnp.float32)
    x1, x2 = xf[..., :half], xf[..., half:]
    return jnp.concatenate([x1 * cos - x2 * sin, x2 * cos + x1 * sin], -1).astype(x.dtype)


def causal_depthwise_conv(x, w):
    k_w, c = w.shape
    return lax.conv_general_dilated(x, w[:, None, :], window_strides=(1,), padding=((k_w - 1, 0),),
                                    dimension_numbers=('NWC', 'WIO', 'NWC'), feature_group_count=c)


def gla_mixer(q, k, v, r, a_lr, w_a2, b_a, norm_g):
    B, S, _ = q.shape
    nc = S // CHUNK
    f32 = jnp.float32
    log_a = jax.nn.log_sigmoid((a_lr @ w_a2 + b_a).astype(f32)) / GLA_TAU

    def chunks(t, d):
        return t.astype(f32).reshape(B, nc, CHUNK, GLA_HEADS, d).transpose(1, 0, 3, 2, 4)

    causal = jnp.tril(jnp.ones((CHUNK, CHUNK), dtype=bool))[:, :, None]

    def step(state, inp):
        qb, kb, vb, la = inp
        b = jnp.cumsum(la, axis=2)
        b_end = b[:, :, -1:, :]
        o_inter = jnp.einsum('bhtd,bhde->bhte', qb * jnp.exp(b), state)
        decay = jnp.exp(jnp.where(causal, b[:, :, :, None, :] - b[:, :, None, :, :], -jnp.inf))
        scores = jnp.einsum('bhtd,bhtsd,bhsd->bhts', qb, decay, kb)
        o = o_inter + jnp.einsum('bhts,bhse->bhte', scores, vb)
        state = (jnp.exp(b_end[:, :, 0, :, None]) * state
                 + jnp.einsum('bhsd,bhse->bhde', kb * jnp.exp(b_end - b), vb))
        return state, o

    state0 = jnp.zeros((B, GLA_HEADS, GLA_DK, GLA_DV), f32)
    _, o = lax.scan(step, state0, (chunks(q, GLA_DK) * GLA_DK ** -0.5, chunks(k, GLA_DK),
                                   chunks(v, GLA_DV), chunks(log_a, GLA_DK)))
    o = o.transpose(1, 0, 3, 2, 4).reshape(B, S, GLA_HEADS, GLA_DV)
    o = head_norm(o, norm_g).reshape(B, S, GLA_VW) * jax.nn.silu(r.astype(f32))
    return o.astype(q.dtype)


def mlstm_mixer(q, k, v, o_pre, i_pre, f_pre, norm_g):
    B, S, _ = q.shape
    nc = S // CHUNK
    f32 = jnp.float32

    def chunks(t, d):
        return t.astype(f32).reshape(B, nc, CHUNK, MLSTM_HEADS, d).transpose(1, 0, 3, 2, 4)

    def gate_chunks(t):
        return t.reshape(B, nc, CHUNK, MLSTM_HEADS).transpose(1, 0, 3, 2)

    log_i = i_pre.astype(f32)
    log_f = jax.nn.log_sigmoid(f_pre.astype(f32))
    causal = jnp.tril(jnp.ones((CHUNK, CHUNK), dtype=bool))

    def step(carry, inp):
        c_st, n_st, m_st = carry
        qb, kb, vb, ig, lf = inp
        fcum = jnp.cumsum(lf, axis=-1)
        d_log = jnp.where(causal, fcum[..., :, None] - fcum[..., None, :] + ig[..., None, :], -jnp.inf)
        inter_log = fcum + m_st[..., None]
        m_t = jnp.maximum(inter_log, jnp.max(d_log, -1))
        w_intra = jnp.exp(d_log - m_t[..., None]) * jnp.einsum('bhtd,bhsd->bhts', qb, kb)
        w_inter = jnp.exp(inter_log - m_t)
        num = (w_inter[..., None] * jnp.einsum('bhtd,bhde->bhte', qb, c_st)
               + jnp.einsum('bhts,bhse->bhte', w_intra, vb))
        den = w_inter * jnp.einsum('bhtd,bhd->bht', qb, n_st) + jnp.sum(w_intra, -1)
        h = num / jnp.maximum(jnp.abs(den), jnp.exp(-m_t))[..., None]
        end_log = fcum[..., -1:] - fcum + ig
        m_new = jnp.maximum(fcum[..., -1] + m_st, jnp.max(end_log, -1))
        w_s = jnp.exp(end_log - m_new[..., None])
        decay = jnp.exp(fcum[..., -1] + m_st - m_new)
        c_st = decay[..., None, None] * c_st + jnp.einsum('bhs,bhsd,bhse->bhde', w_s, kb, vb)
        n_st = decay[..., None] * n_st + jnp.einsum('bhs,bhsd->bhd', w_s, kb)
        return (c_st, n_st, m_new), h

    carry0 = (jnp.zeros((B, MLSTM_HEADS, MLSTM_DK, MLSTM_DV), f32),
              jnp.zeros((B, MLSTM_HEADS, MLSTM_DK), f32),
              jnp.zeros((B, MLSTM_HEADS), f32))
    _, h = lax.scan(step, carry0, (chunks(q, MLSTM_DK) * MLSTM_DK ** -0.5, chunks(k, MLSTM_DK),
                                   chunks(v, MLSTM_DV), gate_chunks(log_i), gate_chunks(log_f)))
    h = h.transpose(1, 0, 3, 2, 4).reshape(B, S, MLSTM_HEADS, MLSTM_DV)
    h = head_norm(h, norm_g).reshape(B, S, ML_VW) * jax.nn.sigmoid(o_pre.astype(f32))
    return h.astype(q.dtype)


def mla_mixer(c_q, c_kv, k_r, pos, q_norm_g, w_uq, kv_norm_g, w_ukv):
    B, S, _ = c_q.shape
    q = (rms_norm(c_q, q_norm_g) @ w_uq).reshape(B, S, MLA_HEADS, MLA_NOPE + MLA_ROPE)
    q_nope = q[..., :MLA_NOPE]
    q_rope = rope(q[..., MLA_NOPE:], pos)
    kv = (rms_norm(c_kv, kv_norm_g) @ w_ukv).reshape(B, S, MLA_HEADS, MLA_NOPE + MLA_V)
    k_nope, v = kv[..., :MLA_NOPE], kv[..., MLA_NOPE:]
    k_rope = rope(k_r[:, :, None, :], pos)[:, :, 0, :]
    scale = (MLA_NOPE + MLA_ROPE) ** -0.5
    nb = S // Q_BLOCK
    qn_b = q_nope.reshape(B, nb, Q_BLOCK, MLA_HEADS, MLA_NOPE).swapaxes(0, 1)
    qr_b = q_rope.reshape(B, nb, Q_BLOCK, MLA_HEADS, MLA_ROPE).swapaxes(0, 1)
    key_chunk = jnp.arange(S) // CHUNK

    def attend(args):
        qn, qr, blk = args
        s = (jnp.einsum('bqhd,bkhd->bhqk', qn, k_nope)
             + jnp.einsum('bqhr,bkr->bhqk', qr, k_rope)).astype(jnp.float32) * scale
        q_chunk = (blk * Q_BLOCK + jnp.arange(Q_BLOCK)) // CHUNK
        mask = key_chunk[None, :] <= q_chunk[:, None]
        p = jax.nn.softmax(jnp.where(mask, s, -jnp.inf), axis=-1).astype(v.dtype)
        return jnp.einsum('bhqk,bkhd->bqhd', p, v)

    o = lax.map(attend, (qn_b, qr_b, jnp.arange(nb)))
    return o.swapaxes(0, 1).reshape(B, S, MLA_OUT)


def memory_cross_attention(x, mem, w_q, w_kv, w_o):
    B, S, D = x.shape
    q = (x @ w_q).reshape(B, S, XA_HEADS, XA_DH)
    kv = (mem @ w_kv).reshape(B, mem.shape[1], 2, XA_HEADS, XA_DH)
    k, v = kv[:, :, 0], kv[:, :, 1]
    s = jnp.einsum('bqhd,bkhd->bhqk', q, k).astype(jnp.float32) * XA_DH ** -0.5
    p = jax.nn.softmax(s, axis=-1).astype(x.dtype)
    o = jnp.einsum('bhqk,bkhd->bqhd', p, v).reshape(B, S, D)
    return o @ w_o


def hierarchical_moe(x, w_group, b_group, w_router, b_router, w_gate, w_up, w_down):
    B, S, D = x.shape
    t = x.reshape(-1, D)
    n_tok = t.shape[0]
    g_prob = jax.nn.softmax((t @ w_group + b_group).astype(jnp.float32), axis=-1)
    g_p, g_idx = lax.top_k(g_prob, 1)
    e_logits = (t @ w_router + b_router).astype(jnp.float32).reshape(n_tok, N_GROUPS, EXPERTS_PER_GROUP)
    e_sel = e_logits[jnp.arange(n_tok), g_idx[:, 0]]
    e_p, e_idx = lax.top_k(jax.nn.softmax(e_sel, axis=-1), EXPERT_TOP_K)
    weights = g_p * (e_p / jnp.sum(e_p, -1, keepdims=True))
    expert_id = g_idx * EXPERTS_PER_GROUP + e_idx
    gate = jnp.sum(jax.nn.one_hot(expert_id, N_EXPERTS, dtype=jnp.float32) * weights[..., None], axis=1)
    gate = gate.astype(t.dtype)
    out = jnp.zeros_like(t)
    for e in range(N_EXPERTS):
        h = jax.nn.silu(t @ w_gate[e]) * (t @ w_up[e])
        out = out + (h @ w_down[e]) * gate[:, e:e + 1]
    return out.reshape(B, S, D)


def hybrid_layer(x, mem, positions, w_in, w_out, gla_w_a2, gla_b_a, gla_norm_g, ml_conv_w, ml_b_i, ml_b_f,
                 ml_norm_g, mla_q_norm_g, mla_w_uq, mla_kv_norm_g, mla_w_ukv, xa_w_q, xa_w_kv, xa_w_o,
                 moe_w_group, moe_b_group, moe_w_router, moe_b_router, moe_w_gate, moe_w_up, moe_w_down,
                 ln1_g, ln1_b, ln2_g, ln2_b, ln3_g, ln3_b):
    y = x @ w_in
    split_at = np.cumsum(IN_SIZES)[:-1].tolist()
    (g_q, g_k, g_v, g_r, g_a, m_qk, m_v, m_o, m_i, m_f, c_q, c_kv, k_r) = jnp.split(y, split_at, axis=-1)
    o_gla = gla_mixer(g_q, g_k, g_v, g_r, g_a, gla_w_a2, gla_b_a, gla_norm_g)
    m_qk = jax.nn.silu(causal_depthwise_conv(m_qk, ml_conv_w))
    o_ml = mlstm_mixer(m_qk[..., :ML_QK], m_qk[..., ML_QK:], m_v, m_o, m_i + ml_b_i, m_f + ml_b_f, ml_norm_g)
    o_mla = mla_mixer(c_q, c_kv, k_r, positions, mla_q_norm_g, mla_w_uq, mla_kv_norm_g, mla_w_ukv)
    mix = jnp.concatenate([o_gla, o_ml, o_mla], axis=-1) @ w_out
    x = layer_norm(ALPHA * x + mix, ln1_g, ln1_b)
    x = layer_norm(ALPHA * x + memory_cross_attention(x, mem, xa_w_q, xa_w_kv, xa_w_o), ln2_g, ln2_b)
    moe = hierarchical_moe(x, moe_w_group, moe_b_group, moe_w_router, moe_b_router, moe_w_gate, moe_w_up, moe_w_down)
    return layer_norm(ALPHA * x + moe, ln3_g, ln3_b)


def setup_inputs(seed: int = 0) -> dict:
    key = jax.random.key(seed)
    ks = iter(jax.random.split(key, 40))
    f32 = jnp.float32

    def nrm(shape, scale):
        return jax.random.normal(next(ks), shape, f32) * scale

    def gain(shape):
        return 1.0 + 0.02 * jax.random.normal(next(ks), shape, f32)

    L = DEPTH
    x = jax.random.normal(next(ks), (BATCH, SEQ, D_MODEL), f32)
    mem = jax.random.normal(next(ks), (BATCH, MEM_LEN, D_MODEL), f32)
    offset = jax.random.randint(next(ks), (BATCH, 1), 0, 64, dtype=jnp.int32) * CHUNK
    positions = (offset + jnp.arange(SEQ, dtype=jnp.int32)[None, :]).astype(jnp.int32)
    f_bias = jnp.linspace(3.0, 6.0, MLSTM_HEADS, dtype=f32)[None, :] + 0.1 * jax.random.normal(next(ks), (L, MLSTM_HEADS), f32)
    return {
        "x": x,
        "mem": mem,
        "positions": positions,
        "w_in": nrm((L, D_MODEL, IN_WIDTH), D_MODEL ** -0.5),
        "w_out": nrm((L, MIX_WIDTH, D_MODEL), MIX_WIDTH ** -0.5 * BETA),
        "gla_w_a2": nrm((L, GLA_GATE_RANK, GLA_QK), GLA_GATE_RANK ** -0.5),
        "gla_b_a": nrm((L, GLA_QK), 0.1),
        "gla_norm_g": gain((L, GLA_VW)),
        "ml_conv_w": nrm((L, MLSTM_CONV, 2 * ML_QK), MLSTM_CONV ** -0.5),
        "ml_b_i": nrm((L, MLSTM_HEADS), 0.1),
        "ml_b_f": f_bias,
        "ml_norm_g": gain((L, ML_VW)),
        "mla_q_norm_g": gain((L, MLA_Q_RANK)),
        "mla_w_uq": nrm((L, MLA_Q_RANK, MLA_HEADS * (MLA_NOPE + MLA_ROPE)), MLA_Q_RANK ** -0.5),
        "mla_kv_norm_g": gain((L, MLA_KV_RANK)),
        "mla_w_ukv": nrm((L, MLA_KV_RANK, MLA_HEADS * (MLA_NOPE + MLA_V)), MLA_KV_RANK ** -0.5),
        "xa_w_q": nrm((L, D_MODEL, D_MODEL), D_MODEL ** -0.5),
        "xa_w_kv": nrm((L, D_MODEL, 2 * D_MODEL), D_MODEL ** -0.5),
        "xa_w_o": nrm((L, D_MODEL, D_MODEL), D_MODEL ** -0.5 * BETA),
        "moe_w_group": nrm((L, D_MODEL, N_GROUPS), D_MODEL ** -0.5),
        "moe_b_group": nrm((L, N_GROUPS), 0.01),
        "moe_w_router": nrm((L, D_MODEL, N_EXPERTS), D_MODEL ** -0.5),
        "moe_b_router": nrm((L, N_EXPERTS), 0.01),
        "moe_w_gate": nrm((L, N_EXPERTS, D_MODEL, D_EXPERT), D_MODEL ** -0.5),
        "moe_w_up": nrm((L, N_EXPERTS, D_MODEL, D_EXPERT), D_MODEL ** -0.5),
        "moe_w_down": nrm((L, N_EXPERTS, D_EXPERT, D_MODEL), D_EXPERT ** -0.5 * BETA),
        "ln1_g": gain((L, D_MODEL)),
        "ln1_b": nrm((L, D_MODEL), 0.01),
        "ln2_g": gain((L, D_MODEL)),
        "ln2_b": nrm((L, D_MODEL), 0.01),
        "ln3_g": gain((L, D_MODEL)),
        "ln3_b": nrm((L, D_MODEL), 0.01),
    }


def reference(x, mem, positions, w_in, w_out, gla_w_a2, gla_b_a, gla_norm_g, ml_conv_w, ml_b_i, ml_b_f,
              ml_norm_g, mla_q_norm_g, mla_w_uq, mla_kv_norm_g, mla_w_ukv, xa_w_q, xa_w_kv, xa_w_o,
              moe_w_group, moe_b_group, moe_w_router, moe_b_router, moe_w_gate, moe_w_up, moe_w_down,
              ln1_g, ln1_b, ln2_g, ln2_b, ln3_g, ln3_b):
    for l in range(DEPTH):
        x = hybrid_layer(x, mem, positions, w_in[l], w_out[l], gla_w_a2[l], gla_b_a[l], gla_norm_g[l],
                         ml_conv_w[l], ml_b_i[l], ml_b_f[l], ml_norm_g[l], mla_q_norm_g[l], mla_w_uq[l],
                         mla_kv_norm_g[l], mla_w_ukv[l], xa_w_q[l], xa_w_kv[l], xa_w_o[l],
                         moe_w_group[l], moe_b_group[l], moe_w_router[l], moe_b_router[l],
                         moe_w_gate[l], moe_w_up[l], moe_w_down[l],
                         ln1_g[l], ln1_b[l], ln2_g[l], ln2_b[l], ln3_g[l], ln3_b[l])
    return x
```

```cpp
#include <hip/hip_runtime.h>
#include <stdint.h>
#include <stdio.h>

#ifndef N_LAUNCH_MODE
#define N_LAUNCH_MODE 1
#endif

typedef unsigned short bf16;
typedef float f32x4 __attribute__((ext_vector_type(4)));
typedef unsigned u32x4 __attribute__((ext_vector_type(4)));
typedef unsigned u32x2 __attribute__((ext_vector_type(2)));
#define LAS __attribute__((address_space(3)))

constexpr int NTOK = 16384, DM = 1024, SEQ = 2048, NBATCH = 8, YW = 2560, NCH = 32;
constexpr int Y_GQ = 0, Y_GK = 256, Y_GV = 512, Y_GR = 768, Y_MQ = 1024, Y_MK = 1280, Y_MV = 1536, Y_MO = 1792, Y_CQ = 2048, Y_T9 = 2304,
              Y_A = 2304, Y_MI = 2320, Y_MF = 2324, Y_CKV = 2328, Y_KR = 2456;
constexpr float ALPHA = 1.41421356237309515f;
constexpr float LN_EPS = 1e-5f;
constexpr float LOG2E = 1.44269504088896341f;
constexpr float QSCALE = 0.10206207261596575f * LOG2E;
constexpr float XSCALE = 0.0625f * LOG2E;
constexpr int NPH = 14;
enum { PH_CONV = 0, PH_G1, PH_LOC, PH_SCAN, PH_MIX, PH_G4, PH_LN1, PH_G5, PH_XATT, PH_G7, PH_LN2, PH_MOE1, PH_MOE2, PH_LN3 };

constexpr size_t MiB = 1u << 20;
constexpr size_t WS_CTL = 0, CTL_BYTES = 1 * MiB;
constexpr size_t W_IN = 1 * MiB;
constexpr size_t W_Q = W_IN + (size_t)2560 * 1024 * 2;
constexpr size_t W_KV = W_Q + (size_t)768 * 256 * 2;
constexpr size_t W_OUT = W_KV + (size_t)1280 * 256 * 2;
constexpr size_t W_XQ = W_OUT + 2 * MiB;
constexpr size_t W_XKV = W_XQ + 2 * MiB;
constexpr size_t W_XO = W_XKV + 4 * MiB;
constexpr size_t W_GU = W_XO + 2 * MiB;
constexpr size_t W_DN = W_GU + 32 * MiB;
constexpr size_t W_END = W_DN + 16 * MiB;
constexpr size_t WS_XB = W_END;
constexpr size_t WS_MEMB = WS_XB + 32 * MiB;
constexpr size_t WS_KVX = WS_MEMB + 4 * MiB;
constexpr size_t WS_ROPE = WS_KVX + 8 * MiB;
constexpr size_t WS_RS = WS_ROPE + 2 * MiB;
constexpr size_t WS_LISTT = WS_RS + 128 * 1024;
constexpr size_t WS_LISTW = WS_LISTT + 2 * MiB;
constexpr size_t WS_NV = WS_LISTW + 2 * MiB;
constexpr size_t WS_DEC = WS_NV + 256 * 1024;
constexpr size_t WS_SC = WS_DEC + 256 * 1024;
constexpr size_t WS_MS = WS_SC + 8 * 1024;
constexpr size_t WS_Y = WS_MS + 8 * 1024;
constexpr size_t WS_QX = WS_Y, WS_OX = WS_Y + 32 * MiB, WS_H = WS_Y;
constexpr size_t WS_QP = WS_Y + 80 * MiB;
constexpr size_t WS_KP = WS_QP + 24 * MiB;
constexpr size_t WS_VP = WS_KP + 24 * MiB;
constexpr size_t WS_ST = WS_VP + 16 * MiB;
constexpr size_t WS_CT = WS_QP;
constexpr size_t WS_TOTAL = WS_ST + 32 * MiB;
static_assert(WS_TOTAL <= (size_t)342000000, "workspace budget");
constexpr int CW_BAR = 4096;
constexpr int CW_CNT = 16384;

constexpr int LDS_BYTES = 147456;
constexpr int LDS_BARW = LDS_BYTES - 16;

struct Params {
    const float* in[32];
    float* out;
    unsigned char* ws;
    int ph_lo, ph_hi;
};

__device__ __forceinline__ float bf2f(unsigned v) { return __uint_as_float(v << 16); }
__device__ __forceinline__ unsigned f2bf(float f) { unsigned u = __float_as_uint(f); return (u + 0x7fffu + ((u >> 16) & 1u)) >> 16; }
__device__ __forceinline__ unsigned pk2(float lo, float hi) { return f2bf(lo) | (f2bf(hi) << 16); }
__device__ __forceinline__ float blo(unsigned w) { return __uint_as_float(w << 16); }
__device__ __forceinline__ float bhi(unsigned w) { return __uint_as_float(w & 0xffff0000u); }
__device__ __forceinline__ float wave_sum(float v) {
#pragma unroll
    for (int o = 1; o < 64; o <<= 1) v += __shfl_xor(v, o);
    return v;
}
__device__ __forceinline__ float logsigmoid(float z) { return fminf(z, 0.f) - log1pf(expf(-fabsf(z))); }
__device__ __forceinline__ float sigmoidf(float x) { return 1.f / (1.f + expf(-x)); }
__device__ __forceinline__ float siluf(float x) { return x / (1.f + expf(-x)); }
__device__ __forceinline__ void st_bf4(bf16* p, f32x4 v) { u32x2 w; w.x = pk2(v[0], v[1]); w.y = pk2(v[2], v[3]); *(u32x2*)p = w; }

#define XB_TMO      128
#define XB_XCNT(j)  (256  + 64 * (j))
#define XB_XSUB(j)  (1280 + 64 * (j))
#define XB_XGEN(j)  (2304 + 64 * (j))
#define XB_TOP      3328
#define XB_TOPGEN   3392
#define XCD_BAR_WORDS 3456
#define XB_SPIN_CAP (1u << 24)
__device__ __forceinline__ unsigned xb_ld(unsigned* p)              { return __hip_atomic_load(p, __ATOMIC_RELAXED, __HIP_MEMORY_SCOPE_AGENT); }
__device__ __forceinline__ unsigned xb_add(unsigned* p, unsigned v) { return __hip_atomic_fetch_add(p, v, __ATOMIC_RELAXED, __HIP_MEMORY_SCOPE_AGENT); }
__device__ __forceinline__ unsigned xb_xcc_id() { return (unsigned)__builtin_amdgcn_s_getreg((3 << 11) | 20) & 0xFu; }
#define XB_SPIN(cond, bar) do { unsigned _sp = 0; while (cond) { __builtin_amdgcn_s_sleep(1); \
    if ((++_sp & 255u) == 0u) { if (xb_ld(&(bar)[XB_TMO])) break; if (_sp > XB_SPIN_CAP) { atomicAdd(&(bar)[XB_TMO], 1u); break; } } } } while (0)
struct XcdBarrier { unsigned* bar; unsigned x; volatile LAS unsigned* st; };
__device__ __forceinline__ XcdBarrier xcd_barrier_post(unsigned* bar, volatile LAS unsigned* st) {
    XcdBarrier b; b.bar = bar; b.x = xb_xcc_id(); b.st = st;
    if (threadIdx.x == 0) (void)xb_add(&bar[XB_XCNT(b.x)], 1u);
    return b;
}
__device__ __forceinline__ void xcd_barrier_complete(unsigned* bar, unsigned x, unsigned& nloc, unsigned& nx) {
    const unsigned G = gridDim.x * gridDim.y * gridDim.z;
    unsigned sum, cnt, mine, sp = 0u;
    for (;;) {
        sum = 0u; cnt = 0u; mine = 0u;
#pragma unroll
        for (unsigned j = 0; j < 16; ++j) { const unsigned c = xb_ld(&bar[XB_XCNT(j)]); sum += c; cnt += (c > 0u) ? 1u : 0u; mine = (j == x) ? c : mine; }
        if (sum == G) break;
        __builtin_amdgcn_s_sleep(1);
        if ((++sp & 255u) == 0u) { if (xb_ld(&bar[XB_TMO])) break; if (sp > XB_SPIN_CAP) { atomicAdd(&bar[XB_TMO], 1u); break; } }
    }
    nloc = mine > 0u ? mine : 1u; nx = cnt > 0u ? cnt : 1u;
}
__device__ __forceinline__ void xcd_barrier(const XcdBarrier& b) {
    asm volatile("s_waitcnt vmcnt(0)" ::: "memory");
    __syncthreads();
    if (threadIdx.x == 0) {
        unsigned* bar = b.bar;
        __builtin_amdgcn_s_waitcnt(0);
        unsigned nloc = b.st[0], nx = b.st[1];
        if (nloc == 0u) { xcd_barrier_complete(bar, b.x, nloc, nx); b.st[0] = nloc; b.st[1] = nx; }
        const unsigned old = xb_add(&bar[XB_XSUB(b.x)], 1u);
        const unsigned gen = old / nloc;
        if (old + 1u == (gen + 1u) * nloc) {
            __builtin_amdgcn_fence(__ATOMIC_RELEASE, "agent");
            asm volatile("s_waitcnt vmcnt(0)" ::: "memory");
            const unsigned og = xb_add(&bar[XB_TOP], 1u);
            const unsigned tg = og / nx;
            if (og + 1u == (tg + 1u) * nx) xb_add(&bar[XB_TOPGEN], 1u);
            else XB_SPIN(xb_ld(&bar[XB_TOPGEN]) == tg, bar);
            __builtin_amdgcn_fence(__ATOMIC_ACQUIRE, "agent");
            xb_add(&bar[XB_XGEN(b.x)], 1u);
            asm volatile("s_waitcnt vmcnt(0)" ::: "memory");
        } else {
            XB_SPIN(xb_ld(&bar[XB_XGEN(b.x)]) == gen, bar);
            __builtin_amdgcn_fence(__ATOMIC_ACQUIRE, "agent");
            asm volatile("s_waitcnt vmcnt(0)" ::: "memory");
        }
    }
    __syncthreads();
}

struct UnitDesc {
    const bf16* A;
    const bf16* B;
    const int* ridx;
    const float* rw;
    int row0, col0;
    int nvalid;
    int gather;
};

template <class Epi>
__device__ __forceinline__ void gemm_unit_naive(unsigned char* smem, const UnitDesc& u, int K, int lda, int ldb, const Epi& E) {
    float* As = (float*)smem;
    float* Bs = As + 16 * 128;
    const int tid = threadIdx.x, ty = tid >> 4, tx = tid & 15;
    const int lr = tid >> 1, lk = (tid & 1) * 8;
    const bf16* brow = u.B + (size_t)lr * ldb;
    const int cb = (tx >> 2) * 32 + (tx & 3) * 4;
#pragma unroll 1
    for (int half = 0; half < 2; ++half) {
        float acc[4][16];
#pragma unroll
        for (int i = 0; i < 4; ++i)
#pragma unroll
            for (int j = 0; j < 16; ++j) acc[i][j] = 0.f;
        const int ar = half * 128 + (lr & 127);
        const bf16* arow;
        if (u.gather) { const int rr = ar < u.nvalid ? ar : 0; arow = u.A + (size_t)(u.ridx[rr] >> 1) * lda; }
        else arow = u.A + (size_t)ar * lda;
#pragma unroll 1
        for (int k0 = 0; k0 < K; k0 += 16) {
            const u32x4 bv = *(const u32x4*)(brow + k0 + lk);
            u32x4 av = {0u, 0u, 0u, 0u};
            if (tid < 256) av = *(const u32x4*)(arow + k0 + lk);
            __syncthreads();
#pragma unroll
            for (int j = 0; j < 4; ++j) {
                if (tid < 256) { As[(lk + 2 * j) * 128 + lr] = blo(av[j]); As[(lk + 2 * j + 1) * 128 + lr] = bhi(av[j]); }
                Bs[(lk + 2 * j) * 256 + lr] = blo(bv[j]); Bs[(lk + 2 * j + 1) * 256 + lr] = bhi(bv[j]);
            }
            __syncthreads();
#pragma unroll 4
            for (int kk = 0; kk < 16; ++kk) {
                float b[16];
                const f32x4 a0 = *(const f32x4*)(As + kk * 128 + ty * 4);
#pragma unroll
                for (int g = 0; g < 2; ++g)
#pragma unroll
                    for (int h2 = 0; h2 < 2; ++h2) {
                        const f32x4 bq = *(const f32x4*)(Bs + kk * 256 + g * 128 + cb + h2 * 16);
                        b[g * 8 + h2 * 4 + 0] = bq[0]; b[g * 8 + h2 * 4 + 1] = bq[1]; b[g * 8 + h2 * 4 + 2] = bq[2]; b[g * 8 + h2 * 4 + 3] = bq[3];
                    }
#pragma unroll
                for (int i = 0; i < 4; ++i)
#pragma unroll
                    for (int j = 0; j < 16; ++j) acc[i][j] = fmaf(a0[i], b[j], acc[i][j]);
            }
        }
#pragma unroll
        for (int i = 0; i < 4; ++i) {
            const int r = half * 128 + ty * 4 + i;
            if (r < u.nvalid) {
#pragma unroll
                for (int g = 0; g < 2; ++g) {
                    const f32x4 v0 = {acc[i][g * 8 + 0], acc[i][g * 8 + 1], acc[i][g * 8 + 2], acc[i][g * 8 + 3]};
                    const f32x4 v1 = {acc[i][g * 8 + 4], acc[i][g * 8 + 5], acc[i][g * 8 + 6], acc[i][g * 8 + 7]};
                    E(u, r, g * 128 + cb, v0, v1);
                }
            }
        }
        __syncthreads();
    }
}

struct EpiBf16Store { bf16* O; int ldo; float scale;
    __device__ __forceinline__ void operator()(const UnitDesc& u, int r, int c, f32x4 v0, f32x4 v1) const {
        bf16* o = O + (size_t)(u.row0 + r) * ldo + u.col0 + c; st_bf4(o, v0 * scale); st_bf4(o + 16, v1 * scale); } };
struct EpiResid { const float* res; float* out;
    __device__ __forceinline__ void operator()(const UnitDesc& u, int r, int c, f32x4 v0, f32x4 v1) const {
        const size_t o = (size_t)(u.row0 + r) * DM + u.col0 + c;
        const f32x4 r0 = *(const f32x4*)(res + o), r1 = *(const f32x4*)(res + o + 16);
        *(f32x4*)(out + o) = r0 * ALPHA + v0; *(f32x4*)(out + o + 16) = r1 * ALPHA + v1; } };
struct EpiG23 { bf16 *QP, *KP, *VP; const float* RS; const float* ROPE;
    __device__ __forceinline__ void grp(int row, int c, f32x4 v) const {
        const int b = row >> 11, s = row & 2047;
        if (c < 768) {
            const int h = c / 96, j = c - h * 96; const float rs = RS[row * 2] * QSCALE;
            v = v * rs;
            if (j >= 64) { const int i = (j - 64) >> 1; const f32x4 cs = *(const f32x4*)(ROPE + ((size_t)row * 16 + i) * 2);
                v = (f32x4){v[0] * cs[0] - v[1] * cs[1], v[1] * cs[0] + v[0] * cs[1], v[2] * cs[2] - v[3] * cs[3], v[3] * cs[2] + v[2] * cs[3]}; }
            st_bf4(QP + ((size_t)((b * 8 + h) * SEQ + s)) * 96 + j, v);
        } else {
            const int cc = c - 768, h = cc / 160, j = cc - h * 160; const float rs = RS[row * 2 + 1];
            if (j < 64) st_bf4(KP + ((size_t)((b * 8 + h) * SEQ + s)) * 96 + j, v * rs);
            else if (j < 96) { const int i = (j - 64) >> 1; const f32x4 cs = *(const f32x4*)(ROPE + ((size_t)row * 16 + i) * 2);
                v = (f32x4){v[0] * cs[0] - v[1] * cs[1], v[1] * cs[0] + v[0] * cs[1], v[2] * cs[2] - v[3] * cs[3], v[3] * cs[2] + v[2] * cs[3]};
                st_bf4(KP + ((size_t)((b * 8 + h) * SEQ + s)) * 96 + j, v); }
            else st_bf4(VP + ((size_t)((b * 8 + h) * SEQ + s)) * 64 + (j - 96), v * rs);
        }
    }
    __device__ __forceinline__ void operator()(const UnitDesc& u, int r, int c, f32x4 v0, f32x4 v1) const {
        grp(u.row0 + r, u.col0 + c, v0); grp(u.row0 + r, u.col0 + c + 16, v1); } };
struct EpiMoe1 { bf16* H;
    __device__ __forceinline__ void operator()(const UnitDesc& u, int r, int c, f32x4 v0, f32x4 v1) const {
        f32x4 h;
#pragma unroll
        for (int j = 0; j < 4; ++j) h[j] = siluf(v0[j]) * v1[j];
        st_bf4(H + (size_t)(u.row0 + r) * 256 + u.col0 + (c >> 5) * 16 + (c & 15), h); } };
struct EpiMoe2 { bf16* CT;
    __device__ __forceinline__ void operator()(const UnitDesc& u, int r, int c, f32x4 v0, f32x4 v1) const {
        const int ent = u.ridx[r]; const float w = u.rw[r];
        bf16* o = CT + ((size_t)(ent & 1) * NTOK + (ent >> 1)) * DM + u.col0 + c; st_bf4(o, v0 * w); st_bf4(o + 16, v1 * w); } };

template <class F>
__device__ __forceinline__ void conv_item(const F& src, bf16* dst, int K, float* scr, int k0, int n0, int lane) {
#pragma unroll 8
    for (int i = 0; i < 32; ++i) { const int kk = 2 * i + (lane >> 5); scr[kk * 33 + (lane & 31)] = src(k0 + kk, n0 + (lane & 31)); }
    asm volatile("s_waitcnt lgkmcnt(0)" ::: "memory");
    const int c = lane & 7;
#pragma unroll
    for (int j = 0; j < 4; ++j) { const int n = (lane >> 3) + 8 * j; const float* s = scr + (8 * c) * 33 + n;
        u32x4 o; o.x = pk2(s[0 * 33], s[1 * 33]); o.y = pk2(s[2 * 33], s[3 * 33]); o.z = pk2(s[4 * 33], s[5 * 33]); o.w = pk2(s[6 * 33], s[7 * 33]);
        *(u32x4*)(dst + (size_t)(n0 + n) * K + k0 + 8 * c) = o; }
    asm volatile("s_waitcnt lgkmcnt(0)" ::: "memory");
}
__device__ __forceinline__ int yc_src(int n) {
    if (n < 1024) return n;
    if (n < 2048) return n + 16;
    if (n < 2304) return n + 24;
    if (n < 2320) return 1024 + (n - 2304);
    if (n < 2328) return 2064 + (n - 2320);
    if (n < 2488) return n;
    return -1;
}

__device__ __forceinline__ void phase_conv(const Params& p, int l, unsigned char* smem) {
    const int tid = threadIdx.x, lane = tid & 63, wave = tid >> 6;
    const int gw = blockIdx.x * 8 + wave, NGW = gridDim.x * 8;
    float* scr = (float*)smem + wave * (64 * 33 + 16);
    unsigned char* ws = p.ws;
    const float* w_in = p.in[3] + (size_t)l * 1024 * 2488;
    const float* w_out = p.in[4] + (size_t)l * 1024 * 1024;
    const float* gq = p.in[12] + l * 256; const float* w_uq = p.in[13] + (size_t)l * 256 * 768;
    const float* gkv = p.in[14] + l * 128; const float* w_ukv = p.in[15] + (size_t)l * 128 * 1024;
    const float* xwq = p.in[16] + (size_t)l * 1024 * 1024; const float* xwkv = p.in[17] + (size_t)l * 1024 * 2048; const float* xwo = p.in[18] + (size_t)l * 1024 * 1024;
    const float* wg = p.in[23] + (size_t)l * 32 * 1024 * 256; const float* wu = p.in[24] + (size_t)l * 32 * 1024 * 256; const float* wd = p.in[25] + (size_t)l * 32 * 256 * 1024;
    constexpr int I_IN = 16 * 80, I_Q = 4 * 24, I_KV = 4 * 40, I_SQ = 16 * 32, I_XKV = 16 * 64, I_GU = 32 * 16 * 16, I_DN = 32 * 4 * 32;
    constexpr int NIT = I_IN + I_Q + I_KV + 3 * I_SQ + I_XKV + I_GU + I_DN;
    for (int it = gw; it < NIT; it += NGW) {
        int r = it;
        if (r < I_IN) { const int kb = r / 80, nb = r % 80;
            conv_item([&](int k, int n) { const int s = yc_src(n); return s >= 0 ? w_in[(size_t)k * 2488 + s] : 0.f; }, (bf16*)(ws + W_IN), 1024, scr, kb * 64, nb * 32, lane); continue; }
        r -= I_IN;
        if (r < I_Q) { const int kb = r / 24, nb = r % 24;
            conv_item([&](int k, int n) { const int h = n / 96, j = n - h * 96; int sc = h * 96 + j; if (j >= 64) { const int jj = j - 64; sc = h * 96 + 64 + (jj >> 1) + 16 * (jj & 1); }
                return gq[k] * w_uq[(size_t)k * 768 + sc]; }, (bf16*)(ws + W_Q), 256, scr, kb * 64, nb * 32, lane); continue; }
        r -= I_Q;
        if (r < I_KV) { const int kb = r / 40, nb = r % 40;
            conv_item([&](int k, int n) { const int h = n / 160, j = n - h * 160;
                if (j >= 64 && j < 96) { const int jj = j - 64; return (k == 152 + (jj >> 1) + 16 * (jj & 1)) ? 1.f : 0.f; }
                const int col = (j < 64) ? h * 128 + j : h * 128 + 64 + (j - 96);
                return (k >= 24 && k < 152) ? gkv[k - 24] * w_ukv[(size_t)(k - 24) * 1024 + col] : 0.f; }, (bf16*)(ws + W_KV), 256, scr, kb * 64, nb * 32, lane); continue; }
        r -= I_KV;
        if (r < 3 * I_SQ) { const int m = r / I_SQ, q = r % I_SQ, kb = q / 32, nb = q % 32; const float* W = m == 0 ? w_out : (m == 1 ? xwq : xwo);
            bf16* D = (bf16*)(ws + (m == 0 ? W_OUT : (m == 1 ? W_XQ : W_XO)));
            conv_item([&](int k, int n) { return W[(size_t)k * 1024 + n]; }, D, 1024, scr, kb * 64, nb * 32, lane); continue; }
        r -= 3 * I_SQ;
        if (r < I_XKV) { const int kb = r / 64, nb = r % 64;
            conv_item([&](int k, int n) { return xwkv[(size_t)k * 2048 + n]; }, (bf16*)(ws + W_XKV), 1024, scr, kb * 64, nb * 32, lane); continue; }
        r -= I_XKV;
        if (r < I_GU) { const int e = r / 256, q = r % 256, kb = q / 16, nb = q % 16; const float* G = wg + (size_t)e * 1024 * 256; const float* U = wu + (size_t)e * 1024 * 256;
            conv_item([&](int k, int n) { const int j = (n >> 5) * 16 + (n & 15); return ((n >> 4) & 1) ? U[(size_t)k * 256 + j] : G[(size_t)k * 256 + j]; },
                      (bf16*)(ws + W_GU) + (size_t)e * 512 * 1024, 1024, scr, kb * 64, nb * 32, lane); continue; }
        r -= I_GU;
        { const int e = r / 128, q = r % 128, kb = q / 32, nb = q % 32; const float* Dn = wd + (size_t)e * 256 * 1024;
            conv_item([&](int k, int n) { return Dn[(size_t)k * 1024 + n]; }, (bf16*)(ws + W_DN) + (size_t)e * 1024 * 256, 256, scr, kb * 64, nb * 32, lane); }
    }
    if (l == 0) {
        const size_t gt = (size_t)blockIdx.x * 512 + tid, GT = (size_t)gridDim.x * 512;
        const float* x = p.in[0]; bf16* XB = (bf16*)(ws + WS_XB);
        for (size_t i = gt; i < (size_t)NTOK * DM / 8; i += GT) { const f32x4 a = *(const f32x4*)(x + i * 8), b = *(const f32x4*)(x + i * 8 + 4);
            u32x4 o; o.x = pk2(a[0], a[1]); o.y = pk2(a[2], a[3]); o.z = pk2(b[0], b[1]); o.w = pk2(b[2], b[3]); *(u32x4*)(XB + i * 8) = o; }
        const float* mem = p.in[1]; bf16* MB = (bf16*)(ws + WS_MEMB);
        for (size_t i = gt; i < (size_t)2048 * DM / 8; i += GT) { const f32x4 a = *(const f32x4*)(mem + i * 8), b = *(const f32x4*)(mem + i * 8 + 4);
            u32x4 o; o.x = pk2(a[0], a[1]); o.y = pk2(a[2], a[3]); o.z = pk2(b[0], b[1]); o.w = pk2(b[2], b[3]); *(u32x4*)(MB + i * 8) = o; }
        const int* pos = (const int*)p.in[2]; float* ROPE = (float*)(ws + WS_ROPE);
        for (size_t i = gt; i < (size_t)NTOK * 16; i += GT) { const int t = (int)(i >> 4), f = (int)(i & 15);
            const double inv = exp(-(double)f * (9.210340371976184 / 16.0)); const double rev = (double)pos[t] * inv * 0.15915494309189535; const float fr = (float)(rev - floor(rev));
            ROPE[i * 2] = __builtin_amdgcn_cosf(fr); ROPE[i * 2 + 1] = __builtin_amdgcn_sinf(fr); }
    }
}

__device__ __forceinline__ void gla_cum(const Params& p, int l, float* bs, int t0, int h) {
    const int tid = threadIdx.x, t = tid >> 3, dg = tid & 7;
    const bf16* Y = (const bf16*)(p.ws + WS_Y);
    const float* w_a2 = p.in[5] + l * 16 * 256; const float* b_a = p.in[6] + l * 256;
    float a[16];
    { const u32x4 a0 = *(const u32x4*)(Y + (size_t)(t0 + t) * YW + Y_A), a1 = *(const u32x4*)(Y + (size_t)(t0 + t) * YW + Y_A + 8);
#pragma unroll
      for (int j = 0; j < 4; ++j) { a[2 * j] = blo(a0[j]); a[2 * j + 1] = bhi(a0[j]); a[8 + 2 * j] = blo(a1[j]); a[8 + 2 * j + 1] = bhi(a1[j]); } }
#pragma unroll
    for (int j = 0; j < 8; ++j) { const int d = dg * 8 + j; float z = b_a[h * 64 + d];
#pragma unroll
        for (int q = 0; q < 16; ++q) z = fmaf(a[q], w_a2[q * 256 + h * 64 + d], z);
        bs[t * 65 + d] = logsigmoid(z) * (1.f / 16.f); }
    __syncthreads();
    if (tid < 64) { float s = 0.f; for (int tt = 0; tt < 64; ++tt) { s += bs[tt * 65 + tid]; bs[tt * 65 + tid] = s; } }
    __syncthreads();
}
__device__ __forceinline__ void ml_gates(const Params& p, int l, float* fc, float* aa, float* pm, int t0, int h) {
    const int tid = threadIdx.x;
    const bf16* Y = (const bf16*)(p.ws + WS_Y);
    if (tid < 64) { const float fp = bf2f(Y[(size_t)(t0 + tid) * YW + Y_MF + h]) + p.in[10][l * 4 + h]; const float ig = bf2f(Y[(size_t)(t0 + tid) * YW + Y_MI + h]) + p.in[9][l * 4 + h];
        fc[tid] = logsigmoid(fp); aa[tid] = ig; }
    __syncthreads();
    if (tid == 0) { float s = 0.f, m = -3.0e38f; for (int i = 0; i < 64; ++i) { s += fc[i]; fc[i] = s; const float a = aa[i] - s; aa[i] = a; m = fmaxf(m, a); pm[i] = m; } }
    __syncthreads();
}
__device__ __forceinline__ void ml_conv(const Params& p, int l, float* dst, int t0, int c, int ycol, int wch, int h, float scale) {
    const int tid = threadIdx.x, s = tid >> 3, dg = tid & 7;
    const bf16* Y = (const bf16*)(p.ws + WS_Y); const float* w = p.in[8] + l * 4 * 512;
    float acc[8];
#pragma unroll
    for (int j = 0; j < 8; ++j) acc[j] = 0.f;
#pragma unroll
    for (int q = 0; q < 4; ++q) { const int ss = c * 64 + s - 3 + q;
        if (ss >= 0) { const u32x4 v = *(const u32x4*)(Y + (size_t)(t0 + s - 3 + q) * YW + ycol + h * 64 + dg * 8); const float* wr = w + q * 512 + wch + h * 64 + dg * 8;
#pragma unroll
            for (int j = 0; j < 4; ++j) { acc[2 * j] = fmaf(wr[2 * j], blo(v[j]), acc[2 * j]); acc[2 * j + 1] = fmaf(wr[2 * j + 1], bhi(v[j]), acc[2 * j + 1]); } } }
#pragma unroll
    for (int j = 0; j < 8; ++j) dst[s * 65 + dg * 8 + j] = siluf(acc[j]) * scale;
}
__device__ __forceinline__ void ld_blk(float* dst, const bf16* src, int ld) {
    const int tid = threadIdx.x, s = tid >> 3, dg = tid & 7; const u32x4 v = *(const u32x4*)(src + (size_t)s * ld + dg * 8);
#pragma unroll
    for (int j = 0; j < 4; ++j) { dst[s * 65 + dg * 8 + 2 * j] = blo(v[j]); dst[s * 65 + dg * 8 + 2 * j + 1] = bhi(v[j]); }
}

__device__ __forceinline__ void phase_loc(const Params& p, int l, unsigned char* smem) {
    const int tid = threadIdx.x, lane = tid & 63, wave = tid >> 6;
    unsigned char* ws = p.ws; const bf16* Y = (const bf16*)(ws + WS_Y);
    float* A0 = (float*)smem; float* A1 = A0 + 64 * 65; float* A2 = A1 + 64 * 65; float* fc = A2 + 64 * 65; float* aa = fc + 64; float* pm = aa + 64;
    float* ST = (float*)(ws + WS_ST); float* NV = (float*)(ws + WS_NV); float* DEC = (float*)(ws + WS_DEC); float* SC = (float*)(ws + WS_SC);
    for (int u = blockIdx.x; u < 2048; u += gridDim.x) {
        const int type = u >> 10, r = u & 1023, bh = r >> 5, c = r & 31, b = bh >> 2, h = bh & 3, t0 = b * SEQ + c * 64;
        const int d = tid >> 3, e0 = (tid & 7) * 8;
        __syncthreads();
        if (type == 0) {
            gla_cum(p, l, A0, t0, h);
            ld_blk(A1, Y + (size_t)t0 * YW + Y_GK + h * 64, YW);
            ld_blk(A2, Y + (size_t)t0 * YW + Y_GV + h * 64, YW);
            __syncthreads();
            for (int i = tid; i < 4096; i += 512) { const int s = i >> 6, dd = i & 63; A1[s * 65 + dd] *= expf(A0[63 * 65 + dd] - A0[s * 65 + dd]); }
            __syncthreads();
            float acc[8];
#pragma unroll
            for (int j = 0; j < 8; ++j) acc[j] = 0.f;
            for (int s = 0; s < 64; ++s) { const float kv = A1[s * 65 + d];
#pragma unroll
                for (int j = 0; j < 8; ++j) acc[j] = fmaf(kv, A2[s * 65 + e0 + j], acc[j]); }
            float* o = ST + (size_t)u * 4096 + d * 64 + e0;
            *(f32x4*)o = (f32x4){acc[0], acc[1], acc[2], acc[3]}; *(f32x4*)(o + 4) = (f32x4){acc[4], acc[5], acc[6], acc[7]};
            if (tid < 64) DEC[(size_t)r * 64 + tid] = expf(A0[63 * 65 + tid]);
        } else {
            ml_gates(p, l, fc, aa, pm, t0, h);
            ml_conv(p, l, A1, t0, c, Y_MK, 256, h, 1.f);
            ld_blk(A2, Y + (size_t)t0 * YW + Y_MV + h * 64, YW);
            __syncthreads();
            const float M63 = pm[63];
            for (int i = tid; i < 4096; i += 512) { const int s = i >> 6, dd = i & 63; A1[s * 65 + dd] *= expf(aa[s] - M63); }
            __syncthreads();
            float acc[8]; float nn = 0.f;
#pragma unroll
            for (int j = 0; j < 8; ++j) acc[j] = 0.f;
            for (int s = 0; s < 64; ++s) { const float kv = A1[s * 65 + d]; nn += kv;
#pragma unroll
                for (int j = 0; j < 8; ++j) acc[j] = fmaf(kv, A2[s * 65 + e0 + j], acc[j]); }
            float* o = ST + (size_t)u * 4096 + d * 64 + e0;
            *(f32x4*)o = (f32x4){acc[0], acc[1], acc[2], acc[3]}; *(f32x4*)(o + 4) = (f32x4){acc[4], acc[5], acc[6], acc[7]};
            if ((tid & 7) == 0) NV[(size_t)r * 64 + d] = nn;
            if (tid == 0) { SC[r * 2] = fc[63]; SC[r * 2 + 1] = fc[63] + M63; }
        }
    }
    float* RS = (float*)(ws + WS_RS);
    for (int row = blockIdx.x * 8 + wave; row < NTOK; row += gridDim.x * 8) {
        const u32x2 q = *(const u32x2*)(Y + (size_t)row * YW + Y_CQ + lane * 4); const unsigned kv = *(const unsigned*)(Y + (size_t)row * YW + Y_CKV + lane * 2);
        float sq = blo(q.x) * blo(q.x) + bhi(q.x) * bhi(q.x) + blo(q.y) * blo(q.y) + bhi(q.y) * bhi(q.y); float sk = blo(kv) * blo(kv) + bhi(kv) * bhi(kv);
        sq = wave_sum(sq); sk = wave_sum(sk);
        if (lane == 0) { RS[row * 2] = 1.f / sqrtf(sq * (1.f / 256.f) + LN_EPS); RS[row * 2 + 1] = 1.f / sqrtf(sk * (1.f / 128.f) + LN_EPS); }
    }
}

__device__ __forceinline__ void phase_scan(const Params& p, int l) {
    unsigned char* ws = p.ws;
    float* ST = (float*)(ws + WS_ST); float* NV = (float*)(ws + WS_NV); const float* DEC = (const float*)(ws + WS_DEC); const float* SC = (const float*)(ws + WS_SC); float* MS = (float*)(ws + WS_MS);
    const int gt = blockIdx.x * 512 + threadIdx.x, GT = gridDim.x * 512;
    for (int idx = gt; idx < 64 * 4096; idx += GT) {
        const int seq = idx >> 12, el = idx & 4095, d = el >> 6;
        float* st = ST + (size_t)seq * 32 * 4096 + el;
        if (seq < 32) { float S = 0.f; const float* dc = DEC + (size_t)seq * 32 * 64 + d;
#pragma unroll 4
            for (int c = 0; c < 32; ++c) { const float tmp = st[(size_t)c * 4096]; st[(size_t)c * 4096] = S; S = fmaf(dc[c * 64], S, tmp); } }
        else { const int sq = seq - 32; float C = 0.f, m = 0.f; const float* sc = SC + (size_t)sq * 32 * 2;
#pragma unroll 4
            for (int c = 0; c < 32; ++c) { const float F = sc[c * 2], ml = sc[c * 2 + 1]; const float tmp = st[(size_t)c * 4096]; st[(size_t)c * 4096] = C;
                const float mn = fmaxf(F + m, ml); C = expf(F + m - mn) * C + expf(ml - mn) * tmp; m = mn; } }
    }
    for (int idx = gt; idx < 32 * 64; idx += GT) {
        const int sq = idx >> 6, d = idx & 63; float n = 0.f, m = 0.f; const float* sc = SC + (size_t)sq * 32 * 2; float* nv = NV + (size_t)sq * 32 * 64 + d;
#pragma unroll 2
        for (int c = 0; c < 32; ++c) { const float F = sc[c * 2], ml = sc[c * 2 + 1]; const float tmp = nv[c * 64]; nv[c * 64] = n; if (d == 0) MS[sq * 32 + c] = m;
            const float mn = fmaxf(F + m, ml); n = expf(F + m - mn) * n + expf(ml - mn) * tmp; m = mn; }
    }
}

template <int DQK, int DV>
__device__ __forceinline__ void attn_naive(unsigned char* smem, const bf16* Q, int qs, const bf16* K, int ks, const bf16* V, int vs, int nk, bf16* O, int os) {
    constexpr int LQ = DQK + 8, LV = DV + 8, EV = DV / 8;
    bf16* Qs = (bf16*)smem; bf16* Ks = Qs + 64 * LQ; bf16* Vs = Ks + 64 * LQ; float* Ss = (float*)(Vs + 64 * LV);
    const int tid = threadIdx.x, t = tid >> 3, g = tid & 7;
    __syncthreads();
    for (int i = tid; i < 64 * DQK / 8; i += 512) { const int r = i / (DQK / 8), c8 = i % (DQK / 8); *(u32x4*)(Qs + r * LQ + c8 * 8) = *(const u32x4*)(Q + (size_t)r * qs + c8 * 8); }
    float acc[EV]; float m = -3.0e38f, lsum = 0.f;
#pragma unroll
    for (int j = 0; j < EV; ++j) acc[j] = 0.f;
    for (int k0 = 0; k0 < nk; k0 += 64) {
        __syncthreads();
        for (int i = tid; i < 64 * DQK / 8; i += 512) { const int r = i / (DQK / 8), c8 = i % (DQK / 8); *(u32x4*)(Ks + r * LQ + c8 * 8) = *(const u32x4*)(K + (size_t)(k0 + r) * ks + c8 * 8); }
        for (int i = tid; i < 64 * DV / 8; i += 512) { const int r = i / (DV / 8), c8 = i % (DV / 8); *(u32x4*)(Vs + r * LV + c8 * 8) = *(const u32x4*)(V + (size_t)(k0 + r) * vs + c8 * 8); }
        __syncthreads();
        float sc[8];
#pragma unroll
        for (int j = 0; j < 8; ++j) sc[j] = 0.f;
        for (int d8 = 0; d8 < DQK / 8; ++d8) { const u32x4 qv = *(const u32x4*)(Qs + t * LQ + d8 * 8);
#pragma unroll
            for (int j = 0; j < 8; ++j) { const u32x4 kv = *(const u32x4*)(Ks + (g + 8 * j) * LQ + d8 * 8);
#pragma unroll
                for (int q = 0; q < 4; ++q) sc[j] = fmaf(blo(qv[q]), blo(kv[q]), fmaf(bhi(qv[q]), bhi(kv[q]), sc[j])); } }
        float mx = sc[0];
#pragma unroll
        for (int j = 1; j < 8; ++j) mx = fmaxf(mx, sc[j]);
        mx = fmaxf(mx, __shfl_xor(mx, 1)); mx = fmaxf(mx, __shfl_xor(mx, 2)); mx = fmaxf(mx, __shfl_xor(mx, 4));
        const float mn = fmaxf(m, mx), al = exp2f(m - mn); float ps = 0.f;
#pragma unroll
        for (int j = 0; j < 8; ++j) { const float pv = exp2f(sc[j] - mn); ps += pv; Ss[t * 65 + g + 8 * j] = pv; }
        ps += __shfl_xor(ps, 1); ps += __shfl_xor(ps, 2); ps += __shfl_xor(ps, 4);
        lsum = lsum * al + ps; m = mn;
#pragma unroll
        for (int j = 0; j < EV; ++j) acc[j] *= al;
        __syncthreads();
        for (int kk = 0; kk < 64; ++kk) { const float pv = Ss[t * 65 + kk];
#pragma unroll
            for (int j8 = 0; j8 < EV / 8; ++j8) { const u32x4 vv = *(const u32x4*)(Vs + kk * LV + g * EV + j8 * 8);
#pragma unroll
                for (int q = 0; q < 4; ++q) { acc[j8 * 8 + 2 * q] = fmaf(pv, blo(vv[q]), acc[j8 * 8 + 2 * q]); acc[j8 * 8 + 2 * q + 1] = fmaf(pv, bhi(vv[q]), acc[j8 * 8 + 2 * q + 1]); } } }
    }
    const float inv = 1.f / lsum;
#pragma unroll
    for (int j8 = 0; j8 < EV / 8; ++j8) { u32x4 o; o.x = pk2(acc[j8 * 8] * inv, acc[j8 * 8 + 1] * inv); o.y = pk2(acc[j8 * 8 + 2] * inv, acc[j8 * 8 + 3] * inv);
        o.z = pk2(acc[j8 * 8 + 4] * inv, acc[j8 * 8 + 5] * inv); o.w = pk2(acc[j8 * 8 + 6] * inv, acc[j8 * 8 + 7] * inv);
        *(u32x4*)(O + (size_t)t * os + g * EV + j8 * 8) = o; }
}

__device__ __forceinline__ void mix_linear_unit(const Params& p, int l, unsigned char* smem, int u) {
    const int tid = threadIdx.x; unsigned char* ws = p.ws; const bf16* Y = (const bf16*)(ws + WS_Y);
    float* A0 = (float*)smem; float* A1 = A0 + 64 * 65; float* A2 = A1 + 64 * 65; float* A3 = A2 + 64 * 65; float* A4 = A3 + 64 * 65; float* A5 = A4 + 64 * 65;
    float* fc = A5 + 64 * 65; float* aa = fc + 64; float* pm = aa + 64; float* nv = pm + 64;
    const float* ST = (const float*)(ws + WS_ST); const float* NV = (const float*)(ws + WS_NV); const float* MS = (const float*)(ws + WS_MS);
    bf16* MIX = (bf16*)(ws + WS_XB);
    const int type = u >> 10, r = u & 1023, bh = r >> 5, c = r & 31, b = bh >> 2, h = bh & 3, t0 = b * SEQ + c * 64;
    const int t = tid >> 3, g = tid & 7, e0 = g * 8;
    __syncthreads();
    for (int i = tid; i < 4096; i += 512) A3[(i >> 6) * 65 + (i & 63)] = ST[(size_t)u * 4096 + i];
    ld_blk(A2, Y + (size_t)t0 * YW + (type == 0 ? Y_GV : Y_MV) + h * 64, YW);
    float mst = 0.f;
    if (type == 0) {
        gla_cum(p, l, A0, t0, h);
        ld_blk(A4, Y + (size_t)t0 * YW + Y_GQ + h * 64, YW); ld_blk(A1, Y + (size_t)t0 * YW + Y_GK + h * 64, YW);
        __syncthreads();
        for (int i = tid; i < 4096; i += 512) { const int s = i >> 6, dd = i & 63; const float bb = A0[s * 65 + dd]; A4[s * 65 + dd] *= 0.125f * expf(bb); A1[s * 65 + dd] *= expf(-bb); }
    } else {
        ml_gates(p, l, fc, aa, pm, t0, h);
        ml_conv(p, l, A4, t0, c, Y_MQ, 0, h, 0.125f); ml_conv(p, l, A1, t0, c, Y_MK, 256, h, 1.f);
        if (tid < 64) nv[tid] = NV[(size_t)r * 64 + tid];
        mst = MS[r];
    }
    __syncthreads();
    const float mm = (type == 1) ? fmaxf(mst, pm[t]) : 0.f;
    {
        float sc[8];
#pragma unroll
        for (int j = 0; j < 8; ++j) sc[j] = 0.f;
        for (int d = 0; d < 64; ++d) { const float qv = A4[t * 65 + d];
#pragma unroll
            for (int j = 0; j < 8; ++j) sc[j] = fmaf(qv, A1[(g + 8 * j) * 65 + d], sc[j]); }
#pragma unroll
        for (int j = 0; j < 8; ++j) { const int s = g + 8 * j; float w = (s <= t) ? sc[j] : 0.f; if (type == 1) w = (s <= t) ? w * expf(aa[s] - mm) : 0.f; A5[t * 65 + s] = w; }
    }
    __syncthreads();
    float acc[8], inter[8];
#pragma unroll
    for (int j = 0; j < 8; ++j) { acc[j] = 0.f; inter[j] = 0.f; }
    for (int d = 0; d < 64; ++d) { const float qv = A4[t * 65 + d];
#pragma unroll
        for (int j = 0; j < 8; ++j) inter[j] = fmaf(qv, A3[d * 65 + e0 + j], inter[j]); }
    for (int s = 0; s < 64; ++s) { const float pv = A5[t * 65 + s];
#pragma unroll
        for (int j = 0; j < 8; ++j) acc[j] = fmaf(pv, A2[s * 65 + e0 + j], acc[j]); }
    float o[8];
    if (type == 0) {
#pragma unroll
        for (int j = 0; j < 8; ++j) o[j] = acc[j] + inter[j];
    } else {
        const float wi = expf(mst - mm);
        float dn = 0.f;
#pragma unroll
        for (int j = 0; j < 8; ++j) dn += wi * A4[t * 65 + e0 + j] * nv[e0 + j] + A5[t * 65 + e0 + j];
        dn += __shfl_xor(dn, 1); dn += __shfl_xor(dn, 2); dn += __shfl_xor(dn, 4);
        const float mt = fc[t] + mm; const float den = fmaxf(fabsf(dn), expf(-mt)); const float inv = 1.f / den;
#pragma unroll
        for (int j = 0; j < 8; ++j) o[j] = (wi * inter[j] + acc[j]) * inv;
    }
    float s1 = 0.f;
#pragma unroll
    for (int j = 0; j < 8; ++j) s1 += o[j];
    s1 += __shfl_xor(s1, 1); s1 += __shfl_xor(s1, 2); s1 += __shfl_xor(s1, 4);
    const float mu = s1 * (1.f / 64.f); float s2 = 0.f;
#pragma unroll
    for (int j = 0; j < 8; ++j) { o[j] -= mu; s2 += o[j] * o[j]; }
    s2 += __shfl_xor(s2, 1); s2 += __shfl_xor(s2, 2); s2 += __shfl_xor(s2, 4);
    const float rstd = 1.f / sqrtf(s2 * (1.f / 64.f) + LN_EPS);
    const float* gn = (type == 0 ? p.in[7] : p.in[11]) + l * 256 + h * 64 + e0;
    const u32x4 gv = *(const u32x4*)(Y + (size_t)(t0 + t) * YW + (type == 0 ? Y_GR : Y_MO) + h * 64 + e0);
    float gate[8];
#pragma unroll
    for (int j = 0; j < 4; ++j) { gate[2 * j] = blo(gv[j]); gate[2 * j + 1] = bhi(gv[j]); }
    float res[8];
#pragma unroll
    for (int j = 0; j < 8; ++j) res[j] = o[j] * rstd * gn[j] * (type == 0 ? siluf(gate[j]) : sigmoidf(gate[j]));
    u32x4 ov; ov.x = pk2(res[0], res[1]); ov.y = pk2(res[2], res[3]); ov.z = pk2(res[4], res[5]); ov.w = pk2(res[6], res[7]);
    *(u32x4*)(MIX + (size_t)(t0 + t) * DM + type * 256 + h * 64 + e0) = ov;
}

__device__ __forceinline__ void phase_mix(const Params& p, int l, unsigned char* smem) {
    unsigned char* ws = p.ws;
    const bf16* QP = (const bf16*)(ws + WS_QP); const bf16* KP = (const bf16*)(ws + WS_KP); const bf16* VP = (const bf16*)(ws + WS_VP); bf16* MIX = (bf16*)(ws + WS_XB);
    for (int u = blockIdx.x; u < 4096; u += gridDim.x) {
        if (u < 2048) {
            const int qc = 31 - (u >> 6), bh = u & 63, b = bh >> 3, h = bh & 7;
            attn_naive<96, 64>(smem, QP + ((size_t)bh * SEQ + qc * 64) * 96, 96, KP + (size_t)bh * SEQ * 96, 96, VP + (size_t)bh * SEQ * 64, 64, 64 * (qc + 1),
                               MIX + (size_t)(b * SEQ + qc * 64) * DM + 512 + h * 64, DM);
        } else mix_linear_unit(p, l, smem, u - 2048);
    }
}

__device__ __forceinline__ void ln_row_store(f32x4 (&v)[4], const float* g, const float* bta, float* of, bf16* ob, int lane) {
    float s = 0.f;
#pragma unroll
    for (int j = 0; j < 4; ++j) s += (v[j][0] + v[j][1]) + (v[j][2] + v[j][3]);
    const float mean = wave_sum(s) * (1.f / DM); float s2 = 0.f;
#pragma unroll
    for (int j = 0; j < 4; ++j) { v[j] = v[j] - mean; s2 += (v[j][0] * v[j][0] + v[j][1] * v[j][1]) + (v[j][2] * v[j][2] + v[j][3] * v[j][3]); }
    const float rstd = 1.f / sqrtf(wave_sum(s2) * (1.f / DM) + LN_EPS);
#pragma unroll
    for (int j = 0; j < 4; ++j) { const f32x4 gg = *(const f32x4*)(g + lane * 4 + 256 * j), bb = *(const f32x4*)(bta + lane * 4 + 256 * j);
        v[j] = v[j] * rstd * gg + bb; *(f32x4*)(of + lane * 4 + 256 * j) = v[j]; st_bf4(ob + lane * 4 + 256 * j, v[j]); }
}

__device__ __forceinline__ void phase_ln(const Params& p, int l, int which  ) {
    const int tid = threadIdx.x, lane = tid & 63, wave = tid >> 6; unsigned char* ws = p.ws;
    float* XR = p.out; bf16* XB = (bf16*)(ws + WS_XB);
    const float* g = p.in[26 + 2 * which] + l * DM; const float* bta = p.in[27 + 2 * which] + l * DM;
    const bf16* CT = (const bf16*)(ws + WS_CT);
    for (int row = blockIdx.x * 8 + wave; row < NTOK; row += gridDim.x * 8) {
        f32x4 v[4];
#pragma unroll
        for (int j = 0; j < 4; ++j) v[j] = *(const f32x4*)(XR + (size_t)row * DM + lane * 4 + 256 * j);
        if (which == 2) {
#pragma unroll
            for (int j = 0; j < 4; ++j) { const u32x2 c0 = *(const u32x2*)(CT + (size_t)row * DM + lane * 4 + 256 * j), c1 = *(const u32x2*)(CT + ((size_t)NTOK + row) * DM + lane * 4 + 256 * j);
                v[j] = v[j] * ALPHA + (f32x4){blo(c0.x), bhi(c0.x), blo(c0.y), bhi(c0.y)} + (f32x4){blo(c1.x), bhi(c1.x), blo(c1.y), bhi(c1.y)}; }
        }
        ln_row_store(v, g, bta, XR + (size_t)row * DM, XB + (size_t)row * DM, lane);
        if (which == 1) {
            const float* wgp = p.in[19] + (size_t)l * DM * 4; const float* bg = p.in[20] + l * 4; const float* wr = p.in[21] + (size_t)l * DM * 32; const float* br = p.in[22] + l * 32;
            float gl[4] = {0.f, 0.f, 0.f, 0.f};
#pragma unroll
            for (int j = 0; j < 4; ++j)
#pragma unroll
                for (int q = 0; q < 4; ++q) { const f32x4 w4 = *(const f32x4*)(wgp + (size_t)(lane * 4 + 256 * j + q) * 4); const float xv = v[j][q];
                    gl[0] = fmaf(xv, w4[0], gl[0]); gl[1] = fmaf(xv, w4[1], gl[1]); gl[2] = fmaf(xv, w4[2], gl[2]); gl[3] = fmaf(xv, w4[3], gl[3]); }
#pragma unroll
            for (int q = 0; q < 4; ++q) gl[q] = wave_sum(gl[q]) + bg[q];
            int gi = 0; float gm = gl[0];
#pragma unroll
            for (int q = 1; q < 4; ++q) if (gl[q] > gm) { gm = gl[q]; gi = q; }
            float gs = 0.f;
#pragma unroll
            for (int q = 0; q < 4; ++q) gs += expf(gl[q] - gm);
            const float gp = 1.f / gs;
            float el[8] = {0.f, 0.f, 0.f, 0.f, 0.f, 0.f, 0.f, 0.f};
#pragma unroll
            for (int j = 0; j < 4; ++j)
#pragma unroll
                for (int q = 0; q < 4; ++q) { const float* wrow = wr + (size_t)(lane * 4 + 256 * j + q) * 32 + gi * 8; const f32x4 w0 = *(const f32x4*)wrow, w1 = *(const f32x4*)(wrow + 4); const float xv = v[j][q];
                    el[0] = fmaf(xv, w0[0], el[0]); el[1] = fmaf(xv, w0[1], el[1]); el[2] = fmaf(xv, w0[2], el[2]); el[3] = fmaf(xv, w0[3], el[3]);
                    el[4] = fmaf(xv, w1[0], el[4]); el[5] = fmaf(xv, w1[1], el[5]); el[6] = fmaf(xv, w1[2], el[6]); el[7] = fmaf(xv, w1[3], el[7]); }
#pragma unroll
            for (int q = 0; q < 8; ++q) el[q] = wave_sum(el[q]) + br[gi * 8 + q];
            int i0 = 0; float m0 = el[0];
#pragma unroll
            for (int q = 1; q < 8; ++q) if (el[q] > m0) { m0 = el[q]; i0 = q; }
            int i1 = -1; float m1 = -3.0e38f;
#pragma unroll
            for (int q = 0; q < 8; ++q) if (q != i0 && el[q] > m1) { m1 = el[q]; i1 = q; }
            const float p1 = expf(m1 - m0); const float w0 = gp / (1.f + p1), w1 = gp * p1 / (1.f + p1);
            if (lane == 0) {
                unsigned* cnt = (unsigned*)(ws + WS_CTL) + CW_CNT + l * 32; int* LT = (int*)(ws + WS_LISTT); float* LW = (float*)(ws + WS_LISTW);
                const int e0 = gi * 8 + i0, e1 = gi * 8 + i1;
                const unsigned p0 = atomicAdd(cnt + e0, 1u); LT[(size_t)e0 * NTOK + p0] = row * 2; LW[(size_t)e0 * NTOK + p0] = w0;
                const unsigned q1 = atomicAdd(cnt + e1, 1u); LT[(size_t)e1 * NTOK + q1] = row * 2 + 1; LW[(size_t)e1 * NTOK + q1] = w1;
            }
        }
    }
}

__device__ __forceinline__ void moe_table(const Params& p, int l, int* tstart, int* cntl) {
    __syncthreads();
    if (threadIdx.x == 0) { const unsigned* cnt = (const unsigned*)(p.ws + WS_CTL) + CW_CNT + l * 32; int s = 0;
        for (int e = 0; e < 32; ++e) { const int c = (int)__hip_atomic_load(cnt + e, __ATOMIC_RELAXED, __HIP_MEMORY_SCOPE_AGENT); cntl[e] = c; tstart[e] = s; s += (c + 255) >> 8; } tstart[32] = s; }
    __syncthreads();
}

__device__ __forceinline__ void phase_moe(const Params& p, int l, unsigned char* smem, int which  ) {
    unsigned char* ws = p.ws;
    int* tstart = (int*)(smem + 65536); int* cntl = tstart + 40;
    moe_table(p, l, tstart, cntl);
    const int T = tstart[32]; const int ncol = which == 0 ? 2 : 4;
    const bf16* XB = (const bf16*)(ws + WS_XB); bf16* H = (bf16*)(ws + WS_H); const int* LT = (const int*)(ws + WS_LISTT); const float* LW = (const float*)(ws + WS_LISTW);
    for (int u = blockIdx.x; u < T * ncol; u += gridDim.x) {
        const int rt = u / ncol, pn = u % ncol; int e = 0;
        for (int q = 1; q < 32; ++q) if (tstart[q] <= rt) e = q;
        const int pos0 = (rt - tstart[e]) * 256; int nv = cntl[e] - pos0; nv = nv > 256 ? 256 : nv;
        UnitDesc ud; ud.ridx = LT + (size_t)e * NTOK + pos0; ud.rw = LW + (size_t)e * NTOK + pos0; ud.nvalid = nv; ud.gather = 1;
        if (which == 0) { ud.A = XB; ud.B = (const bf16*)(ws + W_GU) + ((size_t)e * 512 + pn * 256) * 1024; ud.row0 = rt * 256; ud.col0 = pn * 128;
            EpiMoe1 E{H}; gemm_unit_naive(smem, ud, 1024, 1024, 1024, E); }
        else { ud.A = H + (size_t)rt * 256 * 256; ud.B = (const bf16*)(ws + W_DN) + ((size_t)e * 1024 + pn * 256) * 256; ud.row0 = 0; ud.col0 = pn * 256; ud.gather = 0;
            EpiMoe2 E{(bf16*)(ws + WS_CT)}; gemm_unit_naive(smem, ud, 256, 256, 256, E); }
    }
}

template <unsigned MASK>
__global__ void __launch_bounds__(512, 2) fwd(Params p) {
    extern __shared__ __attribute__((aligned(16))) unsigned char smem[];
    unsigned char* ws = p.ws;
    volatile LAS unsigned* barw = (volatile LAS unsigned*)((LAS unsigned char*)smem + LDS_BARW);
    if (threadIdx.x == 0) { barw[0] = 0u; barw[1] = 0u; }
    __syncthreads();
    XcdBarrier bar; bar.bar = (unsigned*)(ws + WS_CTL) + CW_BAR; bar.x = 0; bar.st = barw;
    const bool multi = (p.ph_hi - p.ph_lo) > 1;
    if (multi) bar = xcd_barrier_post((unsigned*)(ws + WS_CTL) + CW_BAR, barw);
    const int lo = p.ph_lo, hi = p.ph_hi;
#pragma unroll 1
    for (int l = 0; l < 2; ++l) {
        const int base = l * NPH;
#define IN(k) (((MASK >> (k)) & 1u) != 0u && lo <= base + (k) && base + (k) < hi)
#define SEAM(k) do { if (base + (k) + 1 < hi) xcd_barrier(bar); } while (0)
        if (IN(PH_CONV)) { phase_conv(p, l, smem); SEAM(PH_CONV); }
        if (IN(PH_G1)) {
            for (int u = blockIdx.x; u < 640; u += gridDim.x) { const int pm = u / 10, pn = u % 10;
                UnitDesc ud{(const bf16*)(ws + WS_XB) + (size_t)pm * 256 * DM, (const bf16*)(ws + W_IN) + (size_t)pn * 256 * DM, nullptr, nullptr, pm * 256, pn * 256, 256, 0};
                EpiBf16Store E{(bf16*)(ws + WS_Y), YW, 1.f}; gemm_unit_naive(smem, ud, 1024, 1024, 1024, E); }
            for (int u = (blockIdx.x + 128) % gridDim.x; u < 64; u += gridDim.x) { const int pm = u / 8, pn = u % 8;
                UnitDesc ud{(const bf16*)(ws + WS_MEMB) + (size_t)pm * 256 * DM, (const bf16*)(ws + W_XKV) + (size_t)pn * 256 * DM, nullptr, nullptr, pm * 256, pn * 256, 256, 0};
                EpiBf16Store E{(bf16*)(ws + WS_KVX), 2048, 1.f}; gemm_unit_naive(smem, ud, 1024, 1024, 1024, E); }
            SEAM(PH_G1);
        }
        if (IN(PH_LOC)) { phase_loc(p, l, smem); SEAM(PH_LOC); }
        if (IN(PH_SCAN)) {
            phase_scan(p, l);
            for (int u = blockIdx.x; u < 512; u += gridDim.x) { const int pm = u >> 3, pn = u & 7;
                UnitDesc ud{(const bf16*)(ws + WS_Y) + (size_t)pm * 256 * YW + (pn < 3 ? Y_CQ : Y_T9), pn < 3 ? (const bf16*)(ws + W_Q) + (size_t)pn * 256 * 256 : (const bf16*)(ws + W_KV) + (size_t)(pn - 3) * 256 * 256,
                            nullptr, nullptr, pm * 256, pn * 256, 256, 0};
                EpiG23 E{(bf16*)(ws + WS_QP), (bf16*)(ws + WS_KP), (bf16*)(ws + WS_VP), (const float*)(ws + WS_RS), (const float*)(ws + WS_ROPE)};
                gemm_unit_naive(smem, ud, 256, YW, 256, E); }
            SEAM(PH_SCAN);
        }
        if (IN(PH_MIX)) { phase_mix(p, l, smem); SEAM(PH_MIX); }
        if (IN(PH_G4)) {
            for (int u = blockIdx.x; u < 256; u += gridDim.x) { const int pm = u >> 2, pn = u & 3;
                UnitDesc ud{(const bf16*)(ws + WS_XB) + (size_t)pm * 256 * DM, (const bf16*)(ws + W_OUT) + (size_t)pn * 256 * DM, nullptr, nullptr, pm * 256, pn * 256, 256, 0};
                EpiResid E{l == 0 ? p.in[0] : p.out, p.out}; gemm_unit_naive(smem, ud, 1024, 1024, 1024, E); }
            SEAM(PH_G4);
        }
        if (IN(PH_LN1)) { phase_ln(p, l, 0); SEAM(PH_LN1); }
        if (IN(PH_G5)) {
            for (int u = blockIdx.x; u < 256; u += gridDim.x) { const int pm = u >> 2, pn = u & 3;
                UnitDesc ud{(const bf16*)(ws + WS_XB) + (size_t)pm * 256 * DM, (const bf16*)(ws + W_XQ) + (size_t)pn * 256 * DM, nullptr, nullptr, pm * 256, pn * 256, 256, 0};
                EpiBf16Store E{(bf16*)(ws + WS_QX), DM, XSCALE}; gemm_unit_naive(smem, ud, 1024, 1024, 1024, E); }
            SEAM(PH_G5);
        }
        if (IN(PH_XATT)) {
            const bf16* QX = (const bf16*)(ws + WS_QX); const bf16* KVX = (const bf16*)(ws + WS_KVX); bf16* OX = (bf16*)(ws + WS_OX);
            for (int u = blockIdx.x; u < 1024; u += gridDim.x) { const int b = u >> 7, h = (u >> 5) & 3, qt = u & 31;
                attn_naive<256, 256>(smem, QX + (size_t)(b * SEQ + qt * 64) * DM + h * 256, DM, KVX + (size_t)(b * 256) * 2048 + h * 256, 2048, KVX + (size_t)(b * 256) * 2048 + 1024 + h * 256, 2048, 256,
                                     OX + (size_t)(b * SEQ + qt * 64) * DM + h * 256, DM); }
            SEAM(PH_XATT);
        }
        if (IN(PH_G7)) {
            for (int u = blockIdx.x; u < 256; u += gridDim.x) { const int pm = u >> 2, pn = u & 3;
                UnitDesc ud{(const bf16*)(ws + WS_OX) + (size_t)pm * 256 * DM, (const bf16*)(ws + W_XO) + (size_t)pn * 256 * DM, nullptr, nullptr, pm * 256, pn * 256, 256, 0};
                EpiResid E{p.out, p.out}; gemm_unit_naive(smem, ud, 1024, 1024, 1024, E); }
            SEAM(PH_G7);
        }
        if (IN(PH_LN2)) { phase_ln(p, l, 1); SEAM(PH_LN2); }
        if (IN(PH_MOE1)) { phase_moe(p, l, smem, 0); SEAM(PH_MOE1); }
        if (IN(PH_MOE2)) { phase_moe(p, l, smem, 1); SEAM(PH_MOE2); }
        if (IN(PH_LN3)) { phase_ln(p, l, 2); SEAM(PH_LN3); }
#undef IN
#undef SEAM
    }
}

extern "C" void kernel_launch(void* const* d_in, const int* in_sizes, int n_in, void* d_out, int out_size, void* d_ws, size_t ws_size, hipStream_t stream) {
    static int grid = 0;
    typedef void (*kfn_t)(Params);
#if N_LAUNCH_MODE == 1
    static const kfn_t kfn[NPH] = { fwd<1u << 0>, fwd<1u << 1>, fwd<1u << 2>, fwd<1u << 3>, fwd<1u << 4>, fwd<1u << 5>, fwd<1u << 6>, fwd<1u << 7>, fwd<1u << 8>, fwd<1u << 9>, fwd<1u << 10>, fwd<1u << 11>, fwd<1u << 12>, fwd<1u << 13> };
    constexpr int NK = NPH;
#else
    static const kfn_t kfn[1] = { fwd<0x3fffu> };
    constexpr int NK = 1;
#endif
    if (grid == 0) {
        int dev = 0, cus = 0;
        if (n_in != 32 || out_size != NTOK * DM || ws_size < WS_TOTAL) { fprintf(stderr, "kernel_launch: unexpected shapes (n_in %d out %d ws %zu need %zu)\n", n_in, out_size, ws_size, (size_t)WS_TOTAL); }
        (void)hipGetDevice(&dev); (void)hipDeviceGetAttribute(&cus, hipDeviceAttributeMultiprocessorCount, dev);
        for (int i = 0; i < NK; ++i) (void)hipFuncSetAttribute((const void*)kfn[i], hipFuncAttributeMaxDynamicSharedMemorySize, LDS_BYTES);
        int per_cu = 0; (void)hipOccupancyMaxActiveBlocksPerMultiprocessor(&per_cu, (const void*)kfn[0], 512, LDS_BYTES);
        (void)hipGetLastError();
        grid = cus > 0 ? cus : 256;
    }
    (void)hipMemsetAsync((char*)d_ws + WS_CTL, 0, CTL_BYTES, stream);
    Params p{};
    for (int i = 0; i < 32; ++i) p.in[i] = (const float*)d_in[i];
    p.out = (float*)d_out; p.ws = (unsigned char*)d_ws;
#if N_LAUNCH_MODE == 1
    for (int ph = 0; ph < 2 * NPH; ++ph) { p.ph_lo = ph; p.ph_hi = ph + 1; hipLaunchKernelGGL(kfn[ph % NPH], dim3(grid), dim3(512), LDS_BYTES, stream, p); }
#else
    p.ph_lo = 0; p.ph_hi = 2 * NPH; hipLaunchKernelGGL(kfn[0], dim3(grid), dim3(512), LDS_BYTES, stream, p);
#endif
}
```

```cpp
#include <hip/hip_runtime.h>
#include <stdint.h>
#include <stdio.h>

#ifndef N_LAUNCH_MODE
#define N_LAUNCH_MODE 0
#endif

typedef unsigned short bf16;
typedef float f32x4 __attribute__((ext_vector_type(4)));
typedef unsigned u32x4 __attribute__((ext_vector_type(4)));
typedef unsigned u32x2 __attribute__((ext_vector_type(2)));
#define LAS __attribute__((address_space(3)))

constexpr int NTOK = 16384, DM = 1024, SEQ = 2048, NBATCH = 8, YW = 2560, NCH = 32;
constexpr int Y_GQ = 0, Y_GK = 256, Y_GV = 512, Y_GR = 768, Y_MQ = 1024, Y_MK = 1280, Y_MV = 1536, Y_MO = 1792, Y_CQ = 2048, Y_T9 = 2304,
              Y_A = 2304, Y_MI = 2320, Y_MF = 2324, Y_CKV = 2328, Y_KR = 2456;
constexpr float ALPHA = 1.41421356237309515f;
constexpr float LN_EPS = 1e-5f;
constexpr float LOG2E = 1.44269504088896341f;
constexpr float QSCALE = 0.10206207261596575f * LOG2E;
constexpr float XSCALE = 0.0625f * LOG2E;
constexpr int NPH = 14;
enum { PH_CONV = 0, PH_G1, PH_LOC, PH_SCAN, PH_MIX, PH_G4, PH_LN1, PH_G5, PH_XATT, PH_G7, PH_LN2, PH_MOE1, PH_MOE2, PH_LN3 };

constexpr size_t MiB = 1u << 20;
constexpr size_t WS_CTL = 0, CTL_BYTES = 1 * MiB;
constexpr size_t W_IN = 1 * MiB;
constexpr size_t W_Q = W_IN + (size_t)2560 * 1024 * 2;
constexpr size_t W_KV = W_Q + (size_t)768 * 256 * 2;
constexpr size_t W_OUT = W_KV + (size_t)1280 * 256 * 2;
constexpr size_t W_XQ = W_OUT + 2 * MiB;
constexpr size_t W_XKV = W_XQ + 2 * MiB;
constexpr size_t W_XO = W_XKV + 4 * MiB;
constexpr size_t W_GU = W_XO + 2 * MiB;
constexpr size_t W_DN = W_GU + 32 * MiB;
constexpr size_t W_END = W_DN + 16 * MiB;
constexpr size_t WS_XB = W_END;
constexpr size_t WS_MEMB = WS_XB + 32 * MiB;
constexpr size_t WS_KVX = WS_MEMB + 4 * MiB;
constexpr size_t WS_ROPE = WS_KVX + 8 * MiB;
constexpr size_t WS_RS = WS_ROPE + 2 * MiB;
constexpr size_t WS_LISTT = WS_RS + 128 * 1024;
constexpr size_t WS_LISTW = WS_LISTT + 2 * MiB;
constexpr size_t WS_NV = WS_LISTW + 2 * MiB;
constexpr size_t WS_DEC = WS_NV + 256 * 1024;
constexpr size_t WS_SC = WS_DEC + 256 * 1024;
constexpr size_t WS_MS = WS_SC + 8 * 1024;
constexpr size_t WS_Y = WS_MS + 8 * 1024;
constexpr size_t WS_QX = WS_Y, WS_OX = WS_Y + 32 * MiB, WS_H = WS_Y;
constexpr size_t WS_QP = WS_Y + 80 * MiB;
constexpr size_t WS_KP = WS_QP + 24 * MiB;
constexpr size_t WS_VP = WS_KP + 24 * MiB;
constexpr size_t WS_ST = WS_VP + 16 * MiB;
constexpr size_t WS_CT = WS_QP;
constexpr size_t WS_TOTAL = WS_ST + 32 * MiB;
static_assert(WS_TOTAL <= (size_t)342000000, "workspace budget");
constexpr int CW_BAR = 4096;
constexpr int CW_CNT = 16384;

constexpr int LDS_BYTES = 147456;
constexpr int LDS_BARW = LDS_BYTES - 16;

struct Params {
    const float* in[32];
    float* out;
    unsigned char* ws;
    int ph_lo, ph_hi;
};

__device__ __forceinline__ float bf2f(unsigned v) { return __uint_as_float(v << 16); }
__device__ __forceinline__ unsigned f2bf(float f) { unsigned u = __float_as_uint(f); return (u + 0x7fffu + ((u >> 16) & 1u)) >> 16; }
__device__ __forceinline__ unsigned pk2(float lo, float hi) { return f2bf(lo) | (f2bf(hi) << 16); }
__device__ __forceinline__ float blo(unsigned w) { return __uint_as_float(w << 16); }
__device__ __forceinline__ float bhi(unsigned w) { return __uint_as_float(w & 0xffff0000u); }
__device__ __forceinline__ float wave_sum(float v) {
#pragma unroll
    for (int o = 1; o < 64; o <<= 1) v += __shfl_xor(v, o);
    return v;
}
__device__ __forceinline__ float logsigmoid(float z) { return fminf(z, 0.f) - log1pf(expf(-fabsf(z))); }
__device__ __forceinline__ float sigmoidf(float x) { return 1.f / (1.f + expf(-x)); }
__device__ __forceinline__ float siluf(float x) { return x / (1.f + expf(-x)); }
__device__ __forceinline__ void st_bf4(bf16* p, f32x4 v) { u32x2 w; w.x = pk2(v[0], v[1]); w.y = pk2(v[2], v[3]); *(u32x2*)p = w; }

#define XB_TMO      128
#define XB_XCNT(j)  (256  + 64 * (j))
#define XB_XSUB(j)  (1280 + 64 * (j))
#define XB_XGEN(j)  (2304 + 64 * (j))
#define XB_TOP      3328
#define XB_TOPGEN   3392
#define XCD_BAR_WORDS 3456
#define XB_SPIN_CAP (1u << 24)
__device__ __forceinline__ unsigned xb_ld(unsigned* p)              { return __hip_atomic_load(p, __ATOMIC_RELAXED, __HIP_MEMORY_SCOPE_AGENT); }
__device__ __forceinline__ unsigned xb_add(unsigned* p, unsigned v) { return __hip_atomic_fetch_add(p, v, __ATOMIC_RELAXED, __HIP_MEMORY_SCOPE_AGENT); }
__device__ __forceinline__ unsigned xb_xcc_id() { return (unsigned)__builtin_amdgcn_s_getreg((3 << 11) | 20) & 0xFu; }
#define XB_SPIN(cond, bar) do { unsigned _sp = 0; while (cond) { __builtin_amdgcn_s_sleep(1); \
    if ((++_sp & 255u) == 0u) { if (xb_ld(&(bar)[XB_TMO])) break; if (_sp > XB_SPIN_CAP) { atomicAdd(&(bar)[XB_TMO], 1u); break; } } } } while (0)
struct XcdBarrier { unsigned* bar; unsigned x; volatile LAS unsigned* st; };
__device__ __forceinline__ XcdBarrier xcd_barrier_post(unsigned* bar, volatile LAS unsigned* st) {
    XcdBarrier b; b.bar = bar; b.x = xb_xcc_id(); b.st = st;
    if (threadIdx.x == 0) (void)xb_add(&bar[XB_XCNT(b.x)], 1u);
    return b;
}
__device__ __forceinline__ void xcd_barrier_complete(unsigned* bar, unsigned x, unsigned& nloc, unsigned& nx) {
    const unsigned G = gridDim.x * gridDim.y * gridDim.z;
    unsigned sum, cnt, mine, sp = 0u;
    for (;;) {
        sum = 0u; cnt = 0u; mine = 0u;
#pragma unroll
        for (unsigned j = 0; j < 16; ++j) { const unsigned c = xb_ld(&bar[XB_XCNT(j)]); sum += c; cnt += (c > 0u) ? 1u : 0u; mine = (j == x) ? c : mine; }
        if (sum == G) break;
        __builtin_amdgcn_s_sleep(1);
        if ((++sp & 255u) == 0u) { if (xb_ld(&bar[XB_TMO])) break; if (sp > XB_SPIN_CAP) { atomicAdd(&bar[XB_TMO], 1u); break; } }
    }
    nloc = mine > 0u ? mine : 1u; nx = cnt > 0u ? cnt : 1u;
}
__device__ __forceinline__ void xcd_barrier(const XcdBarrier& b) {
    asm volatile("s_waitcnt vmcnt(0)" ::: "memory");
    __syncthreads();
    if (threadIdx.x == 0) {
        unsigned* bar = b.bar;
        __builtin_amdgcn_s_waitcnt(0);
        unsigned nloc = b.st[0], nx = b.st[1];
        if (nloc == 0u) { xcd_barrier_complete(bar, b.x, nloc, nx); b.st[0] = nloc; b.st[1] = nx; }
        const unsigned old = xb_add(&bar[XB_XSUB(b.x)], 1u);
        const unsigned gen = old / nloc;
        if (old + 1u == (gen + 1u) * nloc) {
            __builtin_amdgcn_fence(__ATOMIC_RELEASE, "agent");
            asm volatile("s_waitcnt vmcnt(0)" ::: "memory");
            const unsigned og = xb_add(&bar[XB_TOP], 1u);
            const unsigned tg = og / nx;
            if (og + 1u == (tg + 1u) * nx) xb_add(&bar[XB_TOPGEN], 1u);
            else XB_SPIN(xb_ld(&bar[XB_TOPGEN]) == tg, bar);
            __builtin_amdgcn_fence(__ATOMIC_ACQUIRE, "agent");
            xb_add(&bar[XB_XGEN(b.x)], 1u);
            asm volatile("s_waitcnt vmcnt(0)" ::: "memory");
        } else {
            XB_SPIN(xb_ld(&bar[XB_XGEN(b.x)]) == gen, bar);
            __builtin_amdgcn_fence(__ATOMIC_ACQUIRE, "agent");
            asm volatile("s_waitcnt vmcnt(0)" ::: "memory");
        }
    }
    __syncthreads();
}

__device__ __forceinline__ int TID() { int t = threadIdx.x; asm volatile("" : "+v"(t)); return t; }
__device__ __forceinline__ int BID() { int t = blockIdx.x; asm volatile("" : "+s"(t)); return t; }
__device__ __forceinline__ int GRD() { int t = gridDim.x; asm volatile("" : "+s"(t)); return t; }

struct UnitDesc {
    const bf16* A;
    const bf16* B;
    const int* ridx;
    const float* rw;
    int row0, col0;
    int nvalid;
    int gather;
};

template <class Epi>
__device__ __forceinline__ void gemm_unit_naive(unsigned char* smem, const UnitDesc& u, int K, int lda, int ldb, const Epi& E) {
    float* As = (float*)smem;
    float* Bs = As + 16 * 128;
    const int tid = TID(), ty = tid >> 4, tx = tid & 15;
    const int lr = tid >> 1, lk = (tid & 1) * 8;
    const bf16* brow = u.B + (size_t)lr * ldb;
    const int cb = (tx >> 2) * 32 + (tx & 3) * 4;
#pragma unroll 1
    for (int half = 0; half < 2; ++half) {
        float acc[4][16];
#pragma unroll
        for (int i = 0; i < 4; ++i)
#pragma unroll
            for (int j = 0; j < 16; ++j) acc[i][j] = 0.f;
        const int ar = half * 128 + (lr & 127);
        const bf16* arow;
        if (u.gather) { const int rr = ar < u.nvalid ? ar : 0; arow = u.A + (size_t)(u.ridx[rr] >> 1) * lda; }
        else arow = u.A + (size_t)ar * lda;
#pragma unroll 1
        for (int k0 = 0; k0 < K; k0 += 16) {
            const u32x4 bv = *(const u32x4*)(brow + k0 + lk);
            u32x4 av = {0u, 0u, 0u, 0u};
            if (tid < 256) av = *(const u32x4*)(arow + k0 + lk);
            __syncthreads();
#pragma unroll
            for (int j = 0; j < 4; ++j) {
                if (tid < 256) { As[(lk + 2 * j) * 128 + lr] = blo(av[j]); As[(lk + 2 * j + 1) * 128 + lr] = bhi(av[j]); }
                Bs[(lk + 2 * j) * 256 + lr] = blo(bv[j]); Bs[(lk + 2 * j + 1) * 256 + lr] = bhi(bv[j]);
            }
            __syncthreads();
#pragma unroll 4
            for (int kk = 0; kk < 16; ++kk) {
                float b[16];
                const f32x4 a0 = *(const f32x4*)(As + kk * 128 + ty * 4);
#pragma unroll
                for (int g = 0; g < 2; ++g)
#pragma unroll
                    for (int h2 = 0; h2 < 2; ++h2) {
                        const f32x4 bq = *(const f32x4*)(Bs + kk * 256 + g * 128 + cb + h2 * 16);
                        b[g * 8 + h2 * 4 + 0] = bq[0]; b[g * 8 + h2 * 4 + 1] = bq[1]; b[g * 8 + h2 * 4 + 2] = bq[2]; b[g * 8 + h2 * 4 + 3] = bq[3];
                    }
#pragma unroll
                for (int i = 0; i < 4; ++i)
#pragma unroll
                    for (int j = 0; j < 16; ++j) acc[i][j] = fmaf(a0[i], b[j], acc[i][j]);
            }
        }
        __syncthreads();
        float* Ct = (float*)smem;
#pragma unroll
        for (int i = 0; i < 4; ++i)
#pragma unroll
            for (int g = 0; g < 2; ++g) {
                *(f32x4*)(Ct + (ty * 4 + i) * 260 + g * 128 + cb) = (f32x4){acc[i][g * 8 + 0], acc[i][g * 8 + 1], acc[i][g * 8 + 2], acc[i][g * 8 + 3]};
                *(f32x4*)(Ct + (ty * 4 + i) * 260 + g * 128 + cb + 16) = (f32x4){acc[i][g * 8 + 4], acc[i][g * 8 + 5], acc[i][g * 8 + 6], acc[i][g * 8 + 7]};
            }
        __syncthreads();
#pragma unroll 1
        for (int item = tid; item < 128 * 32; item += 512) {
            const int rr = item >> 5, cg = item & 31, c = (cg >> 4) * 128 + ((cg & 15) >> 2) * 32 + (cg & 3) * 4, r = half * 128 + rr;
            if (r < u.nvalid) { const f32x4 v0 = *(const f32x4*)(Ct + rr * 260 + c), v1 = *(const f32x4*)(Ct + rr * 260 + c + 16); E(u, r, c, v0, v1); }
        }
        __syncthreads();
    }
}

struct EpiBf16Store { bf16* O; int ldo; float scale;
    __device__ __forceinline__ void operator()(const UnitDesc& u, int r, int c, f32x4 v0, f32x4 v1) const {
        bf16* o = O + (size_t)(u.row0 + r) * ldo + u.col0 + c; st_bf4(o, v0 * scale); st_bf4(o + 16, v1 * scale); } };
struct EpiResid { const float* res; float* out;
    __device__ __forceinline__ void operator()(const UnitDesc& u, int r, int c, f32x4 v0, f32x4 v1) const {
        const size_t o = (size_t)(u.row0 + r) * DM + u.col0 + c;
        const f32x4 r0 = *(const f32x4*)(res + o), r1 = *(const f32x4*)(res + o + 16);
        *(f32x4*)(out + o) = r0 * ALPHA + v0; *(f32x4*)(out + o + 16) = r1 * ALPHA + v1; } };
struct EpiG23 { bf16 *QP, *KP, *VP; const float* RS; const float* ROPE;
    __device__ __forceinline__ void grp(int row, int c, f32x4 v) const {
        const int b = row >> 11, s = row & 2047;
        if (c < 768) {
            const int h = c / 96, j = c - h * 96; const float rs = RS[row * 2] * QSCALE;
            v = v * rs;
            if (j >= 64) { const int i = (j - 64) >> 1; const f32x4 cs = *(const f32x4*)(ROPE + ((size_t)row * 16 + i) * 2);
                v = (f32x4){v[0] * cs[0] - v[1] * cs[1], v[1] * cs[0] + v[0] * cs[1], v[2] * cs[2] - v[3] * cs[3], v[3] * cs[2] + v[2] * cs[3]}; }
            st_bf4(QP + ((size_t)((b * 8 + h) * SEQ + s)) * 96 + j, v);
        } else {
            const int cc = c - 768, h = cc / 160, j = cc - h * 160; const float rs = RS[row * 2 + 1];
            if (j < 64) st_bf4(KP + ((size_t)((b * 8 + h) * SEQ + s)) * 96 + j, v * rs);
            else if (j < 96) { const int i = (j - 64) >> 1; const f32x4 cs = *(const f32x4*)(ROPE + ((size_t)row * 16 + i) * 2);
                v = (f32x4){v[0] * cs[0] - v[1] * cs[1], v[1] * cs[0] + v[0] * cs[1], v[2] * cs[2] - v[3] * cs[3], v[3] * cs[2] + v[2] * cs[3]};
                st_bf4(KP + ((size_t)((b * 8 + h) * SEQ + s)) * 96 + j, v); }
            else st_bf4(VP + ((size_t)((b * 8 + h) * SEQ + s)) * 64 + (j - 96), v * rs);
        }
    }
    __device__ __forceinline__ void operator()(const UnitDesc& u, int r, int c, f32x4 v0, f32x4 v1) const {
        grp(u.row0 + r, u.col0 + c, v0); grp(u.row0 + r, u.col0 + c + 16, v1); } };
struct EpiMoe1 { bf16* H;
    __device__ __forceinline__ void operator()(const UnitDesc& u, int r, int c, f32x4 v0, f32x4 v1) const {
        f32x4 h;
#pragma unroll
        for (int j = 0; j < 4; ++j) h[j] = siluf(v0[j]) * v1[j];
        st_bf4(H + (size_t)(u.row0 + r) * 256 + u.col0 + (c >> 5) * 16 + (c & 15), h); } };
struct EpiMoe2 { bf16* CT;
    __device__ __forceinline__ void operator()(const UnitDesc& u, int r, int c, f32x4 v0, f32x4 v1) const {
        const int ent = u.ridx[r]; const float w = u.rw[r];
        bf16* o = CT + ((size_t)(ent & 1) * NTOK + (ent >> 1)) * DM + u.col0 + c; st_bf4(o, v0 * w); st_bf4(o + 16, v1 * w); } };

template <class F>
__device__ __forceinline__ void conv_item(const F& src, bf16* dst, int K, float* scr, int k0, int n0, int lane) {
#pragma unroll 8
    for (int i = 0; i < 32; ++i) { const int kk = 2 * i + (lane >> 5); scr[kk * 33 + (lane & 31)] = src(k0 + kk, n0 + (lane & 31)); }
    asm volatile("s_waitcnt lgkmcnt(0)" ::: "memory");
    const int c = lane & 7;
#pragma unroll
    for (int j = 0; j < 4; ++j) { const int n = (lane >> 3) + 8 * j; const float* s = scr + (8 * c) * 33 + n;
        u32x4 o; o.x = pk2(s[0 * 33], s[1 * 33]); o.y = pk2(s[2 * 33], s[3 * 33]); o.z = pk2(s[4 * 33], s[5 * 33]); o.w = pk2(s[6 * 33], s[7 * 33]);
        *(u32x4*)(dst + (size_t)(n0 + n) * K + k0 + 8 * c) = o; }
    asm volatile("s_waitcnt lgkmcnt(0)" ::: "memory");
}
__device__ __forceinline__ int yc_src(int n) {
    if (n < 1024) return n;
    if (n < 2048) return n + 16;
    if (n < 2304) return n + 24;
    if (n < 2320) return 1024 + (n - 2304);
    if (n < 2328) return 2064 + (n - 2320);
    if (n < 2488) return n;
    return -1;
}

__device__ __forceinline__ void phase_conv(const Params& p, int l, unsigned char* smem) {
    const int tid = TID(), lane = tid & 63, wave = tid >> 6;
    const int gw = BID() * 8 + wave, NGW = GRD() * 8;
    float* scr = (float*)smem + wave * (64 * 33 + 16);
    unsigned char* ws = p.ws;
    const float* w_in = p.in[3] + (size_t)l * 1024 * 2488;
    const float* w_out = p.in[4] + (size_t)l * 1024 * 1024;
    const float* gq = p.in[12] + l * 256; const float* w_uq = p.in[13] + (size_t)l * 256 * 768;
    const float* gkv = p.in[14] + l * 128; const float* w_ukv = p.in[15] + (size_t)l * 128 * 1024;
    const float* xwq = p.in[16] + (size_t)l * 1024 * 1024; const float* xwkv = p.in[17] + (size_t)l * 1024 * 2048; const float* xwo = p.in[18] + (size_t)l * 1024 * 1024;
    const float* wg = p.in[23] + (size_t)l * 32 * 1024 * 256; const float* wu = p.in[24] + (size_t)l * 32 * 1024 * 256; const float* wd = p.in[25] + (size_t)l * 32 * 256 * 1024;
    constexpr int I_IN = 16 * 80, I_Q = 4 * 24, I_KV = 4 * 40, I_SQ = 16 * 32, I_XKV = 16 * 64, I_GU = 32 * 16 * 16, I_DN = 32 * 4 * 32;
    constexpr int NIT = I_IN + I_Q + I_KV + 3 * I_SQ + I_XKV + I_GU + I_DN;
    for (int it = gw; it < NIT; it += NGW) {
        int r = it;
        if (r < I_IN) { const int kb = r / 80, nb = r % 80;
            conv_item([&](int k, int n) { const int s = yc_src(n); return s >= 0 ? w_in[(size_t)k * 2488 + s] : 0.f; }, (bf16*)(ws + W_IN), 1024, scr, kb * 64, nb * 32, lane); continue; }
        r -= I_IN;
        if (r < I_Q) { const int kb = r / 24, nb = r % 24;
            conv_item([&](int k, int n) { const int h = n / 96, j = n - h * 96; int sc = h * 96 + j; if (j >= 64) { const int jj = j - 64; sc = h * 96 + 64 + (jj >> 1) + 16 * (jj & 1); }
                return gq[k] * w_uq[(size_t)k * 768 + sc]; }, (bf16*)(ws + W_Q), 256, scr, kb * 64, nb * 32, lane); continue; }
        r -= I_Q;
        if (r < I_KV) { const int kb = r / 40, nb = r % 40;
            conv_item([&](int k, int n) { const int h = n / 160, j = n - h * 160;
                if (j >= 64 && j < 96) { const int jj = j - 64; return (k == 152 + (jj >> 1) + 16 * (jj & 1)) ? 1.f : 0.f; }
                const int col = (j < 64) ? h * 128 + j : h * 128 + 64 + (j - 96);
                return (k >= 24 && k < 152) ? gkv[k - 24] * w_ukv[(size_t)(k - 24) * 1024 + col] : 0.f; }, (bf16*)(ws + W_KV), 256, scr, kb * 64, nb * 32, lane); continue; }
        r -= I_KV;
        if (r < 3 * I_SQ) { const int m = r / I_SQ, q = r % I_SQ, kb = q / 32, nb = q % 32; const float* W = m == 0 ? w_out : (m == 1 ? xwq : xwo);
            bf16* D = (bf16*)(ws + (m == 0 ? W_OUT : (m == 1 ? W_XQ : W_XO)));
            conv_item([&](int k, int n) { return W[(size_t)k * 1024 + n]; }, D, 1024, scr, kb * 64, nb * 32, lane); continue; }
        r -= 3 * I_SQ;
        if (r < I_XKV) { const int kb = r / 64, nb = r % 64;
            conv_item([&](int k, int n) { return xwkv[(size_t)k * 2048 + n]; }, (bf16*)(ws + W_XKV), 1024, scr, kb * 64, nb * 32, lane); continue; }
        r -= I_XKV;
        if (r < I_GU) { const int e = r / 256, q = r % 256, kb = q / 16, nb = q % 16; const float* G = wg + (size_t)e * 1024 * 256; const float* U = wu + (size_t)e * 1024 * 256;
            conv_item([&](int k, int n) { const int j = (n >> 5) * 16 + (n & 15); return ((n >> 4) & 1) ? U[(size_t)k * 256 + j] : G[(size_t)k * 256 + j]; },
                      (bf16*)(ws + W_GU) + (size_t)e * 512 * 1024, 1024, scr, kb * 64, nb * 32, lane); continue; }
        r -= I_GU;
        { const int e = r / 128, q = r % 128, kb = q / 32, nb = q % 32; const float* Dn = wd + (size_t)e * 256 * 1024;
            conv_item([&](int k, int n) { return Dn[(size_t)k * 1024 + n]; }, (bf16*)(ws + W_DN) + (size_t)e * 1024 * 256, 256, scr, kb * 64, nb * 32, lane); }
    }
    if (l == 0) {
        const size_t gt = (size_t)BID() * 512 + tid, GT = (size_t)GRD() * 512;
        const float* x = p.in[0]; bf16* XB = (bf16*)(ws + WS_XB);
        for (size_t i = gt; i < (size_t)NTOK * DM / 8; i += GT) { const f32x4 a = *(const f32x4*)(x + i * 8), b = *(const f32x4*)(x + i * 8 + 4);
            u32x4 o; o.x = pk2(a[0], a[1]); o.y = pk2(a[2], a[3]); o.z = pk2(b[0], b[1]); o.w = pk2(b[2], b[3]); *(u32x4*)(XB + i * 8) = o; }
        const float* mem = p.in[1]; bf16* MB = (bf16*)(ws + WS_MEMB);
        for (size_t i = gt; i < (size_t)2048 * DM / 8; i += GT) { const f32x4 a = *(const f32x4*)(mem + i * 8), b = *(const f32x4*)(mem + i * 8 + 4);
            u32x4 o; o.x = pk2(a[0], a[1]); o.y = pk2(a[2], a[3]); o.z = pk2(b[0], b[1]); o.w = pk2(b[2], b[3]); *(u32x4*)(MB + i * 8) = o; }
        const int* pos = (const int*)p.in[2]; float* ROPE = (float*)(ws + WS_ROPE);
        for (size_t i = gt; i < (size_t)NTOK * 16; i += GT) { const int t = (int)(i >> 4), f = (int)(i & 15);
            const double inv = exp(-(double)f * (9.210340371976184 / 16.0)); const double rev = (double)pos[t] * inv * 0.15915494309189535; const float fr = (float)(rev - floor(rev));
            ROPE[i * 2] = __builtin_amdgcn_cosf(fr); ROPE[i * 2 + 1] = __builtin_amdgcn_sinf(fr); }
    }
}

__device__ __forceinline__ void gla_cum(const Params& p, int l, float* bs, int t0, int h) {
    const int tid = TID(), t = tid >> 3, dg = tid & 7;
    const bf16* Y = (const bf16*)(p.ws + WS_Y);
    const float* w_a2 = p.in[5] + l * 16 * 256; const float* b_a = p.in[6] + l * 256;
    float a[16];
    { const u32x4 a0 = *(const u32x4*)(Y + (size_t)(t0 + t) * YW + Y_A), a1 = *(const u32x4*)(Y + (size_t)(t0 + t) * YW + Y_A + 8);
#pragma unroll
      for (int j = 0; j < 4; ++j) { a[2 * j] = blo(a0[j]); a[2 * j + 1] = bhi(a0[j]); a[8 + 2 * j] = blo(a1[j]); a[8 + 2 * j + 1] = bhi(a1[j]); } }
#pragma unroll
    for (int j = 0; j < 8; ++j) { const int d = dg * 8 + j; float z = b_a[h * 64 + d];
#pragma unroll
        for (int q = 0; q < 16; ++q) z = fmaf(a[q], w_a2[q * 256 + h * 64 + d], z);
        bs[t * 65 + d] = logsigmoid(z) * (1.f / 16.f); }
    __syncthreads();
    if (tid < 64) { float s = 0.f; for (int tt = 0; tt < 64; ++tt) { s += bs[tt * 65 + tid]; bs[tt * 65 + tid] = s; } }
    __syncthreads();
}
__device__ __forceinline__ void ml_gates(const Params& p, int l, float* fc, float* aa, float* pm, int t0, int h) {
    const int tid = TID();
    const bf16* Y = (const bf16*)(p.ws + WS_Y);
    if (tid < 64) { const float fp = bf2f(Y[(size_t)(t0 + tid) * YW + Y_MF + h]) + p.in[10][l * 4 + h]; const float ig = bf2f(Y[(size_t)(t0 + tid) * YW + Y_MI + h]) + p.in[9][l * 4 + h];
        fc[tid] = logsigmoid(fp); aa[tid] = ig; }
    __syncthreads();
    if (tid == 0) { float s = 0.f, m = -3.0e38f; for (int i = 0; i < 64; ++i) { s += fc[i]; fc[i] = s; const float a = aa[i] - s; aa[i] = a; m = fmaxf(m, a); pm[i] = m; } }
    __syncthreads();
}
__device__ __forceinline__ void ml_conv(const Params& p, int l, float* dst, int t0, int c, int ycol, int wch, int h, float scale) {
    const int tid = TID(), s = tid >> 3, dg = tid & 7;
    const bf16* Y = (const bf16*)(p.ws + WS_Y); const float* w = p.in[8] + l * 4 * 512;
    float acc[8];
#pragma unroll
    for (int j = 0; j < 8; ++j) acc[j] = 0.f;
#pragma unroll
    for (int q = 0; q < 4; ++q) { const int ss = c * 64 + s - 3 + q;
        if (ss >= 0) { const u32x4 v = *(const u32x4*)(Y + (size_t)(t0 + s - 3 + q) * YW + ycol + h * 64 + dg * 8); const float* wr = w + q * 512 + wch + h * 64 + dg * 8;
#pragma unroll
            for (int j = 0; j < 4; ++j) { acc[2 * j] = fmaf(wr[2 * j], blo(v[j]), acc[2 * j]); acc[2 * j + 1] = fmaf(wr[2 * j + 1], bhi(v[j]), acc[2 * j + 1]); } } }
#pragma unroll
    for (int j = 0; j < 8; ++j) dst[s * 65 + dg * 8 + j] = siluf(acc[j]) * scale;
}
__device__ __forceinline__ void ld_blk(float* dst, const bf16* src, int ld) {
    const int tid = TID(), s = tid >> 3, dg = tid & 7; const u32x4 v = *(const u32x4*)(src + (size_t)s * ld + dg * 8);
#pragma unroll
    for (int j = 0; j < 4; ++j) { dst[s * 65 + dg * 8 + 2 * j] = blo(v[j]); dst[s * 65 + dg * 8 + 2 * j + 1] = bhi(v[j]); }
}

__device__ __forceinline__ void phase_loc(const Params& p, int l, unsigned char* smem) {
    const int tid = TID(), lane = tid & 63, wave = tid >> 6;
    unsigned char* ws = p.ws; const bf16* Y = (const bf16*)(ws + WS_Y);
    float* A0 = (float*)smem; float* A1 = A0 + 64 * 65; float* A2 = A1 + 64 * 65; float* fc = A2 + 64 * 65; float* aa = fc + 64; float* pm = aa + 64;
    float* ST = (float*)(ws + WS_ST); float* NV = (float*)(ws + WS_NV); float* DEC = (float*)(ws + WS_DEC); float* SC = (float*)(ws + WS_SC);
    for (int u = BID(); u < 2048; u += GRD()) {
        const int type = u >> 10, r = u & 1023, bh = r >> 5, c = r & 31, b = bh >> 2, h = bh & 3, t0 = b * SEQ + c * 64;
        const int d = tid >> 3, e0 = (tid & 7) * 8;
        __syncthreads();
        if (type == 0) {
            gla_cum(p, l, A0, t0, h);
            ld_blk(A1, Y + (size_t)t0 * YW + Y_GK + h * 64, YW);
            ld_blk(A2, Y + (size_t)t0 * YW + Y_GV + h * 64, YW);
            __syncthreads();
            for (int i = tid; i < 4096; i += 512) { const int s = i >> 6, dd = i & 63; A1[s * 65 + dd] *= expf(A0[63 * 65 + dd] - A0[s * 65 + dd]); }
            __syncthreads();
            float acc[8];
#pragma unroll
            for (int j = 0; j < 8; ++j) acc[j] = 0.f;
            for (int s = 0; s < 64; ++s) { const float kv = A1[s * 65 + d];
#pragma unroll
                for (int j = 0; j < 8; ++j) acc[j] = fmaf(kv, A2[s * 65 + e0 + j], acc[j]); }
            float* o = ST + (size_t)u * 4096 + d * 64 + e0;
            *(f32x4*)o = (f32x4){acc[0], acc[1], acc[2], acc[3]}; *(f32x4*)(o + 4) = (f32x4){acc[4], acc[5], acc[6], acc[7]};
            if (tid < 64) DEC[(size_t)r * 64 + tid] = expf(A0[63 * 65 + tid]);
        } else {
            ml_gates(p, l, fc, aa, pm, t0, h);
            ml_conv(p, l, A1, t0, c, Y_MK, 256, h, 1.f);
            ld_blk(A2, Y + (size_t)t0 * YW + Y_MV + h * 64, YW);
            __syncthreads();
            const float M63 = pm[63];
            for (int i = tid; i < 4096; i += 512) { const int s = i >> 6, dd = i & 63; A1[s * 65 + dd] *= expf(aa[s] - M63); }
            __syncthreads();
            float acc[8]; float nn = 0.f;
#pragma unroll
            for (int j = 0; j < 8; ++j) acc[j] = 0.f;
            for (int s = 0; s < 64; ++s) { const float kv = A1[s * 65 + d]; nn += kv;
#pragma unroll
                for (int j = 0; j < 8; ++j) acc[j] = fmaf(kv, A2[s * 65 + e0 + j], acc[j]); }
            float* o = ST + (size_t)u * 4096 + d * 64 + e0;
            *(f32x4*)o = (f32x4){acc[0], acc[1], acc[2], acc[3]}; *(f32x4*)(o + 4) = (f32x4){acc[4], acc[5], acc[6], acc[7]};
            if ((tid & 7) == 0) NV[(size_t)r * 64 + d] = nn;
            if (tid == 0) { SC[r * 2] = fc[63]; SC[r * 2 + 1] = fc[63] + M63; }
        }
    }
    float* RS = (float*)(ws + WS_RS);
    for (int row = BID() * 8 + wave; row < NTOK; row += GRD() * 8) {
        const u32x2 q = *(const u32x2*)(Y + (size_t)row * YW + Y_CQ + lane * 4); const unsigned kv = *(const unsigned*)(Y + (size_t)row * YW + Y_CKV + lane * 2);
        float sq = blo(q.x) * blo(q.x) + bhi(q.x) * bhi(q.x) + blo(q.y) * blo(q.y) + bhi(q.y) * bhi(q.y); float sk = blo(kv) * blo(kv) + bhi(kv) * bhi(kv);
        sq = wave_sum(sq); sk = wave_sum(sk);
        if (lane == 0) { RS[row * 2] = 1.f / sqrtf(sq * (1.f / 256.f) + LN_EPS); RS[row * 2 + 1] = 1.f / sqrtf(sk * (1.f / 128.f) + LN_EPS); }
    }
}

__device__ __forceinline__ void phase_scan(const Params& p, int l) {
    unsigned char* ws = p.ws;
    float* ST = (float*)(ws + WS_ST); float* NV = (float*)(ws + WS_NV); const float* DEC = (const float*)(ws + WS_DEC); const float* SC = (const float*)(ws + WS_SC); float* MS = (float*)(ws + WS_MS);
    const int gt = BID() * 512 + TID(), GT = GRD() * 512;
    for (int idx = gt; idx < 64 * 4096; idx += GT) {
        const int seq = idx >> 12, el = idx & 4095, d = el >> 6;
        float* st = ST + (size_t)seq * 32 * 4096 + el;
        if (seq < 32) { float S = 0.f; const float* dc = DEC + (size_t)seq * 32 * 64 + d;
#pragma unroll 4
            for (int c = 0; c < 32; ++c) { const float tmp = st[(size_t)c * 4096]; st[(size_t)c * 4096] = S; S = fmaf(dc[c * 64], S, tmp); } }
        else { const int sq = seq - 32; float C = 0.f, m = 0.f; const float* sc = SC + (size_t)sq * 32 * 2;
#pragma unroll 4
            for (int c = 0; c < 32; ++c) { const float F = sc[c * 2], ml = sc[c * 2 + 1]; const float tmp = st[(size_t)c * 4096]; st[(size_t)c * 4096] = C;
                const float mn = fmaxf(F + m, ml); C = expf(F + m - mn) * C + expf(ml - mn) * tmp; m = mn; } }
    }
    for (int idx = gt; idx < 32 * 64; idx += GT) {
        const int sq = idx >> 6, d = idx & 63; float n = 0.f, m = 0.f; const float* sc = SC + (size_t)sq * 32 * 2; float* nv = NV + (size_t)sq * 32 * 64 + d;
#pragma unroll 2
        for (int c = 0; c < 32; ++c) { const float F = sc[c * 2], ml = sc[c * 2 + 1]; const float tmp = nv[c * 64]; nv[c * 64] = n; if (d == 0) MS[sq * 32 + c] = m;
            const float mn = fmaxf(F + m, ml); n = expf(F + m - mn) * n + expf(ml - mn) * tmp; m = mn; }
    }
}

template <int DQK, int DV>
__device__ __forceinline__ void attn_naive(unsigned char* smem, const bf16* Q, int qs, const bf16* K, int ks, const bf16* V, int vs, int nk, bf16* O, int os) {
    constexpr int LQ = DQK + 8, LV = DV + 8, EV = DV / 8;
    bf16* Qs = (bf16*)smem; bf16* Ks = Qs + 64 * LQ; bf16* Vs = Ks + 64 * LQ; float* Ss = (float*)(Vs + 64 * LV);
    const int tid = TID(), t = tid >> 3, g = tid & 7;
    __syncthreads();
    for (int i = tid; i < 64 * DQK / 8; i += 512) { const int r = i / (DQK / 8), c8 = i % (DQK / 8); *(u32x4*)(Qs + r * LQ + c8 * 8) = *(const u32x4*)(Q + (size_t)r * qs + c8 * 8); }
    float acc[EV]; float m = -3.0e38f, lsum = 0.f;
#pragma unroll
    for (int j = 0; j < EV; ++j) acc[j] = 0.f;
    for (int k0 = 0; k0 < nk; k0 += 64) {
        __syncthreads();
        for (int i = tid; i < 64 * DQK / 8; i += 512) { const int r = i / (DQK / 8), c8 = i % (DQK / 8); *(u32x4*)(Ks + r * LQ + c8 * 8) = *(const u32x4*)(K + (size_t)(k0 + r) * ks + c8 * 8); }
        for (int i = tid; i < 64 * DV / 8; i += 512) { const int r = i / (DV / 8), c8 = i % (DV / 8); *(u32x4*)(Vs + r * LV + c8 * 8) = *(const u32x4*)(V + (size_t)(k0 + r) * vs + c8 * 8); }
        __syncthreads();
        float sc[8];
#pragma unroll
        for (int j = 0; j < 8; ++j) sc[j] = 0.f;
        for (int d8 = 0; d8 < DQK / 8; ++d8) { const u32x4 qv = *(const u32x4*)(Qs + t * LQ + d8 * 8);
#pragma unroll
            for (int j = 0; j < 8; ++j) { const u32x4 kv = *(const u32x4*)(Ks + (g + 8 * j) * LQ + d8 * 8);
#pragma unroll
                for (int q = 0; q < 4; ++q) sc[j] = fmaf(blo(qv[q]), blo(kv[q]), fmaf(bhi(qv[q]), bhi(kv[q]), sc[j])); } }
        float mx = sc[0];
#pragma unroll
        for (int j = 1; j < 8; ++j) mx = fmaxf(mx, sc[j]);
        mx = fmaxf(mx, __shfl_xor(mx, 1)); mx = fmaxf(mx, __shfl_xor(mx, 2)); mx = fmaxf(mx, __shfl_xor(mx, 4));
        const float mn = fmaxf(m, mx), al = exp2f(m - mn); float ps = 0.f;
#pragma unroll
        for (int j = 0; j < 8; ++j) { const float pv = exp2f(sc[j] - mn); ps += pv; Ss[t * 65 + g + 8 * j] = pv; }
        ps += __shfl_xor(ps, 1); ps += __shfl_xor(ps, 2); ps += __shfl_xor(ps, 4);
        lsum = lsum * al + ps; m = mn;
#pragma unroll
        for (int j = 0; j < EV; ++j) acc[j] *= al;
        __syncthreads();
        for (int kk = 0; kk < 64; ++kk) { const float pv = Ss[t * 65 + kk];
#pragma unroll
            for (int j8 = 0; j8 < EV / 8; ++j8) { const u32x4 vv = *(const u32x4*)(Vs + kk * LV + g * EV + j8 * 8);
#pragma unroll
                for (int q = 0; q < 4; ++q) { acc[j8 * 8 + 2 * q] = fmaf(pv, blo(vv[q]), acc[j8 * 8 + 2 * q]); acc[j8 * 8 + 2 * q + 1] = fmaf(pv, bhi(vv[q]), acc[j8 * 8 + 2 * q + 1]); } } }
    }
    const float inv = 1.f / lsum;
#pragma unroll
    for (int j8 = 0; j8 < EV / 8; ++j8) { u32x4 o; o.x = pk2(acc[j8 * 8] * inv, acc[j8 * 8 + 1] * inv); o.y = pk2(acc[j8 * 8 + 2] * inv, acc[j8 * 8 + 3] * inv);
        o.z = pk2(acc[j8 * 8 + 4] * inv, acc[j8 * 8 + 5] * inv); o.w = pk2(acc[j8 * 8 + 6] * inv, acc[j8 * 8 + 7] * inv);
        *(u32x4*)(O + (size_t)t * os + g * EV + j8 * 8) = o; }
}

__device__ __forceinline__ void mix_linear_unit(const Params& p, int l, unsigned char* smem, int u) {
    const int tid = TID(); unsigned char* ws = p.ws; const bf16* Y = (const bf16*)(ws + WS_Y);
    float* A0 = (float*)smem; float* A1 = A0 + 64 * 65; float* A2 = A1 + 64 * 65; float* A3 = A2 + 64 * 65; float* A4 = A3 + 64 * 65; float* A5 = A4 + 64 * 65;
    float* fc = A5 + 64 * 65; float* aa = fc + 64; float* pm = aa + 64; float* nv = pm + 64;
    const float* ST = (const float*)(ws + WS_ST); const float* NV = (const float*)(ws + WS_NV); const float* MS = (const float*)(ws + WS_MS);
    bf16* MIX = (bf16*)(ws + WS_XB);
    const int type = u >> 10, r = u & 1023, bh = r >> 5, c = r & 31, b = bh >> 2, h = bh & 3, t0 = b * SEQ + c * 64;
    const int t = tid >> 3, g = tid & 7, e0 = g * 8;
    __syncthreads();
    for (int i = tid; i < 4096; i += 512) A3[(i >> 6) * 65 + (i & 63)] = ST[(size_t)u * 4096 + i];
    ld_blk(A2, Y + (size_t)t0 * YW + (type == 0 ? Y_GV : Y_MV) + h * 64, YW);
    float mst = 0.f;
    if (type == 0) {
        gla_cum(p, l, A0, t0, h);
        ld_blk(A4, Y + (size_t)t0 * YW + Y_GQ + h * 64, YW); ld_blk(A1, Y + (size_t)t0 * YW + Y_GK + h * 64, YW);
        __syncthreads();
        for (int i = tid; i < 4096; i += 512) { const int s = i >> 6, dd = i & 63; const float bb = A0[s * 65 + dd]; A4[s * 65 + dd] *= 0.125f * expf(bb); A1[s * 65 + dd] *= expf(-bb); }
    } else {
        ml_gates(p, l, fc, aa, pm, t0, h);
        ml_conv(p, l, A4, t0, c, Y_MQ, 0, h, 0.125f); ml_conv(p, l, A1, t0, c, Y_MK, 256, h, 1.f);
        if (tid < 64) nv[tid] = NV[(size_t)r * 64 + tid];
        mst = MS[r];
    }
    __syncthreads();
    const float mm = (type == 1) ? fmaxf(mst, pm[t]) : 0.f;
    {
        float sc[8];
#pragma unroll
        for (int j = 0; j < 8; ++j) sc[j] = 0.f;
        for (int d = 0; d < 64; ++d) { const float qv = A4[t * 65 + d];
#pragma unroll
            for (int j = 0; j < 8; ++j) sc[j] = fmaf(qv, A1[(g + 8 * j) * 65 + d], sc[j]); }
#pragma unroll
        for (int j = 0; j < 8; ++j) { const int s = g + 8 * j; float w = (s <= t) ? sc[j] : 0.f; if (type == 1) w = (s <= t) ? w * expf(aa[s] - mm) : 0.f; A5[t * 65 + s] = w; }
    }
    __syncthreads();
    float acc[8], inter[8];
#pragma unroll
    for (int j = 0; j < 8; ++j) { acc[j] = 0.f; inter[j] = 0.f; }
    for (int d = 0; d < 64; ++d) { const float qv = A4[t * 65 + d];
#pragma unroll
        for (int j = 0; j < 8; ++j) inter[j] = fmaf(qv, A3[d * 65 + e0 + j], inter[j]); }
    for (int s = 0; s < 64; ++s) { const float pv = A5[t * 65 + s];
#pragma unroll
        for (int j = 0; j < 8; ++j) acc[j] = fmaf(pv, A2[s * 65 + e0 + j], acc[j]); }
    float o[8];
    if (type == 0) {
#pragma unroll
        for (int j = 0; j < 8; ++j) o[j] = acc[j] + inter[j];
    } else {
        const float wi = expf(mst - mm);
        float dn = 0.f;
#pragma unroll
        for (int j = 0; j < 8; ++j) dn += wi * A4[t * 65 + e0 + j] * nv[e0 + j] + A5[t * 65 + e0 + j];
        dn += __shfl_xor(dn, 1); dn += __shfl_xor(dn, 2); dn += __shfl_xor(dn, 4);
        const float mt = fc[t] + mm; const float den = fmaxf(fabsf(dn), expf(-mt)); const float inv = 1.f / den;
#pragma unroll
        for (int j = 0; j < 8; ++j) o[j] = (wi * inter[j] + acc[j]) * inv;
    }
    float s1 = 0.f;
#pragma unroll
    for (int j = 0; j < 8; ++j) s1 += o[j];
    s1 += __shfl_xor(s1, 1); s1 += __shfl_xor(s1, 2); s1 += __shfl_xor(s1, 4);
    const float mu = s1 * (1.f / 64.f); float s2 = 0.f;
#pragma unroll
    for (int j = 0; j < 8; ++j) { o[j] -= mu; s2 += o[j] * o[j]; }
    s2 += __shfl_xor(s2, 1); s2 += __shfl_xor(s2, 2); s2 += __shfl_xor(s2, 4);
    const float rstd = 1.f / sqrtf(s2 * (1.f / 64.f) + LN_EPS);
    const float* gn = (type == 0 ? p.in[7] : p.in[11]) + l * 256 + h * 64 + e0;
    const u32x4 gv = *(const u32x4*)(Y + (size_t)(t0 + t) * YW + (type == 0 ? Y_GR : Y_MO) + h * 64 + e0);
    float gate[8];
#pragma unroll
    for (int j = 0; j < 4; ++j) { gate[2 * j] = blo(gv[j]); gate[2 * j + 1] = bhi(gv[j]); }
    float res[8];
#pragma unroll
    for (int j = 0; j < 8; ++j) res[j] = o[j] * rstd * gn[j] * (type == 0 ? siluf(gate[j]) : sigmoidf(gate[j]));
    u32x4 ov; ov.x = pk2(res[0], res[1]); ov.y = pk2(res[2], res[3]); ov.z = pk2(res[4], res[5]); ov.w = pk2(res[6], res[7]);
    *(u32x4*)(MIX + (size_t)(t0 + t) * DM + type * 256 + h * 64 + e0) = ov;
}

__device__ __forceinline__ void phase_mix(const Params& p, int l, unsigned char* smem) {
    unsigned char* ws = p.ws;
    const bf16* QP = (const bf16*)(ws + WS_QP); const bf16* KP = (const bf16*)(ws + WS_KP); const bf16* VP = (const bf16*)(ws + WS_VP); bf16* MIX = (bf16*)(ws + WS_XB);
    for (int u = BID(); u < 4096; u += GRD()) {
        if (u < 2048) {
            const int qc = 31 - (u >> 6), bh = u & 63, b = bh >> 3, h = bh & 7;
            attn_naive<96, 64>(smem, QP + ((size_t)bh * SEQ + qc * 64) * 96, 96, KP + (size_t)bh * SEQ * 96, 96, VP + (size_t)bh * SEQ * 64, 64, 64 * (qc + 1),
                               MIX + (size_t)(b * SEQ + qc * 64) * DM + 512 + h * 64, DM);
        } else mix_linear_unit(p, l, smem, u - 2048);
    }
}

__device__ __forceinline__ void ln_row_store(f32x4 (&v)[4], const float* g, const float* bta, float* of, bf16* ob, int lane) {
    float s = 0.f;
#pragma unroll
    for (int j = 0; j < 4; ++j) s += (v[j][0] + v[j][1]) + (v[j][2] + v[j][3]);
    const float mean = wave_sum(s) * (1.f / DM); float s2 = 0.f;
#pragma unroll
    for (int j = 0; j < 4; ++j) { v[j] = v[j] - mean; s2 += (v[j][0] * v[j][0] + v[j][1] * v[j][1]) + (v[j][2] * v[j][2] + v[j][3] * v[j][3]); }
    const float rstd = 1.f / sqrtf(wave_sum(s2) * (1.f / DM) + LN_EPS);
#pragma unroll
    for (int j = 0; j < 4; ++j) { const f32x4 gg = *(const f32x4*)(g + lane * 4 + 256 * j), bb = *(const f32x4*)(bta + lane * 4 + 256 * j);
        v[j] = v[j] * rstd * gg + bb; *(f32x4*)(of + lane * 4 + 256 * j) = v[j]; st_bf4(ob + lane * 4 + 256 * j, v[j]); }
}

__device__ __forceinline__ void phase_ln(const Params& p, int l, int which  ) {
    const int tid = TID(), lane = tid & 63, wave = tid >> 6; unsigned char* ws = p.ws;
    float* XR = p.out; bf16* XB = (bf16*)(ws + WS_XB);
    const float* g = p.in[26 + 2 * which] + l * DM; const float* bta = p.in[27 + 2 * which] + l * DM;
    const bf16* CT = (const bf16*)(ws + WS_CT);
    for (int row = BID() * 8 + wave; row < NTOK; row += GRD() * 8) {
        f32x4 v[4];
#pragma unroll
        for (int j = 0; j < 4; ++j) v[j] = *(const f32x4*)(XR + (size_t)row * DM + lane * 4 + 256 * j);
        if (which == 2) {
#pragma unroll
            for (int j = 0; j < 4; ++j) { const u32x2 c0 = *(const u32x2*)(CT + (size_t)row * DM + lane * 4 + 256 * j), c1 = *(const u32x2*)(CT + ((size_t)NTOK + row) * DM + lane * 4 + 256 * j);
                v[j] = v[j] * ALPHA + (f32x4){blo(c0.x), bhi(c0.x), blo(c0.y), bhi(c0.y)} + (f32x4){blo(c1.x), bhi(c1.x), blo(c1.y), bhi(c1.y)}; }
        }
        ln_row_store(v, g, bta, XR + (size_t)row * DM, XB + (size_t)row * DM, lane);
        if (which == 1) {
            const float* wgp = p.in[19] + (size_t)l * DM * 4; const float* bg = p.in[20] + l * 4; const float* wr = p.in[21] + (size_t)l * DM * 32; const float* br = p.in[22] + l * 32;
            float gl[4] = {0.f, 0.f, 0.f, 0.f};
#pragma unroll
            for (int j = 0; j < 4; ++j)
#pragma unroll
                for (int q = 0; q < 4; ++q) { const f32x4 w4 = *(const f32x4*)(wgp + (size_t)(lane * 4 + 256 * j + q) * 4); const float xv = v[j][q];
                    gl[0] = fmaf(xv, w4[0], gl[0]); gl[1] = fmaf(xv, w4[1], gl[1]); gl[2] = fmaf(xv, w4[2], gl[2]); gl[3] = fmaf(xv, w4[3], gl[3]); }
#pragma unroll
            for (int q = 0; q < 4; ++q) gl[q] = wave_sum(gl[q]) + bg[q];
            int gi = 0; float gm = gl[0];
#pragma unroll
            for (int q = 1; q < 4; ++q) if (gl[q] > gm) { gm = gl[q]; gi = q; }
            float gs = 0.f;
#pragma unroll
            for (int q = 0; q < 4; ++q) gs += expf(gl[q] - gm);
            const float gp = 1.f / gs;
            float el[8] = {0.f, 0.f, 0.f, 0.f, 0.f, 0.f, 0.f, 0.f};
#pragma unroll
            for (int j = 0; j < 4; ++j)
#pragma unroll
                for (int q = 0; q < 4; ++q) { const float* wrow = wr + (size_t)(lane * 4 + 256 * j + q) * 32 + gi * 8; const f32x4 w0 = *(const f32x4*)wrow, w1 = *(const f32x4*)(wrow + 4); const float xv = v[j][q];
                    el[0] = fmaf(xv, w0[0], el[0]); el[1] = fmaf(xv, w0[1], el[1]); el[2] = fmaf(xv, w0[2], el[2]); el[3] = fmaf(xv, w0[3], el[3]);
                    el[4] = fmaf(xv, w1[0], el[4]); el[5] = fmaf(xv, w1[1], el[5]); el[6] = fmaf(xv, w1[2], el[6]); el[7] = fmaf(xv, w1[3], el[7]); }
#pragma unroll
            for (int q = 0; q < 8; ++q) el[q] = wave_sum(el[q]) + br[gi * 8 + q];
            int i0 = 0; float m0 = el[0];
#pragma unroll
            for (int q = 1; q < 8; ++q) if (el[q] > m0) { m0 = el[q]; i0 = q; }
            int i1 = -1; float m1 = -3.0e38f;
#pragma unroll
            for (int q = 0; q < 8; ++q) if (q != i0 && el[q] > m1) { m1 = el[q]; i1 = q; }
            const float p1 = expf(m1 - m0); const float w0 = gp / (1.f + p1), w1 = gp * p1 / (1.f + p1);
            if (lane == 0) {
                unsigned* cnt = (unsigned*)(ws + WS_CTL) + CW_CNT + l * 32; int* LT = (int*)(ws + WS_LISTT); float* LW = (float*)(ws + WS_LISTW);
                const int e0 = gi * 8 + i0, e1 = gi * 8 + i1;
                const unsigned p0 = atomicAdd(cnt + e0, 1u); LT[(size_t)e0 * NTOK + p0] = row * 2; LW[(size_t)e0 * NTOK + p0] = w0;
                const unsigned q1 = atomicAdd(cnt + e1, 1u); LT[(size_t)e1 * NTOK + q1] = row * 2 + 1; LW[(size_t)e1 * NTOK + q1] = w1;
            }
        }
    }
}

__device__ __forceinline__ void moe_table(const Params& p, int l, int* tstart, int* cntl) {
    __syncthreads();
    if (TID() == 0) { const unsigned* cnt = (const unsigned*)(p.ws + WS_CTL) + CW_CNT + l * 32; int s = 0;
        for (int e = 0; e < 32; ++e) { const int c = (int)__hip_atomic_load(cnt + e, __ATOMIC_RELAXED, __HIP_MEMORY_SCOPE_AGENT); cntl[e] = c; tstart[e] = s; s += (c + 255) >> 8; } tstart[32] = s; }
    __syncthreads();
}

__device__ __forceinline__ void phase_moe(const Params& p, int l, unsigned char* smem, int which  ) {
    unsigned char* ws = p.ws;
    int* tstart = (int*)(smem + LDS_BYTES - 1024); int* cntl = tstart + 40;
    moe_table(p, l, tstart, cntl);
    const int T = tstart[32]; const int ncol = which == 0 ? 2 : 4;
    const bf16* XB = (const bf16*)(ws + WS_XB); bf16* H = (bf16*)(ws + WS_H); const int* LT = (const int*)(ws + WS_LISTT); const float* LW = (const float*)(ws + WS_LISTW);
    for (int u = BID(); u < T * ncol; u += GRD()) {
        const int rt = u / ncol, pn = u % ncol; int e = 0;
        for (int q = 1; q < 32; ++q) if (tstart[q] <= rt) e = q;
        const int pos0 = (rt - tstart[e]) * 256; int nv = cntl[e] - pos0; nv = nv > 256 ? 256 : nv;
        UnitDesc ud; ud.ridx = LT + (size_t)e * NTOK + pos0; ud.rw = LW + (size_t)e * NTOK + pos0; ud.nvalid = nv; ud.gather = 1;
        if (which == 0) { ud.A = XB; ud.B = (const bf16*)(ws + W_GU) + ((size_t)e * 512 + pn * 256) * 1024; ud.row0 = rt * 256; ud.col0 = pn * 128;
            EpiMoe1 E{H}; gemm_unit_naive(smem, ud, 1024, 1024, 1024, E); }
        else { ud.A = H + (size_t)rt * 256 * 256; ud.B = (const bf16*)(ws + W_DN) + ((size_t)e * 1024 + pn * 256) * 256; ud.row0 = 0; ud.col0 = pn * 256; ud.gather = 0;
            EpiMoe2 E{(bf16*)(ws + WS_CT)}; gemm_unit_naive(smem, ud, 256, 256, 256, E); }
    }
}

constexpr int LDS_PARAMS = LDS_BYTES - 512;
#define GETP const Params& p = *(const Params*)(smem + LDS_PARAMS); unsigned char* ws = p.ws; (void)ws
#ifndef FULL_MASK
#define FULL_MASK 0x3fffu
#endif
#ifndef PHASE_ATTR
#define PHASE_ATTR __forceinline__
#endif
__device__ PHASE_ATTR void ph_conv(unsigned char* smem, int l) { GETP; phase_conv(p, l, smem); }
__device__ PHASE_ATTR void ph_g1(unsigned char* smem, int l) { GETP;
    for (int u = blockIdx.x; u < 640; u += gridDim.x) { const int pm = u / 10, pn = u % 10;
        UnitDesc ud{(const bf16*)(ws + WS_XB) + (size_t)pm * 256 * DM, (const bf16*)(ws + W_IN) + (size_t)pn * 256 * DM, nullptr, nullptr, pm * 256, pn * 256, 256, 0};
        EpiBf16Store E{(bf16*)(ws + WS_Y), YW, 1.f}; gemm_unit_naive(smem, ud, 1024, 1024, 1024, E); }
    for (int u = (blockIdx.x + 128) % gridDim.x; u < 64; u += gridDim.x) { const int pm = u / 8, pn = u % 8;
        UnitDesc ud{(const bf16*)(ws + WS_MEMB) + (size_t)pm * 256 * DM, (const bf16*)(ws + W_XKV) + (size_t)pn * 256 * DM, nullptr, nullptr, pm * 256, pn * 256, 256, 0};
        EpiBf16Store E{(bf16*)(ws + WS_KVX), 2048, 1.f}; gemm_unit_naive(smem, ud, 1024, 1024, 1024, E); }
}
__device__ PHASE_ATTR void ph_loc(unsigned char* smem, int l) { GETP; phase_loc(p, l, smem); }
__device__ PHASE_ATTR void ph_scan(unsigned char* smem, int l) { GETP;
    phase_scan(p, l);
    for (int u = blockIdx.x; u < 512; u += gridDim.x) { const int pm = u >> 3, pn = u & 7;
        UnitDesc ud{(const bf16*)(ws + WS_Y) + (size_t)pm * 256 * YW + (pn < 3 ? Y_CQ : Y_T9), pn < 3 ? (const bf16*)(ws + W_Q) + (size_t)pn * 256 * 256 : (const bf16*)(ws + W_KV) + (size_t)(pn - 3) * 256 * 256,
                    nullptr, nullptr, pm * 256, pn * 256, 256, 0};
        EpiG23 E{(bf16*)(ws + WS_QP), (bf16*)(ws + WS_KP), (bf16*)(ws + WS_VP), (const float*)(ws + WS_RS), (const float*)(ws + WS_ROPE)};
        gemm_unit_naive(smem, ud, 256, YW, 256, E); }
}
__device__ PHASE_ATTR void ph_mix(unsigned char* smem, int l) { GETP; phase_mix(p, l, smem); }
__device__ PHASE_ATTR void ph_g4(unsigned char* smem, int l) { GETP;
    for (int u = blockIdx.x; u < 256; u += gridDim.x) { const int pm = u >> 2, pn = u & 3;
        UnitDesc ud{(const bf16*)(ws + WS_XB) + (size_t)pm * 256 * DM, (const bf16*)(ws + W_OUT) + (size_t)pn * 256 * DM, nullptr, nullptr, pm * 256, pn * 256, 256, 0};
        EpiResid E{l == 0 ? p.in[0] : p.out, p.out}; gemm_unit_naive(smem, ud, 1024, 1024, 1024, E); }
}
__device__ PHASE_ATTR void ph_ln(unsigned char* smem, int l, int which) { GETP; phase_ln(p, l, which); }
__device__ PHASE_ATTR void ph_g5(unsigned char* smem, int l) { GETP;
    for (int u = blockIdx.x; u < 256; u += gridDim.x) { const int pm = u >> 2, pn = u & 3;
        UnitDesc ud{(const bf16*)(ws + WS_XB) + (size_t)pm * 256 * DM, (const bf16*)(ws + W_XQ) + (size_t)pn * 256 * DM, nullptr, nullptr, pm * 256, pn * 256, 256, 0};
        EpiBf16Store E{(bf16*)(ws + WS_QX), DM, XSCALE}; gemm_unit_naive(smem, ud, 1024, 1024, 1024, E); }
}
__device__ PHASE_ATTR void ph_xatt(unsigned char* smem, int l) { GETP;
    const bf16* QX = (const bf16*)(ws + WS_QX); const bf16* KVX = (const bf16*)(ws + WS_KVX); bf16* OX = (bf16*)(ws + WS_OX);
    for (int u = blockIdx.x; u < 1024; u += gridDim.x) { const int b = u >> 7, h = (u >> 5) & 3, qt = u & 31;
        attn_naive<256, 256>(smem, QX + (size_t)(b * SEQ + qt * 64) * DM + h * 256, DM, KVX + (size_t)(b * 256) * 2048 + h * 256, 2048, KVX + (size_t)(b * 256) * 2048 + 1024 + h * 256, 2048, 256,
                             OX + (size_t)(b * SEQ + qt * 64) * DM + h * 256, DM); }
}
__device__ PHASE_ATTR void ph_g7(unsigned char* smem, int l) { GETP;
    for (int u = blockIdx.x; u < 256; u += gridDim.x) { const int pm = u >> 2, pn = u & 3;
        UnitDesc ud{(const bf16*)(ws + WS_OX) + (size_t)pm * 256 * DM, (const bf16*)(ws + W_XO) + (size_t)pn * 256 * DM, nullptr, nullptr, pm * 256, pn * 256, 256, 0};
        EpiResid E{p.out, p.out}; gemm_unit_naive(smem, ud, 1024, 1024, 1024, E); }
}
__device__ PHASE_ATTR void ph_moe(unsigned char* smem, int l, int which) { GETP; phase_moe(p, l, smem, which); }

template <unsigned MASK>
__global__ void __launch_bounds__(512, 2) fwd(Params pk) {
    extern __shared__ __attribute__((aligned(16))) unsigned char smem[];
    { const unsigned* src = (const unsigned*)&pk; unsigned* dst = (unsigned*)(smem + LDS_PARAMS); for (int i = threadIdx.x; i < (int)(sizeof(Params) / 4); i += 512) dst[i] = src[i]; }
    unsigned char* ws = pk.ws;
    volatile LAS unsigned* barw = (volatile LAS unsigned*)((LAS unsigned char*)smem + LDS_BARW);
    if (threadIdx.x == 0) { barw[0] = 0u; barw[1] = 0u; }
    __syncthreads();
    XcdBarrier bar; bar.bar = (unsigned*)(ws + WS_CTL) + CW_BAR; bar.x = 0; bar.st = barw;
    const int lo = pk.ph_lo, hi = pk.ph_hi;
    const bool multi = (hi - lo) > 1;
    if (multi) bar = xcd_barrier_post((unsigned*)(ws + WS_CTL) + CW_BAR, barw);
#pragma unroll 1
    for (int l = 0; l < 2; ++l) {
        const int base = l * NPH;
#define IN(k) (((MASK >> (k)) & 1u) != 0u && lo <= base + (k) && base + (k) < hi)
#define SEAM(k) do { if (base + (k) + 1 < hi) xcd_barrier(bar); } while (0)
        if (IN(PH_CONV)) { ph_conv(smem, l); SEAM(PH_CONV); }
        if (IN(PH_G1)) { ph_g1(smem, l); SEAM(PH_G1); }
        if (IN(PH_LOC)) { ph_loc(smem, l); SEAM(PH_LOC); }
        if (IN(PH_SCAN)) { ph_scan(smem, l); SEAM(PH_SCAN); }
        if (IN(PH_MIX)) { ph_mix(smem, l); SEAM(PH_MIX); }
        if (IN(PH_G4)) { ph_g4(smem, l); SEAM(PH_G4); }
        if (IN(PH_LN1)) { ph_ln(smem, l, 0); SEAM(PH_LN1); }
        if (IN(PH_G5)) { ph_g5(smem, l); SEAM(PH_G5); }
        if (IN(PH_XATT)) { ph_xatt(smem, l); SEAM(PH_XATT); }
        if (IN(PH_G7)) { ph_g7(smem, l); SEAM(PH_G7); }
        if (IN(PH_LN2)) { ph_ln(smem, l, 1); SEAM(PH_LN2); }
        if (IN(PH_MOE1)) { ph_moe(smem, l, 0); SEAM(PH_MOE1); }
        if (IN(PH_MOE2)) { ph_moe(smem, l, 1); SEAM(PH_MOE2); }
        if (IN(PH_LN3)) { ph_ln(smem, l, 2); SEAM(PH_LN3); }
#undef IN
#undef SEAM
    }
}

extern "C" void kernel_launch(void* const* d_in, const int* in_sizes, int n_in, void* d_out, int out_size, void* d_ws, size_t ws_size, hipStream_t stream) {
    static int grid = 0;
    typedef void (*kfn_t)(Params);
#if N_LAUNCH_MODE == 1
    static const kfn_t kfn[NPH] = { fwd<1u << 0>, fwd<1u << 1>, fwd<1u << 2>, fwd<1u << 3>, fwd<1u << 4>, fwd<1u << 5>, fwd<1u << 6>, fwd<1u << 7>, fwd<1u << 8>, fwd<1u << 9>, fwd<1u << 10>, fwd<1u << 11>, fwd<1u << 12>, fwd<1u << 13> };
    constexpr int NK = NPH;
#else
    static const kfn_t kfn[1] = { fwd<FULL_MASK> };
    constexpr int NK = 1;
#endif
    if (grid == 0) {
        int dev = 0, cus = 0;
        if (n_in != 32 || out_size != NTOK * DM || ws_size < WS_TOTAL) { fprintf(stderr, "kernel_launch: unexpected shapes (n_in %d out %d ws %zu need %zu)\n", n_in, out_size, ws_size, (size_t)WS_TOTAL); }
        (void)hipGetDevice(&dev); (void)hipDeviceGetAttribute(&cus, hipDeviceAttributeMultiprocessorCount, dev);
        for (int i = 0; i < NK; ++i) (void)hipFuncSetAttribute((const void*)kfn[i], hipFuncAttributeMaxDynamicSharedMemorySize, LDS_BYTES);
        int per_cu = 0; (void)hipOccupancyMaxActiveBlocksPerMultiprocessor(&per_cu, (const void*)kfn[0], 512, LDS_BYTES);
        (void)hipGetLastError();
        grid = cus > 0 ? cus : 256;
    }
    (void)hipMemsetAsync((char*)d_ws + WS_CTL, 0, CTL_BYTES, stream);
    Params p{};
    for (int i = 0; i < 32; ++i) p.in[i] = (const float*)d_in[i];
    p.out = (float*)d_out; p.ws = (unsigned char*)d_ws;
#if N_LAUNCH_MODE == 1
    for (int ph = 0; ph < 2 * NPH; ++ph) { p.ph_lo = ph; p.ph_hi = ph + 1; hipLaunchKernelGGL(kfn[ph % NPH], dim3(grid), dim3(512), LDS_BYTES, stream, p); }
#else
    p.ph_lo = 0; p.ph_hi = 2 * NPH; hipLaunchKernelGGL(kfn[0], dim3(grid), dim3(512), LDS_BYTES, stream, p);
#endif
}
```

```cpp
#include <hip/hip_runtime.h>
#include <stdint.h>
#include <stdio.h>

#ifndef N_LAUNCH_MODE
#define N_LAUNCH_MODE 0
#endif

typedef unsigned short bf16;
typedef float f32x4 __attribute__((ext_vector_type(4)));
typedef unsigned u32x4 __attribute__((ext_vector_type(4)));
typedef unsigned u32x2 __attribute__((ext_vector_type(2)));
#define LAS __attribute__((address_space(3)))

constexpr int NTOK = 16384, DM = 1024, SEQ = 2048, NBATCH = 8, YW = 2560, NCH = 32;
constexpr int Y_GQ = 0, Y_GK = 256, Y_GV = 512, Y_GR = 768, Y_MQ = 1024, Y_MK = 1280, Y_MV = 1536, Y_MO = 1792, Y_CQ = 2048, Y_T9 = 2304,
              Y_A = 2304, Y_MI = 2320, Y_MF = 2324, Y_CKV = 2328, Y_KR = 2456;
constexpr float ALPHA = 1.41421356237309515f;
constexpr float LN_EPS = 1e-5f;
constexpr float LOG2E = 1.44269504088896341f;
constexpr float QSCALE = 0.10206207261596575f * LOG2E;
constexpr float XSCALE = 0.0625f * LOG2E;
constexpr int NPH = 14;
enum { PH_CONV = 0, PH_G1, PH_LOC, PH_SCAN, PH_MIX, PH_G4, PH_LN1, PH_G5, PH_XATT, PH_G7, PH_LN2, PH_MOE1, PH_MOE2, PH_LN3 };

constexpr size_t MiB = 1u << 20;
constexpr size_t WS_CTL = 0, CTL_BYTES = 1 * MiB;
constexpr size_t W_IN = 1 * MiB;
constexpr size_t W_Q = W_IN + (size_t)2560 * 1024 * 2;
constexpr size_t W_KV = W_Q + (size_t)768 * 256 * 2;
constexpr size_t W_OUT = W_KV + (size_t)1280 * 256 * 2;
constexpr size_t W_XQ = W_OUT + 2 * MiB;
constexpr size_t W_XKV = W_XQ + 2 * MiB;
constexpr size_t W_XO = W_XKV + 4 * MiB;
constexpr size_t W_GU = W_XO + 2 * MiB;
constexpr size_t W_DN = W_GU + 32 * MiB;
constexpr size_t W_END = W_DN + 16 * MiB;
constexpr size_t WS_XB = W_END;
constexpr size_t WS_MEMB = WS_XB + 32 * MiB;
constexpr size_t WS_KVX = WS_MEMB + 4 * MiB;
constexpr size_t WS_ROPE = WS_KVX + 8 * MiB;
constexpr size_t WS_RS = WS_ROPE + 2 * MiB;
constexpr size_t WS_LISTT = WS_RS + 128 * 1024;
constexpr size_t WS_LISTW = WS_LISTT + 2 * MiB;
constexpr size_t WS_NV = WS_LISTW + 2 * MiB;
constexpr size_t WS_DEC = WS_NV + 256 * 1024;
constexpr size_t WS_SC = WS_DEC + 256 * 1024;
constexpr size_t WS_MS = WS_SC + 8 * 1024;
constexpr size_t WS_Y = WS_MS + 8 * 1024;
constexpr size_t WS_QX = WS_Y, WS_OX = WS_Y + 32 * MiB, WS_H = WS_Y;
constexpr size_t WS_QP = WS_Y + 80 * MiB;
constexpr size_t WS_KP = WS_QP + 24 * MiB;
constexpr size_t WS_VP = WS_KP + 24 * MiB;
constexpr size_t WS_ST = WS_VP + 16 * MiB;
constexpr size_t WS_CT = WS_QP;
constexpr size_t WS_TOTAL = WS_ST + 32 * MiB;
static_assert(WS_TOTAL <= (size_t)342000000, "workspace budget");
constexpr int CW_BAR = 4096;
constexpr int CW_CNT = 16384;

constexpr int LDS_BYTES = 147456;
constexpr int LDS_BARW = LDS_BYTES - 16;

struct Params {
    const float* in[32];
    float* out;
    unsigned char* ws;
    int ph_lo, ph_hi;
};

__device__ __forceinline__ float bf2f(unsigned v) { return __uint_as_float(v << 16); }
__device__ __forceinline__ unsigned f2bf(float f) { unsigned u = __float_as_uint(f); return (u + 0x7fffu + ((u >> 16) & 1u)) >> 16; }
__device__ __forceinline__ unsigned pk2(float lo, float hi) { return f2bf(lo) | (f2bf(hi) << 16); }
__device__ __forceinline__ float blo(unsigned w) { return __uint_as_float(w << 16); }
__device__ __forceinline__ float bhi(unsigned w) { return __uint_as_float(w & 0xffff0000u); }
__device__ __forceinline__ float wave_sum(float v) {
#pragma unroll
    for (int o = 1; o < 64; o <<= 1) v += __shfl_xor(v, o);
    return v;
}
__device__ __forceinline__ float logsigmoid(float z) { return fminf(z, 0.f) - log1pf(expf(-fabsf(z))); }
__device__ __forceinline__ float sigmoidf(float x) { return 1.f / (1.f + expf(-x)); }
__device__ __forceinline__ float siluf(float x) { return x / (1.f + expf(-x)); }
__device__ __forceinline__ void st_bf4(bf16* p, f32x4 v) { u32x2 w; w.x = pk2(v[0], v[1]); w.y = pk2(v[2], v[3]); *(u32x2*)p = w; }

#define XB_TMO      128
#define XB_XCNT(j)  (256  + 64 * (j))
#define XB_XSUB(j)  (1280 + 64 * (j))
#define XB_XGEN(j)  (2304 + 64 * (j))
#define XB_TOP      3328
#define XB_TOPGEN   3392
#define XCD_BAR_WORDS 3456
#define XB_SPIN_CAP (1u << 24)
__device__ __forceinline__ unsigned xb_ld(unsigned* p)              { return __hip_atomic_load(p, __ATOMIC_RELAXED, __HIP_MEMORY_SCOPE_AGENT); }
__device__ __forceinline__ unsigned xb_add(unsigned* p, unsigned v) { return __hip_atomic_fetch_add(p, v, __ATOMIC_RELAXED, __HIP_MEMORY_SCOPE_AGENT); }
__device__ __forceinline__ unsigned xb_xcc_id() { return (unsigned)__builtin_amdgcn_s_getreg((3 << 11) | 20) & 0xFu; }
#define XB_SPIN(cond, bar) do { unsigned _sp = 0; while (cond) { __builtin_amdgcn_s_sleep(1); \
    if ((++_sp & 255u) == 0u) { if (xb_ld(&(bar)[XB_TMO])) break; if (_sp > XB_SPIN_CAP) { atomicAdd(&(bar)[XB_TMO], 1u); break; } } } } while (0)
struct XcdBarrier { unsigned* bar; unsigned x; volatile LAS unsigned* st; };
__device__ __forceinline__ XcdBarrier xcd_barrier_post(unsigned* bar, volatile LAS unsigned* st) {
    XcdBarrier b; b.bar = bar; b.x = xb_xcc_id(); b.st = st;
    if (threadIdx.x == 0) (void)xb_add(&bar[XB_XCNT(b.x)], 1u);
    return b;
}
__device__ __forceinline__ void xcd_barrier_complete(unsigned* bar, unsigned x, unsigned& nloc, unsigned& nx) {
    const unsigned G = gridDim.x * gridDim.y * gridDim.z;
    unsigned sum, cnt, mine, sp = 0u;
    for (;;) {
        sum = 0u; cnt = 0u; mine = 0u;
#pragma unroll
        for (unsigned j = 0; j < 16; ++j) { const unsigned c = xb_ld(&bar[XB_XCNT(j)]); sum += c; cnt += (c > 0u) ? 1u : 0u; mine = (j == x) ? c : mine; }
        if (sum == G) break;
        __builtin_amdgcn_s_sleep(1);
        if ((++sp & 255u) == 0u) { if (xb_ld(&bar[XB_TMO])) break; if (sp > XB_SPIN_CAP) { atomicAdd(&bar[XB_TMO], 1u); break; } }
    }
    nloc = mine > 0u ? mine : 1u; nx = cnt > 0u ? cnt : 1u;
}
__device__ __noinline__ void xcd_barrier(const XcdBarrier b) {
    asm volatile("s_waitcnt vmcnt(0)" ::: "memory");
    __syncthreads();
    if (threadIdx.x == 0) {
        unsigned* bar = b.bar;
        __builtin_amdgcn_s_waitcnt(0);
        unsigned nloc = b.st[0], nx = b.st[1];
        if (nloc == 0u) { xcd_barrier_complete(bar, b.x, nloc, nx); b.st[0] = nloc; b.st[1] = nx; }
        const unsigned old = xb_add(&bar[XB_XSUB(b.x)], 1u);
        const unsigned gen = old / nloc;
        if (old + 1u == (gen + 1u) * nloc) {
            __builtin_amdgcn_fence(__ATOMIC_RELEASE, "agent");
            asm volatile("s_waitcnt vmcnt(0)" ::: "memory");
            const unsigned og = xb_add(&bar[XB_TOP], 1u);
            const unsigned tg = og / nx;
            if (og + 1u == (tg + 1u) * nx) xb_add(&bar[XB_TOPGEN], 1u);
            else XB_SPIN(xb_ld(&bar[XB_TOPGEN]) == tg, bar);
            __builtin_amdgcn_fence(__ATOMIC_ACQUIRE, "agent");
            xb_add(&bar[XB_XGEN(b.x)], 1u);
            asm volatile("s_waitcnt vmcnt(0)" ::: "memory");
        } else {
            XB_SPIN(xb_ld(&bar[XB_XGEN(b.x)]) == gen, bar);
            __builtin_amdgcn_fence(__ATOMIC_ACQUIRE, "agent");
            asm volatile("s_waitcnt vmcnt(0)" ::: "memory");
        }
    }
    __syncthreads();
}

__device__ __forceinline__ int TID() { int t = threadIdx.x; asm volatile("" : "+v"(t)); return t; }
__device__ __forceinline__ int BID() { int t = blockIdx.x; asm volatile("" : "+s"(t)); return t; }
__device__ __forceinline__ int GRD() { int t = gridDim.x; asm volatile("" : "+s"(t)); return t; }

struct UnitDesc {
    const bf16* A;
    const bf16* B;
    const int* ridx;
    const float* rw;
    int arow0, acol;
    int row0, col0;
    int nvalid;
    int gather;
};

template <class Epi>
__device__ __forceinline__ void gemm_unit_naive(unsigned char* smem, const UnitDesc& u, int K, int lda, int ldb, const Epi& E) {
    float* As = (float*)smem;
    float* Bs = As + 16 * 128;
    const int tid = TID(), ty = tid >> 4, tx = tid & 15;
    const int lr = tid >> 1, lk = (tid & 1) * 8;
    const bf16* brow = u.B + (size_t)lr * ldb;
    const int cb = (tx >> 2) * 32 + (tx & 3) * 4;
#pragma unroll 1
    for (int half = 0; half < 2; ++half) {
        float acc[4][16];
#pragma unroll
        for (int i = 0; i < 4; ++i)
#pragma unroll
            for (int j = 0; j < 16; ++j) acc[i][j] = 0.f;
        const int ar = half * 128 + (lr & 127);
        const bf16* arow;
        if (u.gather) { const int rr = ar < u.nvalid ? ar : 0; arow = u.A + (size_t)(u.ridx[rr] >> 1) * lda + u.acol; }
        else arow = u.A + (size_t)(u.arow0 + ar) * lda + u.acol;
#pragma unroll 1
        for (int k0 = 0; k0 < K; k0 += 16) {
            const u32x4 bv = *(const u32x4*)(brow + k0 + lk);
            u32x4 av = {0u, 0u, 0u, 0u};
            if (tid < 256) av = *(const u32x4*)(arow + k0 + lk);
            __syncthreads();
#pragma unroll
            for (int j = 0; j < 4; ++j) {
                if (tid < 256) { As[(lk + 2 * j) * 128 + lr] = blo(av[j]); As[(lk + 2 * j + 1) * 128 + lr] = bhi(av[j]); }
                Bs[(lk + 2 * j) * 256 + lr] = blo(bv[j]); Bs[(lk + 2 * j + 1) * 256 + lr] = bhi(bv[j]);
            }
            __syncthreads();
#pragma unroll 4
            for (int kk = 0; kk < 16; ++kk) {
                float b[16];
                const f32x4 a0 = *(const f32x4*)(As + kk * 128 + ty * 4);
#pragma unroll
                for (int g = 0; g < 2; ++g)
#pragma unroll
                    for (int h2 = 0; h2 < 2; ++h2) {
                        const f32x4 bq = *(const f32x4*)(Bs + kk * 256 + g * 128 + cb + h2 * 16);
                        b[g * 8 + h2 * 4 + 0] = bq[0]; b[g * 8 + h2 * 4 + 1] = bq[1]; b[g * 8 + h2 * 4 + 2] = bq[2]; b[g * 8 + h2 * 4 + 3] = bq[3];
                    }
#pragma unroll
                for (int i = 0; i < 4; ++i)
#pragma unroll
                    for (int j = 0; j < 16; ++j) acc[i][j] = fmaf(a0[i], b[j], acc[i][j]);
            }
        }
        __syncthreads();
        float* Ct = (float*)smem;
#pragma unroll
        for (int i = 0; i < 4; ++i)
#pragma unroll
            for (int g = 0; g < 2; ++g) {
                *(f32x4*)(Ct + (ty * 4 + i) * 260 + g * 128 + cb) = (f32x4){acc[i][g * 8 + 0], acc[i][g * 8 + 1], acc[i][g * 8 + 2], acc[i][g * 8 + 3]};
                *(f32x4*)(Ct + (ty * 4 + i) * 260 + g * 128 + cb + 16) = (f32x4){acc[i][g * 8 + 4], acc[i][g * 8 + 5], acc[i][g * 8 + 6], acc[i][g * 8 + 7]};
            }
        __syncthreads();
#pragma unroll 1
        for (int item = tid; item < 128 * 32; item += 512) {
            const int rr = item >> 5, cg = item & 31, c = (cg >> 4) * 128 + ((cg & 15) >> 2) * 32 + (cg & 3) * 4, r = half * 128 + rr;
            if (r < u.nvalid) { const f32x4 v0 = *(const f32x4*)(Ct + rr * 260 + c), v1 = *(const f32x4*)(Ct + rr * 260 + c + 16); E(u, r, c, v0, v1); }
        }
        __syncthreads();
    }
}

struct EpiBf16Store { bf16* O; int ldo; float scale;
    __device__ __forceinline__ void operator()(const UnitDesc& u, int r, int c, f32x4 v0, f32x4 v1) const {
        bf16* o = O + (size_t)(u.row0 + r) * ldo + u.col0 + c; st_bf4(o, v0 * scale); st_bf4(o + 16, v1 * scale); } };
struct EpiResid { const float* res; float* out;
    __device__ __forceinline__ void operator()(const UnitDesc& u, int r, int c, f32x4 v0, f32x4 v1) const {
        const size_t o = (size_t)(u.row0 + r) * DM + u.col0 + c;
        const f32x4 r0 = *(const f32x4*)(res + o), r1 = *(const f32x4*)(res + o + 16);
        *(f32x4*)(out + o) = r0 * ALPHA + v0; *(f32x4*)(out + o + 16) = r1 * ALPHA + v1; } };
__device__ __forceinline__ f32x4 rope4(f32x4 v, const float* ROPE, int row, int i) {
    const f32x4 cs = *(const f32x4*)(ROPE + ((size_t)row * 16 + i) * 2);
    return (f32x4){v[0] * cs[0] - v[1] * cs[1], v[1] * cs[0] + v[0] * cs[1], v[2] * cs[2] - v[3] * cs[3], v[3] * cs[2] + v[2] * cs[3]}; }
struct EpiMlaQ { bf16* QP; const float* RS; const float* ROPE;
    __device__ __forceinline__ void grp(int row, int c, f32x4 v) const {
        asm volatile("" : "+v"(row), "+v"(c));
        const int b = row >> 11, s = row & 2047, h = c / 96, j = c - h * 96;
        v = v * (RS[row * 2] * QSCALE);
        if (j >= 64) v = rope4(v, ROPE, row, (j - 64) >> 1);
        st_bf4(QP + ((size_t)((b * 8 + h) * SEQ + s)) * 96 + j, v); }
    __device__ __forceinline__ void operator()(const UnitDesc& u, int r, int c, f32x4 v0, f32x4 v1) const {
        grp(u.row0 + r, u.col0 + c, v0); grp(u.row0 + r, u.col0 + c + 16, v1); } };
struct EpiMlaKV { bf16 *KP, *VP; const float* RS; const float* ROPE;
    __device__ __forceinline__ void grp(int row, int c, f32x4 v) const {
        asm volatile("" : "+v"(row), "+v"(c));
        const int b = row >> 11, s = row & 2047, h = c / 160, j = c - h * 160; const float rs = RS[row * 2 + 1];
        if (j < 64) st_bf4(KP + ((size_t)((b * 8 + h) * SEQ + s)) * 96 + j, v * rs);
        else if (j < 96) st_bf4(KP + ((size_t)((b * 8 + h) * SEQ + s)) * 96 + j, rope4(v, ROPE, row, (j - 64) >> 1));
        else st_bf4(VP + ((size_t)((b * 8 + h) * SEQ + s)) * 64 + (j - 96), v * rs); }
    __device__ __forceinline__ void operator()(const UnitDesc& u, int r, int c, f32x4 v0, f32x4 v1) const {
        grp(u.row0 + r, u.col0 + c, v0); grp(u.row0 + r, u.col0 + c + 16, v1); } };
struct EpiMoe1 { bf16* H;
    __device__ __forceinline__ void operator()(const UnitDesc& u, int r, int c, f32x4 v0, f32x4 v1) const {
        f32x4 h;
#pragma unroll
        for (int j = 0; j < 4; ++j) h[j] = siluf(v0[j]) * v1[j];
        st_bf4(H + (size_t)(u.row0 + r) * 256 + u.col0 + (c >> 5) * 16 + (c & 15), h); } };
struct EpiMoe2 { bf16* CT;
    __device__ __forceinline__ void operator()(const UnitDesc& u, int r, int c, f32x4 v0, f32x4 v1) const {
        asm volatile("" : "+v"(r), "+v"(c));
        const int ent = u.ridx[r]; const float w = u.rw[r];
        bf16* o = CT + ((size_t)(ent & 1) * NTOK + (ent >> 1)) * DM + u.col0 + c; st_bf4(o, v0 * w); st_bf4(o + 16, v1 * w); } };

typedef short bf16x8 __attribute__((ext_vector_type(8)));
namespace mg {
constexpr int BK = 64, HALF = 128, HTB = HALF * BK * 2, STAGE_BYTES = 8 * HTB;
__device__ __forceinline__ int lds_byte(int r, int c) { const int st = (r >> 4) * 2 + (c >> 5), rr = r & 15, cc = c & 31, ob = rr * 64 + cc * 2; return st * 1024 + (ob ^ (((ob >> 9) & 1) << 5)); }
__device__ __forceinline__ void stage_rc(int b, int& R, int& C) { const int st = b / 1024, sb = b % 1024, swz = sb ^ (((sb >> 9) & 1) << 5); R = (st >> 1) * 16 + swz / 64; C = (st & 1) * 32 + (swz % 64) / 2; }

template <bool GATHER, class Sched, class Epi>
__device__ __forceinline__ void gemm_mfma(LAS unsigned char* lds, const Sched& S, const int K, const int lda, const int ldb, const Epi& E) {
    const int tid = TID(), wid = __builtin_amdgcn_readfirstlane(tid >> 6), lane = tid & 63, wr = wid >> 2, wc = wid & 3, fr = lane & 15, fq = lane >> 4;
    const int nt = K / BK;
    unsigned voffB[2], voffA[2];
    { int R0, C0, R1, C1; stage_rc(tid * 16, R0, C0); stage_rc(tid * 16 + 8192, R1, C1); voffB[0] = (unsigned)(R0 * ldb + C0) * 2u; voffB[1] = (unsigned)(R1 * ldb + C1) * 2u;
      voffA[0] = (unsigned)(R0 * lda + C0) * 2u; voffA[1] = (unsigned)(R1 * lda + C1) * 2u; }
    const size_t kstep = (size_t)(BK * 2);
    const size_t hstepB = (size_t)HALF * ldb * 2, hstepA = (size_t)HALF * lda * 2;
    const unsigned ldsw = (unsigned)wid * 1024u;
    const int aoff = lds_byte(wr * 64 + fr, fq * 8), boff = lds_byte(wc * 32 + fr, fq * 8);
#define MG_SA(b, h) (((b) * 2 + (h)) * HTB)
#define MG_SB(b, h) ((4 + (b) * 2 + (h)) * HTB)
#define MG_STAGE(bufoff, gbase, voff) do { _Pragma("unroll") for (int _i = 0; _i < 2; ++_i) \
        __builtin_amdgcn_global_load_lds((const unsigned*)((const char*)(gbase) + (voff)[_i]), (LAS unsigned*)(lds + (bufoff) + ldsw + _i * 8192), 16, 0, 0); } while (0)
#define MG_STA(bufoff, base, h, nx) do { if constexpr (GATHER) { if (nx) MG_STAGE(bufoff, base, vn[h]); else MG_STAGE(bufoff, base, vc[h]); } else { MG_STAGE(bufoff, (base) + (h) * hstepA, voffA); } } while (0)
#define MG_LDA(dst, b, h) do { _Pragma("unroll") for (int m = 0; m < 4; ++m) _Pragma("unroll") for (int k = 0; k < 2; ++k) dst[m][k] = *(const LAS bf16x8*)(lds + MG_SA(b, h) + aoff + m * 2048 + k * 1024); } while (0)
#define MG_LDB(dst, b, h) do { _Pragma("unroll") for (int n = 0; n < 2; ++n) _Pragma("unroll") for (int k = 0; k < 2; ++k) dst[n][k] = *(const LAS bf16x8*)(lds + MG_SB(b, h) + boff + n * 2048 + k * 1024); } while (0)
#define MG_MMA(ai, bj, At, Bt) do { __builtin_amdgcn_s_setprio(1); _Pragma("unroll") for (int m = 0; m < 4; ++m) _Pragma("unroll") for (int n = 0; n < 2; ++n) _Pragma("unroll") for (int k = 0; k < 2; ++k) \
        acc[ai][bj][m][n] = __builtin_amdgcn_mfma_f32_16x16x32_bf16(Bt[n][k], At[m][k], acc[ai][bj][m][n], 0, 0, 0); __builtin_amdgcn_s_setprio(0); } while (0)
#define MG_WAIT_V(n) asm volatile("s_waitcnt vmcnt(" #n ")" ::: "memory")
#define MG_WAIT_L(n) asm volatile("s_waitcnt lgkmcnt(" #n ")" ::: "memory")
#define MG_BAR __builtin_amdgcn_s_barrier()
#define MG_SCHED __builtin_amdgcn_sched_barrier(0)
#define MG_MKOFF(u, v) do { if constexpr (GATHER) { int R0, C0, R1, C1; { const int _t = TID(); stage_rc(_t * 16, R0, C0); stage_rc(_t * 16 + 8192, R1, C1); } _Pragma("unroll") for (int _h = 0; _h < 2; ++_h) { \
        const int _r0 = R0 + 128 * _h, _r1 = R1 + 128 * _h; const int _l = (u).nvalid - 1; const int _a0 = (u).ridx[_r0 < _l ? _r0 : _l] >> 1, _a1 = (u).ridx[_r1 < _l ? _r1 : _l] >> 1; \
        v[_h][0] = ((unsigned)_a0 * (unsigned)lda + (unsigned)C0) * 2u; v[_h][1] = ((unsigned)_a1 * (unsigned)lda + (unsigned)C1) * 2u; } } } while (0)
#define MG_ABASE(u) (GATHER ? (const char*)((u).A + (u).acol) : (const char*)((u).A + (size_t)(u).arow0 * lda + (u).acol))
    UnitDesc cur, nxt; int ui = 0;
    if (!S.get(0, cur)) return;
    f32x4 acc[2][2][4][2];
#pragma unroll
    for (int a = 0; a < 2; ++a)
#pragma unroll
        for (int b = 0; b < 2; ++b)
#pragma unroll
            for (int m = 0; m < 4; ++m)
#pragma unroll
                for (int n = 0; n < 2; ++n) acc[a][b][m][n] = (f32x4){0.f, 0.f, 0.f, 0.f};
    bf16x8 At[4][2], B0[2][2], B1[2][2];
    unsigned vc[2][2], vn[2][2];
    MG_MKOFF(cur, vc);
    const char* cA = MG_ABASE(cur); const char* cB = (const char*)cur.B;
    MG_STAGE(MG_SB(0, 0), cB, voffB); MG_STA(MG_SA(0, 0), cA, 0, false); MG_STAGE(MG_SB(0, 1), cB + hstepB, voffB); MG_STA(MG_SA(0, 1), cA, 1, false);
    if (wr == 1) MG_BAR;
    MG_WAIT_V(4); MG_BAR;
    MG_STAGE(MG_SB(1, 0), cB + kstep, voffB); MG_STA(MG_SA(1, 0), cA + kstep, 0, false); MG_STAGE(MG_SB(1, 1), cB + hstepB + kstep, voffB);
    MG_WAIT_V(6); MG_BAR;
    for (;;) {
        const bool has_next = S.get(ui + 1, nxt);
        const char* nA = has_next ? MG_ABASE(nxt) : cA; const char* nB = has_next ? (const char*)nxt.B : cB;
        if constexpr (GATHER) { if (has_next) { MG_MKOFF(nxt, vn); } else { vn[0][0] = vc[0][0]; vn[0][1] = vc[0][1]; vn[1][0] = vc[1][0]; vn[1][1] = vc[1][1]; } }
#pragma unroll 1
        for (int t = 0; t < nt; t += 2) {
            const bool last = (t == nt - 2);
            const char* a1 = cA + (size_t)(t + 1) * kstep;
            const char* a2 = last ? nA : cA + (size_t)(t + 2) * kstep; const char* b2 = last ? nB : cB + (size_t)(t + 2) * kstep;
            const char* a3 = a2 + kstep; const char* b3 = b2 + kstep;
            MG_LDB(B0, 0, 0); MG_SCHED; MG_LDA(At, 0, 0); MG_STA(MG_SA(1, 1), a1, 1, false);
            MG_WAIT_L(8); MG_BAR; MG_WAIT_L(0); MG_MMA(0, 0, At, B0); MG_BAR; MG_SCHED;
            MG_LDB(B1, 0, 1); MG_STAGE(MG_SB(0, 0), b2, voffB);
            MG_BAR; MG_WAIT_L(0); MG_MMA(0, 1, At, B1); MG_BAR;
            MG_LDA(At, 0, 1); MG_STA(MG_SA(0, 0), a2, 0, last);
            MG_BAR; MG_WAIT_L(0); MG_MMA(1, 0, At, B0); MG_BAR; MG_SCHED;
            MG_STAGE(MG_SB(0, 1), b2 + hstepB, voffB);
            MG_WAIT_V(6); MG_BAR; MG_MMA(1, 1, At, B1); MG_BAR;
            MG_LDB(B0, 1, 0); MG_SCHED; MG_LDA(At, 1, 0); MG_STA(MG_SA(0, 1), a2, 1, last);
            MG_WAIT_L(8); MG_BAR; MG_WAIT_L(0); MG_MMA(0, 0, At, B0); MG_BAR; MG_SCHED;
            MG_LDB(B1, 1, 1); MG_STAGE(MG_SB(1, 0), b3, voffB);
            MG_BAR; MG_WAIT_L(0); MG_MMA(0, 1, At, B1); MG_BAR;
            MG_LDA(At, 1, 1); MG_STA(MG_SA(1, 0), a3, 0, last);
            MG_BAR; MG_WAIT_L(0); MG_MMA(1, 0, At, B0); MG_BAR; MG_SCHED;
            MG_STAGE(MG_SB(1, 1), b3 + hstepB, voffB);
            MG_WAIT_V(6); MG_BAR; MG_MMA(1, 1, At, B1); MG_BAR;
        }
#pragma unroll
        for (int ai = 0; ai < 2; ++ai)
#pragma unroll
            for (int m = 0; m < 4; ++m) { const int r = ai * HALF + wr * 64 + m * 16 + fr;
                if (r < cur.nvalid) {
#pragma unroll
                    for (int bj = 0; bj < 2; ++bj) E(cur, r, bj * HALF + wc * 32 + 4 * fq, acc[ai][bj][m][0], acc[ai][bj][m][1]); }
                asm volatile("" ::: "memory"); }
        if (!has_next) break;
#pragma unroll
        for (int a = 0; a < 2; ++a)
#pragma unroll
            for (int b = 0; b < 2; ++b)
#pragma unroll
                for (int m = 0; m < 4; ++m)
#pragma unroll
                    for (int n = 0; n < 2; ++n) acc[a][b][m][n] = (f32x4){0.f, 0.f, 0.f, 0.f};
        cur = nxt; cA = nA; cB = nB; ++ui;
        if constexpr (GATHER) { vc[0][0] = vn[0][0]; vc[0][1] = vn[0][1]; vc[1][0] = vn[1][0]; vc[1][1] = vn[1][1]; }
    }
    MG_WAIT_V(0);
    if (wr == 0) MG_BAR;
    MG_BAR;
#undef MG_SA
#undef MG_SB
#undef MG_STAGE
#undef MG_LDA
#undef MG_LDB
#undef MG_MMA
#undef MG_WAIT_V
#undef MG_WAIT_L
#undef MG_BAR
#undef MG_SCHED
#undef MG_MKOFF
#undef MG_STA
#undef MG_ABASE
}
}

#ifndef USE_MFMA
#define USE_MFMA 1
#endif
template <bool GATHER = false, class Sched, class Epi>
__device__ __forceinline__ void gemm_run(unsigned char* smem, const Sched& S, int K, int lda, int ldb, const Epi& E) {
#if USE_MFMA
    __syncthreads();
    mg::gemm_mfma<GATHER>((LAS unsigned char*)smem, S, K, lda, ldb, E);
    __syncthreads();
#else
    UnitDesc u; for (int i = 0; S.get(i, u); ++i) gemm_unit_naive(smem, u, K, lda, ldb, E);
#endif
}
struct SchedGrid { const bf16* A; const bf16* B; int ldb, npn, nunits, rot, acol;
    __device__ __forceinline__ bool get(int i, UnitDesc& u) const {
        const int G = GRD(); const int idx = (BID() + rot) % G + i * G; if (idx >= nunits) return false;
        const int pm = idx / npn, pn = idx - pm * npn;
        u.A = A; u.B = B + (size_t)pn * 256 * ldb; u.ridx = nullptr; u.rw = nullptr; u.arow0 = pm * 256; u.acol = acol; u.row0 = pm * 256; u.col0 = pn * 256; u.nvalid = 256; u.gather = 0; return true; } };
struct SchedMoe { const int* tstart; const int* cntl; const int* LT; const float* LW; const bf16* A; const bf16* W; int which;
    __device__ __forceinline__ bool get(int i, UnitDesc& u) const {
        const int ncol = which == 0 ? 2 : 4; const int idx = BID() + i * GRD(); if (idx >= __builtin_amdgcn_readfirstlane(tstart[32]) * ncol) return false;
        const int rt = idx / ncol, pn = idx - rt * ncol; int e = 0;
        for (int q = 1; q < 32; ++q) if (__builtin_amdgcn_readfirstlane(tstart[q]) <= rt) e = q;
        const int pos0 = (rt - __builtin_amdgcn_readfirstlane(tstart[e])) * 256; int nv = __builtin_amdgcn_readfirstlane(cntl[e]) - pos0; nv = nv > 256 ? 256 : nv;
        u.ridx = LT + (size_t)e * NTOK + pos0; u.rw = LW + (size_t)e * NTOK + pos0; u.nvalid = nv; u.acol = 0; u.A = A;
        if (which == 0) { u.B = W + ((size_t)e * 512 + pn * 256) * 1024; u.arow0 = 0; u.row0 = rt * 256; u.col0 = pn * 128; u.gather = 1; }
        else { u.B = W + ((size_t)e * 1024 + pn * 256) * 256; u.arow0 = rt * 256; u.row0 = 0; u.col0 = pn * 256; u.gather = 0; }
        return true; } };

template <class F>
__device__ __forceinline__ void conv_item(const F& src, bf16* dst, int K, float* scr, int k0, int n0, int lane) {
#pragma unroll 8
    for (int i = 0; i < 32; ++i) { const int kk = 2 * i + (lane >> 5); scr[kk * 33 + (lane & 31)] = src(k0 + kk, n0 + (lane & 31)); }
    asm volatile("s_waitcnt lgkmcnt(0)" ::: "memory");
    const int c = lane & 7;
#pragma unroll
    for (int j = 0; j < 4; ++j) { const int n = (lane >> 3) + 8 * j; const float* s = scr + (8 * c) * 33 + n;
        u32x4 o; o.x = pk2(s[0 * 33], s[1 * 33]); o.y = pk2(s[2 * 33], s[3 * 33]); o.z = pk2(s[4 * 33], s[5 * 33]); o.w = pk2(s[6 * 33], s[7 * 33]);
        *(u32x4*)(dst + (size_t)(n0 + n) * K + k0 + 8 * c) = o; }
    asm volatile("s_waitcnt lgkmcnt(0)" ::: "memory");
}
__device__ __forceinline__ int yc_src(int n) {
    if (n < 1024) return n;
    if (n < 2048) return n + 16;
    if (n < 2304) return n + 24;
    if (n < 2320) return 1024 + (n - 2304);
    if (n < 2328) return 2064 + (n - 2320);
    if (n < 2488) return n;
    return -1;
}

__device__ __forceinline__ void phase_conv(const Params& p, int l, unsigned char* smem) {
    const int tid = TID(), lane = tid & 63, wave = tid >> 6;
    const int gw = BID() * 8 + wave, NGW = GRD() * 8;
    float* scr = (float*)smem + wave * (64 * 33 + 16);
    unsigned char* ws = p.ws;
    const float* w_in = p.in[3] + (size_t)l * 1024 * 2488;
    const float* w_out = p.in[4] + (size_t)l * 1024 * 1024;
    const float* gq = p.in[12] + l * 256; const float* w_uq = p.in[13] + (size_t)l * 256 * 768;
    const float* gkv = p.in[14] + l * 128; const float* w_ukv = p.in[15] + (size_t)l * 128 * 1024;
    const float* xwq = p.in[16] + (size_t)l * 1024 * 1024; const float* xwkv = p.in[17] + (size_t)l * 1024 * 2048; const float* xwo = p.in[18] + (size_t)l * 1024 * 1024;
    const float* wg = p.in[23] + (size_t)l * 32 * 1024 * 256; const float* wu = p.in[24] + (size_t)l * 32 * 1024 * 256; const float* wd = p.in[25] + (size_t)l * 32 * 256 * 1024;
    constexpr int I_IN = 16 * 80, I_Q = 4 * 24, I_KV = 4 * 40, I_SQ = 16 * 32, I_XKV = 16 * 64, I_GU = 32 * 16 * 16, I_DN = 32 * 4 * 32;
    constexpr int NIT = I_IN + I_Q + I_KV + 3 * I_SQ + I_XKV + I_GU + I_DN;
    for (int it = gw; it < NIT; it += NGW) {
        int r = it;
        if (r < I_IN) { const int kb = r / 80, nb = r % 80;
            conv_item([&](int k, int n) { const int s = yc_src(n); return s >= 0 ? w_in[(size_t)k * 2488 + s] : 0.f; }, (bf16*)(ws + W_IN), 1024, scr, kb * 64, nb * 32, lane); continue; }
        r -= I_IN;
        if (r < I_Q) { const int kb = r / 24, nb = r % 24;
            conv_item([&](int k, int n) { const int h = n / 96, j = n - h * 96; int sc = h * 96 + j; if (j >= 64) { const int jj = j - 64; sc = h * 96 + 64 + (jj >> 1) + 16 * (jj & 1); }
                return gq[k] * w_uq[(size_t)k * 768 + sc]; }, (bf16*)(ws + W_Q), 256, scr, kb * 64, nb * 32, lane); continue; }
        r -= I_Q;
        if (r < I_KV) { const int kb = r / 40, nb = r % 40;
            conv_item([&](int k, int n) { const int h = n / 160, j = n - h * 160;
                if (j >= 64 && j < 96) { const int jj = j - 64; return (k == 152 + (jj >> 1) + 16 * (jj & 1)) ? 1.f : 0.f; }
                const int col = (j < 64) ? h * 128 + j : h * 128 + 64 + (j - 96);
                return (k >= 24 && k < 152) ? gkv[k - 24] * w_ukv[(size_t)(k - 24) * 1024 + col] : 0.f; }, (bf16*)(ws + W_KV), 256, scr, kb * 64, nb * 32, lane); continue; }
        r -= I_KV;
        if (r < 3 * I_SQ) { const int m = r / I_SQ, q = r % I_SQ, kb = q / 32, nb = q % 32; const float* W = m == 0 ? w_out : (m == 1 ? xwq : xwo);
            bf16* D = (bf16*)(ws + (m == 0 ? W_OUT : (m == 1 ? W_XQ : W_XO)));
            conv_item([&](int k, int n) { return W[(size_t)k * 1024 + n]; }, D, 1024, scr, kb * 64, nb * 32, lane); continue; }
        r -= 3 * I_SQ;
        if (r < I_XKV) { const int kb = r / 64, nb = r % 64;
            conv_item([&](int k, int n) { return xwkv[(size_t)k * 2048 + n]; }, (bf16*)(ws + W_XKV), 1024, scr, kb * 64, nb * 32, lane); continue; }
        r -= I_XKV;
        if (r < I_GU) { const int e = r / 256, q = r % 256, kb = q / 16, nb = q % 16; const float* G = wg + (size_t)e * 1024 * 256; const float* U = wu + (size_t)e * 1024 * 256;
            conv_item([&](int k, int n) { const int j = (n >> 5) * 16 + (n & 15); return ((n >> 4) & 1) ? U[(size_t)k * 256 + j] : G[(size_t)k * 256 + j]; },
                      (bf16*)(ws + W_GU) + (size_t)e * 512 * 1024, 1024, scr, kb * 64, nb * 32, lane); continue; }
        r -= I_GU;
        { const int e = r / 128, q = r % 128, kb = q / 32, nb = q % 32; const float* Dn = wd + (size_t)e * 256 * 1024;
            conv_item([&](int k, int n) { return Dn[(size_t)k * 1024 + n]; }, (bf16*)(ws + W_DN) + (size_t)e * 1024 * 256, 256, scr, kb * 64, nb * 32, lane); }
    }
}

__device__ __forceinline__ void phase_pre(const Params& p) {
    const int tid = TID(); unsigned char* ws = p.ws;
    {
        const size_t gt = (size_t)BID() * 512 + tid, GT = (size_t)GRD() * 512;
        const float* x = p.in[0]; bf16* XB = (bf16*)(ws + WS_XB);
        for (size_t i = gt; i < (size_t)NTOK * DM / 8; i += GT) { const f32x4 a = *(const f32x4*)(x + i * 8), b = *(const f32x4*)(x + i * 8 + 4);
            u32x4 o; o.x = pk2(a[0], a[1]); o.y = pk2(a[2], a[3]); o.z = pk2(b[0], b[1]); o.w = pk2(b[2], b[3]); *(u32x4*)(XB + i * 8) = o; }
        const float* mem = p.in[1]; bf16* MB = (bf16*)(ws + WS_MEMB);
        for (size_t i = gt; i < (size_t)2048 * DM / 8; i += GT) { const f32x4 a = *(const f32x4*)(mem + i * 8), b = *(const f32x4*)(mem + i * 8 + 4);
            u32x4 o; o.x = pk2(a[0], a[1]); o.y = pk2(a[2], a[3]); o.z = pk2(b[0], b[1]); o.w = pk2(b[2], b[3]); *(u32x4*)(MB + i * 8) = o; }
        const int* pos = (const int*)p.in[2]; float* ROPE = (float*)(ws + WS_ROPE);
        for (size_t i = gt; i < (size_t)NTOK * 16; i += GT) { const int t = (int)(i >> 4), f = (int)(i & 15);
            double inv = 0.15915494309189535;
            for (int q = 0; q < f; ++q) inv *= 0.5623413251903491;
            const double rev = (double)pos[t] * inv; const float fr = (float)(rev - floor(rev));
            ROPE[i * 2] = __builtin_amdgcn_cosf(fr); ROPE[i * 2 + 1] = __builtin_amdgcn_sinf(fr); }
    }
}

__device__ __forceinline__ void gla_cum(const Params& p, int l, float* bs, int t0, int h) {
    const int tid = TID(), t = tid >> 3, dg = tid & 7;
    const bf16* Y = (const bf16*)(p.ws + WS_Y);
    const float* w_a2 = p.in[5] + l * 16 * 256; const float* b_a = p.in[6] + l * 256;
    float a[16];
    { const u32x4 a0 = *(const u32x4*)(Y + (size_t)(t0 + t) * YW + Y_A), a1 = *(const u32x4*)(Y + (size_t)(t0 + t) * YW + Y_A + 8);
#pragma unroll
      for (int j = 0; j < 4; ++j) { a[2 * j] = blo(a0[j]); a[2 * j + 1] = bhi(a0[j]); a[8 + 2 * j] = blo(a1[j]); a[8 + 2 * j + 1] = bhi(a1[j]); } }
#pragma unroll
    for (int j = 0; j < 8; ++j) { const int d = dg * 8 + j; float z = b_a[h * 64 + d];
#pragma unroll
        for (int q = 0; q < 16; ++q) z = fmaf(a[q], w_a2[q * 256 + h * 64 + d], z);
        bs[t * 65 + d] = logsigmoid(z) * (1.f / 16.f); }
    __syncthreads();
    if (tid < 64) { float s = 0.f; for (int tt = 0; tt < 64; ++tt) { s += bs[tt * 65 + tid]; bs[tt * 65 + tid] = s; } }
    __syncthreads();
}
__device__ __forceinline__ void ml_gates(const Params& p, int l, float* fc, float* aa, float* pm, int t0, int h) {
    const int tid = TID();
    const bf16* Y = (const bf16*)(p.ws + WS_Y);
    if (tid < 64) { const float fp = bf2f(Y[(size_t)(t0 + tid) * YW + Y_MF + h]) + p.in[10][l * 4 + h]; const float ig = bf2f(Y[(size_t)(t0 + tid) * YW + Y_MI + h]) + p.in[9][l * 4 + h];
        fc[tid] = logsigmoid(fp); aa[tid] = ig; }
    __syncthreads();
    if (tid == 0) { float s = 0.f, m = -3.0e38f; for (int i = 0; i < 64; ++i) { s += fc[i]; fc[i] = s; const float a = aa[i] - s; aa[i] = a; m = fmaxf(m, a); pm[i] = m; } }
    __syncthreads();
}
__device__ __forceinline__ void ml_conv(const Params& p, int l, float* dst, int t0, int c, int ycol, int wch, int h, float scale) {
    const int tid = TID(), s = tid >> 3, dg = tid & 7;
    const bf16* Y = (const bf16*)(p.ws + WS_Y); const float* w = p.in[8] + l * 4 * 512;
    float acc[8];
#pragma unroll
    for (int j = 0; j < 8; ++j) acc[j] = 0.f;
#pragma unroll
    for (int q = 0; q < 4; ++q) { const int ss = c * 64 + s - 3 + q;
        if (ss >= 0) { const u32x4 v = *(const u32x4*)(Y + (size_t)(t0 + s - 3 + q) * YW + ycol + h * 64 + dg * 8); const float* wr = w + q * 512 + wch + h * 64 + dg * 8;
#pragma unroll
            for (int j = 0; j < 4; ++j) { acc[2 * j] = fmaf(wr[2 * j], blo(v[j]), acc[2 * j]); acc[2 * j + 1] = fmaf(wr[2 * j + 1], bhi(v[j]), acc[2 * j + 1]); } } }
#pragma unroll
    for (int j = 0; j < 8; ++j) dst[s * 65 + dg * 8 + j] = siluf(acc[j]) * scale;
}
__device__ __forceinline__ void ld_blk(float* dst, const bf16* src, int ld) {
    const int tid = TID(), s = tid >> 3, dg = tid & 7; const u32x4 v = *(const u32x4*)(src + (size_t)s * ld + dg * 8);
#pragma unroll
    for (int j = 0; j < 4; ++j) { dst[s * 65 + dg * 8 + 2 * j] = blo(v[j]); dst[s * 65 + dg * 8 + 2 * j + 1] = bhi(v[j]); }
}

__device__ __forceinline__ void phase_loc(const Params& p, int l, unsigned char* smem) {
    const int tid = TID(), lane = tid & 63, wave = tid >> 6;
    unsigned char* ws = p.ws; const bf16* Y = (const bf16*)(ws + WS_Y);
    float* A0 = (float*)smem; float* A1 = A0 + 64 * 65; float* A2 = A1 + 64 * 65; float* fc = A2 + 64 * 65; float* aa = fc + 64; float* pm = aa + 64;
    float* ST = (float*)(ws + WS_ST); float* NV = (float*)(ws + WS_NV); float* DEC = (float*)(ws + WS_DEC); float* SC = (float*)(ws + WS_SC);
    for (int u = BID(); u < 2048; u += GRD()) {
        const int type = u >> 10, r = u & 1023, bh = r >> 5, c = r & 31, b = bh >> 2, h = bh & 3, t0 = b * SEQ + c * 64;
        const int d = tid >> 3, e0 = (tid & 7) * 8;
        __syncthreads();
        if (type == 0) {
            gla_cum(p, l, A0, t0, h);
            ld_blk(A1, Y + (size_t)t0 * YW + Y_GK + h * 64, YW);
            ld_blk(A2, Y + (size_t)t0 * YW + Y_GV + h * 64, YW);
            __syncthreads();
            for (int i = tid; i < 4096; i += 512) { const int s = i >> 6, dd = i & 63; A1[s * 65 + dd] *= expf(A0[63 * 65 + dd] - A0[s * 65 + dd]); }
            __syncthreads();
            float acc[8];
#pragma unroll
            for (int j = 0; j < 8; ++j) acc[j] = 0.f;
            for (int s = 0; s < 64; ++s) { const float kv = A1[s * 65 + d];
#pragma unroll
                for (int j = 0; j < 8; ++j) acc[j] = fmaf(kv, A2[s * 65 + e0 + j], acc[j]); }
            float* o = ST + (size_t)u * 4096 + d * 64 + e0;
            *(f32x4*)o = (f32x4){acc[0], acc[1], acc[2], acc[3]}; *(f32x4*)(o + 4) = (f32x4){acc[4], acc[5], acc[6], acc[7]};
            if (tid < 64) DEC[(size_t)r * 64 + tid] = expf(A0[63 * 65 + tid]);
        } else {
            ml_gates(p, l, fc, aa, pm, t0, h);
            ml_conv(p, l, A1, t0, c, Y_MK, 256, h, 1.f);
            ld_blk(A2, Y + (size_t)t0 * YW + Y_MV + h * 64, YW);
            __syncthreads();
            const float M63 = pm[63];
            for (int i = tid; i < 4096; i += 512) { const int s = i >> 6, dd = i & 63; A1[s * 65 + dd] *= expf(aa[s] - M63); }
            __syncthreads();
            float acc[8]; float nn = 0.f;
#pragma unroll
            for (int j = 0; j < 8; ++j) acc[j] = 0.f;
            for (int s = 0; s < 64; ++s) { const float kv = A1[s * 65 + d]; nn += kv;
#pragma unroll
                for (int j = 0; j < 8; ++j) acc[j] = fmaf(kv, A2[s * 65 + e0 + j], acc[j]); }
            float* o = ST + (size_t)u * 4096 + d * 64 + e0;
            *(f32x4*)o = (f32x4){acc[0], acc[1], acc[2], acc[3]}; *(f32x4*)(o + 4) = (f32x4){acc[4], acc[5], acc[6], acc[7]};
            if ((tid & 7) == 0) NV[(size_t)r * 64 + d] = nn;
            if (tid == 0) { SC[r * 2] = fc[63]; SC[r * 2 + 1] = fc[63] + M63; }
        }
    }
    float* RS = (float*)(ws + WS_RS);
    for (int row = BID() * 8 + wave; row < NTOK; row += GRD() * 8) {
        const u32x2 q = *(const u32x2*)(Y + (size_t)row * YW + Y_CQ + lane * 4); const unsigned kv = *(const unsigned*)(Y + (size_t)row * YW + Y_CKV + lane * 2);
        float sq = blo(q.x) * blo(q.x) + bhi(q.x) * bhi(q.x) + blo(q.y) * blo(q.y) + bhi(q.y) * bhi(q.y); float sk = blo(kv) * blo(kv) + bhi(kv) * bhi(kv);
        sq = wave_sum(sq); sk = wave_sum(sk);
        if (lane == 0) { RS[row * 2] = 1.f / sqrtf(sq * (1.f / 256.f) + LN_EPS); RS[row * 2 + 1] = 1.f / sqrtf(sk * (1.f / 128.f) + LN_EPS); }
    }
}

__device__ __forceinline__ void phase_scan(const Params& p, int l) {
    unsigned char* ws = p.ws;
    float* ST = (float*)(ws + WS_ST); float* NV = (float*)(ws + WS_NV); const float* DEC = (const float*)(ws + WS_DEC); const float* SC = (const float*)(ws + WS_SC); float* MS = (float*)(ws + WS_MS);
    const int gt = BID() * 512 + TID(), GT = GRD() * 512;
    for (int idx = gt; idx < 64 * 4096; idx += GT) {
        const int seq = idx >> 12, el = idx & 4095, d = el >> 6;
        float* st = ST + (size_t)seq * 32 * 4096 + el;
        if (seq < 32) { float S = 0.f; const float* dc = DEC + (size_t)seq * 32 * 64 + d;
#pragma unroll 4
            for (int c = 0; c < 32; ++c) { const float tmp = st[(size_t)c * 4096]; st[(size_t)c * 4096] = S; S = fmaf(dc[c * 64], S, tmp); } }
        else { const int sq = seq - 32; float C = 0.f, m = 0.f; const float* sc = SC + (size_t)sq * 32 * 2;
#pragma unroll 4
            for (int c = 0; c < 32; ++c) { const float F = sc[c * 2], ml = sc[c * 2 + 1]; const float tmp = st[(size_t)c * 4096]; st[(size_t)c * 4096] = C;
                const float mn = fmaxf(F + m, ml); C = expf(F + m - mn) * C + expf(ml - mn) * tmp; m = mn; } }
    }
    for (int idx = gt; idx < 32 * 64; idx += GT) {
        const int sq = idx >> 6, d = idx & 63; float n = 0.f, m = 0.f; const float* sc = SC + (size_t)sq * 32 * 2; float* nv = NV + (size_t)sq * 32 * 64 + d;
#pragma unroll 2
        for (int c = 0; c < 32; ++c) { const float F = sc[c * 2], ml = sc[c * 2 + 1]; const float tmp = nv[c * 64]; nv[c * 64] = n; if (d == 0) MS[sq * 32 + c] = m;
            const float mn = fmaxf(F + m, ml); n = expf(F + m - mn) * n + expf(ml - mn) * tmp; m = mn; }
    }
}

template <int DQK, int DV>
__device__ __forceinline__ void attn_naive(unsigned char* smem, const bf16* Q, int qs, const bf16* K, int ks, const bf16* V, int vs, int nk, bf16* O, int os) {
    constexpr int LQ = DQK + 8, LV = DV + 8, EV = DV / 8;
    bf16* Qs = (bf16*)smem; bf16* Ks = Qs + 64 * LQ; bf16* Vs = Ks + 64 * LQ; float* Ss = (float*)(Vs + 64 * LV);
    const int tid = TID(), t = tid >> 3, g = tid & 7;
    __syncthreads();
    for (int i = tid; i < 64 * DQK / 8; i += 512) { const int r = i / (DQK / 8), c8 = i % (DQK / 8); *(u32x4*)(Qs + r * LQ + c8 * 8) = *(const u32x4*)(Q + (size_t)r * qs + c8 * 8); }
    float acc[EV]; float m = -3.0e38f, lsum = 0.f;
#pragma unroll
    for (int j = 0; j < EV; ++j) acc[j] = 0.f;
    for (int k0 = 0; k0 < nk; k0 += 64) {
        __syncthreads();
        for (int i = tid; i < 64 * DQK / 8; i += 512) { const int r = i / (DQK / 8), c8 = i % (DQK / 8); *(u32x4*)(Ks + r * LQ + c8 * 8) = *(const u32x4*)(K + (size_t)(k0 + r) * ks + c8 * 8); }
        for (int i = tid; i < 64 * DV / 8; i += 512) { const int r = i / (DV / 8), c8 = i % (DV / 8); *(u32x4*)(Vs + r * LV + c8 * 8) = *(const u32x4*)(V + (size_t)(k0 + r) * vs + c8 * 8); }
        __syncthreads();
        float sc[8];
#pragma unroll
        for (int j = 0; j < 8; ++j) sc[j] = 0.f;
        for (int d8 = 0; d8 < DQK / 8; ++d8) { const u32x4 qv = *(const u32x4*)(Qs + t * LQ + d8 * 8);
#pragma unroll
            for (int j = 0; j < 8; ++j) { const u32x4 kv = *(const u32x4*)(Ks + (g + 8 * j) * LQ + d8 * 8);
#pragma unroll
                for (int q = 0; q < 4; ++q) sc[j] = fmaf(blo(qv[q]), blo(kv[q]), fmaf(bhi(qv[q]), bhi(kv[q]), sc[j])); } }
        float mx = sc[0];
#pragma unroll
        for (int j = 1; j < 8; ++j) mx = fmaxf(mx, sc[j]);
        mx = fmaxf(mx, __shfl_xor(mx, 1)); mx = fmaxf(mx, __shfl_xor(mx, 2)); mx = fmaxf(mx, __shfl_xor(mx, 4));
        const float mn = fmaxf(m, mx), al = exp2f(m - mn); float ps = 0.f;
#pragma unroll
        for (int j = 0; j < 8; ++j) { const float pv = exp2f(sc[j] - mn); ps += pv; Ss[t * 65 + g + 8 * j] = pv; }
        ps += __shfl_xor(ps, 1); ps += __shfl_xor(ps, 2); ps += __shfl_xor(ps, 4);
        lsum = lsum * al + ps; m = mn;
#pragma unroll
        for (int j = 0; j < EV; ++j) acc[j] *= al;
        __syncthreads();
        for (int kk = 0; kk < 64; ++kk) { const float pv = Ss[t * 65 + kk];
#pragma unroll
            for (int j8 = 0; j8 < EV / 8; ++j8) { const u32x4 vv = *(const u32x4*)(Vs + kk * LV + g * EV + j8 * 8);
#pragma unroll
                for (int q = 0; q < 4; ++q) { acc[j8 * 8 + 2 * q] = fmaf(pv, blo(vv[q]), acc[j8 * 8 + 2 * q]); acc[j8 * 8 + 2 * q + 1] = fmaf(pv, bhi(vv[q]), acc[j8 * 8 + 2 * q + 1]); } } }
    }
    const float inv = 1.f / lsum;
#pragma unroll
    for (int j8 = 0; j8 < EV / 8; ++j8) { u32x4 o; o.x = pk2(acc[j8 * 8] * inv, acc[j8 * 8 + 1] * inv); o.y = pk2(acc[j8 * 8 + 2] * inv, acc[j8 * 8 + 3] * inv);
        o.z = pk2(acc[j8 * 8 + 4] * inv, acc[j8 * 8 + 5] * inv); o.w = pk2(acc[j8 * 8 + 6] * inv, acc[j8 * 8 + 7] * inv);
        *(u32x4*)(O + (size_t)t * os + g * EV + j8 * 8) = o; }
}

__device__ __forceinline__ void mix_linear_unit(const Params& p, int l, unsigned char* smem, int u) {
    const int tid = TID(); unsigned char* ws = p.ws; const bf16* Y = (const bf16*)(ws + WS_Y);
    float* A0 = (float*)smem; float* A1 = A0 + 64 * 65; float* A2 = A1 + 64 * 65; float* A3 = A2 + 64 * 65; float* A4 = A3 + 64 * 65; float* A5 = A4 + 64 * 65;
    float* fc = A5 + 64 * 65; float* aa = fc + 64; float* pm = aa + 64; float* nv = pm + 64;
    const float* ST = (const float*)(ws + WS_ST); const float* NV = (const float*)(ws + WS_NV); const float* MS = (const float*)(ws + WS_MS);
    bf16* MIX = (bf16*)(ws + WS_XB);
    const int type = u >> 10, r = u & 1023, bh = r >> 5, c = r & 31, b = bh >> 2, h = bh & 3, t0 = b * SEQ + c * 64;
    const int t = tid >> 3, g = tid & 7, e0 = g * 8;
    __syncthreads();
    for (int i = tid; i < 4096; i += 512) A3[(i >> 6) * 65 + (i & 63)] = ST[(size_t)u * 4096 + i];
    ld_blk(A2, Y + (size_t)t0 * YW + (type == 0 ? Y_GV : Y_MV) + h * 64, YW);
    float mst = 0.f;
    if (type == 0) {
        gla_cum(p, l, A0, t0, h);
        ld_blk(A4, Y + (size_t)t0 * YW + Y_GQ + h * 64, YW); ld_blk(A1, Y + (size_t)t0 * YW + Y_GK + h * 64, YW);
        __syncthreads();
        for (int i = tid; i < 4096; i += 512) { const int s = i >> 6, dd = i & 63; const float bb = A0[s * 65 + dd]; A4[s * 65 + dd] *= 0.125f * expf(bb); A1[s * 65 + dd] *= expf(-bb); }
    } else {
        ml_gates(p, l, fc, aa, pm, t0, h);
        ml_conv(p, l, A4, t0, c, Y_MQ, 0, h, 0.125f); ml_conv(p, l, A1, t0, c, Y_MK, 256, h, 1.f);
        if (tid < 64) nv[tid] = NV[(size_t)r * 64 + tid];
        mst = MS[r];
    }
    __syncthreads();
    const float mm = (type == 1) ? fmaxf(mst, pm[t]) : 0.f;
    {
        float sc[8];
#pragma unroll
        for (int j = 0; j < 8; ++j) sc[j] = 0.f;
        for (int d = 0; d < 64; ++d) { const float qv = A4[t * 65 + d];
#pragma unroll
            for (int j = 0; j < 8; ++j) sc[j] = fmaf(qv, A1[(g + 8 * j) * 65 + d], sc[j]); }
#pragma unroll
        for (int j = 0; j < 8; ++j) { const int s = g + 8 * j; float w = (s <= t) ? sc[j] : 0.f; if (type == 1) w = (s <= t) ? w * expf(aa[s] - mm) : 0.f; A5[t * 65 + s] = w; }
    }
    __syncthreads();
    float acc[8], inter[8];
#pragma unroll
    for (int j = 0; j < 8; ++j) { acc[j] = 0.f; inter[j] = 0.f; }
    for (int d = 0; d < 64; ++d) { const float qv = A4[t * 65 + d];
#pragma unroll
        for (int j = 0; j < 8; ++j) inter[j] = fmaf(qv, A3[d * 65 + e0 + j], inter[j]); }
    for (int s = 0; s < 64; ++s) { const float pv = A5[t * 65 + s];
#pragma unroll
        for (int j = 0; j < 8; ++j) acc[j] = fmaf(pv, A2[s * 65 + e0 + j], acc[j]); }
    float o[8];
    if (type == 0) {
#pragma unroll
        for (int j = 0; j < 8; ++j) o[j] = acc[j] + inter[j];
    } else {
        const float wi = expf(mst - mm);
        float dn = 0.f;
#pragma unroll
        for (int j = 0; j < 8; ++j) dn += wi * A4[t * 65 + e0 + j] * nv[e0 + j] + A5[t * 65 + e0 + j];
        dn += __shfl_xor(dn, 1); dn += __shfl_xor(dn, 2); dn += __shfl_xor(dn, 4);
        const float mt = fc[t] + mm; const float den = fmaxf(fabsf(dn), expf(-mt)); const float inv = 1.f / den;
#pragma unroll
        for (int j = 0; j < 8; ++j) o[j] = (wi * inter[j] + acc[j]) * inv;
    }
    float s1 = 0.f;
#pragma unroll
    for (int j = 0; j < 8; ++j) s1 += o[j];
    s1 += __shfl_xor(s1, 1); s1 += __shfl_xor(s1, 2); s1 += __shfl_xor(s1, 4);
    const float mu = s1 * (1.f / 64.f); float s2 = 0.f;
#pragma unroll
    for (int j = 0; j < 8; ++j) { o[j] -= mu; s2 += o[j] * o[j]; }
    s2 += __shfl_xor(s2, 1); s2 += __shfl_xor(s2, 2); s2 += __shfl_xor(s2, 4);
    const float rstd = 1.f / sqrtf(s2 * (1.f / 64.f) + LN_EPS);
    const float* gn = (type == 0 ? p.in[7] : p.in[11]) + l * 256 + h * 64 + e0;
    const u32x4 gv = *(const u32x4*)(Y + (size_t)(t0 + t) * YW + (type == 0 ? Y_GR : Y_MO) + h * 64 + e0);
    float gate[8];
#pragma unroll
    for (int j = 0; j < 4; ++j) { gate[2 * j] = blo(gv[j]); gate[2 * j + 1] = bhi(gv[j]); }
    float res[8];
#pragma unroll
    for (int j = 0; j < 8; ++j) res[j] = o[j] * rstd * gn[j] * (type == 0 ? siluf(gate[j]) : sigmoidf(gate[j]));
    u32x4 ov; ov.x = pk2(res[0], res[1]); ov.y = pk2(res[2], res[3]); ov.z = pk2(res[4], res[5]); ov.w = pk2(res[6], res[7]);
    *(u32x4*)(MIX + (size_t)(t0 + t) * DM + type * 256 + h * 64 + e0) = ov;
}

__device__ __forceinline__ void phase_mix(const Params& p, int l, unsigned char* smem) {
    unsigned char* ws = p.ws;
    const bf16* QP = (const bf16*)(ws + WS_QP); const bf16* KP = (const bf16*)(ws + WS_KP); const bf16* VP = (const bf16*)(ws + WS_VP); bf16* MIX = (bf16*)(ws + WS_XB);
    for (int u = BID(); u < 4096; u += GRD()) {
        if (u < 2048) {
            const int qc = 31 - (u >> 6), bh = u & 63, b = bh >> 3, h = bh & 7;
            attn_naive<96, 64>(smem, QP + ((size_t)bh * SEQ + qc * 64) * 96, 96, KP + (size_t)bh * SEQ * 96, 96, VP + (size_t)bh * SEQ * 64, 64, 64 * (qc + 1),
                               MIX + (size_t)(b * SEQ + qc * 64) * DM + 512 + h * 64, DM);
        } else mix_linear_unit(p, l, smem, u - 2048);
    }
}

__device__ __forceinline__ void ln_row_store(f32x4 (&v)[4], const float* g, const float* bta, float* of, bf16* ob, int lane) {
    float s = 0.f;
#pragma unroll
    for (int j = 0; j < 4; ++j) s += (v[j][0] + v[j][1]) + (v[j][2] + v[j][3]);
    const float mean = wave_sum(s) * (1.f / DM); float s2 = 0.f;
#pragma unroll
    for (int j = 0; j < 4; ++j) { v[j] = v[j] - mean; s2 += (v[j][0] * v[j][0] + v[j][1] * v[j][1]) + (v[j][2] * v[j][2] + v[j][3] * v[j][3]); }
    const float rstd = 1.f / sqrtf(wave_sum(s2) * (1.f / DM) + LN_EPS);
#pragma unroll
    for (int j = 0; j < 4; ++j) { const f32x4 gg = *(const f32x4*)(g + lane * 4 + 256 * j), bb = *(const f32x4*)(bta + lane * 4 + 256 * j);
        v[j] = v[j] * rstd * gg + bb; *(f32x4*)(of + lane * 4 + 256 * j) = v[j]; st_bf4(ob + lane * 4 + 256 * j, v[j]); }
}

__device__ __forceinline__ void phase_ln(const Params& p, int l, int which  ) {
    const int tid = TID(), lane = tid & 63, wave = tid >> 6; unsigned char* ws = p.ws;
    float* XR = p.out; bf16* XB = (bf16*)(ws + WS_XB);
    const float* g = p.in[26 + 2 * which] + l * DM; const float* bta = p.in[27 + 2 * which] + l * DM;
    const bf16* CT = (const bf16*)(ws + WS_CT);
    for (int row = BID() * 8 + wave; row < NTOK; row += GRD() * 8) {
        f32x4 v[4];
#pragma unroll
        for (int j = 0; j < 4; ++j) v[j] = *(const f32x4*)(XR + (size_t)row * DM + lane * 4 + 256 * j);
        if (which == 2) {
#pragma unroll
            for (int j = 0; j < 4; ++j) { const u32x2 c0 = *(const u32x2*)(CT + (size_t)row * DM + lane * 4 + 256 * j), c1 = *(const u32x2*)(CT + ((size_t)NTOK + row) * DM + lane * 4 + 256 * j);
                v[j] = v[j] * ALPHA + (f32x4){blo(c0.x), bhi(c0.x), blo(c0.y), bhi(c0.y)} + (f32x4){blo(c1.x), bhi(c1.x), blo(c1.y), bhi(c1.y)}; }
        }
        ln_row_store(v, g, bta, XR + (size_t)row * DM, XB + (size_t)row * DM, lane);
        if (which == 1) {
            const float* wgp = p.in[19] + (size_t)l * DM * 4; const float* bg = p.in[20] + l * 4; const float* wr = p.in[21] + (size_t)l * DM * 32; const float* br = p.in[22] + l * 32;
            float gl[4] = {0.f, 0.f, 0.f, 0.f};
#pragma unroll
            for (int j = 0; j < 4; ++j)
#pragma unroll
                for (int q = 0; q < 4; ++q) { const f32x4 w4 = *(const f32x4*)(wgp + (size_t)(lane * 4 + 256 * j + q) * 4); const float xv = v[j][q];
                    gl[0] = fmaf(xv, w4[0], gl[0]); gl[1] = fmaf(xv, w4[1], gl[1]); gl[2] = fmaf(xv, w4[2], gl[2]); gl[3] = fmaf(xv, w4[3], gl[3]); }
#pragma unroll
            for (int q = 0; q < 4; ++q) gl[q] = wave_sum(gl[q]) + bg[q];
            int gi = 0; float gm = gl[0];
#pragma unroll
            for (int q = 1; q < 4; ++q) if (gl[q] > gm) { gm = gl[q]; gi = q; }
            float gs = 0.f;
#pragma unroll
            for (int q = 0; q < 4; ++q) gs += expf(gl[q] - gm);
            const float gp = 1.f / gs;
            float el[8] = {0.f, 0.f, 0.f, 0.f, 0.f, 0.f, 0.f, 0.f};
#pragma unroll
            for (int j = 0; j < 4; ++j)
#pragma unroll
                for (int q = 0; q < 4; ++q) { const float* wrow = wr + (size_t)(lane * 4 + 256 * j + q) * 32 + gi * 8; const f32x4 w0 = *(const f32x4*)wrow, w1 = *(const f32x4*)(wrow + 4); const float xv = v[j][q];
                    el[0] = fmaf(xv, w0[0], el[0]); el[1] = fmaf(xv, w0[1], el[1]); el[2] = fmaf(xv, w0[2], el[2]); el[3] = fmaf(xv, w0[3], el[3]);
                    el[4] = fmaf(xv, w1[0], el[4]); el[5] = fmaf(xv, w1[1], el[5]); el[6] = fmaf(xv, w1[2], el[6]); el[7] = fmaf(xv, w1[3], el[7]); }
#pragma unroll
            for (int q = 0; q < 8; ++q) el[q] = wave_sum(el[q]) + br[gi * 8 + q];
            int i0 = 0; float m0 = el[0];
#pragma unroll
            for (int q = 1; q < 8; ++q) if (el[q] > m0) { m0 = el[q]; i0 = q; }
            int i1 = -1; float m1 = -3.0e38f;
#pragma unroll
            for (int q = 0; q < 8; ++q) if (q != i0 && el[q] > m1) { m1 = el[q]; i1 = q; }
            const float p1 = expf(m1 - m0); const float w0 = gp / (1.f + p1), w1 = gp * p1 / (1.f + p1);
            if (lane == 0) {
                unsigned* cnt = (unsigned*)(ws + WS_CTL) + CW_CNT + l * 32; int* LT = (int*)(ws + WS_LISTT); float* LW = (float*)(ws + WS_LISTW);
                const int e0 = gi * 8 + i0, e1 = gi * 8 + i1;
                const unsigned p0 = atomicAdd(cnt + e0, 1u); LT[(size_t)e0 * NTOK + p0] = row * 2; LW[(size_t)e0 * NTOK + p0] = w0;
                const unsigned q1 = atomicAdd(cnt + e1, 1u); LT[(size_t)e1 * NTOK + q1] = row * 2 + 1; LW[(size_t)e1 * NTOK + q1] = w1;
            }
        }
    }
}

__device__ __forceinline__ void moe_table(const Params& p, int l, int* tstart, int* cntl) {
    __syncthreads();
    if (TID() == 0) { const unsigned* cnt = (const unsigned*)(p.ws + WS_CTL) + CW_CNT + l * 32; int s = 0;
        for (int e = 0; e < 32; ++e) { const int c = (int)__hip_atomic_load(cnt + e, __ATOMIC_RELAXED, __HIP_MEMORY_SCOPE_AGENT); cntl[e] = c; tstart[e] = s; s += (c + 255) >> 8; } tstart[32] = s; }
    __syncthreads();
}

__device__ __forceinline__ void phase_moe(const Params& p, int l, unsigned char* smem, int which  ) {
    unsigned char* ws = p.ws;
    int* tstart = (int*)(smem + LDS_BYTES - 1024); int* cntl = tstart + 40;
    moe_table(p, l, tstart, cntl);
    if (which == 0) { SchedMoe S{tstart, cntl, (const int*)(ws + WS_LISTT), (const float*)(ws + WS_LISTW), (const bf16*)(ws + WS_XB), (const bf16*)(ws + W_GU), 0};
        EpiMoe1 E{(bf16*)(ws + WS_H)}; gemm_run<true>(smem, S, 1024, 1024, 1024, E); }
    else { SchedMoe S{tstart, cntl, (const int*)(ws + WS_LISTT), (const float*)(ws + WS_LISTW), (const bf16*)(ws + WS_H), (const bf16*)(ws + W_DN), 1};
        EpiMoe2 E{(bf16*)(ws + WS_CT)}; gemm_run(smem, S, 256, 256, 256, E); }
}

constexpr int LDS_PARAMS = LDS_BYTES - 512;
#define GETP const Params& p = *(const Params*)(smem + LDS_PARAMS); unsigned char* ws = p.ws; (void)ws
#ifndef FULL_MASK
#define FULL_MASK 0x3fffu
#endif
#ifndef PHASE_ATTR
#define PHASE_ATTR __forceinline__
#endif
__device__ PHASE_ATTR void ph_conv(unsigned char* smem, int l) { GETP; phase_conv(p, l, smem); }
__device__ PHASE_ATTR void ph_pre(unsigned char* smem) { GETP; phase_pre(p); }
__device__ PHASE_ATTR void ph_g1(unsigned char* smem, int l) { GETP;
    { SchedGrid S{(const bf16*)(ws + WS_XB), (const bf16*)(ws + W_IN), 1024, 10, 640, 0, 0}; EpiBf16Store E{(bf16*)(ws + WS_Y), YW, 1.f}; gemm_run(smem, S, 1024, 1024, 1024, E); }
    { SchedGrid S{(const bf16*)(ws + WS_MEMB), (const bf16*)(ws + W_XKV), 1024, 8, 64, 128, 0}; EpiBf16Store E{(bf16*)(ws + WS_KVX), 2048, 1.f}; gemm_run(smem, S, 1024, 1024, 1024, E); }
}
__device__ PHASE_ATTR void ph_loc(unsigned char* smem, int l) { GETP; phase_loc(p, l, smem); }
__device__ PHASE_ATTR void ph_scan(unsigned char* smem, int l) { GETP;
    { SchedGrid S{(const bf16*)(ws + WS_Y), (const bf16*)(ws + W_Q), 256, 3, 192, 0, Y_CQ};
      EpiMlaQ E{(bf16*)(ws + WS_QP), (const float*)(ws + WS_RS), (const float*)(ws + WS_ROPE)}; gemm_run(smem, S, 256, YW, 256, E); }
    { SchedGrid S{(const bf16*)(ws + WS_Y), (const bf16*)(ws + W_KV), 256, 5, 320, 64, Y_T9};
      EpiMlaKV E{(bf16*)(ws + WS_KP), (bf16*)(ws + WS_VP), (const float*)(ws + WS_RS), (const float*)(ws + WS_ROPE)}; gemm_run(smem, S, 256, YW, 256, E); }
    phase_scan(p, l);
}
__device__ PHASE_ATTR void ph_mix(unsigned char* smem, int l) { GETP; phase_mix(p, l, smem); }
__device__ PHASE_ATTR void ph_g4(unsigned char* smem, int l) { GETP;
    SchedGrid S{(const bf16*)(ws + WS_XB), (const bf16*)(ws + W_OUT), 1024, 4, 256, 0, 0}; EpiResid E{l == 0 ? p.in[0] : p.out, p.out}; gemm_run(smem, S, 1024, 1024, 1024, E);
}
__device__ PHASE_ATTR void ph_ln(unsigned char* smem, int l, int which) { GETP; phase_ln(p, l, which); }
__device__ PHASE_ATTR void ph_g5(unsigned char* smem, int l) { GETP;
    SchedGrid S{(const bf16*)(ws + WS_XB), (const bf16*)(ws + W_XQ), 1024, 4, 256, 0, 0}; EpiBf16Store E{(bf16*)(ws + WS_QX), DM, XSCALE}; gemm_run(smem, S, 1024, 1024, 1024, E);
}
__device__ PHASE_ATTR void ph_xatt(unsigned char* smem, int l) { GETP;
    const bf16* QX = (const bf16*)(ws + WS_QX); const bf16* KVX = (const bf16*)(ws + WS_KVX); bf16* OX = (bf16*)(ws + WS_OX);
    for (int u = blockIdx.x; u < 1024; u += gridDim.x) { const int b = u >> 7, h = (u >> 5) & 3, qt = u & 31;
        attn_naive<256, 256>(smem, QX + (size_t)(b * SEQ + qt * 64) * DM + h * 256, DM, KVX + (size_t)(b * 256) * 2048 + h * 256, 2048, KVX + (size_t)(b * 256) * 2048 + 1024 + h * 256, 2048, 256,
                             OX + (size_t)(b * SEQ + qt * 64) * DM + h * 256, DM); }
}
__device__ PHASE_ATTR void ph_g7(unsigned char* smem, int l) { GETP;
    SchedGrid S{(const bf16*)(ws + WS_OX), (const bf16*)(ws + W_XO), 1024, 4, 256, 0, 0}; EpiResid E{p.out, p.out}; gemm_run(smem, S, 1024, 1024, 1024, E);
}
__device__ PHASE_ATTR void ph_moe(unsigned char* smem, int l, int which) { GETP; phase_moe(p, l, smem, which); }

template <unsigned MASK>
__global__ void __launch_bounds__(512, 2) fwd(Params pk) {
    extern __shared__ __attribute__((aligned(16))) unsigned char smem[];
    { const unsigned* src = (const unsigned*)&pk; unsigned* dst = (unsigned*)(smem + LDS_PARAMS); for (int i = threadIdx.x; i < (int)(sizeof(Params) / 4); i += 512) dst[i] = src[i]; }
    unsigned char* ws = pk.ws;
    volatile LAS unsigned* barw = (volatile LAS unsigned*)((LAS unsigned char*)smem + LDS_BARW);
    if (threadIdx.x == 0) { barw[0] = 0u; barw[1] = 0u; }
    __syncthreads();
    XcdBarrier bar; bar.bar = (unsigned*)(ws + WS_CTL) + CW_BAR; bar.x = 0; bar.st = barw;
    const int lo = pk.ph_lo, hi = pk.ph_hi;
    const bool multi = (hi - lo) > 1;
    if (multi) bar = xcd_barrier_post((unsigned*)(ws + WS_CTL) + CW_BAR, barw);
    if (lo == 0) ph_pre(smem);
#pragma unroll 1
    for (int l = 0; l < 2; ++l) {
        const int base = l * NPH;
#define IN(k) (((MASK >> (k)) & 1u) != 0u && lo <= base + (k) && base + (k) < hi)
#define SEAM(k) do { if (base + (k) + 1 < hi) xcd_barrier(bar); } while (0)
        if (IN(PH_CONV)) { ph_conv(smem, l); SEAM(PH_CONV); }
        if (IN(PH_G1)) { ph_g1(smem, l); SEAM(PH_G1); }
        if (IN(PH_LOC)) { ph_loc(smem, l); SEAM(PH_LOC); }
        if (IN(PH_SCAN)) { ph_scan(smem, l); SEAM(PH_SCAN); }
        if (IN(PH_MIX)) { ph_mix(smem, l); SEAM(PH_MIX); }
        if (IN(PH_G4)) { ph_g4(smem, l); SEAM(PH_G4); }
        if (IN(PH_LN1)) { ph_ln(smem, l, 0); SEAM(PH_LN1); }
        if (IN(PH_G5)) { ph_g5(smem, l); SEAM(PH_G5); }
        if (IN(PH_XATT)) { ph_xatt(smem, l); SEAM(PH_XATT); }
        if (IN(PH_G7)) { ph_g7(smem, l); SEAM(PH_G7); }
        if (IN(PH_LN2)) { ph_ln(smem, l, 1); SEAM(PH_LN2); }
        if (IN(PH_MOE1)) { ph_moe(smem, l, 0); SEAM(PH_MOE1); }
        if (IN(PH_MOE2)) { ph_moe(smem, l, 1); SEAM(PH_MOE2); }
        if (IN(PH_LN3)) { ph_ln(smem, l, 2); SEAM(PH_LN3); }
#undef IN
#undef SEAM
    }
}

extern "C" void kernel_launch(void* const* d_in, const int* in_sizes, int n_in, void* d_out, int out_size, void* d_ws, size_t ws_size, hipStream_t stream) {
    static int grid = 0;
    typedef void (*kfn_t)(Params);
#if N_LAUNCH_MODE == 1
    static const kfn_t kfn[NPH] = { fwd<1u << 0>, fwd<1u << 1>, fwd<1u << 2>, fwd<1u << 3>, fwd<1u << 4>, fwd<1u << 5>, fwd<1u << 6>, fwd<1u << 7>, fwd<1u << 8>, fwd<1u << 9>, fwd<1u << 10>, fwd<1u << 11>, fwd<1u << 12>, fwd<1u << 13> };
    constexpr int NK = NPH;
#else
    static const kfn_t kfn[1] = { fwd<FULL_MASK> };
    constexpr int NK = 1;
#endif
    if (grid == 0) {
        int dev = 0, cus = 0;
        if (n_in != 32 || out_size != NTOK * DM || ws_size < WS_TOTAL) { fprintf(stderr, "kernel_launch: unexpected shapes (n_in %d out %d ws %zu need %zu)\n", n_in, out_size, ws_size, (size_t)WS_TOTAL); }
        (void)hipGetDevice(&dev); (void)hipDeviceGetAttribute(&cus, hipDeviceAttributeMultiprocessorCount, dev);
        for (int i = 0; i < NK; ++i) (void)hipFuncSetAttribute((const void*)kfn[i], hipFuncAttributeMaxDynamicSharedMemorySize, LDS_BYTES);
        int per_cu = 0; (void)hipOccupancyMaxActiveBlocksPerMultiprocessor(&per_cu, (const void*)kfn[0], 512, LDS_BYTES);
        (void)hipGetLastError();
        grid = cus > 0 ? cus : 256;
    }
    (void)hipMemsetAsync((char*)d_ws + WS_CTL, 0, CTL_BYTES, stream);
    Params p{};
    for (int i = 0; i < 32; ++i) p.in[i] = (const float*)d_in[i];
    p.out = (float*)d_out; p.ws = (unsigned char*)d_ws;
#if N_LAUNCH_MODE == 1
    for (int ph = 0; ph < 2 * NPH; ++ph) { p.ph_lo = ph; p.ph_hi = ph + 1; hipLaunchKernelGGL(kfn[ph % NPH], dim3(grid), dim3(512), LDS_BYTES, stream, p); }
#else
    p.ph_lo = 0; p.ph_hi = 2 * NPH; hipLaunchKernelGGL(kfn[0], dim3(grid), dim3(512), LDS_BYTES, stream, p);
#endif
}
```

```cpp
#include <hip/hip_runtime.h>
#include <stdint.h>
#include <stdio.h>

#ifndef N_LAUNCH_MODE
#define N_LAUNCH_MODE 0
#endif

typedef unsigned short bf16;
typedef float f32x4 __attribute__((ext_vector_type(4)));
typedef unsigned u32x4 __attribute__((ext_vector_type(4)));
typedef unsigned u32x2 __attribute__((ext_vector_type(2)));
#define LAS __attribute__((address_space(3)))

constexpr int NTOK = 16384, DM = 1024, SEQ = 2048, NBATCH = 8, YW = 2560, NCH = 32;
constexpr int Y_GQ = 0, Y_GK = 256, Y_GV = 512, Y_GR = 768, Y_MQ = 1024, Y_MK = 1280, Y_MV = 1536, Y_MO = 1792, Y_CQ = 2048, Y_T9 = 2304,
              Y_A = 2304, Y_MI = 2320, Y_MF = 2324, Y_CKV = 2328, Y_KR = 2456;
constexpr float ALPHA = 1.41421356237309515f;
constexpr float LN_EPS = 1e-5f;
constexpr float LOG2E = 1.44269504088896341f;
constexpr float QSCALE = 0.10206207261596575f * LOG2E;
constexpr float XSCALE = 0.0625f * LOG2E;
constexpr int NPH = 14;
enum { PH_CONV = 0, PH_G1, PH_LOC, PH_SCAN, PH_MIX, PH_G4, PH_LN1, PH_G5, PH_XATT, PH_G7, PH_LN2, PH_MOE1, PH_MOE2, PH_LN3 };

constexpr size_t MiB = 1u << 20;
constexpr size_t WS_CTL = 0, CTL_BYTES = 1 * MiB;
constexpr size_t W_IN = 1 * MiB;
constexpr size_t W_Q = W_IN + (size_t)2560 * 1024 * 2;
constexpr size_t W_KV = W_Q + (size_t)768 * 256 * 2;
constexpr size_t W_OUT = W_KV + (size_t)1280 * 256 * 2;
constexpr size_t W_XQ = W_OUT + 2 * MiB;
constexpr size_t W_XKV = W_XQ + 2 * MiB;
constexpr size_t W_XO = W_XKV + 4 * MiB;
constexpr size_t W_GU = W_XO + 2 * MiB;
constexpr size_t W_DN = W_GU + 32 * MiB;
constexpr size_t W_END = W_DN + 16 * MiB;
constexpr size_t WS_XB = W_END;
constexpr size_t WS_MEMB = WS_XB + 32 * MiB;
constexpr size_t WS_KVX = WS_MEMB + 4 * MiB;
constexpr size_t WS_ROPE = WS_KVX + 8 * MiB;
constexpr size_t WS_RS = WS_ROPE + 2 * MiB;
constexpr size_t WS_LISTT = WS_RS + 128 * 1024;
constexpr size_t WS_LISTW = WS_LISTT + 2 * MiB;
constexpr size_t WS_NV = WS_LISTW + 2 * MiB;
constexpr size_t WS_DEC = WS_NV + 256 * 1024;
constexpr size_t WS_SC = WS_DEC + 256 * 1024;
constexpr size_t WS_MS = WS_SC + 8 * 1024;
constexpr size_t WS_Y = WS_MS + 8 * 1024;
constexpr size_t WS_QX = WS_Y, WS_OX = WS_Y + 32 * MiB, WS_H = WS_Y;
constexpr size_t WS_QP = WS_Y + 80 * MiB;
constexpr size_t WS_KP = WS_QP + 24 * MiB;
constexpr size_t WS_VP = WS_KP + 24 * MiB;
constexpr size_t WS_ST = WS_VP + 16 * MiB;
constexpr size_t WS_CT = WS_QP;
constexpr size_t WS_TOTAL = WS_ST + 32 * MiB;
static_assert(WS_TOTAL <= (size_t)342000000, "workspace budget");
constexpr int CW_BAR = 4096;
constexpr int CW_CNT = 16384;

constexpr int LDS_BYTES = 147456;
constexpr int LDS_BARW = LDS_BYTES - 16;

struct Params {
    const float* in[32];
    float* out;
    unsigned char* ws;
    int ph_lo, ph_hi;
};

__device__ __forceinline__ float bf2f(unsigned v) { return __uint_as_float(v << 16); }
__device__ __forceinline__ unsigned f2bf(float f) { unsigned u = __float_as_uint(f); return (u + 0x7fffu + ((u >> 16) & 1u)) >> 16; }
__device__ __forceinline__ unsigned pk2(float lo, float hi) { return f2bf(lo) | (f2bf(hi) << 16); }
__device__ __forceinline__ float blo(unsigned w) { return __uint_as_float(w << 16); }
__device__ __forceinline__ float bhi(unsigned w) { return __uint_as_float(w & 0xffff0000u); }
__device__ __forceinline__ float wave_sum(float v) {
#pragma unroll
    for (int o = 1; o < 64; o <<= 1) v += __shfl_xor(v, o);
    return v;
}
__device__ __forceinline__ float logsigmoid(float z) { return fminf(z, 0.f) - log1pf(expf(-fabsf(z))); }
__device__ __forceinline__ float sigmoidf(float x) { return 1.f / (1.f + expf(-x)); }
__device__ __forceinline__ float siluf(float x) { return x / (1.f + expf(-x)); }
__device__ __forceinline__ void st_bf4(bf16* p, f32x4 v) { u32x2 w; w.x = pk2(v[0], v[1]); w.y = pk2(v[2], v[3]); *(u32x2*)p = w; }

#define XB_TMO      128
#define XB_XCNT(j)  (256  + 64 * (j))
#define XB_XSUB(j)  (1280 + 64 * (j))
#define XB_XGEN(j)  (2304 + 64 * (j))
#define XB_TOP      3328
#define XB_TOPGEN   3392
#define XCD_BAR_WORDS 3456
#define XB_SPIN_CAP (1u << 24)
__device__ __forceinline__ unsigned xb_ld(unsigned* p)              { return __hip_atomic_load(p, __ATOMIC_RELAXED, __HIP_MEMORY_SCOPE_AGENT); }
__device__ __forceinline__ unsigned xb_add(unsigned* p, unsigned v) { return __hip_atomic_fetch_add(p, v, __ATOMIC_RELAXED, __HIP_MEMORY_SCOPE_AGENT); }
__device__ __forceinline__ unsigned xb_xcc_id() { return (unsigned)__builtin_amdgcn_s_getreg((3 << 11) | 20) & 0xFu; }
#define XB_SPIN(cond, bar) do { unsigned _sp = 0; while (cond) { __builtin_amdgcn_s_sleep(1); \
    if ((++_sp & 255u) == 0u) { if (xb_ld(&(bar)[XB_TMO])) break; if (_sp > XB_SPIN_CAP) { atomicAdd(&(bar)[XB_TMO], 1u); break; } } } } while (0)
struct XcdBarrier { unsigned* bar; unsigned x; volatile LAS unsigned* st; };
__device__ __forceinline__ XcdBarrier xcd_barrier_post(unsigned* bar, volatile LAS unsigned* st) {
    XcdBarrier b; b.bar = bar; b.x = xb_xcc_id(); b.st = st;
    if (threadIdx.x == 0) (void)xb_add(&bar[XB_XCNT(b.x)], 1u);
    return b;
}
__device__ __forceinline__ void xcd_barrier_complete(unsigned* bar, unsigned x, unsigned& nloc, unsigned& nx) {
    const unsigned G = gridDim.x * gridDim.y * gridDim.z;
    unsigned sum, cnt, mine, sp = 0u;
    for (;;) {
        sum = 0u; cnt = 0u; mine = 0u;
#pragma unroll
        for (unsigned j = 0; j < 16; ++j) { const unsigned c = xb_ld(&bar[XB_XCNT(j)]); sum += c; cnt += (c > 0u) ? 1u : 0u; mine = (j == x) ? c : mine; }
        if (sum == G) break;
        __builtin_amdgcn_s_sleep(1);
        if ((++sp & 255u) == 0u) { if (xb_ld(&bar[XB_TMO])) break; if (sp > XB_SPIN_CAP) { atomicAdd(&bar[XB_TMO], 1u); break; } }
    }
    nloc = mine > 0u ? mine : 1u; nx = cnt > 0u ? cnt : 1u;
}
__device__ __noinline__ void xcd_barrier(const XcdBarrier b) {
    asm volatile("s_waitcnt vmcnt(0)" ::: "memory");
    __syncthreads();
    if (threadIdx.x == 0) {
        unsigned* bar = b.bar;
        __builtin_amdgcn_s_waitcnt(0);
        unsigned nloc = b.st[0], nx = b.st[1];
        if (nloc == 0u) { xcd_barrier_complete(bar, b.x, nloc, nx); b.st[0] = nloc; b.st[1] = nx; }
        const unsigned old = xb_add(&bar[XB_XSUB(b.x)], 1u);
        const unsigned gen = old / nloc;
        if (old + 1u == (gen + 1u) * nloc) {
            __builtin_amdgcn_fence(__ATOMIC_RELEASE, "agent");
            asm volatile("s_waitcnt vmcnt(0)" ::: "memory");
            const unsigned og = xb_add(&bar[XB_TOP], 1u);
            const unsigned tg = og / nx;
            if (og + 1u == (tg + 1u) * nx) xb_add(&bar[XB_TOPGEN], 1u);
            else XB_SPIN(xb_ld(&bar[XB_TOPGEN]) == tg, bar);
            __builtin_amdgcn_fence(__ATOMIC_ACQUIRE, "agent");
            xb_add(&bar[XB_XGEN(b.x)], 1u);
            asm volatile("s_waitcnt vmcnt(0)" ::: "memory");
        } else {
            XB_SPIN(xb_ld(&bar[XB_XGEN(b.x)]) == gen, bar);
            __builtin_amdgcn_fence(__ATOMIC_ACQUIRE, "agent");
            asm volatile("s_waitcnt vmcnt(0)" ::: "memory");
        }
    }
    __syncthreads();
}

__device__ __forceinline__ int TID() { int t = threadIdx.x; asm volatile("" : "+v"(t)); return t; }
__device__ __forceinline__ int BID() { int t = blockIdx.x; asm volatile("" : "+s"(t)); return t; }
__device__ __forceinline__ int GRD() { int t = gridDim.x; asm volatile("" : "+s"(t)); return t; }

struct UnitDesc {
    const bf16* A;
    const bf16* B;
    const int* ridx;
    const float* rw;
    int arow0, acol;
    int row0, col0;
    int nvalid;
    int gather;
};

template <class Epi>
__device__ __forceinline__ void gemm_unit_naive(unsigned char* smem, const UnitDesc& u, int K, int lda, int ldb, const Epi& E) {
    float* As = (float*)smem;
    float* Bs = As + 16 * 128;
    const int tid = TID(), ty = tid >> 4, tx = tid & 15;
    const int lr = tid >> 1, lk = (tid & 1) * 8;
    const bf16* brow = u.B + (size_t)lr * ldb;
    const int cb = (tx >> 2) * 32 + (tx & 3) * 4;
#pragma unroll 1
    for (int half = 0; half < 2; ++half) {
        float acc[4][16];
#pragma unroll
        for (int i = 0; i < 4; ++i)
#pragma unroll
            for (int j = 0; j < 16; ++j) acc[i][j] = 0.f;
        const int ar = half * 128 + (lr & 127);
        const bf16* arow;
        if (u.gather) { const int rr = ar < u.nvalid ? ar : 0; arow = u.A + (size_t)(u.ridx[rr] >> 1) * lda + u.acol; }
        else arow = u.A + (size_t)(u.arow0 + ar) * lda + u.acol;
#pragma unroll 1
        for (int k0 = 0; k0 < K; k0 += 16) {
            const u32x4 bv = *(const u32x4*)(brow + k0 + lk);
            u32x4 av = {0u, 0u, 0u, 0u};
            if (tid < 256) av = *(const u32x4*)(arow + k0 + lk);
            __syncthreads();
#pragma unroll
            for (int j = 0; j < 4; ++j) {
                if (tid < 256) { As[(lk + 2 * j) * 128 + lr] = blo(av[j]); As[(lk + 2 * j + 1) * 128 + lr] = bhi(av[j]); }
                Bs[(lk + 2 * j) * 256 + lr] = blo(bv[j]); Bs[(lk + 2 * j + 1) * 256 + lr] = bhi(bv[j]);
            }
            __syncthreads();
#pragma unroll 4
            for (int kk = 0; kk < 16; ++kk) {
                float b[16];
                const f32x4 a0 = *(const f32x4*)(As + kk * 128 + ty * 4);
#pragma unroll
                for (int g = 0; g < 2; ++g)
#pragma unroll
                    for (int h2 = 0; h2 < 2; ++h2) {
                        const f32x4 bq = *(const f32x4*)(Bs + kk * 256 + g * 128 + cb + h2 * 16);
                        b[g * 8 + h2 * 4 + 0] = bq[0]; b[g * 8 + h2 * 4 + 1] = bq[1]; b[g * 8 + h2 * 4 + 2] = bq[2]; b[g * 8 + h2 * 4 + 3] = bq[3];
                    }
#pragma unroll
                for (int i = 0; i < 4; ++i)
#pragma unroll
                    for (int j = 0; j < 16; ++j) acc[i][j] = fmaf(a0[i], b[j], acc[i][j]);
            }
        }
        __syncthreads();
        float* Ct = (float*)smem;
#pragma unroll
        for (int i = 0; i < 4; ++i)
#pragma unroll
            for (int g = 0; g < 2; ++g) {
                *(f32x4*)(Ct + (ty * 4 + i) * 260 + g * 128 + cb) = (f32x4){acc[i][g * 8 + 0], acc[i][g * 8 + 1], acc[i][g * 8 + 2], acc[i][g * 8 + 3]};
                *(f32x4*)(Ct + (ty * 4 + i) * 260 + g * 128 + cb + 16) = (f32x4){acc[i][g * 8 + 4], acc[i][g * 8 + 5], acc[i][g * 8 + 6], acc[i][g * 8 + 7]};
            }
        __syncthreads();
#pragma unroll 1
        for (int item = tid; item < 128 * 32; item += 512) {
            const int rr = item >> 5, cg = item & 31, c = (cg >> 4) * 128 + ((cg & 15) >> 2) * 32 + (cg & 3) * 4, r = half * 128 + rr;
            if (r < u.nvalid) { const f32x4 v0 = *(const f32x4*)(Ct + rr * 260 + c), v1 = *(const f32x4*)(Ct + rr * 260 + c + 16); E(u, r, c, v0, v1); }
        }
        __syncthreads();
    }
}

struct EpiBf16Store { bf16* O; int ldo; float scale;
    __device__ __forceinline__ void operator()(const UnitDesc& u, int r, int c, f32x4 v0, f32x4 v1) const {
        bf16* o = O + (size_t)(u.row0 + r) * ldo + u.col0 + c; st_bf4(o, v0 * scale); st_bf4(o + 16, v1 * scale); } };
struct EpiKVX { bf16* KX; bf16* VXT;
    __device__ __forceinline__ void grp(int row, int c, f32x4 v) const {
        if (c < 1024) st_bf4(KX + (size_t)row * 1024 + c, v);
        else { const int cc = c - 1024, b = row >> 8, key = row & 255; bf16* vt = VXT + ((size_t)(b * 1024 + cc)) * 256 + key;
            vt[0] = (bf16)f2bf(v[0]); vt[256] = (bf16)f2bf(v[1]); vt[512] = (bf16)f2bf(v[2]); vt[768] = (bf16)f2bf(v[3]); } }
    __device__ __forceinline__ void operator()(const UnitDesc& u, int r, int c, f32x4 v0, f32x4 v1) const {
        grp(u.row0 + r, u.col0 + c, v0); grp(u.row0 + r, u.col0 + c + 16, v1); } };
struct EpiResid { const float* res; float* out;
    __device__ __forceinline__ void operator()(const UnitDesc& u, int r, int c, f32x4 v0, f32x4 v1) const {
        const size_t o = (size_t)(u.row0 + r) * DM + u.col0 + c;
        const f32x4 r0 = *(const f32x4*)(res + o), r1 = *(const f32x4*)(res + o + 16);
        *(f32x4*)(out + o) = r0 * ALPHA + v0; *(f32x4*)(out + o + 16) = r1 * ALPHA + v1; } };
__device__ __forceinline__ f32x4 rope4(f32x4 v, const float* ROPE, int row, int i) {
    const f32x4 cs = *(const f32x4*)(ROPE + ((size_t)row * 16 + i) * 2);
    return (f32x4){v[0] * cs[0] - v[1] * cs[1], v[1] * cs[0] + v[0] * cs[1], v[2] * cs[2] - v[3] * cs[3], v[3] * cs[2] + v[2] * cs[3]}; }
struct EpiMlaQ { bf16* QP; const float* RS; const float* ROPE;
    __device__ __forceinline__ void grp(int row, int c, f32x4 v) const {
        asm volatile("" : "+v"(row), "+v"(c));
        const int b = row >> 11, s = row & 2047, h = c / 96, j = c - h * 96;
        v = v * (RS[row * 2] * QSCALE);
        if (j >= 64) v = rope4(v, ROPE, row, (j - 64) >> 1);
        st_bf4(QP + ((size_t)((b * 8 + h) * SEQ + s)) * 96 + j, v); }
    __device__ __forceinline__ void operator()(const UnitDesc& u, int r, int c, f32x4 v0, f32x4 v1) const {
        grp(u.row0 + r, u.col0 + c, v0); grp(u.row0 + r, u.col0 + c + 16, v1); } };
struct EpiMlaKV { bf16 *KP, *VP; const float* RS; const float* ROPE;
    __device__ __forceinline__ void grp(int row, int c, f32x4 v) const {
        asm volatile("" : "+v"(row), "+v"(c));
        const int b = row >> 11, s = row & 2047, h = c / 160, j = c - h * 160; const float rs = RS[row * 2 + 1];
        if (j < 64) st_bf4(KP + ((size_t)((b * 8 + h) * SEQ + s)) * 96 + j, v * rs);
        else if (j < 96) st_bf4(KP + ((size_t)((b * 8 + h) * SEQ + s)) * 96 + j, rope4(v, ROPE, row, (j - 64) >> 1));
        else { bf16* vt = VP + ((size_t)((b * 8 + h) * 64 + (j - 96))) * SEQ + s;
            vt[0] = (bf16)f2bf(v[0] * rs); vt[SEQ] = (bf16)f2bf(v[1] * rs); vt[2 * SEQ] = (bf16)f2bf(v[2] * rs); vt[3 * SEQ] = (bf16)f2bf(v[3] * rs); } }
    __device__ __forceinline__ void operator()(const UnitDesc& u, int r, int c, f32x4 v0, f32x4 v1) const {
        grp(u.row0 + r, u.col0 + c, v0); grp(u.row0 + r, u.col0 + c + 16, v1); } };
struct EpiMoe1 { bf16* H;
    __device__ __forceinline__ void operator()(const UnitDesc& u, int r, int c, f32x4 v0, f32x4 v1) const {
        f32x4 h;
#pragma unroll
        for (int j = 0; j < 4; ++j) h[j] = siluf(v0[j]) * v1[j];
        st_bf4(H + (size_t)(u.row0 + r) * 256 + u.col0 + (c >> 5) * 16 + (c & 15), h); } };
struct EpiMoe2 { bf16* CT;
    __device__ __forceinline__ void operator()(const UnitDesc& u, int r, int c, f32x4 v0, f32x4 v1) const {
        asm volatile("" : "+v"(r), "+v"(c));
        const int ent = u.ridx[r]; const float w = u.rw[r];
        bf16* o = CT + ((size_t)(ent & 1) * NTOK + (ent >> 1)) * DM + u.col0 + c; st_bf4(o, v0 * w); st_bf4(o + 16, v1 * w); } };

typedef short bf16x8 __attribute__((ext_vector_type(8)));
namespace mg {
constexpr int BK = 64, HALF = 128, HTB = HALF * BK * 2, STAGE_BYTES = 8 * HTB;
__device__ __forceinline__ int lds_byte(int r, int c) { const int st = (r >> 4) * 2 + (c >> 5), rr = r & 15, cc = c & 31, ob = rr * 64 + cc * 2; return st * 1024 + (ob ^ (((ob >> 9) & 1) << 5)); }
__device__ __forceinline__ void stage_rc(int b, int& R, int& C) { const int st = b / 1024, sb = b % 1024, swz = sb ^ (((sb >> 9) & 1) << 5); R = (st >> 1) * 16 + swz / 64; C = (st & 1) * 32 + (swz % 64) / 2; }

template <bool GATHER, class Sched, class Epi>
__device__ __forceinline__ void gemm_mfma(LAS unsigned char* lds, const Sched& S, const int K, const int lda, const int ldb, const Epi& E) {
    const int tid = TID(), wid = __builtin_amdgcn_readfirstlane(tid >> 6), lane = tid & 63, wr = wid >> 2, wc = wid & 3, fr = lane & 15, fq = lane >> 4;
    const int nt = K / BK;
    unsigned voffB[2], voffA[2];
    { int R0, C0, R1, C1; stage_rc(tid * 16, R0, C0); stage_rc(tid * 16 + 8192, R1, C1); voffB[0] = (unsigned)(R0 * ldb + C0) * 2u; voffB[1] = (unsigned)(R1 * ldb + C1) * 2u;
      voffA[0] = (unsigned)(R0 * lda + C0) * 2u; voffA[1] = (unsigned)(R1 * lda + C1) * 2u; }
    const size_t kstep = (size_t)(BK * 2);
    const size_t hstepB = (size_t)HALF * ldb * 2, hstepA = (size_t)HALF * lda * 2;
    const unsigned ldsw = (unsigned)wid * 1024u;
    const int aoff = lds_byte(wr * 64 + fr, fq * 8), boff = lds_byte(wc * 32 + fr, fq * 8);
#define MG_SA(b, h) (((b) * 2 + (h)) * HTB)
#define MG_SB(b, h) ((4 + (b) * 2 + (h)) * HTB)
#define MG_STAGE(bufoff, gbase, voff) do { _Pragma("unroll") for (int _i = 0; _i < 2; ++_i) \
        __builtin_amdgcn_global_load_lds((const unsigned*)((const char*)(gbase) + (voff)[_i]), (LAS unsigned*)(lds + (bufoff) + ldsw + _i * 8192), 16, 0, 0); } while (0)
#define MG_STA(bufoff, base, h, nx) do { if constexpr (GATHER) { if (nx) MG_STAGE(bufoff, base, vn[h]); else MG_STAGE(bufoff, base, vc[h]); } else { MG_STAGE(bufoff, (base) + (h) * hstepA, voffA); } } while (0)
#define MG_LDA(dst, b, h) do { _Pragma("unroll") for (int m = 0; m < 4; ++m) _Pragma("unroll") for (int k = 0; k < 2; ++k) dst[m][k] = *(const LAS bf16x8*)(lds + MG_SA(b, h) + aoff + m * 2048 + k * 1024); } while (0)
#define MG_LDB(dst, b, h) do { _Pragma("unroll") for (int n = 0; n < 2; ++n) _Pragma("unroll") for (int k = 0; k < 2; ++k) dst[n][k] = *(const LAS bf16x8*)(lds + MG_SB(b, h) + boff + n * 2048 + k * 1024); } while (0)
#define MG_MMA(ai, bj, At, Bt) do { __builtin_amdgcn_s_setprio(1); _Pragma("unroll") for (int m = 0; m < 4; ++m) _Pragma("unroll") for (int n = 0; n < 2; ++n) _Pragma("unroll") for (int k = 0; k < 2; ++k) \
        acc[ai][bj][m][n] = __builtin_amdgcn_mfma_f32_16x16x32_bf16(Bt[n][k], At[m][k], acc[ai][bj][m][n], 0, 0, 0); __builtin_amdgcn_s_setprio(0); } while (0)
#define MG_WAIT_V(n) asm volatile("s_waitcnt vmcnt(" #n ")" ::: "memory")
#define MG_WAIT_L(n) asm volatile("s_waitcnt lgkmcnt(" #n ")" ::: "memory")
#define MG_BAR __builtin_amdgcn_s_barrier()
#define MG_SCHED __builtin_amdgcn_sched_barrier(0)
#define MG_MKOFF(u, v) do { if constexpr (GATHER) { int R0, C0, R1, C1; { const int _t = TID(); stage_rc(_t * 16, R0, C0); stage_rc(_t * 16 + 8192, R1, C1); } _Pragma("unroll") for (int _h = 0; _h < 2; ++_h) { \
        const int _r0 = R0 + 128 * _h, _r1 = R1 + 128 * _h; const int _l = (u).nvalid - 1; const int _a0 = (u).ridx[_r0 < _l ? _r0 : _l] >> 1, _a1 = (u).ridx[_r1 < _l ? _r1 : _l] >> 1; \
        v[_h][0] = ((unsigned)_a0 * (unsigned)lda + (unsigned)C0) * 2u; v[_h][1] = ((unsigned)_a1 * (unsigned)lda + (unsigned)C1) * 2u; } } } while (0)
#define MG_ABASE(u) (GATHER ? (const char*)((u).A + (u).acol) : (const char*)((u).A + (size_t)(u).arow0 * lda + (u).acol))
    UnitDesc cur, nxt; int ui = 0;
    if (!S.get(0, cur)) return;
    f32x4 acc[2][2][4][2];
#pragma unroll
    for (int a = 0; a < 2; ++a)
#pragma unroll
        for (int b = 0; b < 2; ++b)
#pragma unroll
            for (int m = 0; m < 4; ++m)
#pragma unroll
                for (int n = 0; n < 2; ++n) acc[a][b][m][n] = (f32x4){0.f, 0.f, 0.f, 0.f};
    bf16x8 At[4][2], B0[2][2], B1[2][2];
    unsigned vc[2][2], vn[2][2];
    MG_MKOFF(cur, vc);
    const char* cA = MG_ABASE(cur); const char* cB = (const char*)cur.B;
    MG_STAGE(MG_SB(0, 0), cB, voffB); MG_STA(MG_SA(0, 0), cA, 0, false); MG_STAGE(MG_SB(0, 1), cB + hstepB, voffB); MG_STA(MG_SA(0, 1), cA, 1, false);
    if (wr == 1) MG_BAR;
    MG_WAIT_V(4); MG_BAR;
    MG_STAGE(MG_SB(1, 0), cB + kstep, voffB); MG_STA(MG_SA(1, 0), cA + kstep, 0, false); MG_STAGE(MG_SB(1, 1), cB + hstepB + kstep, voffB);
    MG_WAIT_V(6); MG_BAR;
    for (;;) {
        const bool has_next = S.get(ui + 1, nxt);
        const char* nA = has_next ? MG_ABASE(nxt) : cA; const char* nB = has_next ? (const char*)nxt.B : cB;
        if constexpr (GATHER) { if (has_next) { MG_MKOFF(nxt, vn); } else { vn[0][0] = vc[0][0]; vn[0][1] = vc[0][1]; vn[1][0] = vc[1][0]; vn[1][1] = vc[1][1]; } }
#pragma unroll 1
        for (int t = 0; t < nt; t += 2) {
            const bool last = (t == nt - 2);
            const char* a1 = cA + (size_t)(t + 1) * kstep;
            const char* a2 = last ? nA : cA + (size_t)(t + 2) * kstep; const char* b2 = last ? nB : cB + (size_t)(t + 2) * kstep;
            const char* a3 = a2 + kstep; const char* b3 = b2 + kstep;
            MG_LDB(B0, 0, 0); MG_SCHED; MG_LDA(At, 0, 0); MG_STA(MG_SA(1, 1), a1, 1, false);
            MG_WAIT_L(8); MG_BAR; MG_WAIT_L(0); MG_MMA(0, 0, At, B0); MG_BAR; MG_SCHED;
            MG_LDB(B1, 0, 1); MG_STAGE(MG_SB(0, 0), b2, voffB);
            MG_BAR; MG_WAIT_L(0); MG_MMA(0, 1, At, B1); MG_BAR;
            MG_LDA(At, 0, 1); MG_STA(MG_SA(0, 0), a2, 0, last);
            MG_BAR; MG_WAIT_L(0); MG_MMA(1, 0, At, B0); MG_BAR; MG_SCHED;
            MG_STAGE(MG_SB(0, 1), b2 + hstepB, voffB);
            MG_WAIT_V(6); MG_BAR; MG_MMA(1, 1, At, B1); MG_BAR;
            MG_LDB(B0, 1, 0); MG_SCHED; MG_LDA(At, 1, 0); MG_STA(MG_SA(0, 1), a2, 1, last);
            MG_WAIT_L(8); MG_BAR; MG_WAIT_L(0); MG_MMA(0, 0, At, B0); MG_BAR; MG_SCHED;
            MG_LDB(B1, 1, 1); MG_STAGE(MG_SB(1, 0), b3, voffB);
            MG_BAR; MG_WAIT_L(0); MG_MMA(0, 1, At, B1); MG_BAR;
            MG_LDA(At, 1, 1); MG_STA(MG_SA(1, 0), a3, 0, last);
            MG_BAR; MG_WAIT_L(0); MG_MMA(1, 0, At, B0); MG_BAR; MG_SCHED;
            MG_STAGE(MG_SB(1, 1), b3 + hstepB, voffB);
            MG_WAIT_V(6); MG_BAR; MG_MMA(1, 1, At, B1); MG_BAR;
        }
#pragma unroll
        for (int ai = 0; ai < 2; ++ai)
#pragma unroll
            for (int m = 0; m < 4; ++m) { const int r = ai * HALF + wr * 64 + m * 16 + fr;
                if (r < cur.nvalid) {
#pragma unroll
                    for (int bj = 0; bj < 2; ++bj) E(cur, r, bj * HALF + wc * 32 + 4 * fq, acc[ai][bj][m][0], acc[ai][bj][m][1]); }
                asm volatile("" ::: "memory"); }
        if (!has_next) break;
#pragma unroll
        for (int a = 0; a < 2; ++a)
#pragma unroll
            for (int b = 0; b < 2; ++b)
#pragma unroll
                for (int m = 0; m < 4; ++m)
#pragma unroll
                    for (int n = 0; n < 2; ++n) acc[a][b][m][n] = (f32x4){0.f, 0.f, 0.f, 0.f};
        cur = nxt; cA = nA; cB = nB; ++ui;
        if constexpr (GATHER) { vc[0][0] = vn[0][0]; vc[0][1] = vn[0][1]; vc[1][0] = vn[1][0]; vc[1][1] = vn[1][1]; }
    }
    MG_WAIT_V(0);
    if (wr == 0) MG_BAR;
    MG_BAR;
#undef MG_SA
#undef MG_SB
#undef MG_STAGE
#undef MG_LDA
#undef MG_LDB
#undef MG_MMA
#undef MG_WAIT_V
#undef MG_WAIT_L
#undef MG_BAR
#undef MG_SCHED
#undef MG_MKOFF
#undef MG_STA
#undef MG_ABASE
}
}

#ifndef USE_MFMA
#define USE_MFMA 1
#endif
template <bool GATHER = false, class Sched, class Epi>
__device__ __forceinline__ void gemm_run(unsigned char* smem, const Sched& S, int K, int lda, int ldb, const Epi& E) {
#if USE_MFMA
    __syncthreads();
    mg::gemm_mfma<GATHER>((LAS unsigned char*)smem, S, K, lda, ldb, E);
    __syncthreads();
#else
    UnitDesc u; for (int i = 0; S.get(i, u); ++i) gemm_unit_naive(smem, u, K, lda, ldb, E);
#endif
}
struct SchedGrid { const bf16* A; const bf16* B; int ldb, npn, nunits, rot, acol;
    __device__ __forceinline__ bool get(int i, UnitDesc& u) const {
        const int G = GRD(); const int idx = (BID() + rot) % G + i * G; if (idx >= nunits) return false;
        const int pm = idx / npn, pn = idx - pm * npn;
        u.A = A; u.B = B + (size_t)pn * 256 * ldb; u.ridx = nullptr; u.rw = nullptr; u.arow0 = pm * 256; u.acol = acol; u.row0 = pm * 256; u.col0 = pn * 256; u.nvalid = 256; u.gather = 0; return true; } };
struct SchedMoe { const int* tstart; const int* cntl; const int* LT; const float* LW; const bf16* A; const bf16* W; int which;
    __device__ __forceinline__ bool get(int i, UnitDesc& u) const {
        const int ncol = which == 0 ? 2 : 4; const int idx = BID() + i * GRD(); if (idx >= __builtin_amdgcn_readfirstlane(tstart[32]) * ncol) return false;
        const int rt = idx / ncol, pn = idx - rt * ncol; int e = 0;
        for (int q = 1; q < 32; ++q) if (__builtin_amdgcn_readfirstlane(tstart[q]) <= rt) e = q;
        const int pos0 = (rt - __builtin_amdgcn_readfirstlane(tstart[e])) * 256; int nv = __builtin_amdgcn_readfirstlane(cntl[e]) - pos0; nv = nv > 256 ? 256 : nv;
        u.ridx = LT + (size_t)e * NTOK + pos0; u.rw = LW + (size_t)e * NTOK + pos0; u.nvalid = nv; u.acol = 0; u.A = A;
        if (which == 0) { u.B = W + ((size_t)e * 512 + pn * 256) * 1024; u.arow0 = 0; u.row0 = rt * 256; u.col0 = pn * 128; u.gather = 1; }
        else { u.B = W + ((size_t)e * 1024 + pn * 256) * 256; u.arow0 = rt * 256; u.row0 = 0; u.col0 = pn * 256; u.gather = 0; }
        return true; } };

template <class F>
__device__ __forceinline__ void conv_item(const F& src, bf16* dst, int K, float* scr, int k0, int n0, int lane) {
#pragma unroll 8
    for (int i = 0; i < 32; ++i) { const int kk = 2 * i + (lane >> 5); scr[kk * 33 + (lane & 31)] = src(k0 + kk, n0 + (lane & 31)); }
    asm volatile("s_waitcnt lgkmcnt(0)" ::: "memory");
    const int c = lane & 7;
#pragma unroll
    for (int j = 0; j < 4; ++j) { const int n = (lane >> 3) + 8 * j; const float* s = scr + (8 * c) * 33 + n;
        u32x4 o; o.x = pk2(s[0 * 33], s[1 * 33]); o.y = pk2(s[2 * 33], s[3 * 33]); o.z = pk2(s[4 * 33], s[5 * 33]); o.w = pk2(s[6 * 33], s[7 * 33]);
        *(u32x4*)(dst + (size_t)(n0 + n) * K + k0 + 8 * c) = o; }
    asm volatile("s_waitcnt lgkmcnt(0)" ::: "memory");
}
__device__ __forceinline__ int yc_src(int n) {
    if (n < 1024) return n;
    if (n < 2048) return n + 16;
    if (n < 2304) return n + 24;
    if (n < 2320) return 1024 + (n - 2304);
    if (n < 2328) return 2064 + (n - 2320);
    if (n < 2488) return n;
    return -1;
}

__device__ __forceinline__ void phase_conv(const Params& p, int l, unsigned char* smem) {
    const int tid = TID(), lane = tid & 63, wave = tid >> 6;
    const int gw = BID() * 8 + wave, NGW = GRD() * 8;
    float* scr = (float*)smem + wave * (64 * 33 + 16);
    unsigned char* ws = p.ws;
    const float* w_in = p.in[3] + (size_t)l * 1024 * 2488;
    const float* w_out = p.in[4] + (size_t)l * 1024 * 1024;
    const float* gq = p.in[12] + l * 256; const float* w_uq = p.in[13] + (size_t)l * 256 * 768;
    const float* gkv = p.in[14] + l * 128; const float* w_ukv = p.in[15] + (size_t)l * 128 * 1024;
    const float* xwq = p.in[16] + (size_t)l * 1024 * 1024; const float* xwkv = p.in[17] + (size_t)l * 1024 * 2048; const float* xwo = p.in[18] + (size_t)l * 1024 * 1024;
    const float* wg = p.in[23] + (size_t)l * 32 * 1024 * 256; const float* wu = p.in[24] + (size_t)l * 32 * 1024 * 256; const float* wd = p.in[25] + (size_t)l * 32 * 256 * 1024;
    constexpr int I_IN = 16 * 80, I_Q = 4 * 24, I_KV = 4 * 40, I_SQ = 16 * 32, I_XKV = 16 * 64, I_GU = 32 * 16 * 16, I_DN = 32 * 4 * 32;
    constexpr int NIT = I_IN + I_Q + I_KV + 3 * I_SQ + I_XKV + I_GU + I_DN;
    for (int it = gw; it < NIT; it += NGW) {
        int r = it;
        if (r < I_IN) { const int kb = r / 80, nb = r % 80;
            conv_item([&](int k, int n) { const int s = yc_src(n); return s >= 0 ? w_in[(size_t)k * 2488 + s] : 0.f; }, (bf16*)(ws + W_IN), 1024, scr, kb * 64, nb * 32, lane); continue; }
        r -= I_IN;
        if (r < I_Q) { const int kb = r / 24, nb = r % 24;
            conv_item([&](int k, int n) { const int h = n / 96, j = n - h * 96; int sc = h * 96 + j; if (j >= 64) { const int jj = j - 64; sc = h * 96 + 64 + (jj >> 1) + 16 * (jj & 1); }
                return gq[k] * w_uq[(size_t)k * 768 + sc]; }, (bf16*)(ws + W_Q), 256, scr, kb * 64, nb * 32, lane); continue; }
        r -= I_Q;
        if (r < I_KV) { const int kb = r / 40, nb = r % 40;
            conv_item([&](int k, int n) { const int h = n / 160, j = n - h * 160;
                if (j >= 64 && j < 96) { const int jj = j - 64; return (k == 152 + (jj >> 1) + 16 * (jj & 1)) ? 1.f : 0.f; }
                const int col = (j < 64) ? h * 128 + j : h * 128 + 64 + (j - 96);
                return (k >= 24 && k < 152) ? gkv[k - 24] * w_ukv[(size_t)(k - 24) * 1024 + col] : 0.f; }, (bf16*)(ws + W_KV), 256, scr, kb * 64, nb * 32, lane); continue; }
        r -= I_KV;
        if (r < 3 * I_SQ) { const int m = r / I_SQ, q = r % I_SQ, kb = q / 32, nb = q % 32; const float* W = m == 0 ? w_out : (m == 1 ? xwq : xwo);
            bf16* D = (bf16*)(ws + (m == 0 ? W_OUT : (m == 1 ? W_XQ : W_XO)));
            conv_item([&](int k, int n) { return W[(size_t)k * 1024 + n]; }, D, 1024, scr, kb * 64, nb * 32, lane); continue; }
        r -= 3 * I_SQ;
        if (r < I_XKV) { const int kb = r / 64, nb = r % 64;
            conv_item([&](int k, int n) { return xwkv[(size_t)k * 2048 + n]; }, (bf16*)(ws + W_XKV), 1024, scr, kb * 64, nb * 32, lane); continue; }
        r -= I_XKV;
        if (r < I_GU) { const int e = r / 256, q = r % 256, kb = q / 16, nb = q % 16; const float* G = wg + (size_t)e * 1024 * 256; const float* U = wu + (size_t)e * 1024 * 256;
            conv_item([&](int k, int n) { const int j = (n >> 5) * 16 + (n & 15); return ((n >> 4) & 1) ? U[(size_t)k * 256 + j] : G[(size_t)k * 256 + j]; },
                      (bf16*)(ws + W_GU) + (size_t)e * 512 * 1024, 1024, scr, kb * 64, nb * 32, lane); continue; }
        r -= I_GU;
        { const int e = r / 128, q = r % 128, kb = q / 32, nb = q % 32; const float* Dn = wd + (size_t)e * 256 * 1024;
            conv_item([&](int k, int n) { return Dn[(size_t)k * 1024 + n]; }, (bf16*)(ws + W_DN) + (size_t)e * 1024 * 256, 256, scr, kb * 64, nb * 32, lane); }
    }
}

__device__ __forceinline__ void phase_pre(const Params& p) {
    const int tid = TID(); unsigned char* ws = p.ws;
    {
        const size_t gt = (size_t)BID() * 512 + tid, GT = (size_t)GRD() * 512;
        const float* x = p.in[0]; bf16* XB = (bf16*)(ws + WS_XB);
        for (size_t i = gt; i < (size_t)NTOK * DM / 8; i += GT) { const f32x4 a = *(const f32x4*)(x + i * 8), b = *(const f32x4*)(x + i * 8 + 4);
            u32x4 o; o.x = pk2(a[0], a[1]); o.y = pk2(a[2], a[3]); o.z = pk2(b[0], b[1]); o.w = pk2(b[2], b[3]); *(u32x4*)(XB + i * 8) = o; }
        const float* mem = p.in[1]; bf16* MB = (bf16*)(ws + WS_MEMB);
        for (size_t i = gt; i < (size_t)2048 * DM / 8; i += GT) { const f32x4 a = *(const f32x4*)(mem + i * 8), b = *(const f32x4*)(mem + i * 8 + 4);
            u32x4 o; o.x = pk2(a[0], a[1]); o.y = pk2(a[2], a[3]); o.z = pk2(b[0], b[1]); o.w = pk2(b[2], b[3]); *(u32x4*)(MB + i * 8) = o; }
        const int* pos = (const int*)p.in[2]; float* ROPE = (float*)(ws + WS_ROPE);
        for (size_t i = gt; i < (size_t)NTOK * 16; i += GT) { const int t = (int)(i >> 4), f = (int)(i & 15);
            double inv = 0.15915494309189535;
            for (int q = 0; q < f; ++q) inv *= 0.5623413251903491;
            const double rev = (double)pos[t] * inv; const float fr = (float)(rev - floor(rev));
            ROPE[i * 2] = __builtin_amdgcn_cosf(fr); ROPE[i * 2 + 1] = __builtin_amdgcn_sinf(fr); }
    }
}

__device__ __forceinline__ void gla_cum(const Params& p, int l, float* bs, int t0, int h) {
    const int tid = TID(), t = tid >> 3, dg = tid & 7;
    const bf16* Y = (const bf16*)(p.ws + WS_Y);
    const float* w_a2 = p.in[5] + l * 16 * 256; const float* b_a = p.in[6] + l * 256;
    float a[16];
    { const u32x4 a0 = *(const u32x4*)(Y + (size_t)(t0 + t) * YW + Y_A), a1 = *(const u32x4*)(Y + (size_t)(t0 + t) * YW + Y_A + 8);
#pragma unroll
      for (int j = 0; j < 4; ++j) { a[2 * j] = blo(a0[j]); a[2 * j + 1] = bhi(a0[j]); a[8 + 2 * j] = blo(a1[j]); a[8 + 2 * j + 1] = bhi(a1[j]); } }
#pragma unroll
    for (int j = 0; j < 8; ++j) { const int d = dg * 8 + j; float z = b_a[h * 64 + d];
#pragma unroll
        for (int q = 0; q < 16; ++q) z = fmaf(a[q], w_a2[q * 256 + h * 64 + d], z);
        bs[t * 65 + d] = logsigmoid(z) * (1.f / 16.f); }
    __syncthreads();
    if (tid < 64) { float s = 0.f; for (int tt = 0; tt < 64; ++tt) { s += bs[tt * 65 + tid]; bs[tt * 65 + tid] = s; } }
    __syncthreads();
}
__device__ __forceinline__ void ml_gates(const Params& p, int l, float* fc, float* aa, float* pm, int t0, int h) {
    const int tid = TID();
    const bf16* Y = (const bf16*)(p.ws + WS_Y);
    if (tid < 64) { const float fp = bf2f(Y[(size_t)(t0 + tid) * YW + Y_MF + h]) + p.in[10][l * 4 + h]; const float ig = bf2f(Y[(size_t)(t0 + tid) * YW + Y_MI + h]) + p.in[9][l * 4 + h];
        fc[tid] = logsigmoid(fp); aa[tid] = ig; }
    __syncthreads();
    if (tid == 0) { float s = 0.f, m = -3.0e38f; for (int i = 0; i < 64; ++i) { s += fc[i]; fc[i] = s; const float a = aa[i] - s; aa[i] = a; m = fmaxf(m, a); pm[i] = m; } }
    __syncthreads();
}
__device__ __forceinline__ void ml_conv(const Params& p, int l, float* dst, int t0, int c, int ycol, int wch, int h, float scale) {
    const int tid = TID(), s = tid >> 3, dg = tid & 7;
    const bf16* Y = (const bf16*)(p.ws + WS_Y); const float* w = p.in[8] + l * 4 * 512;
    float acc[8];
#pragma unroll
    for (int j = 0; j < 8; ++j) acc[j] = 0.f;
#pragma unroll
    for (int q = 0; q < 4; ++q) { const int ss = c * 64 + s - 3 + q;
        if (ss >= 0) { const u32x4 v = *(const u32x4*)(Y + (size_t)(t0 + s - 3 + q) * YW + ycol + h * 64 + dg * 8); const float* wr = w + q * 512 + wch + h * 64 + dg * 8;
#pragma unroll
            for (int j = 0; j < 4; ++j) { acc[2 * j] = fmaf(wr[2 * j], blo(v[j]), acc[2 * j]); acc[2 * j + 1] = fmaf(wr[2 * j + 1], bhi(v[j]), acc[2 * j + 1]); } } }
#pragma unroll
    for (int j = 0; j < 8; ++j) dst[s * 65 + dg * 8 + j] = siluf(acc[j]) * scale;
}
__device__ __forceinline__ void ld_blk(float* dst, const bf16* src, int ld) {
    const int tid = TID(), s = tid >> 3, dg = tid & 7; const u32x4 v = *(const u32x4*)(src + (size_t)s * ld + dg * 8);
#pragma unroll
    for (int j = 0; j < 4; ++j) { dst[s * 65 + dg * 8 + 2 * j] = blo(v[j]); dst[s * 65 + dg * 8 + 2 * j + 1] = bhi(v[j]); }
}

__device__ __forceinline__ void phase_loc(const Params& p, int l, unsigned char* smem) {
    const int tid = TID(), lane = tid & 63, wave = tid >> 6;
    unsigned char* ws = p.ws; const bf16* Y = (const bf16*)(ws + WS_Y);
    float* A0 = (float*)smem; float* A1 = A0 + 64 * 65; float* A2 = A1 + 64 * 65; float* fc = A2 + 64 * 65; float* aa = fc + 64; float* pm = aa + 64;
    float* ST = (float*)(ws + WS_ST); float* NV = (float*)(ws + WS_NV); float* DEC = (float*)(ws + WS_DEC); float* SC = (float*)(ws + WS_SC);
    for (int u = BID(); u < 2048; u += GRD()) {
        const int type = u >> 10, r = u & 1023, bh = r >> 5, c = r & 31, b = bh >> 2, h = bh & 3, t0 = b * SEQ + c * 64;
        const int d = tid >> 3, e0 = (tid & 7) * 8;
        __syncthreads();
        if (type == 0) {
            gla_cum(p, l, A0, t0, h);
            ld_blk(A1, Y + (size_t)t0 * YW + Y_GK + h * 64, YW);
            ld_blk(A2, Y + (size_t)t0 * YW + Y_GV + h * 64, YW);
            __syncthreads();
            for (int i = tid; i < 4096; i += 512) { const int s = i >> 6, dd = i & 63; A1[s * 65 + dd] *= expf(A0[63 * 65 + dd] - A0[s * 65 + dd]); }
            __syncthreads();
            float acc[8];
#pragma unroll
            for (int j = 0; j < 8; ++j) acc[j] = 0.f;
            for (int s = 0; s < 64; ++s) { const float kv = A1[s * 65 + d];
#pragma unroll
                for (int j = 0; j < 8; ++j) acc[j] = fmaf(kv, A2[s * 65 + e0 + j], acc[j]); }
            float* o = ST + (size_t)u * 4096 + d * 64 + e0;
            *(f32x4*)o = (f32x4){acc[0], acc[1], acc[2], acc[3]}; *(f32x4*)(o + 4) = (f32x4){acc[4], acc[5], acc[6], acc[7]};
            if (tid < 64) DEC[(size_t)r * 64 + tid] = expf(A0[63 * 65 + tid]);
        } else {
            ml_gates(p, l, fc, aa, pm, t0, h);
            ml_conv(p, l, A1, t0, c, Y_MK, 256, h, 1.f);
            ld_blk(A2, Y + (size_t)t0 * YW + Y_MV + h * 64, YW);
            __syncthreads();
            const float M63 = pm[63];
            for (int i = tid; i < 4096; i += 512) { const int s = i >> 6, dd = i & 63; A1[s * 65 + dd] *= expf(aa[s] - M63); }
            __syncthreads();
            float acc[8]; float nn = 0.f;
#pragma unroll
            for (int j = 0; j < 8; ++j) acc[j] = 0.f;
            for (int s = 0; s < 64; ++s) { const float kv = A1[s * 65 + d]; nn += kv;
#pragma unroll
                for (int j = 0; j < 8; ++j) acc[j] = fmaf(kv, A2[s * 65 + e0 + j], acc[j]); }
            float* o = ST + (size_t)u * 4096 + d * 64 + e0;
            *(f32x4*)o = (f32x4){acc[0], acc[1], acc[2], acc[3]}; *(f32x4*)(o + 4) = (f32x4){acc[4], acc[5], acc[6], acc[7]};
            if ((tid & 7) == 0) NV[(size_t)r * 64 + d] = nn;
            if (tid == 0) { SC[r * 2] = fc[63]; SC[r * 2 + 1] = fc[63] + M63; }
        }
    }
    float* RS = (float*)(ws + WS_RS);
    for (int row = BID() * 8 + wave; row < NTOK; row += GRD() * 8) {
        const u32x2 q = *(const u32x2*)(Y + (size_t)row * YW + Y_CQ + lane * 4); const unsigned kv = *(const unsigned*)(Y + (size_t)row * YW + Y_CKV + lane * 2);
        float sq = blo(q.x) * blo(q.x) + bhi(q.x) * bhi(q.x) + blo(q.y) * blo(q.y) + bhi(q.y) * bhi(q.y); float sk = blo(kv) * blo(kv) + bhi(kv) * bhi(kv);
        sq = wave_sum(sq); sk = wave_sum(sk);
        if (lane == 0) { RS[row * 2] = 1.f / sqrtf(sq * (1.f / 256.f) + LN_EPS); RS[row * 2 + 1] = 1.f / sqrtf(sk * (1.f / 128.f) + LN_EPS); }
    }
}

__device__ __forceinline__ void phase_scan(const Params& p, int l) {
    unsigned char* ws = p.ws;
    float* ST = (float*)(ws + WS_ST); float* NV = (float*)(ws + WS_NV); const float* DEC = (const float*)(ws + WS_DEC); const float* SC = (const float*)(ws + WS_SC); float* MS = (float*)(ws + WS_MS);
    const int gt = BID() * 512 + TID(), GT = GRD() * 512;
    for (int idx = gt; idx < 64 * 4096; idx += GT) {
        const int seq = idx >> 12, el = idx & 4095, d = el >> 6;
        float* st = ST + (size_t)seq * 32 * 4096 + el;
        if (seq < 32) { float S = 0.f; const float* dc = DEC + (size_t)seq * 32 * 64 + d;
#pragma unroll 4
            for (int c = 0; c < 32; ++c) { const float tmp = st[(size_t)c * 4096]; st[(size_t)c * 4096] = S; S = fmaf(dc[c * 64], S, tmp); } }
        else { const int sq = seq - 32; float C = 0.f, m = 0.f; const float* sc = SC + (size_t)sq * 32 * 2;
#pragma unroll 4
            for (int c = 0; c < 32; ++c) { const float F = sc[c * 2], ml = sc[c * 2 + 1]; const float tmp = st[(size_t)c * 4096]; st[(size_t)c * 4096] = C;
                const float mn = fmaxf(F + m, ml); C = expf(F + m - mn) * C + expf(ml - mn) * tmp; m = mn; } }
    }
    for (int idx = gt; idx < 32 * 64; idx += GT) {
        const int sq = idx >> 6, d = idx & 63; float n = 0.f, m = 0.f; const float* sc = SC + (size_t)sq * 32 * 2; float* nv = NV + (size_t)sq * 32 * 64 + d;
#pragma unroll 2
        for (int c = 0; c < 32; ++c) { const float F = sc[c * 2], ml = sc[c * 2 + 1]; const float tmp = nv[c * 64]; nv[c * 64] = n; if (d == 0) MS[sq * 32 + c] = m;
            const float mn = fmaxf(F + m, ml); n = expf(F + m - mn) * n + expf(ml - mn) * tmp; m = mn; }
    }
}

template <int DQK, int DV>
__device__ __forceinline__ void attn_naive(unsigned char* smem, const bf16* Q, int qs, const bf16* K, int ks, const bf16* V, int vs, int nk, bf16* O, int os) {
    constexpr int LQ = DQK + 8, LV = DV + 8, EV = DV / 8;
    bf16* Qs = (bf16*)smem; bf16* Ks = Qs + 64 * LQ; bf16* Vs = Ks + 64 * LQ; float* Ss = (float*)(Vs + 64 * LV);
    const int tid = TID(), t = tid >> 3, g = tid & 7;
    __syncthreads();
    for (int i = tid; i < 64 * DQK / 8; i += 512) { const int r = i / (DQK / 8), c8 = i % (DQK / 8); *(u32x4*)(Qs + r * LQ + c8 * 8) = *(const u32x4*)(Q + (size_t)r * qs + c8 * 8); }
    float acc[EV]; float m = -3.0e38f, lsum = 0.f;
#pragma unroll
    for (int j = 0; j < EV; ++j) acc[j] = 0.f;
    for (int k0 = 0; k0 < nk; k0 += 64) {
        __syncthreads();
        for (int i = tid; i < 64 * DQK / 8; i += 512) { const int r = i / (DQK / 8), c8 = i % (DQK / 8); *(u32x4*)(Ks + r * LQ + c8 * 8) = *(const u32x4*)(K + (size_t)(k0 + r) * ks + c8 * 8); }
        for (int i = tid; i < 64 * DV / 8; i += 512) { const int r = i / (DV / 8), c8 = i % (DV / 8); *(u32x4*)(Vs + r * LV + c8 * 8) = *(const u32x4*)(V + (size_t)(k0 + r) * vs + c8 * 8); }
        __syncthreads();
        float sc[8];
#pragma unroll
        for (int j = 0; j < 8; ++j) sc[j] = 0.f;
        for (int d8 = 0; d8 < DQK / 8; ++d8) { const u32x4 qv = *(const u32x4*)(Qs + t * LQ + d8 * 8);
#pragma unroll
            for (int j = 0; j < 8; ++j) { const u32x4 kv = *(const u32x4*)(Ks + (g + 8 * j) * LQ + d8 * 8);
#pragma unroll
                for (int q = 0; q < 4; ++q) sc[j] = fmaf(blo(qv[q]), blo(kv[q]), fmaf(bhi(qv[q]), bhi(kv[q]), sc[j])); } }
        float mx = sc[0];
#pragma unroll
        for (int j = 1; j < 8; ++j) mx = fmaxf(mx, sc[j]);
        mx = fmaxf(mx, __shfl_xor(mx, 1)); mx = fmaxf(mx, __shfl_xor(mx, 2)); mx = fmaxf(mx, __shfl_xor(mx, 4));
        const float mn = fmaxf(m, mx), al = exp2f(m - mn); float ps = 0.f;
#pragma unroll
        for (int j = 0; j < 8; ++j) { const float pv = exp2f(sc[j] - mn); ps += pv; Ss[t * 65 + g + 8 * j] = pv; }
        ps += __shfl_xor(ps, 1); ps += __shfl_xor(ps, 2); ps += __shfl_xor(ps, 4);
        lsum = lsum * al + ps; m = mn;
#pragma unroll
        for (int j = 0; j < EV; ++j) acc[j] *= al;
        __syncthreads();
        for (int kk = 0; kk < 64; ++kk) { const float pv = Ss[t * 65 + kk];
#pragma unroll
            for (int j8 = 0; j8 < EV / 8; ++j8) { const u32x4 vv = *(const u32x4*)(Vs + kk * LV + g * EV + j8 * 8);
#pragma unroll
                for (int q = 0; q < 4; ++q) { acc[j8 * 8 + 2 * q] = fmaf(pv, blo(vv[q]), acc[j8 * 8 + 2 * q]); acc[j8 * 8 + 2 * q + 1] = fmaf(pv, bhi(vv[q]), acc[j8 * 8 + 2 * q + 1]); } } }
    }
    const float inv = 1.f / lsum;
#pragma unroll
    for (int j8 = 0; j8 < EV / 8; ++j8) { u32x4 o; o.x = pk2(acc[j8 * 8] * inv, acc[j8 * 8 + 1] * inv); o.y = pk2(acc[j8 * 8 + 2] * inv, acc[j8 * 8 + 3] * inv);
        o.z = pk2(acc[j8 * 8 + 4] * inv, acc[j8 * 8 + 5] * inv); o.w = pk2(acc[j8 * 8 + 6] * inv, acc[j8 * 8 + 7] * inv);
        *(u32x4*)(O + (size_t)t * os + g * EV + j8 * 8) = o; }
}

template <int DQK, int DV, int QG>
__device__ __forceinline__ void attn_mfma_unit(unsigned char* smem, const bf16* Q, int qs, const bf16* K, int ks, const bf16* VT, int vts, int ntile_wave, int ntile_max, bf16* O, int os) {
    constexpr int LK = DQK + 8, LV = 72, KS = DQK / 32, NDV = DV / 16;
    constexpr int NKPIECE = 64 * DQK / 8, NVPIECE = DV * 8, NKP = (NKPIECE + 511) / 512, NVP = (NVPIECE + 511) / 512;
    bf16* Ks = (bf16*)smem; bf16* Vs = Ks + 64 * LK;
    const int tid = TID(), wave = tid >> 6, lane = tid & 63, q = lane & 15, g = lane >> 4;
    bf16x8 qf[QG][KS];
#pragma unroll
    for (int qg = 0; qg < QG; ++qg)
#pragma unroll
        for (int kk = 0; kk < KS; ++kk) qf[qg][kk] = *(const bf16x8*)(Q + (size_t)(wave * 16 * QG + qg * 16 + q) * qs + kk * 32 + g * 8);
    f32x4 o[QG][NDV]; float mrun[QG], lrun[QG];
#pragma unroll
    for (int qg = 0; qg < QG; ++qg) { mrun[qg] = -3.0e38f; lrun[qg] = 0.f;
#pragma unroll
        for (int d = 0; d < NDV; ++d) o[qg][d] = (f32x4){0.f, 0.f, 0.f, 0.f}; }
    u32x4 kr[NKP], vr[NVP];
#define AT_GLOAD(kt) do { _Pragma("unroll") for (int _i = 0; _i < NKP; ++_i) { const int _x = tid + 512 * _i; if (_x < NKPIECE) { const int _r = _x / (DQK / 8), _c = _x % (DQK / 8); kr[_i] = *(const u32x4*)(K + (size_t)((kt) * 64 + _r) * ks + _c * 8); } } \
        _Pragma("unroll") for (int _i = 0; _i < NVP; ++_i) { const int _x = tid + 512 * _i; if (_x < NVPIECE) { const int _r = _x >> 3, _c = _x & 7; vr[_i] = *(const u32x4*)(VT + (size_t)_r * vts + (kt) * 64 + _c * 8); } } } while (0)
#define AT_LSTORE() do { _Pragma("unroll") for (int _i = 0; _i < NKP; ++_i) { const int _x = tid + 512 * _i; if (_x < NKPIECE) { const int _r = _x / (DQK / 8), _c = _x % (DQK / 8); *(u32x4*)(Ks + _r * LK + _c * 8) = kr[_i]; } } \
        _Pragma("unroll") for (int _i = 0; _i < NVP; ++_i) { const int _x = tid + 512 * _i; if (_x < NVPIECE) { const int _r = _x >> 3, _c = _x & 7; *(u32x4*)(Vs + _r * LV + _c * 8) = vr[_i]; } } } while (0)
    AT_GLOAD(0);
    for (int kt = 0; kt < ntile_max; ++kt) {
        __syncthreads();
        AT_LSTORE();
        __syncthreads();
        if (kt + 1 < ntile_max) AT_GLOAD(kt + 1);
        if (kt < ntile_wave) {
            f32x4 sc[QG][4];
#pragma unroll
            for (int qg = 0; qg < QG; ++qg)
#pragma unroll
                for (int b = 0; b < 4; ++b) sc[qg][b] = (f32x4){0.f, 0.f, 0.f, 0.f};
#pragma unroll
            for (int b = 0; b < 4; ++b)
#pragma unroll
                for (int kk = 0; kk < KS; ++kk) { const bf16x8 kf = *(const bf16x8*)(Ks + (b * 16 + q) * LK + kk * 32 + g * 8);
#pragma unroll
                    for (int qg = 0; qg < QG; ++qg) sc[qg][b] = __builtin_amdgcn_mfma_f32_16x16x32_bf16(kf, qf[qg][kk], sc[qg][b], 0, 0, 0); }
            bf16x8 pf[QG][2];
#pragma unroll
            for (int qg = 0; qg < QG; ++qg) {
                float mx = sc[qg][0][0];
#pragma unroll
                for (int b = 0; b < 4; ++b)
#pragma unroll
                    for (int i = 0; i < 4; ++i) mx = fmaxf(mx, sc[qg][b][i]);
                mx = fmaxf(mx, __shfl_xor(mx, 16)); mx = fmaxf(mx, __shfl_xor(mx, 32));
                const float mn = fmaxf(mrun[qg], mx), al = exp2f(mrun[qg] - mn); float ps = 0.f;
#pragma unroll
                for (int b = 0; b < 4; ++b)
#pragma unroll
                    for (int i = 0; i < 4; ++i) { const float pv = exp2f(sc[qg][b][i] - mn); sc[qg][b][i] = pv; ps += pv; }
                lrun[qg] = lrun[qg] * al + ps; mrun[qg] = mn;
#pragma unroll
                for (int d = 0; d < NDV; ++d) o[qg][d] = o[qg][d] * al;
#pragma unroll
                for (int st = 0; st < 2; ++st) { u32x4 w; w.x = pk2(sc[qg][2 * st][0], sc[qg][2 * st][1]); w.y = pk2(sc[qg][2 * st][2], sc[qg][2 * st][3]);
                    w.z = pk2(sc[qg][2 * st + 1][0], sc[qg][2 * st + 1][1]); w.w = pk2(sc[qg][2 * st + 1][2], sc[qg][2 * st + 1][3]); pf[qg][st] = __builtin_bit_cast(bf16x8, w); }
            }
#pragma unroll
            for (int d = 0; d < NDV; ++d)
#pragma unroll
                for (int st = 0; st < 2; ++st) { const u32x2 v0 = *(const u32x2*)(Vs + (d * 16 + q) * LV + st * 32 + 4 * g), v1 = *(const u32x2*)(Vs + (d * 16 + q) * LV + st * 32 + 16 + 4 * g);
                    const u32x4 vv = {v0.x, v0.y, v1.x, v1.y}; const bf16x8 vf = __builtin_bit_cast(bf16x8, vv);
#pragma unroll
                    for (int qg = 0; qg < QG; ++qg) o[qg][d] = __builtin_amdgcn_mfma_f32_16x16x32_bf16(vf, pf[qg][st], o[qg][d], 0, 0, 0); }
        }
    }
#undef AT_GLOAD
#undef AT_LSTORE
#pragma unroll
    for (int qg = 0; qg < QG; ++qg) { float lt = lrun[qg]; lt += __shfl_xor(lt, 16); lt += __shfl_xor(lt, 32); const float inv = 1.f / lt;
        bf16* orow = O + (size_t)(wave * 16 * QG + qg * 16 + q) * os + 4 * g;
#pragma unroll
        for (int d = 0; d < NDV; ++d) st_bf4(orow + d * 16, o[qg][d] * inv); }
}

__device__ __forceinline__ void mix_linear_unit(const Params& p, int l, unsigned char* smem, int u) {
    const int tid = TID(); unsigned char* ws = p.ws; const bf16* Y = (const bf16*)(ws + WS_Y);
    float* A0 = (float*)smem; float* A1 = A0 + 64 * 65; float* A2 = A1 + 64 * 65; float* A3 = A2 + 64 * 65; float* A4 = A3 + 64 * 65; float* A5 = A4 + 64 * 65;
    float* fc = A5 + 64 * 65; float* aa = fc + 64; float* pm = aa + 64; float* nv = pm + 64;
    const float* ST = (const float*)(ws + WS_ST); const float* NV = (const float*)(ws + WS_NV); const float* MS = (const float*)(ws + WS_MS);
    bf16* MIX = (bf16*)(ws + WS_XB);
    const int type = u >> 10, r = u & 1023, bh = r >> 5, c = r & 31, b = bh >> 2, h = bh & 3, t0 = b * SEQ + c * 64;
    const int t = tid >> 3, g = tid & 7, e0 = g * 8;
    __syncthreads();
    for (int i = tid; i < 4096; i += 512) A3[(i >> 6) * 65 + (i & 63)] = ST[(size_t)u * 4096 + i];
    ld_blk(A2, Y + (size_t)t0 * YW + (type == 0 ? Y_GV : Y_MV) + h * 64, YW);
    float mst = 0.f;
    if (type == 0) {
        gla_cum(p, l, A0, t0, h);
        ld_blk(A4, Y + (size_t)t0 * YW + Y_GQ + h * 64, YW); ld_blk(A1, Y + (size_t)t0 * YW + Y_GK + h * 64, YW);
        __syncthreads();
        for (int i = tid; i < 4096; i += 512) { const int s = i >> 6, dd = i & 63; const float bb = A0[s * 65 + dd]; A4[s * 65 + dd] *= 0.125f * expf(bb); A1[s * 65 + dd] *= expf(-bb); }
    } else {
        ml_gates(p, l, fc, aa, pm, t0, h);
        ml_conv(p, l, A4, t0, c, Y_MQ, 0, h, 0.125f); ml_conv(p, l, A1, t0, c, Y_MK, 256, h, 1.f);
        if (tid < 64) nv[tid] = NV[(size_t)r * 64 + tid];
        mst = MS[r];
    }
    __syncthreads();
    const float mm = (type == 1) ? fmaxf(mst, pm[t]) : 0.f;
    {
        float sc[8];
#pragma unroll
        for (int j = 0; j < 8; ++j) sc[j] = 0.f;
        for (int d = 0; d < 64; ++d) { const float qv = A4[t * 65 + d];
#pragma unroll
            for (int j = 0; j < 8; ++j) sc[j] = fmaf(qv, A1[(g + 8 * j) * 65 + d], sc[j]); }
#pragma unroll
        for (int j = 0; j < 8; ++j) { const int s = g + 8 * j; float w = (s <= t) ? sc[j] : 0.f; if (type == 1) w = (s <= t) ? w * expf(aa[s] - mm) : 0.f; A5[t * 65 + s] = w; }
    }
    __syncthreads();
    float acc[8], inter[8];
#pragma unroll
    for (int j = 0; j < 8; ++j) { acc[j] = 0.f; inter[j] = 0.f; }
    for (int d = 0; d < 64; ++d) { const float qv = A4[t * 65 + d];
#pragma unroll
        for (int j = 0; j < 8; ++j) inter[j] = fmaf(qv, A3[d * 65 + e0 + j], inter[j]); }
    for (int s = 0; s < 64; ++s) { const float pv = A5[t * 65 + s];
#pragma unroll
        for (int j = 0; j < 8; ++j) acc[j] = fmaf(pv, A2[s * 65 + e0 + j], acc[j]); }
    float o[8];
    if (type == 0) {
#pragma unroll
        for (int j = 0; j < 8; ++j) o[j] = acc[j] + inter[j];
    } else {
        const float wi = expf(mst - mm);
        float dn = 0.f;
#pragma unroll
        for (int j = 0; j < 8; ++j) dn += wi * A4[t * 65 + e0 + j] * nv[e0 + j] + A5[t * 65 + e0 + j];
        dn += __shfl_xor(dn, 1); dn += __shfl_xor(dn, 2); dn += __shfl_xor(dn, 4);
        const float mt = fc[t] + mm; const float den = fmaxf(fabsf(dn), expf(-mt)); const float inv = 1.f / den;
#pragma unroll
        for (int j = 0; j < 8; ++j) o[j] = (wi * inter[j] + acc[j]) * inv;
    }
    float s1 = 0.f;
#pragma unroll
    for (int j = 0; j < 8; ++j) s1 += o[j];
    s1 += __shfl_xor(s1, 1); s1 += __shfl_xor(s1, 2); s1 += __shfl_xor(s1, 4);
    const float mu = s1 * (1.f / 64.f); float s2 = 0.f;
#pragma unroll
    for (int j = 0; j < 8; ++j) { o[j] -= mu; s2 += o[j] * o[j]; }
    s2 += __shfl_xor(s2, 1); s2 += __shfl_xor(s2, 2); s2 += __shfl_xor(s2, 4);
    const float rstd = 1.f / sqrtf(s2 * (1.f / 64.f) + LN_EPS);
    const float* gn = (type == 0 ? p.in[7] : p.in[11]) + l * 256 + h * 64 + e0;
    const u32x4 gv = *(const u32x4*)(Y + (size_t)(t0 + t) * YW + (type == 0 ? Y_GR : Y_MO) + h * 64 + e0);
    float gate[8];
#pragma unroll
    for (int j = 0; j < 4; ++j) { gate[2 * j] = blo(gv[j]); gate[2 * j + 1] = bhi(gv[j]); }
    float res[8];
#pragma unroll
    for (int j = 0; j < 8; ++j) res[j] = o[j] * rstd * gn[j] * (type == 0 ? siluf(gate[j]) : sigmoidf(gate[j]));
    u32x4 ov; ov.x = pk2(res[0], res[1]); ov.y = pk2(res[2], res[3]); ov.z = pk2(res[4], res[5]); ov.w = pk2(res[6], res[7]);
    *(u32x4*)(MIX + (size_t)(t0 + t) * DM + type * 256 + h * 64 + e0) = ov;
}

__device__ __forceinline__ void phase_mix(const Params& p, int l, unsigned char* smem) {
    unsigned char* ws = p.ws;
    const bf16* QP = (const bf16*)(ws + WS_QP); const bf16* KP = (const bf16*)(ws + WS_KP); const bf16* VPT = (const bf16*)(ws + WS_VP); bf16* MIX = (bf16*)(ws + WS_XB);
    for (int u = BID(); u < 512; u += GRD()) {
        const int bh = u & 63, Qb = u < 256 ? 7 - (u >> 6) : (u - 256) >> 6, b = bh >> 3, h = bh & 7;
        const int wave = TID() >> 6;
        attn_mfma_unit<96, 64, 2>(smem, QP + ((size_t)bh * SEQ + Qb * 256) * 96, 96, KP + (size_t)bh * SEQ * 96, 96, VPT + (size_t)bh * 64 * SEQ, SEQ,
                                  Qb * 4 + (wave >> 1) + 1, Qb * 4 + 4, MIX + (size_t)(b * SEQ + Qb * 256) * DM + 512 + h * 64, DM);
    }
    for (int u = BID(); u < 2048; u += GRD()) mix_linear_unit(p, l, smem, u);
}

__device__ __forceinline__ void ln_row_store(f32x4 (&v)[4], const float* g, const float* bta, float* of, bf16* ob, int lane) {
    float s = 0.f;
#pragma unroll
    for (int j = 0; j < 4; ++j) s += (v[j][0] + v[j][1]) + (v[j][2] + v[j][3]);
    const float mean = wave_sum(s) * (1.f / DM); float s2 = 0.f;
#pragma unroll
    for (int j = 0; j < 4; ++j) { v[j] = v[j] - mean; s2 += (v[j][0] * v[j][0] + v[j][1] * v[j][1]) + (v[j][2] * v[j][2] + v[j][3] * v[j][3]); }
    const float rstd = 1.f / sqrtf(wave_sum(s2) * (1.f / DM) + LN_EPS);
#pragma unroll
    for (int j = 0; j < 4; ++j) { const f32x4 gg = *(const f32x4*)(g + lane * 4 + 256 * j), bb = *(const f32x4*)(bta + lane * 4 + 256 * j);
        v[j] = v[j] * rstd * gg + bb; *(f32x4*)(of + lane * 4 + 256 * j) = v[j]; st_bf4(ob + lane * 4 + 256 * j, v[j]); }
}

__device__ __forceinline__ void phase_ln(const Params& p, int l, int which  ) {
    const int tid = TID(), lane = tid & 63, wave = tid >> 6; unsigned char* ws = p.ws;
    float* XR = p.out; bf16* XB = (bf16*)(ws + WS_XB);
    const float* g = p.in[26 + 2 * which] + l * DM; const float* bta = p.in[27 + 2 * which] + l * DM;
    const bf16* CT = (const bf16*)(ws + WS_CT);
    for (int row = BID() * 8 + wave; row < NTOK; row += GRD() * 8) {
        f32x4 v[4];
#pragma unroll
        for (int j = 0; j < 4; ++j) v[j] = *(const f32x4*)(XR + (size_t)row * DM + lane * 4 + 256 * j);
        if (which == 2) {
#pragma unroll
            for (int j = 0; j < 4; ++j) { const u32x2 c0 = *(const u32x2*)(CT + (size_t)row * DM + lane * 4 + 256 * j), c1 = *(const u32x2*)(CT + ((size_t)NTOK + row) * DM + lane * 4 + 256 * j);
                v[j] = v[j] * ALPHA + (f32x4){blo(c0.x), bhi(c0.x), blo(c0.y), bhi(c0.y)} + (f32x4){blo(c1.x), bhi(c1.x), blo(c1.y), bhi(c1.y)}; }
        }
        ln_row_store(v, g, bta, XR + (size_t)row * DM, XB + (size_t)row * DM, lane);
        if (which == 1) {
            const float* wgp = p.in[19] + (size_t)l * DM * 4; const float* bg = p.in[20] + l * 4; const float* wr = p.in[21] + (size_t)l * DM * 32; const float* br = p.in[22] + l * 32;
            float gl[4] = {0.f, 0.f, 0.f, 0.f};
#pragma unroll
            for (int j = 0; j < 4; ++j)
#pragma unroll
                for (int q = 0; q < 4; ++q) { const f32x4 w4 = *(const f32x4*)(wgp + (size_t)(lane * 4 + 256 * j + q) * 4); const float xv = v[j][q];
                    gl[0] = fmaf(xv, w4[0], gl[0]); gl[1] = fmaf(xv, w4[1], gl[1]); gl[2] = fmaf(xv, w4[2], gl[2]); gl[3] = fmaf(xv, w4[3], gl[3]); }
#pragma unroll
            for (int q = 0; q < 4; ++q) gl[q] = wave_sum(gl[q]) + bg[q];
            int gi = 0; float gm = gl[0];
#pragma unroll
            for (int q = 1; q < 4; ++q) if (gl[q] > gm) { gm = gl[q]; gi = q; }
            float gs = 0.f;
#pragma unroll
            for (int q = 0; q < 4; ++q) gs += expf(gl[q] - gm);
            const float gp = 1.f / gs;
            float el[8] = {0.f, 0.f, 0.f, 0.f, 0.f, 0.f, 0.f, 0.f};
#pragma unroll
            for (int j = 0; j < 4; ++j)
#pragma unroll
                for (int q = 0; q < 4; ++q) { const float* wrow = wr + (size_t)(lane * 4 + 256 * j + q) * 32 + gi * 8; const f32x4 w0 = *(const f32x4*)wrow, w1 = *(const f32x4*)(wrow + 4); const float xv = v[j][q];
                    el[0] = fmaf(xv, w0[0], el[0]); el[1] = fmaf(xv, w0[1], el[1]); el[2] = fmaf(xv, w0[2], el[2]); el[3] = fmaf(xv, w0[3], el[3]);
                    el[4] = fmaf(xv, w1[0], el[4]); el[5] = fmaf(xv, w1[1], el[5]); el[6] = fmaf(xv, w1[2], el[6]); el[7] = fmaf(xv, w1[3], el[7]); }
#pragma unroll
            for (int q = 0; q < 8; ++q) el[q] = wave_sum(el[q]) + br[gi * 8 + q];
            int i0 = 0; float m0 = el[0];
#pragma unroll
            for (int q = 1; q < 8; ++q) if (el[q] > m0) { m0 = el[q]; i0 = q; }
            int i1 = -1; float m1 = -3.0e38f;
#pragma unroll
            for (int q = 0; q < 8; ++q) if (q != i0 && el[q] > m1) { m1 = el[q]; i1 = q; }
            const float p1 = expf(m1 - m0); const float w0 = gp / (1.f + p1), w1 = gp * p1 / (1.f + p1);
            if (lane == 0) {
                unsigned* cnt = (unsigned*)(ws + WS_CTL) + CW_CNT + l * 32; int* LT = (int*)(ws + WS_LISTT); float* LW = (float*)(ws + WS_LISTW);
                const int e0 = gi * 8 + i0, e1 = gi * 8 + i1;
                const unsigned p0 = atomicAdd(cnt + e0, 1u); LT[(size_t)e0 * NTOK + p0] = row * 2; LW[(size_t)e0 * NTOK + p0] = w0;
                const unsigned q1 = atomicAdd(cnt + e1, 1u); LT[(size_t)e1 * NTOK + q1] = row * 2 + 1; LW[(size_t)e1 * NTOK + q1] = w1;
            }
        }
    }
}

__device__ __forceinline__ void moe_table(const Params& p, int l, int* tstart, int* cntl) {
    __syncthreads();
    if (TID() == 0) { const unsigned* cnt = (const unsigned*)(p.ws + WS_CTL) + CW_CNT + l * 32; int s = 0;
        for (int e = 0; e < 32; ++e) { const int c = (int)__hip_atomic_load(cnt + e, __ATOMIC_RELAXED, __HIP_MEMORY_SCOPE_AGENT); cntl[e] = c; tstart[e] = s; s += (c + 255) >> 8; } tstart[32] = s; }
    __syncthreads();
}

__device__ __forceinline__ void phase_moe(const Params& p, int l, unsigned char* smem, int which  ) {
    unsigned char* ws = p.ws;
    int* tstart = (int*)(smem + LDS_BYTES - 1024); int* cntl = tstart + 40;
    moe_table(p, l, tstart, cntl);
    if (which == 0) { SchedMoe S{tstart, cntl, (const int*)(ws + WS_LISTT), (const float*)(ws + WS_LISTW), (const bf16*)(ws + WS_XB), (const bf16*)(ws + W_GU), 0};
        EpiMoe1 E{(bf16*)(ws + WS_H)}; gemm_run<true>(smem, S, 1024, 1024, 1024, E); }
    else { SchedMoe S{tstart, cntl, (const int*)(ws + WS_LISTT), (const float*)(ws + WS_LISTW), (const bf16*)(ws + WS_H), (const bf16*)(ws + W_DN), 1};
        EpiMoe2 E{(bf16*)(ws + WS_CT)}; gemm_run(smem, S, 256, 256, 256, E); }
}

constexpr int LDS_PARAMS = LDS_BYTES - 512;
#define GETP const Params& p = *(const Params*)(smem + LDS_PARAMS); unsigned char* ws = p.ws; (void)ws
#ifndef FULL_MASK
#define FULL_MASK 0x3fffu
#endif
#ifndef PHASE_ATTR
#define PHASE_ATTR __forceinline__
#endif
__device__ PHASE_ATTR void ph_conv(unsigned char* smem, int l) { GETP; phase_conv(p, l, smem); }
__device__ PHASE_ATTR void ph_pre(unsigned char* smem) { GETP; phase_pre(p); }
__device__ PHASE_ATTR void ph_g1(unsigned char* smem, int l) { GETP;
    { SchedGrid S{(const bf16*)(ws + WS_XB), (const bf16*)(ws + W_IN), 1024, 10, 640, 0, 0}; EpiBf16Store E{(bf16*)(ws + WS_Y), YW, 1.f}; gemm_run(smem, S, 1024, 1024, 1024, E); }
    { SchedGrid S{(const bf16*)(ws + WS_MEMB), (const bf16*)(ws + W_XKV), 1024, 8, 64, 128, 0}; EpiKVX E{(bf16*)(ws + WS_KVX), (bf16*)(ws + WS_KVX + 4 * MiB)}; gemm_run(smem, S, 1024, 1024, 1024, E); }
}
__device__ PHASE_ATTR void ph_loc(unsigned char* smem, int l) { GETP; phase_loc(p, l, smem); }
__device__ PHASE_ATTR void ph_scan(unsigned char* smem, int l) { GETP;
    { SchedGrid S{(const bf16*)(ws + WS_Y), (const bf16*)(ws + W_Q), 256, 3, 192, 0, Y_CQ};
      EpiMlaQ E{(bf16*)(ws + WS_QP), (const float*)(ws + WS_RS), (const float*)(ws + WS_ROPE)}; gemm_run(smem, S, 256, YW, 256, E); }
    { SchedGrid S{(const bf16*)(ws + WS_Y), (const bf16*)(ws + W_KV), 256, 5, 320, 64, Y_T9};
      EpiMlaKV E{(bf16*)(ws + WS_KP), (bf16*)(ws + WS_VP), (const float*)(ws + WS_RS), (const float*)(ws + WS_ROPE)}; gemm_run(smem, S, 256, YW, 256, E); }
    phase_scan(p, l);
}
__device__ PHASE_ATTR void ph_mix(unsigned char* smem, int l) { GETP; phase_mix(p, l, smem); }
__device__ PHASE_ATTR void ph_g4(unsigned char* smem, int l) { GETP;
    SchedGrid S{(const bf16*)(ws + WS_XB), (const bf16*)(ws + W_OUT), 1024, 4, 256, 0, 0}; EpiResid E{l == 0 ? p.in[0] : p.out, p.out}; gemm_run(smem, S, 1024, 1024, 1024, E);
}
__device__ PHASE_ATTR void ph_ln(unsigned char* smem, int l, int which) { GETP; phase_ln(p, l, which); }
__device__ PHASE_ATTR void ph_g5(unsigned char* smem, int l) { GETP;
    SchedGrid S{(const bf16*)(ws + WS_XB), (const bf16*)(ws + W_XQ), 1024, 4, 256, 0, 0}; EpiBf16Store E{(bf16*)(ws + WS_QX), DM, XSCALE}; gemm_run(smem, S, 1024, 1024, 1024, E);
}
__device__ PHASE_ATTR void ph_xatt(unsigned char* smem, int l) { GETP;
    const bf16* QX = (const bf16*)(ws + WS_QX); const bf16* KX = (const bf16*)(ws + WS_KVX); const bf16* VXT = (const bf16*)(ws + WS_KVX + 4 * MiB); bf16* OX = (bf16*)(ws + WS_OX);
    for (int u = BID(); u < 512; u += GRD()) { const int b = u >> 6, h = (u >> 4) & 3, qt = u & 15;
        attn_mfma_unit<256, 256, 1>(smem, QX + (size_t)(b * SEQ + qt * 128) * DM + h * 256, DM, KX + (size_t)(b * 256) * 1024 + h * 256, 1024, VXT + (size_t)((b * 4 + h) * 256) * 256, 256, 4, 4,
                                    OX + (size_t)(b * SEQ + qt * 128) * DM + h * 256, DM); }
}
__device__ PHASE_ATTR void ph_g7(unsigned char* smem, int l) { GETP;
    SchedGrid S{(const bf16*)(ws + WS_OX), (const bf16*)(ws + W_XO), 1024, 4, 256, 0, 0}; EpiResid E{p.out, p.out}; gemm_run(smem, S, 1024, 1024, 1024, E);
}
__device__ PHASE_ATTR void ph_moe(unsigned char* smem, int l, int which) { GETP; phase_moe(p, l, smem, which); }

template <unsigned MASK>
__global__ void __launch_bounds__(512, 2) fwd(Params pk) {
    extern __shared__ __attribute__((aligned(16))) unsigned char smem[];
    { const unsigned* src = (const unsigned*)&pk; unsigned* dst = (unsigned*)(smem + LDS_PARAMS); for (int i = threadIdx.x; i < (int)(sizeof(Params) / 4); i += 512) dst[i] = src[i]; }
    unsigned char* ws = pk.ws;
    volatile LAS unsigned* barw = (volatile LAS unsigned*)((LAS unsigned char*)smem + LDS_BARW);
    if (threadIdx.x == 0) { barw[0] = 0u; barw[1] = 0u; }
    __syncthreads();
    XcdBarrier bar; bar.bar = (unsigned*)(ws + WS_CTL) + CW_BAR; bar.x = 0; bar.st = barw;
    const int lo = pk.ph_lo, hi = pk.ph_hi;
    const bool multi = (hi - lo) > 1;
    if (multi) bar = xcd_barrier_post((unsigned*)(ws + WS_CTL) + CW_BAR, barw);
    if (lo == 0) ph_pre(smem);
#pragma unroll 1
    for (int l = 0; l < 2; ++l) {
        const int base = l * NPH;
#define IN(k) (((MASK >> (k)) & 1u) != 0u && lo <= base + (k) && base + (k) < hi)
#define SEAM(k) do { if (base + (k) + 1 < hi) xcd_barrier(bar); } while (0)
        if (IN(PH_CONV)) { ph_conv(smem, l); SEAM(PH_CONV); }
        if (IN(PH_G1)) { ph_g1(smem, l); SEAM(PH_G1); }
        if (IN(PH_LOC)) { ph_loc(smem, l); SEAM(PH_LOC); }
        if (IN(PH_SCAN)) { ph_scan(smem, l); SEAM(PH_SCAN); }
        if (IN(PH_MIX)) { ph_mix(smem, l); SEAM(PH_MIX); }
        if (IN(PH_G4)) { ph_g4(smem, l); SEAM(PH_G4); }
        if (IN(PH_LN1)) { ph_ln(smem, l, 0); SEAM(PH_LN1); }
        if (IN(PH_G5)) { ph_g5(smem, l); SEAM(PH_G5); }
        if (IN(PH_XATT)) { ph_xatt(smem, l); SEAM(PH_XATT); }
        if (IN(PH_G7)) { ph_g7(smem, l); SEAM(PH_G7); }
        if (IN(PH_LN2)) { ph_ln(smem, l, 1); SEAM(PH_LN2); }
        if (IN(PH_MOE1)) { ph_moe(smem, l, 0); SEAM(PH_MOE1); }
        if (IN(PH_MOE2)) { ph_moe(smem, l, 1); SEAM(PH_MOE2); }
        if (IN(PH_LN3)) { ph_ln(smem, l, 2); SEAM(PH_LN3); }
#undef IN
#undef SEAM
    }
}

extern "C" void kernel_launch(void* const* d_in, const int* in_sizes, int n_in, void* d_out, int out_size, void* d_ws, size_t ws_size, hipStream_t stream) {
    static int grid = 0;
    typedef void (*kfn_t)(Params);
#if N_LAUNCH_MODE == 1
    static const kfn_t kfn[NPH] = { fwd<1u << 0>, fwd<1u << 1>, fwd<1u << 2>, fwd<1u << 3>, fwd<1u << 4>, fwd<1u << 5>, fwd<1u << 6>, fwd<1u << 7>, fwd<1u << 8>, fwd<1u << 9>, fwd<1u << 10>, fwd<1u << 11>, fwd<1u << 12>, fwd<1u << 13> };
    constexpr int NK = NPH;
#else
    static const kfn_t kfn[1] = { fwd<FULL_MASK> };
    constexpr int NK = 1;
#endif
    if (grid == 0) {
        int dev = 0, cus = 0;
        if (n_in != 32 || out_size != NTOK * DM || ws_size < WS_TOTAL) { fprintf(stderr, "kernel_launch: unexpected shapes (n_in %d out %d ws %zu need %zu)\n", n_in, out_size, ws_size, (size_t)WS_TOTAL); }
        (void)hipGetDevice(&dev); (void)hipDeviceGetAttribute(&cus, hipDeviceAttributeMultiprocessorCount, dev);
        for (int i = 0; i < NK; ++i) (void)hipFuncSetAttribute((const void*)kfn[i], hipFuncAttributeMaxDynamicSharedMemorySize, LDS_BYTES);
        int per_cu = 0; (void)hipOccupancyMaxActiveBlocksPerMultiprocessor(&per_cu, (const void*)kfn[0], 512, LDS_BYTES);
        (void)hipGetLastError();
        grid = cus > 0 ? cus : 256;
    }
    (void)hipMemsetAsync((char*)d_ws + WS_CTL, 0, CTL_BYTES, stream);
    Params p{};
    for (int i = 0; i < 32; ++i) p.in[i] = (const float*)d_in[i];
    p.out = (float*)d_out; p.ws = (unsigned char*)d_ws;
#if N_LAUNCH_MODE == 1
    for (int ph = 0; ph < 2 * NPH; ++ph) { p.ph_lo = ph; p.ph_hi = ph + 1; hipLaunchKernelGGL(kfn[ph % NPH], dim3(grid), dim3(512), LDS_BYTES, stream, p); }
#else
    p.ph_lo = 0; p.ph_hi = 2 * NPH; hipLaunchKernelGGL(kfn[0], dim3(grid), dim3(512), LDS_BYTES, stream, p);
#endif
}
```

```cpp
#include <hip/hip_runtime.h>
#include <stdint.h>
#include <stdio.h>

#ifndef N_LAUNCH_MODE
#define N_LAUNCH_MODE 0
#endif

typedef unsigned short bf16;
typedef float f32x4 __attribute__((ext_vector_type(4)));
typedef unsigned u32x4 __attribute__((ext_vector_type(4)));
typedef unsigned u32x2 __attribute__((ext_vector_type(2)));
#define LAS __attribute__((address_space(3)))

constexpr int NTOK = 16384, DM = 1024, SEQ = 2048, NBATCH = 8, YW = 2560, NCH = 32;
constexpr int Y_GQ = 0, Y_GK = 256, Y_GV = 512, Y_GR = 768, Y_MQ = 1024, Y_MK = 1280, Y_MV = 1536, Y_MO = 1792, Y_CQ = 2048, Y_T9 = 2304,
              Y_A = 2304, Y_MI = 2320, Y_MF = 2324, Y_CKV = 2328, Y_KR = 2456;
constexpr float ALPHA = 1.41421356237309515f;
constexpr float LN_EPS = 1e-5f;
constexpr float LOG2E = 1.44269504088896341f;
constexpr float QSCALE = 0.10206207261596575f * LOG2E;
constexpr float XSCALE = 0.0625f * LOG2E;
constexpr int NPH = 14;
enum { PH_CONV = 0, PH_G1, PH_LOC, PH_SCAN, PH_MIX, PH_G4, PH_LN1, PH_G5, PH_XATT, PH_G7, PH_LN2, PH_MOE1, PH_MOE2, PH_LN3 };

constexpr size_t MiB = 1u << 20;
constexpr size_t WS_CTL = 0, CTL_BYTES = 1 * MiB;
constexpr size_t W_IN = 1 * MiB;
constexpr size_t W_Q = W_IN + (size_t)2560 * 1024 * 2;
constexpr size_t W_KV = W_Q + (size_t)768 * 256 * 2;
constexpr size_t W_OUT = W_KV + (size_t)1280 * 256 * 2;
constexpr size_t W_XQ = W_OUT + 2 * MiB;
constexpr size_t W_XKV = W_XQ + 2 * MiB;
constexpr size_t W_XO = W_XKV + 4 * MiB;
constexpr size_t W_GU = W_XO + 2 * MiB;
constexpr size_t W_DN = W_GU + 32 * MiB;
constexpr size_t W_END = W_DN + 16 * MiB;
constexpr size_t WS_XB = W_END;
constexpr size_t WS_MEMB = WS_XB + 32 * MiB;
constexpr size_t WS_KVX = WS_MEMB + 4 * MiB;
constexpr size_t WS_ROPE = WS_KVX + 8 * MiB;
constexpr size_t WS_RS = WS_ROPE + 2 * MiB;
constexpr size_t WS_LISTT = WS_RS + 128 * 1024;
constexpr size_t WS_LISTW = WS_LISTT + 2 * MiB;
constexpr size_t WS_NV = WS_LISTW + 2 * MiB;
constexpr size_t WS_DEC = WS_NV + 256 * 1024;
constexpr size_t WS_SC = WS_DEC + 256 * 1024;
constexpr size_t WS_MS = WS_SC + 8 * 1024;
constexpr size_t WS_BC = WS_MS + 8 * 1024;
constexpr size_t WS_QKC = WS_BC + 16 * MiB;
constexpr size_t WS_Y = WS_QKC + 16 * MiB;
constexpr size_t WS_QX = WS_Y, WS_OX = WS_Y + 32 * MiB, WS_H = WS_Y;
constexpr size_t WS_QP = WS_Y + 80 * MiB;
constexpr size_t WS_KP = WS_QP + 24 * MiB;
constexpr size_t WS_VP = WS_KP + 24 * MiB;
constexpr size_t WS_ST = WS_VP + 16 * MiB;
constexpr size_t WS_CT = WS_QP;
constexpr size_t WS_TOTAL = WS_ST + 32 * MiB;
static_assert(WS_TOTAL <= (size_t)342000000, "workspace budget");
constexpr int CW_BAR = 4096;
constexpr int CW_CNT = 16384;

constexpr int LDS_BYTES = 147456;
constexpr int LDS_BARW = LDS_BYTES - 16;

struct Params {
    const float* in[32];
    float* out;
    unsigned char* ws;
    int ph_lo, ph_hi;
};

__device__ __forceinline__ float bf2f(unsigned v) { return __uint_as_float(v << 16); }
__device__ __forceinline__ unsigned f2bf(float f) { unsigned u = __float_as_uint(f); return (u + 0x7fffu + ((u >> 16) & 1u)) >> 16; }
__device__ __forceinline__ unsigned pk2(float lo, float hi) { return f2bf(lo) | (f2bf(hi) << 16); }
__device__ __forceinline__ float blo(unsigned w) { return __uint_as_float(w << 16); }
__device__ __forceinline__ float bhi(unsigned w) { return __uint_as_float(w & 0xffff0000u); }
__device__ __forceinline__ float wave_sum(float v) {
#pragma unroll
    for (int o = 1; o < 64; o <<= 1) v += __shfl_xor(v, o);
    return v;
}
__device__ __forceinline__ float logsigmoid(float z) { return fminf(z, 0.f) - log1pf(expf(-fabsf(z))); }
__device__ __forceinline__ float sigmoidf(float x) { return 1.f / (1.f + expf(-x)); }
__device__ __forceinline__ float siluf(float x) { return x / (1.f + expf(-x)); }
__device__ __forceinline__ void st_bf4(bf16* p, f32x4 v) { u32x2 w; w.x = pk2(v[0], v[1]); w.y = pk2(v[2], v[3]); *(u32x2*)p = w; }

#define XB_TMO      128
#define XB_XCNT(j)  (256  + 64 * (j))
#define XB_XSUB(j)  (1280 + 64 * (j))
#define XB_XGEN(j)  (2304 + 64 * (j))
#define XB_TOP      3328
#define XB_TOPGEN   3392
#define XCD_BAR_WORDS 3456
#define XB_SPIN_CAP (1u << 24)
__device__ __forceinline__ unsigned xb_ld(unsigned* p)              { return __hip_atomic_load(p, __ATOMIC_RELAXED, __HIP_MEMORY_SCOPE_AGENT); }
__device__ __forceinline__ unsigned xb_add(unsigned* p, unsigned v) { return __hip_atomic_fetch_add(p, v, __ATOMIC_RELAXED, __HIP_MEMORY_SCOPE_AGENT); }
__device__ __forceinline__ unsigned xb_xcc_id() { return (unsigned)__builtin_amdgcn_s_getreg((3 << 11) | 20) & 0xFu; }
#define XB_SPIN(cond, bar) do { unsigned _sp = 0; while (cond) { __builtin_amdgcn_s_sleep(1); \
    if ((++_sp & 255u) == 0u) { if (xb_ld(&(bar)[XB_TMO])) break; if (_sp > XB_SPIN_CAP) { atomicAdd(&(bar)[XB_TMO], 1u); break; } } } } while (0)
struct XcdBarrier { unsigned* bar; unsigned x; volatile LAS unsigned* st; };
__device__ __forceinline__ XcdBarrier xcd_barrier_post(unsigned* bar, volatile LAS unsigned* st) {
    XcdBarrier b; b.bar = bar; b.x = xb_xcc_id(); b.st = st;
    if (threadIdx.x == 0) (void)xb_add(&bar[XB_XCNT(b.x)], 1u);
    return b;
}
__device__ __forceinline__ void xcd_barrier_complete(unsigned* bar, unsigned x, unsigned& nloc, unsigned& nx) {
    const unsigned G = gridDim.x * gridDim.y * gridDim.z;
    unsigned sum, cnt, mine, sp = 0u;
    for (;;) {
        sum = 0u; cnt = 0u; mine = 0u;
#pragma unroll
        for (unsigned j = 0; j < 16; ++j) { const unsigned c = xb_ld(&bar[XB_XCNT(j)]); sum += c; cnt += (c > 0u) ? 1u : 0u; mine = (j == x) ? c : mine; }
        if (sum == G) break;
        __builtin_amdgcn_s_sleep(1);
        if ((++sp & 255u) == 0u) { if (xb_ld(&bar[XB_TMO])) break; if (sp > XB_SPIN_CAP) { atomicAdd(&bar[XB_TMO], 1u); break; } }
    }
    nloc = mine > 0u ? mine : 1u; nx = cnt > 0u ? cnt : 1u;
}
__device__ __forceinline__ void xcd_barrier(const XcdBarrier& b) {
    asm volatile("s_waitcnt vmcnt(0)" ::: "memory");
    __syncthreads();
    if (threadIdx.x == 0) {
        unsigned* bar = b.bar; asm volatile("" : "+s"(bar));
        __builtin_amdgcn_s_waitcnt(0);
        unsigned nloc = b.st[0], nx = b.st[1];
        if (nloc == 0u) { xcd_barrier_complete(bar, b.x, nloc, nx); b.st[0] = nloc; b.st[1] = nx; }
        const unsigned old = xb_add(&bar[XB_XSUB(b.x)], 1u);
        const unsigned gen = old / nloc;
        if (old + 1u == (gen + 1u) * nloc) {
            __builtin_amdgcn_fence(__ATOMIC_RELEASE, "agent");
            asm volatile("s_waitcnt vmcnt(0)" ::: "memory");
            const unsigned og = xb_add(&bar[XB_TOP], 1u);
            const unsigned tg = og / nx;
            if (og + 1u == (tg + 1u) * nx) xb_add(&bar[XB_TOPGEN], 1u);
            else XB_SPIN(xb_ld(&bar[XB_TOPGEN]) == tg, bar);
            __builtin_amdgcn_fence(__ATOMIC_ACQUIRE, "agent");
            xb_add(&bar[XB_XGEN(b.x)], 1u);
            asm volatile("s_waitcnt vmcnt(0)" ::: "memory");
        } else {
            XB_SPIN(xb_ld(&bar[XB_XGEN(b.x)]) == gen, bar);
            __builtin_amdgcn_fence(__ATOMIC_ACQUIRE, "agent");
            asm volatile("s_waitcnt vmcnt(0)" ::: "memory");
        }
    }
    __syncthreads();
}

__device__ __forceinline__ int TID() { int t = threadIdx.x; asm volatile("" : "+v"(t)); return t; }
__device__ __forceinline__ int BID() { int t = blockIdx.x; asm volatile("" : "+s"(t)); return t; }
__device__ __forceinline__ int GRD() { int t = gridDim.x; asm volatile("" : "+s"(t)); return t; }

struct UnitDesc {
    const bf16* A;
    const bf16* B;
    const int* ridx;
    const float* rw;
    int arow0, acol;
    int row0, col0;
    int nvalid;
    int gather;
};

template <class Epi>
__device__ __forceinline__ void gemm_unit_naive(unsigned char* smem, const UnitDesc& u, int K, int lda, int ldb, const Epi& E) {
    float* As = (float*)smem;
    float* Bs = As + 16 * 128;
    const int tid = TID(), ty = tid >> 4, tx = tid & 15;
    const int lr = tid >> 1, lk = (tid & 1) * 8;
    const bf16* brow = u.B + (size_t)lr * ldb;
    const int cb = (tx >> 2) * 32 + (tx & 3) * 4;
#pragma unroll 1
    for (int half = 0; half < 2; ++half) {
        float acc[4][16];
#pragma unroll
        for (int i = 0; i < 4; ++i)
#pragma unroll
            for (int j = 0; j < 16; ++j) acc[i][j] = 0.f;
        const int ar = half * 128 + (lr & 127);
        const bf16* arow;
        if (u.gather) { const int rr = ar < u.nvalid ? ar : 0; arow = u.A + (size_t)(u.ridx[rr] >> 1) * lda + u.acol; }
        else arow = u.A + (size_t)(u.arow0 + ar) * lda + u.acol;
#pragma unroll 1
        for (int k0 = 0; k0 < K; k0 += 16) {
            const u32x4 bv = *(const u32x4*)(brow + k0 + lk);
            u32x4 av = {0u, 0u, 0u, 0u};
            if (tid < 256) av = *(const u32x4*)(arow + k0 + lk);
            __syncthreads();
#pragma unroll
            for (int j = 0; j < 4; ++j) {
                if (tid < 256) { As[(lk + 2 * j) * 128 + lr] = blo(av[j]); As[(lk + 2 * j + 1) * 128 + lr] = bhi(av[j]); }
                Bs[(lk + 2 * j) * 256 + lr] = blo(bv[j]); Bs[(lk + 2 * j + 1) * 256 + lr] = bhi(bv[j]);
            }
            __syncthreads();
#pragma unroll 4
            for (int kk = 0; kk < 16; ++kk) {
                float b[16];
                const f32x4 a0 = *(const f32x4*)(As + kk * 128 + ty * 4);
#pragma unroll
                for (int g = 0; g < 2; ++g)
#pragma unroll
                    for (int h2 = 0; h2 < 2; ++h2) {
                        const f32x4 bq = *(const f32x4*)(Bs + kk * 256 + g * 128 + cb + h2 * 16);
                        b[g * 8 + h2 * 4 + 0] = bq[0]; b[g * 8 + h2 * 4 + 1] = bq[1]; b[g * 8 + h2 * 4 + 2] = bq[2]; b[g * 8 + h2 * 4 + 3] = bq[3];
                    }
#pragma unroll
                for (int i = 0; i < 4; ++i)
#pragma unroll
                    for (int j = 0; j < 16; ++j) acc[i][j] = fmaf(a0[i], b[j], acc[i][j]);
            }
        }
        __syncthreads();
        float* Ct = (float*)smem;
#pragma unroll
        for (int i = 0; i < 4; ++i)
#pragma unroll
            for (int g = 0; g < 2; ++g) {
                *(f32x4*)(Ct + (ty * 4 + i) * 260 + g * 128 + cb) = (f32x4){acc[i][g * 8 + 0], acc[i][g * 8 + 1], acc[i][g * 8 + 2], acc[i][g * 8 + 3]};
                *(f32x4*)(Ct + (ty * 4 + i) * 260 + g * 128 + cb + 16) = (f32x4){acc[i][g * 8 + 4], acc[i][g * 8 + 5], acc[i][g * 8 + 6], acc[i][g * 8 + 7]};
            }
        __syncthreads();
#pragma unroll 1
        for (int item = tid; item < 128 * 32; item += 512) {
            const int rr = item >> 5, cg = item & 31, c = (cg >> 4) * 128 + ((cg & 15) >> 2) * 32 + (cg & 3) * 4, r = half * 128 + rr;
            if (r < u.nvalid) { const f32x4 v0 = *(const f32x4*)(Ct + rr * 260 + c), v1 = *(const f32x4*)(Ct + rr * 260 + c + 16); E(u, r, c, v0, v1); }
        }
        __syncthreads();
    }
}

struct EpiBf16Store { bf16* O; int ldo; float scale;
    __device__ __forceinline__ void operator()(const UnitDesc& u, int r, int c, f32x4 v0, f32x4 v1) const {
        bf16* o = O + (size_t)(u.row0 + r) * ldo + u.col0 + c; st_bf4(o, v0 * scale); st_bf4(o + 16, v1 * scale); } };
struct EpiKVX { bf16* KX; bf16* VXT;
    __device__ __forceinline__ void grp(int row, int c, f32x4 v) const {
        if (c < 1024) st_bf4(KX + (size_t)row * 1024 + c, v);
        else { const int cc = c - 1024, b = row >> 8, key = row & 255; bf16* vt = VXT + ((size_t)(b * 1024 + cc)) * 256 + key;
            vt[0] = (bf16)f2bf(v[0]); vt[256] = (bf16)f2bf(v[1]); vt[512] = (bf16)f2bf(v[2]); vt[768] = (bf16)f2bf(v[3]); } }
    __device__ __forceinline__ void operator()(const UnitDesc& u, int r, int c, f32x4 v0, f32x4 v1) const {
        grp(u.row0 + r, u.col0 + c, v0); grp(u.row0 + r, u.col0 + c + 16, v1); } };
struct EpiResid { const float* res; float* out;
    __device__ __forceinline__ void operator()(const UnitDesc& u, int r, int c, f32x4 v0, f32x4 v1) const {
        const size_t o = (size_t)(u.row0 + r) * DM + u.col0 + c;
        const f32x4 r0 = *(const f32x4*)(res + o), r1 = *(const f32x4*)(res + o + 16);
        *(f32x4*)(out + o) = r0 * ALPHA + v0; *(f32x4*)(out + o + 16) = r1 * ALPHA + v1; } };
__device__ __forceinline__ f32x4 rope4(f32x4 v, const float* ROPE, int row, int i) {
    const f32x4 cs = *(const f32x4*)(ROPE + ((size_t)row * 16 + i) * 2);
    return (f32x4){v[0] * cs[0] - v[1] * cs[1], v[1] * cs[0] + v[0] * cs[1], v[2] * cs[2] - v[3] * cs[3], v[3] * cs[2] + v[2] * cs[3]}; }
struct EpiMlaQ { bf16* QP; const float* RS; const float* ROPE;
    __device__ __forceinline__ void grp(int row, int c, f32x4 v) const {
        asm volatile("" : "+v"(row), "+v"(c));
        const int b = row >> 11, s = row & 2047, h = c / 96, j = c - h * 96;
        v = v * (RS[row * 2] * QSCALE);
        if (j >= 64) v = rope4(v, ROPE, row, (j - 64) >> 1);
        st_bf4(QP + ((size_t)((b * 8 + h) * SEQ + s)) * 96 + j, v); }
    __device__ __forceinline__ void operator()(const UnitDesc& u, int r, int c, f32x4 v0, f32x4 v1) const {
        grp(u.row0 + r, u.col0 + c, v0); grp(u.row0 + r, u.col0 + c + 16, v1); } };
struct EpiMlaKV { bf16 *KP, *VP; const float* RS; const float* ROPE;
    __device__ __forceinline__ void grp(int row, int c, f32x4 v) const {
        asm volatile("" : "+v"(row), "+v"(c));
        const int b = row >> 11, s = row & 2047, h = c / 160, j = c - h * 160; const float rs = RS[row * 2 + 1];
        if (j < 64) st_bf4(KP + ((size_t)((b * 8 + h) * SEQ + s)) * 96 + j, v * rs);
        else if (j < 96) st_bf4(KP + ((size_t)((b * 8 + h) * SEQ + s)) * 96 + j, rope4(v, ROPE, row, (j - 64) >> 1));
        else { bf16* vt = VP + ((size_t)((b * 8 + h) * 64 + (j - 96))) * SEQ + s;
            vt[0] = (bf16)f2bf(v[0] * rs); vt[SEQ] = (bf16)f2bf(v[1] * rs); vt[2 * SEQ] = (bf16)f2bf(v[2] * rs); vt[3 * SEQ] = (bf16)f2bf(v[3] * rs); } }
    __device__ __forceinline__ void operator()(const UnitDesc& u, int r, int c, f32x4 v0, f32x4 v1) const {
        grp(u.row0 + r, u.col0 + c, v0); grp(u.row0 + r, u.col0 + c + 16, v1); } };
struct EpiMoe1 { bf16* H;
    __device__ __forceinline__ void operator()(const UnitDesc& u, int r, int c, f32x4 v0, f32x4 v1) const {
        f32x4 h;
#pragma unroll
        for (int j = 0; j < 4; ++j) h[j] = siluf(v0[j]) * v1[j];
        st_bf4(H + (size_t)(u.row0 + r) * 256 + u.col0 + (c >> 5) * 16 + (c & 15), h); } };
struct EpiMoe2 { bf16* CT;
    __device__ __forceinline__ void operator()(const UnitDesc& u, int r, int c, f32x4 v0, f32x4 v1) const {
        asm volatile("" : "+v"(r), "+v"(c));
        const int ent = u.ridx[r]; const float w = u.rw[r];
        bf16* o = CT + ((size_t)(ent & 1) * NTOK + (ent >> 1)) * DM + u.col0 + c; st_bf4(o, v0 * w); st_bf4(o + 16, v1 * w); } };

typedef short bf16x8 __attribute__((ext_vector_type(8)));
namespace mg {
constexpr int BK = 64, HALF = 128, HTB = HALF * BK * 2, STAGE_BYTES = 8 * HTB;
__device__ __forceinline__ int lds_byte(int r, int c) { const int st = (r >> 4) * 2 + (c >> 5), rr = r & 15, cc = c & 31, ob = rr * 64 + cc * 2; return st * 1024 + (ob ^ (((ob >> 9) & 1) << 5)); }
__device__ __forceinline__ void stage_rc(int b, int& R, int& C) { const int st = b / 1024, sb = b % 1024, swz = sb ^ (((sb >> 9) & 1) << 5); R = (st >> 1) * 16 + swz / 64; C = (st & 1) * 32 + (swz % 64) / 2; }

template <bool GATHER, class Sched, class Epi>
__device__ __forceinline__ void gemm_mfma(LAS unsigned char* lds, const Sched& S, const int K, const int lda, const int ldb, const Epi& E) {
    const int tid = TID(), wid = __builtin_amdgcn_readfirstlane(tid >> 6), lane = tid & 63, wr = wid >> 2, wc = wid & 3, fr = lane & 15, fq = lane >> 4;
    const int nt = K / BK;
    unsigned voffB[2], voffA[2];
    { int R0, C0, R1, C1; stage_rc(tid * 16, R0, C0); stage_rc(tid * 16 + 8192, R1, C1); voffB[0] = (unsigned)(R0 * ldb + C0) * 2u; voffB[1] = (unsigned)(R1 * ldb + C1) * 2u;
      voffA[0] = (unsigned)(R0 * lda + C0) * 2u; voffA[1] = (unsigned)(R1 * lda + C1) * 2u; }
    const size_t kstep = (size_t)(BK * 2);
    const size_t hstepB = (size_t)HALF * ldb * 2, hstepA = (size_t)HALF * lda * 2;
    const unsigned ldsw = (unsigned)wid * 1024u;
    const int aoff = lds_byte(wr * 64 + fr, fq * 8), boff = lds_byte(wc * 32 + fr, fq * 8);
#define MG_SA(b, h) (((b) * 2 + (h)) * HTB)
#define MG_SB(b, h) ((4 + (b) * 2 + (h)) * HTB)
#define MG_STAGE(bufoff, gbase, voff) do { _Pragma("unroll") for (int _i = 0; _i < 2; ++_i) \
        __builtin_amdgcn_global_load_lds((const unsigned*)((const char*)(gbase) + (voff)[_i]), (LAS unsigned*)(lds + (bufoff) + ldsw + _i * 8192), 16, 0, 0); } while (0)
#define MG_STA(bufoff, base, h, nx) do { if constexpr (GATHER) { MG_STAGE(bufoff, base, vc[h]); } else { MG_STAGE(bufoff, (base) + (h) * hstepA, voffA); } } while (0)
#define MG_LDA(dst, b, h) do { _Pragma("unroll") for (int m = 0; m < 4; ++m) _Pragma("unroll") for (int k = 0; k < 2; ++k) dst[m][k] = *(const LAS bf16x8*)(lds + MG_SA(b, h) + aoff + m * 2048 + k * 1024); } while (0)
#define MG_LDB(dst, b, h) do { _Pragma("unroll") for (int n = 0; n < 2; ++n) _Pragma("unroll") for (int k = 0; k < 2; ++k) dst[n][k] = *(const LAS bf16x8*)(lds + MG_SB(b, h) + boff + n * 2048 + k * 1024); } while (0)
#define MG_MMA(ai, bj, At, Bt) do { __builtin_amdgcn_s_setprio(1); _Pragma("unroll") for (int m = 0; m < 4; ++m) _Pragma("unroll") for (int n = 0; n < 2; ++n) _Pragma("unroll") for (int k = 0; k < 2; ++k) \
        acc[ai][bj][m][n] = __builtin_amdgcn_mfma_f32_16x16x32_bf16(Bt[n][k], At[m][k], acc[ai][bj][m][n], 0, 0, 0); __builtin_amdgcn_s_setprio(0); } while (0)
#define MG_WAIT_V(n) asm volatile("s_waitcnt vmcnt(" #n ")" ::: "memory")
#define MG_WAIT_L(n) asm volatile("s_waitcnt lgkmcnt(" #n ")" ::: "memory")
#define MG_BAR __builtin_amdgcn_s_barrier()
#define MG_SCHED __builtin_amdgcn_sched_barrier(0)
#define MG_MKOFF(u, v) do { if constexpr (GATHER) { int R0, C0, R1, C1; { const int _t = TID(); stage_rc(_t * 16, R0, C0); stage_rc(_t * 16 + 8192, R1, C1); } _Pragma("unroll") for (int _h = 0; _h < 2; ++_h) { \
        const int _r0 = R0 + 128 * _h, _r1 = R1 + 128 * _h; const int _l = (u).nvalid - 1; const int _a0 = (u).ridx[_r0 < _l ? _r0 : _l] >> 1, _a1 = (u).ridx[_r1 < _l ? _r1 : _l] >> 1; \
        v[_h][0] = ((unsigned)_a0 * (unsigned)lda + (unsigned)C0) * 2u; v[_h][1] = ((unsigned)_a1 * (unsigned)lda + (unsigned)C1) * 2u; } } } while (0)
#define MG_ABASE(u) (GATHER ? (const char*)((u).A + (u).acol) : (const char*)((u).A + (size_t)(u).arow0 * lda + (u).acol))
    UnitDesc cur, nxt; int ui = 0;
    if (!S.get(0, cur)) return;
    f32x4 acc[2][2][4][2];
#pragma unroll
    for (int a = 0; a < 2; ++a)
#pragma unroll
        for (int b = 0; b < 2; ++b)
#pragma unroll
            for (int m = 0; m < 4; ++m)
#pragma unroll
                for (int n = 0; n < 2; ++n) acc[a][b][m][n] = (f32x4){0.f, 0.f, 0.f, 0.f};
    bf16x8 At[4][2], B0[2][2], B1[2][2];
    unsigned vc[2][2];
    MG_MKOFF(cur, vc);
    const char* cA = MG_ABASE(cur); const char* cB = (const char*)cur.B;
    MG_STAGE(MG_SB(0, 0), cB, voffB); MG_STA(MG_SA(0, 0), cA, 0, false); MG_STAGE(MG_SB(0, 1), cB + hstepB, voffB); MG_STA(MG_SA(0, 1), cA, 1, false);
    if (wr == 1) MG_BAR;
    MG_WAIT_V(4); MG_BAR;
    MG_STAGE(MG_SB(1, 0), cB + kstep, voffB); MG_STA(MG_SA(1, 0), cA + kstep, 0, false); MG_STAGE(MG_SB(1, 1), cB + hstepB + kstep, voffB);
    MG_WAIT_V(6); MG_BAR;
    for (;;) {
        const bool has_next = S.get(ui + 1, nxt);
        const char* nA = has_next ? MG_ABASE(nxt) : cA; const char* nB = has_next ? (const char*)nxt.B : cB;
#pragma unroll 1
        for (int t = 0; t < nt; t += 2) {
            const bool last = (t == nt - 2);
            const char* a1 = cA + (size_t)(t + 1) * kstep;
            const char* a2 = last ? nA : cA + (size_t)(t + 2) * kstep; const char* b2 = last ? nB : cB + (size_t)(t + 2) * kstep;
            const char* a3 = a2 + kstep; const char* b3 = b2 + kstep;
            MG_LDB(B0, 0, 0); MG_SCHED; MG_LDA(At, 0, 0); MG_STA(MG_SA(1, 1), a1, 1, false);
            if constexpr (GATHER) { if (last && has_next) { MG_MKOFF(nxt, vc); } }
            MG_WAIT_L(8); MG_BAR; MG_WAIT_L(0); MG_MMA(0, 0, At, B0); MG_BAR; MG_SCHED;
            MG_LDB(B1, 0, 1); MG_STAGE(MG_SB(0, 0), b2, voffB);
            MG_BAR; MG_WAIT_L(0); MG_MMA(0, 1, At, B1); MG_BAR;
            MG_LDA(At, 0, 1); MG_STA(MG_SA(0, 0), a2, 0, last);
            MG_BAR; MG_WAIT_L(0); MG_MMA(1, 0, At, B0); MG_BAR; MG_SCHED;
            MG_STAGE(MG_SB(0, 1), b2 + hstepB, voffB);
            MG_WAIT_V(6); MG_BAR; MG_MMA(1, 1, At, B1); MG_BAR;
            MG_LDB(B0, 1, 0); MG_SCHED; MG_LDA(At, 1, 0); MG_STA(MG_SA(0, 1), a2, 1, last);
            MG_WAIT_L(8); MG_BAR; MG_WAIT_L(0); MG_MMA(0, 0, At, B0); MG_BAR; MG_SCHED;
            MG_LDB(B1, 1, 1); MG_STAGE(MG_SB(1, 0), b3, voffB);
            MG_BAR; MG_WAIT_L(0); MG_MMA(0, 1, At, B1); MG_BAR;
            MG_LDA(At, 1, 1); MG_STA(MG_SA(1, 0), a3, 0, last);
            MG_BAR; MG_WAIT_L(0); MG_MMA(1, 0, At, B0); MG_BAR; MG_SCHED;
            MG_STAGE(MG_SB(1, 1), b3 + hstepB, voffB);
            MG_WAIT_V(6); MG_BAR; MG_MMA(1, 1, At, B1); MG_BAR;
        }
#pragma unroll
        for (int ai = 0; ai < 2; ++ai)
#pragma unroll
            for (int m = 0; m < 4; ++m) { const int r = ai * HALF + wr * 64 + m * 16 + fr;
                if (r < cur.nvalid) {
#pragma unroll
                    for (int bj = 0; bj < 2; ++bj) E(cur, r, bj * HALF + wc * 32 + 4 * fq, acc[ai][bj][m][0], acc[ai][bj][m][1]); }
                asm volatile("" ::: "memory"); }
        if (!has_next) break;
#pragma unroll
        for (int a = 0; a < 2; ++a)
#pragma unroll
            for (int b = 0; b < 2; ++b)
#pragma unroll
                for (int m = 0; m < 4; ++m)
#pragma unroll
                    for (int n = 0; n < 2; ++n) acc[a][b][m][n] = (f32x4){0.f, 0.f, 0.f, 0.f};
        cur = nxt; cA = nA; cB = nB; ++ui;
    }
    MG_WAIT_V(0);
    if (wr == 0) MG_BAR;
    MG_BAR;
#undef MG_SA
#undef MG_SB
#undef MG_STAGE
#undef MG_LDA
#undef MG_LDB
#undef MG_MMA
#undef MG_WAIT_V
#undef MG_WAIT_L
#undef MG_BAR
#undef MG_SCHED
#undef MG_MKOFF
#undef MG_STA
#undef MG_ABASE
}
}

#ifndef USE_MFMA
#define USE_MFMA 1
#endif
template <bool GATHER = false, class Sched, class Epi>
__device__ __forceinline__ void gemm_run(unsigned char* smem, const Sched& S, int K, int lda, int ldb, const Epi& E) {
#if USE_MFMA
    __syncthreads();
    mg::gemm_mfma<GATHER>((LAS unsigned char*)smem, S, K, lda, ldb, E);
    __syncthreads();
#else
    UnitDesc u; for (int i = 0; S.get(i, u); ++i) gemm_unit_naive(smem, u, K, lda, ldb, E);
#endif
}
struct SchedGrid { const bf16* A; const bf16* B; int ldb, npn, nunits, rot, acol;
    __device__ __forceinline__ bool get(int i, UnitDesc& u) const {
        const int G = GRD(); const int idx = (BID() + rot) % G + i * G; if (idx >= nunits) return false;
        const int pm = idx / npn, pn = idx - pm * npn;
        u.A = A; u.B = B + (size_t)pn * 256 * ldb; u.ridx = nullptr; u.rw = nullptr; u.arow0 = pm * 256; u.acol = acol; u.row0 = pm * 256; u.col0 = pn * 256; u.nvalid = 256; u.gather = 0; return true; } };
struct SchedMoe { const int* tstart; const int* cntl; const int* LT; const float* LW; const bf16* A; const bf16* W; int which;
    __device__ __forceinline__ bool get(int i, UnitDesc& u) const {
        const int ncol = which == 0 ? 2 : 4; const int idx = BID() + i * GRD(); if (idx >= __builtin_amdgcn_readfirstlane(tstart[32]) * ncol) return false;
        const int rt = idx / ncol, pn = idx - rt * ncol; int e = 0;
        for (int q = 1; q < 32; ++q) if (__builtin_amdgcn_readfirstlane(tstart[q]) <= rt) e = q;
        const int pos0 = (rt - __builtin_amdgcn_readfirstlane(tstart[e])) * 256; int nv = __builtin_amdgcn_readfirstlane(cntl[e]) - pos0; nv = nv > 256 ? 256 : nv;
        u.ridx = LT + (size_t)e * NTOK + pos0; u.rw = LW + (size_t)e * NTOK + pos0; u.nvalid = nv; u.acol = 0; u.A = A;
        if (which == 0) { u.B = W + ((size_t)e * 512 + pn * 256) * 1024; u.arow0 = 0; u.row0 = rt * 256; u.col0 = pn * 128; u.gather = 1; }
        else { u.B = W + ((size_t)e * 1024 + pn * 256) * 256; u.arow0 = rt * 256; u.row0 = 0; u.col0 = pn * 256; u.gather = 0; }
        return true; } };

template <class F>
__device__ __forceinline__ void conv_item(const F& src, bf16* dst, int K, float* scr, int k0, int n0, int lane) {
#pragma unroll 8
    for (int i = 0; i < 32; ++i) { const int kk = 2 * i + (lane >> 5); scr[kk * 33 + (lane & 31)] = src(k0 + kk, n0 + (lane & 31)); }
    asm volatile("s_waitcnt lgkmcnt(0)" ::: "memory");
    const int c = lane & 7;
#pragma unroll
    for (int j = 0; j < 4; ++j) { const int n = (lane >> 3) + 8 * j; const float* s = scr + (8 * c) * 33 + n;
        u32x4 o; o.x = pk2(s[0 * 33], s[1 * 33]); o.y = pk2(s[2 * 33], s[3 * 33]); o.z = pk2(s[4 * 33], s[5 * 33]); o.w = pk2(s[6 * 33], s[7 * 33]);
        *(u32x4*)(dst + (size_t)(n0 + n) * K + k0 + 8 * c) = o; }
    asm volatile("s_waitcnt lgkmcnt(0)" ::: "memory");
}
__device__ __forceinline__ int yc_src(int n) {
    if (n < 1024) return n;
    if (n < 2048) return n + 16;
    if (n < 2304) return n + 24;
    if (n < 2320) return 1024 + (n - 2304);
    if (n < 2328) return 2064 + (n - 2320);
    if (n < 2488) return n;
    return -1;
}

__device__ __forceinline__ void phase_conv(const Params& p, int l, unsigned char* smem) {
    const int tid = TID(), lane = tid & 63, wave = tid >> 6;
    const int gw = BID() * 8 + wave, NGW = GRD() * 8;
    float* scr = (float*)smem + wave * (64 * 33 + 16);
    unsigned char* ws = p.ws;
    const float* w_in = p.in[3] + (size_t)l * 1024 * 2488;
    const float* w_out = p.in[4] + (size_t)l * 1024 * 1024;
    const float* gq = p.in[12] + l * 256; const float* w_uq = p.in[13] + (size_t)l * 256 * 768;
    const float* gkv = p.in[14] + l * 128; const float* w_ukv = p.in[15] + (size_t)l * 128 * 1024;
    const float* xwq = p.in[16] + (size_t)l * 1024 * 1024; const float* xwkv = p.in[17] + (size_t)l * 1024 * 2048; const float* xwo = p.in[18] + (size_t)l * 1024 * 1024;
    const float* wg = p.in[23] + (size_t)l * 32 * 1024 * 256; const float* wu = p.in[24] + (size_t)l * 32 * 1024 * 256; const float* wd = p.in[25] + (size_t)l * 32 * 256 * 1024;
    constexpr int I_IN = 16 * 80, I_Q = 4 * 24, I_KV = 4 * 40, I_SQ = 16 * 32, I_XKV = 16 * 64, I_GU = 32 * 16 * 16, I_DN = 32 * 4 * 32;
    constexpr int NIT = I_IN + I_Q + I_KV + 3 * I_SQ + I_XKV + I_GU + I_DN;
    for (int it = gw; it < NIT; it += NGW) {
        int r = it;
        if (r < I_IN) { const int kb = r / 80, nb = r % 80;
            conv_item([&](int k, int n) { const int s = yc_src(n); return s >= 0 ? w_in[(size_t)k * 2488 + s] : 0.f; }, (bf16*)(ws + W_IN), 1024, scr, kb * 64, nb * 32, lane); continue; }
        r -= I_IN;
        if (r < I_Q) { const int kb = r / 24, nb = r % 24;
            conv_item([&](int k, int n) { const int h = n / 96, j = n - h * 96; int sc = h * 96 + j; if (j >= 64) { const int jj = j - 64; sc = h * 96 + 64 + (jj >> 1) + 16 * (jj & 1); }
                return gq[k] * w_uq[(size_t)k * 768 + sc]; }, (bf16*)(ws + W_Q), 256, scr, kb * 64, nb * 32, lane); continue; }
        r -= I_Q;
        if (r < I_KV) { const int kb = r / 40, nb = r % 40;
            conv_item([&](int k, int n) { const int h = n / 160, j = n - h * 160;
                if (j >= 64 && j < 96) { const int jj = j - 64; return (k == 152 + (jj >> 1) + 16 * (jj & 1)) ? 1.f : 0.f; }
                const int col = (j < 64) ? h * 128 + j : h * 128 + 64 + (j - 96);
                return (k >= 24 && k < 152) ? gkv[k - 24] * w_ukv[(size_t)(k - 24) * 1024 + col] : 0.f; }, (bf16*)(ws + W_KV), 256, scr, kb * 64, nb * 32, lane); continue; }
        r -= I_KV;
        if (r < 3 * I_SQ) { const int m = r / I_SQ, q = r % I_SQ, kb = q / 32, nb = q % 32; const float* W = m == 0 ? w_out : (m == 1 ? xwq : xwo);
            bf16* D = (bf16*)(ws + (m == 0 ? W_OUT : (m == 1 ? W_XQ : W_XO)));
            conv_item([&](int k, int n) { return W[(size_t)k * 1024 + n]; }, D, 1024, scr, kb * 64, nb * 32, lane); continue; }
        r -= 3 * I_SQ;
        if (r < I_XKV) { const int kb = r / 64, nb = r % 64;
            conv_item([&](int k, int n) { return xwkv[(size_t)k * 2048 + n]; }, (bf16*)(ws + W_XKV), 1024, scr, kb * 64, nb * 32, lane); continue; }
        r -= I_XKV;
        if (r < I_GU) { const int e = r / 256, q = r % 256, kb = q / 16, nb = q % 16; const float* G = wg + (size_t)e * 1024 * 256; const float* U = wu + (size_t)e * 1024 * 256;
            conv_item([&](int k, int n) { const int j = (n >> 5) * 16 + (n & 15); return ((n >> 4) & 1) ? U[(size_t)k * 256 + j] : G[(size_t)k * 256 + j]; },
                      (bf16*)(ws + W_GU) + (size_t)e * 512 * 1024, 1024, scr, kb * 64, nb * 32, lane); continue; }
        r -= I_GU;
        { const int e = r / 128, q = r % 128, kb = q / 32, nb = q % 32; const float* Dn = wd + (size_t)e * 256 * 1024;
            conv_item([&](int k, int n) { return Dn[(size_t)k * 1024 + n]; }, (bf16*)(ws + W_DN) + (size_t)e * 1024 * 256, 256, scr, kb * 64, nb * 32, lane); }
    }
}

__device__ __forceinline__ void phase_pre(const Params& p) {
    const int tid = TID(); unsigned char* ws = p.ws;
    {
        const size_t gt = (size_t)BID() * 512 + tid, GT = (size_t)GRD() * 512;
        const float* x = p.in[0]; bf16* XB = (bf16*)(ws + WS_XB);
#pragma unroll 2
        for (size_t i = gt; i < (size_t)NTOK * DM / 8; i += GT) { const f32x4 a = *(const f32x4*)(x + i * 8), b = *(const f32x4*)(x + i * 8 + 4);
            u32x4 o; o.x = pk2(a[0], a[1]); o.y = pk2(a[2], a[3]); o.z = pk2(b[0], b[1]); o.w = pk2(b[2], b[3]); *(u32x4*)(XB + i * 8) = o; }
        const float* mem = p.in[1]; bf16* MB = (bf16*)(ws + WS_MEMB);
#pragma unroll 2
        for (size_t i = gt; i < (size_t)2048 * DM / 8; i += GT) { const f32x4 a = *(const f32x4*)(mem + i * 8), b = *(const f32x4*)(mem + i * 8 + 4);
            u32x4 o; o.x = pk2(a[0], a[1]); o.y = pk2(a[2], a[3]); o.z = pk2(b[0], b[1]); o.w = pk2(b[2], b[3]); *(u32x4*)(MB + i * 8) = o; }
        const int* pos = (const int*)p.in[2]; float* ROPE = (float*)(ws + WS_ROPE);
#pragma unroll 1
        for (size_t i = gt; i < (size_t)NTOK * 16; i += GT) { const int t = (int)(i >> 4), f = (int)(i & 15);
            double inv = 0.15915494309189535;
            for (int q = 0; q < f; ++q) inv *= 0.5623413251903491;
            const double rev = (double)pos[t] * inv; const float fr = (float)(rev - floor(rev));
            ROPE[i * 2] = __builtin_amdgcn_cosf(fr); ROPE[i * 2 + 1] = __builtin_amdgcn_sinf(fr); }
    }
}

__device__ __forceinline__ void gla_cum(const Params& p, int l, float* bs, int t0, int h) {
    const int tid = TID(), t = tid >> 3, dg = tid & 7;
    const bf16* Y = (const bf16*)(p.ws + WS_Y);
    const float* w_a2 = p.in[5] + l * 16 * 256; const float* b_a = p.in[6] + l * 256;
    float a[16];
    { const u32x4 a0 = *(const u32x4*)(Y + (size_t)(t0 + t) * YW + Y_A), a1 = *(const u32x4*)(Y + (size_t)(t0 + t) * YW + Y_A + 8);
#pragma unroll
      for (int j = 0; j < 4; ++j) { a[2 * j] = blo(a0[j]); a[2 * j + 1] = bhi(a0[j]); a[8 + 2 * j] = blo(a1[j]); a[8 + 2 * j + 1] = bhi(a1[j]); } }
#pragma unroll
    for (int j = 0; j < 8; ++j) { const int d = dg * 8 + j; float z = b_a[h * 64 + d];
#pragma unroll
        for (int q = 0; q < 16; ++q) z = fmaf(a[q], w_a2[q * 256 + h * 64 + d], z);
        bs[t * 65 + d] = logsigmoid(z) * (1.f / 16.f); }
    __syncthreads();
    if (tid < 64) { float s = 0.f; for (int tt = 0; tt < 64; ++tt) { s += bs[tt * 65 + tid]; bs[tt * 65 + tid] = s; } }
    __syncthreads();
}
__device__ __forceinline__ void ml_gates(const Params& p, int l, float* fc, float* aa, float* pm, int t0, int h) {
    const int tid = TID();
    const bf16* Y = (const bf16*)(p.ws + WS_Y);
    if (tid < 64) { const float fp = bf2f(Y[(size_t)(t0 + tid) * YW + Y_MF + h]) + p.in[10][l * 4 + h]; const float ig = bf2f(Y[(size_t)(t0 + tid) * YW + Y_MI + h]) + p.in[9][l * 4 + h];
        fc[tid] = logsigmoid(fp); aa[tid] = ig; }
    __syncthreads();
    if (tid == 0) { float s = 0.f, m = -3.0e38f; for (int i = 0; i < 64; ++i) { s += fc[i]; fc[i] = s; const float a = aa[i] - s; aa[i] = a; m = fmaxf(m, a); pm[i] = m; } }
    __syncthreads();
}
__device__ __forceinline__ void ml_conv(const Params& p, int l, float* dst, int t0, int c, int ycol, int wch, int h, float scale) {
    const int tid = TID(), s = tid >> 3, dg = tid & 7;
    const bf16* Y = (const bf16*)(p.ws + WS_Y); const float* w = p.in[8] + l * 4 * 512;
    float acc[8];
#pragma unroll
    for (int j = 0; j < 8; ++j) acc[j] = 0.f;
#pragma unroll
    for (int q = 0; q < 4; ++q) { const int ss = c * 64 + s - 3 + q;
        if (ss >= 0) { const u32x4 v = *(const u32x4*)(Y + (size_t)(t0 + s - 3 + q) * YW + ycol + h * 64 + dg * 8); const float* wr = w + q * 512 + wch + h * 64 + dg * 8;
#pragma unroll
            for (int j = 0; j < 4; ++j) { acc[2 * j] = fmaf(wr[2 * j], blo(v[j]), acc[2 * j]); acc[2 * j + 1] = fmaf(wr[2 * j + 1], bhi(v[j]), acc[2 * j + 1]); } } }
#pragma unroll
    for (int j = 0; j < 8; ++j) dst[s * 65 + dg * 8 + j] = siluf(acc[j]) * scale;
}
__device__ __forceinline__ void ld_blk(float* dst, const bf16* src, int ld) {
    const int tid = TID(), s = tid >> 3, dg = tid & 7; const u32x4 v = *(const u32x4*)(src + (size_t)s * ld + dg * 8);
#pragma unroll
    for (int j = 0; j < 4; ++j) { dst[s * 65 + dg * 8 + 2 * j] = blo(v[j]); dst[s * 65 + dg * 8 + 2 * j + 1] = bhi(v[j]); }
}

#define FENCE() do { asm volatile("" ::: "memory"); __builtin_amdgcn_sched_barrier(0); } while (0)
__device__ __forceinline__ f32x4 mfma16(bf16x8 a, bf16x8 b, f32x4 c) { return __builtin_amdgcn_mfma_f32_16x16x32_bf16(a, b, c, 0, 0, 0); }
__device__ __forceinline__ bf16x8 pack8(f32x4 a, f32x4 b) { u32x4 w; w.x = pk2(a[0], a[1]); w.y = pk2(a[2], a[3]); w.z = pk2(b[0], b[1]); w.w = pk2(b[2], b[3]); return __builtin_bit_cast(bf16x8, w); }
__device__ __forceinline__ f32x4 up4(u32x2 w) { return (f32x4){blo(w.x), bhi(w.x), blo(w.y), bhi(w.y)}; }
constexpr int LT = 68;
constexpr int WAVE_LDS = 18304;
__device__ __forceinline__ bf16x8 colfrag(const bf16* T, int col, int ra, int rb) {
    u32x4 w;
    w.x = (unsigned)T[(ra + 0) * LT + col] | ((unsigned)T[(ra + 1) * LT + col] << 16); w.y = (unsigned)T[(ra + 2) * LT + col] | ((unsigned)T[(ra + 3) * LT + col] << 16);
    w.z = (unsigned)T[(rb + 0) * LT + col] | ((unsigned)T[(rb + 1) * LT + col] << 16); w.w = (unsigned)T[(rb + 2) * LT + col] | ((unsigned)T[(rb + 3) * LT + col] << 16);
    return __builtin_bit_cast(bf16x8, w);
}
__device__ __forceinline__ void conv8(const bf16* Y, const float* cw  , int t0, int c, int rr, int ycol, float scale, f32x4& o0, f32x4& o1) {
    f32x4 a0 = {0.f, 0.f, 0.f, 0.f}, a1 = {0.f, 0.f, 0.f, 0.f};
#pragma unroll
    for (int tap = 0; tap < 4; ++tap) { const int ss = c * 64 + rr - 3 + tap;
        if (ss >= 0) { const u32x4 v = *(const u32x4*)(Y + (size_t)(t0 + rr - 3 + tap) * YW + ycol); const f32x4 w0 = *(const f32x4*)(cw + tap * 512), w1 = *(const f32x4*)(cw + tap * 512 + 4);
            a0 += w0 * (f32x4){blo(v.x), bhi(v.x), blo(v.y), bhi(v.y)}; a1 += w1 * (f32x4){blo(v.z), bhi(v.z), blo(v.w), bhi(v.w)}; } }
#pragma unroll
    for (int j = 0; j < 4; ++j) { o0[j] = siluf(a0[j]) * scale; o1[j] = siluf(a1[j]) * scale; }
}
__device__ __forceinline__ void v_to_lds(bf16* Vt, const bf16* vsrc, int lane) {
#pragma unroll
    for (int i = 0; i < 16; ++i) { const int x = lane + 64 * i, rr = x >> 4, cc = x & 15; *(u32x2*)(Vt + rr * LT + cc * 4) = *(const u32x2*)(vsrc + (size_t)rr * YW + cc * 4); }
}

__device__ __forceinline__ void lin_loc_wave(const Params& p, int l, bf16* Kt, bf16* Vt, int u, int lane) {
    asm volatile("" : "+v"(lane));
    unsigned char* ws = p.ws; const bf16* Y = (const bf16*)(ws + WS_Y);
    const int type = u >> 10, ur = u & 1023, bh = ur >> 5, c = ur & 31, b = bh >> 2, h = bh & 3, t0 = b * SEQ + c * 64;
    const int q = lane & 15, g = lane >> 4;
    float* ST = (float*)(ws + WS_ST) + (size_t)u * 4096;
    v_to_lds(Vt, Y + (size_t)t0 * YW + (type == 0 ? Y_GV : Y_MV) + h * 64, lane);
    if (type == 0) {
        const float* w_a2 = p.in[5] + l * 16 * 256 + h * 64; const float* b_a = p.in[6] + l * 256 + h * 64;
        const bf16x8 zero8 = {0, 0, 0, 0, 0, 0, 0, 0};
        bf16x8 wf[4], af[4];
#pragma unroll
        for (int db = 0; db < 4; ++db) { wf[db] = zero8;
            if (g < 2) { f32x4 w0, w1;
#pragma unroll
                for (int j = 0; j < 4; ++j) { w0[j] = w_a2[(8 * g + j) * 256 + 16 * db + q]; w1[j] = w_a2[(8 * g + 4 + j) * 256 + 16 * db + q]; }
                wf[db] = pack8(w0, w1); } }
#pragma unroll
        for (int tb = 0; tb < 4; ++tb) { af[tb] = zero8; if (g < 2) af[tb] = *(const bf16x8*)(Y + (size_t)(t0 + 16 * tb + q) * YW + Y_A + 8 * g); }
        float* BC = (float*)(ws + WS_BC); float* DEC = (float*)(ws + WS_DEC) + (size_t)ur * 64;
#pragma unroll
        for (int db = 0; db < 4; ++db) {
            const f32x4 ba = *(const f32x4*)(b_a + 16 * db + 4 * g);
            f32x4 bb[4]; f32x4 carry = {0.f, 0.f, 0.f, 0.f};
#pragma unroll
            for (int tb = 0; tb < 4; ++tb) { const f32x4 z = mfma16(wf[db], af[tb], (f32x4){0.f, 0.f, 0.f, 0.f});
#pragma unroll
                for (int r = 0; r < 4; ++r) { float x = logsigmoid(z[r] + ba[r]) * (1.f / 16.f);
#pragma unroll
                    for (int k = 1; k < 16; k <<= 1) { const float y = __shfl_up(x, k, 16); if (q >= k) x += y; }
                    x += carry[r]; bb[tb][r] = x; carry[r] = __shfl(x, (lane & 48) + 15); } }
#pragma unroll
            for (int sb = 0; sb < 4; ++sb) { const size_t row = (size_t)(t0 + 16 * sb + q);
                f32x4 kv = up4(*(const u32x2*)(Y + row * YW + Y_GK + h * 64 + 16 * db + 4 * g));
#pragma unroll
                for (int r = 0; r < 4; ++r) kv[r] *= expf(carry[r] - bb[sb][r]);
                st_bf4(Kt + (16 * sb + q) * LT + 16 * db + 4 * g, kv);
                *(f32x4*)(BC + row * 256 + h * 64 + 16 * db + 4 * g) = bb[sb]; }
            if (q == 0) *(f32x4*)(DEC + 16 * db + 4 * g) = (f32x4){expf(carry[0]), expf(carry[1]), expf(carry[2]), expf(carry[3])};
            FENCE();
        }
    } else {
        const float fp = bf2f(Y[(size_t)(t0 + lane) * YW + Y_MF + h]) + p.in[10][l * 4 + h], ig = bf2f(Y[(size_t)(t0 + lane) * YW + Y_MI + h]) + p.in[9][l * 4 + h];
        float fc = logsigmoid(fp);
#pragma unroll
        for (int k = 1; k < 64; k <<= 1) { const float y = __shfl_up(fc, k); if (lane >= k) fc += y; }
        const float a = ig - fc; float M = a;
#pragma unroll
        for (int o = 1; o < 64; o <<= 1) M = fmaxf(M, __shfl_xor(M, o));
        const float F = __shfl(fc, 63), wl = expf(a - M);
        const float* cw = p.in[8] + l * 4 * 512 + 256 + h * 64;
#pragma unroll
        for (int sb = 0; sb < 4; ++sb) { const float wrow = __shfl(wl, 16 * sb + q);
#pragma unroll
            for (int ks = 0; ks < 2; ++ks) { const int d0 = 32 * ks + 8 * g; f32x4 o0, o1; bf16* qk = (bf16*)(ws + WS_QKC) + (size_t)(t0 + 16 * sb + q) * 512 + h * 64 + d0;
                conv8(Y, cw + d0, t0, c, 16 * sb + q, Y_MK + h * 64 + d0, 1.f, o0, o1);
                st_bf4(qk + 256, o0); st_bf4(qk + 260, o1);
                st_bf4(Kt + (16 * sb + q) * LT + d0, o0 * wrow); st_bf4(Kt + (16 * sb + q) * LT + d0 + 4, o1 * wrow); FENCE();
                conv8(Y, cw - 256 + d0, t0, c, 16 * sb + q, Y_MQ + h * 64 + d0, 0.125f, o0, o1);
                st_bf4(qk, o0); st_bf4(qk + 4, o1); FENCE(); } }
        if (lane == 0) { float* SC = (float*)(ws + WS_SC); SC[ur * 2] = F; SC[ur * 2 + 1] = F + M; }
    }
    bf16x8 vf[4][2], kf[4][2];
#pragma unroll
    for (int eb = 0; eb < 4; ++eb)
#pragma unroll
        for (int ks = 0; ks < 2; ++ks) { vf[eb][ks] = colfrag(Vt, 16 * eb + q, 32 * ks + 8 * g, 32 * ks + 8 * g + 4); kf[eb][ks] = colfrag(Kt, 16 * eb + q, 32 * ks + 8 * g, 32 * ks + 8 * g + 4); FENCE(); }
#pragma unroll
    for (int eb = 0; eb < 4; ++eb)
#pragma unroll
        for (int db = 0; db < 4; ++db) { f32x4 acc = {0.f, 0.f, 0.f, 0.f};
#pragma unroll
            for (int ks = 0; ks < 2; ++ks) acc = mfma16(vf[eb][ks], kf[db][ks], acc);
#pragma unroll
            for (int r = 0; r < 4; ++r) ST[(16 * eb + 4 * g + r) * 64 + 16 * db + q] = acc[r]; }
    if (type == 1) { const u32x4 o1 = {0x3f803f80u, 0x3f803f80u, 0x3f803f80u, 0x3f803f80u}; const bf16x8 ones = __builtin_bit_cast(bf16x8, o1); float* NV = (float*)(ws + WS_NV) + (size_t)ur * 64;
#pragma unroll
        for (int db = 0; db < 4; ++db) { f32x4 acc = {0.f, 0.f, 0.f, 0.f};
#pragma unroll
            for (int ks = 0; ks < 2; ++ks) acc = mfma16(ones, kf[db][ks], acc);
            if (g == 0) NV[16 * db + q] = acc[0]; } }
}

__device__ __forceinline__ void lin_mix_wave(const Params& p, int l, bf16* Vt, int u, int lane) {
    asm volatile("" : "+v"(lane));
    unsigned char* ws = p.ws; const bf16* Y = (const bf16*)(ws + WS_Y);
    const int type = u >> 10, ur = u & 1023, bh = ur >> 5, c = ur & 31, b = bh >> 2, h = bh & 3, t0 = b * SEQ + c * 64;
    const int q = lane & 15, g = lane >> 4;
    const float* ST = (const float*)(ws + WS_ST) + (size_t)u * 4096;
    bf16* MIX = (bf16*)(ws + WS_XB);
    v_to_lds(Vt, Y + (size_t)t0 * YW + (type == 0 ? Y_GV : Y_MV) + h * 64, lane);
    bf16x8 kf[4][2];
    float fcl = 0.f, al = 0.f, pml = 0.f, mst = 0.f;
    const float* BC = (const float*)(ws + WS_BC);
    const bf16* QKC = (const bf16*)(ws + WS_QKC);
    if (type == 0) {
#pragma unroll
        for (int blk = 0; blk < 4; ++blk)
#pragma unroll
            for (int ks = 0; ks < 2; ++ks) { const size_t row = (size_t)(t0 + 16 * blk + q); const int d0 = 32 * ks + 8 * g;
                const f32x4 b0 = *(const f32x4*)(BC + row * 256 + h * 64 + d0), b1 = *(const f32x4*)(BC + row * 256 + h * 64 + d0 + 4);
                const u32x4 kk = *(const u32x4*)(Y + row * YW + Y_GK + h * 64 + d0);
                f32x4 k0 = {blo(kk.x), bhi(kk.x), blo(kk.y), bhi(kk.y)}, k1 = {blo(kk.z), bhi(kk.z), blo(kk.w), bhi(kk.w)};
#pragma unroll
                for (int j = 0; j < 4; ++j) { k0[j] *= expf(-b0[j]); k1[j] *= expf(-b1[j]); }
                kf[blk][ks] = pack8(k0, k1); FENCE(); }
    } else {
        const float fp = bf2f(Y[(size_t)(t0 + lane) * YW + Y_MF + h]) + p.in[10][l * 4 + h], ig = bf2f(Y[(size_t)(t0 + lane) * YW + Y_MI + h]) + p.in[9][l * 4 + h];
        float fc = logsigmoid(fp);
#pragma unroll
        for (int k = 1; k < 64; k <<= 1) { const float y = __shfl_up(fc, k); if (lane >= k) fc += y; }
        fcl = fc; al = ig - fc; pml = al;
#pragma unroll
        for (int k = 1; k < 64; k <<= 1) { const float y = __shfl_up(pml, k); if (lane >= k) pml = fmaxf(pml, y); }
        mst = ((const float*)(ws + WS_MS))[ur];
#pragma unroll
        for (int blk = 0; blk < 4; ++blk)
#pragma unroll
            for (int ks = 0; ks < 2; ++ks) kf[blk][ks] = *(const bf16x8*)(QKC + (size_t)(t0 + 16 * blk + q) * 512 + 256 + h * 64 + 32 * ks + 8 * g);
    }
    bf16x8 vf[4][2];
#pragma unroll
    for (int eb = 0; eb < 4; ++eb)
#pragma unroll
        for (int ks = 0; ks < 2; ++ks) { vf[eb][ks] = colfrag(Vt, 16 * eb + q, 32 * ks + 4 * g, 32 * ks + 16 + 4 * g); FENCE(); }
    const float* gn = (type == 0 ? p.in[7] : p.in[11]) + l * 256 + h * 64;
#pragma unroll
    for (int tb = 0; tb < 4; ++tb) {
        const int t = 16 * tb + q;
        bf16x8 qf[2];
#pragma unroll
        for (int ks = 0; ks < 2; ++ks) { const int d0 = 32 * ks + 8 * g;
            if (type == 0) { const size_t row = (size_t)(t0 + t);
                const f32x4 b0 = *(const f32x4*)(BC + row * 256 + h * 64 + d0), b1 = *(const f32x4*)(BC + row * 256 + h * 64 + d0 + 4);
                const u32x4 qq = *(const u32x4*)(Y + row * YW + Y_GQ + h * 64 + d0);
                f32x4 q0 = {blo(qq.x), bhi(qq.x), blo(qq.y), bhi(qq.y)}, q1 = {blo(qq.z), bhi(qq.z), blo(qq.w), bhi(qq.w)};
#pragma unroll
                for (int j = 0; j < 4; ++j) { q0[j] *= 0.125f * expf(b0[j]); q1[j] *= 0.125f * expf(b1[j]); }
                qf[ks] = pack8(q0, q1);
            } else qf[ks] = *(const bf16x8*)(QKC + (size_t)(t0 + t) * 512 + h * 64 + d0); }
        f32x4 pt[4];
#pragma unroll
        for (int sb = 0; sb < 4; ++sb) { pt[sb] = (f32x4){0.f, 0.f, 0.f, 0.f};
            if (sb <= tb) {
#pragma unroll
                for (int ks = 0; ks < 2; ++ks) pt[sb] = mfma16(kf[sb][ks], qf[ks], pt[sb]); } }
        float mm = 0.f, wi = 1.f;
        if (type == 1) { mm = fmaxf(mst, __shfl(pml, t)); wi = expf(mst - mm); }
        float dsum = 0.f;
#pragma unroll
        for (int sb = 0; sb < 4; ++sb) if (sb <= tb) {
#pragma unroll
            for (int r = 0; r < 4; ++r) { const int sidx = 16 * sb + 4 * g + r; float w = pt[sb][r];
                if (type == 1) w *= expf(__shfl(al, sidx) - mm);
                w = (sidx <= t) ? w : 0.f; pt[sb][r] = w; dsum += w; } }
        bf16x8 pf[2]; pf[0] = pack8(pt[0], pt[1]); pf[1] = pack8(pt[2], pt[3]);
        f32x4 ot[4];
#pragma unroll
        for (int eb = 0; eb < 4; ++eb) { f32x4 acc = {0.f, 0.f, 0.f, 0.f};
#pragma unroll
            for (int ks = 0; ks < 2; ++ks) { const float* sp = ST + (16 * eb + q) * 64 + 32 * ks + 8 * g;
                acc = mfma16(pack8(*(const f32x4*)sp, *(const f32x4*)(sp + 4)), qf[ks], acc); }
            acc = acc * wi;
            acc = mfma16(vf[eb][0], pf[0], acc);
            if (tb >= 2) acc = mfma16(vf[eb][1], pf[1], acc);
            ot[eb] = acc; }
        if (type == 1) {
            float qn = 0.f;
#pragma unroll
            for (int ks = 0; ks < 2; ++ks) { const u32x4 w = __builtin_bit_cast(u32x4, qf[ks]); const float* nvp = (const float*)(ws + WS_NV) + (size_t)ur * 64 + 32 * ks + 8 * g; const f32x4 n0 = *(const f32x4*)nvp, n1 = *(const f32x4*)(nvp + 4);
                qn += blo(w.x) * n0[0] + bhi(w.x) * n0[1] + blo(w.y) * n0[2] + bhi(w.y) * n0[3] + blo(w.z) * n1[0] + bhi(w.z) * n1[1] + blo(w.w) * n1[2] + bhi(w.w) * n1[3]; }
            qn += __shfl_xor(qn, 16); qn += __shfl_xor(qn, 32); dsum += __shfl_xor(dsum, 16); dsum += __shfl_xor(dsum, 32);
            const float den = wi * qn + dsum, mt = __shfl(fcl, t) + mm; const float inv = 1.f / fmaxf(fabsf(den), expf(-mt));
#pragma unroll
            for (int eb = 0; eb < 4; ++eb) ot[eb] = ot[eb] * inv;
        }
        float s1 = 0.f;
#pragma unroll
        for (int eb = 0; eb < 4; ++eb) s1 += (ot[eb][0] + ot[eb][1]) + (ot[eb][2] + ot[eb][3]);
        s1 += __shfl_xor(s1, 16); s1 += __shfl_xor(s1, 32);
        const float mu = s1 * (1.f / 64.f); float s2 = 0.f;
#pragma unroll
        for (int eb = 0; eb < 4; ++eb) { ot[eb] = ot[eb] - mu; s2 += (ot[eb][0] * ot[eb][0] + ot[eb][1] * ot[eb][1]) + (ot[eb][2] * ot[eb][2] + ot[eb][3] * ot[eb][3]); }
        s2 += __shfl_xor(s2, 16); s2 += __shfl_xor(s2, 32);
        const float rstd = 1.f / sqrtf(s2 * (1.f / 64.f) + LN_EPS);
#pragma unroll
        for (int eb = 0; eb < 4; ++eb) { const int e0 = 16 * eb + 4 * g;
            const f32x4 gate = up4(*(const u32x2*)(Y + (size_t)(t0 + t) * YW + (type == 0 ? Y_GR : Y_MO) + h * 64 + e0)); const f32x4 gg = *(const f32x4*)(gn + e0);
            f32x4 res;
#pragma unroll
            for (int r = 0; r < 4; ++r) res[r] = ot[eb][r] * rstd * gg[r] * (type == 0 ? siluf(gate[r]) : sigmoidf(gate[r]));
            st_bf4(MIX + (size_t)(t0 + t) * DM + type * 256 + h * 64 + e0, res); }
        FENCE();
    }
}

__device__ __forceinline__ void phase_loc(const Params& p, int l, unsigned char* smem) {
    const int tid = TID(), lane = tid & 63, wave = __builtin_amdgcn_readfirstlane(tid >> 6);
    unsigned char* ws = p.ws; const bf16* Y = (const bf16*)(ws + WS_Y);
    { bf16* Kt = (bf16*)(smem + wave * WAVE_LDS); bf16* Vt = Kt + 64 * LT;
      for (int u = BID() * 8 + wave; u < 2048; u += GRD() * 8) lin_loc_wave(p, l, Kt, Vt, u, lane); }
    float* RS = (float*)(ws + WS_RS);
    for (int row = BID() * 8 + wave; row < NTOK; row += GRD() * 8) {
        const u32x2 q = *(const u32x2*)(Y + (size_t)row * YW + Y_CQ + lane * 4); const unsigned kv = *(const unsigned*)(Y + (size_t)row * YW + Y_CKV + lane * 2);
        float sq = blo(q.x) * blo(q.x) + bhi(q.x) * bhi(q.x) + blo(q.y) * blo(q.y) + bhi(q.y) * bhi(q.y); float sk = blo(kv) * blo(kv) + bhi(kv) * bhi(kv);
        sq = wave_sum(sq); sk = wave_sum(sk);
        if (lane == 0) { RS[row * 2] = 1.f / sqrtf(sq * (1.f / 256.f) + LN_EPS); RS[row * 2 + 1] = 1.f / sqrtf(sk * (1.f / 128.f) + LN_EPS); }
    }
}

__device__ __forceinline__ void phase_scan(const Params& p, int l) {
    unsigned char* ws = p.ws;
    float* ST = (float*)(ws + WS_ST); float* NV = (float*)(ws + WS_NV); const float* DEC = (const float*)(ws + WS_DEC); const float* SC = (const float*)(ws + WS_SC); float* MS = (float*)(ws + WS_MS);
    const int gt = BID() * 512 + TID(), GT = GRD() * 512;
    for (int idx = gt; idx < 64 * 4096; idx += GT) {
        const int seq = idx >> 12, el = idx & 4095, d = el & 63;
        float* st = ST + (size_t)seq * 32 * 4096 + el;
        float tv[32];
#pragma unroll
        for (int c = 0; c < 32; ++c) tv[c] = st[(size_t)c * 4096];
        if (seq < 32) { const float* dc = DEC + (size_t)seq * 32 * 64 + d; float dv[32];
#pragma unroll
            for (int c = 0; c < 32; ++c) dv[c] = dc[c * 64];
            float S = 0.f;
#pragma unroll
            for (int c = 0; c < 32; ++c) { const float tmp = tv[c]; tv[c] = S; S = fmaf(dv[c], S, tmp); } }
        else { const float* sc = SC + (size_t)(seq - 32) * 32 * 2; float C = 0.f, m = 0.f;
#pragma unroll
            for (int c = 0; c < 32; ++c) { const float F = sc[c * 2], ml = sc[c * 2 + 1]; const float tmp = tv[c]; tv[c] = C;
                const float mn = fmaxf(F + m, ml); C = expf(F + m - mn) * C + expf(ml - mn) * tmp; m = mn; } }
#pragma unroll
        for (int c = 0; c < 32; ++c) st[(size_t)c * 4096] = tv[c];
    }
    for (int idx = gt; idx < 32 * 64; idx += GT) {
        const int sq = idx >> 6, d = idx & 63; float n = 0.f, m = 0.f; const float* sc = SC + (size_t)sq * 32 * 2; float* nv = NV + (size_t)sq * 32 * 64 + d;
#pragma unroll 4
        for (int c = 0; c < 32; ++c) { const float F = sc[c * 2], ml = sc[c * 2 + 1]; const float tmp = nv[c * 64]; nv[c * 64] = n; if (d == 0) MS[sq * 32 + c] = m;
            const float mn = fmaxf(F + m, ml); n = expf(F + m - mn) * n + expf(ml - mn) * tmp; m = mn; }
    }
}

template <int DQK, int DV>
__device__ __forceinline__ void attn_naive(unsigned char* smem, const bf16* Q, int qs, const bf16* K, int ks, const bf16* V, int vs, int nk, bf16* O, int os) {
    constexpr int LQ = DQK + 8, LV = DV + 8, EV = DV / 8;
    bf16* Qs = (bf16*)smem; bf16* Ks = Qs + 64 * LQ; bf16* Vs = Ks + 64 * LQ; float* Ss = (float*)(Vs + 64 * LV);
    const int tid = TID(), t = tid >> 3, g = tid & 7;
    __syncthreads();
    for (int i = tid; i < 64 * DQK / 8; i += 512) { const int r = i / (DQK / 8), c8 = i % (DQK / 8); *(u32x4*)(Qs + r * LQ + c8 * 8) = *(const u32x4*)(Q + (size_t)r * qs + c8 * 8); }
    float acc[EV]; float m = -3.0e38f, lsum = 0.f;
#pragma unroll
    for (int j = 0; j < EV; ++j) acc[j] = 0.f;
    for (int k0 = 0; k0 < nk; k0 += 64) {
        __syncthreads();
        for (int i = tid; i < 64 * DQK / 8; i += 512) { const int r = i / (DQK / 8), c8 = i % (DQK / 8); *(u32x4*)(Ks + r * LQ + c8 * 8) = *(const u32x4*)(K + (size_t)(k0 + r) * ks + c8 * 8); }
        for (int i = tid; i < 64 * DV / 8; i += 512) { const int r = i / (DV / 8), c8 = i % (DV / 8); *(u32x4*)(Vs + r * LV + c8 * 8) = *(const u32x4*)(V + (size_t)(k0 + r) * vs + c8 * 8); }
        __syncthreads();
        float sc[8];
#pragma unroll
        for (int j = 0; j < 8; ++j) sc[j] = 0.f;
        for (int d8 = 0; d8 < DQK / 8; ++d8) { const u32x4 qv = *(const u32x4*)(Qs + t * LQ + d8 * 8);
#pragma unroll
            for (int j = 0; j < 8; ++j) { const u32x4 kv = *(const u32x4*)(Ks + (g + 8 * j) * LQ + d8 * 8);
#pragma unroll
                for (int q = 0; q < 4; ++q) sc[j] = fmaf(blo(qv[q]), blo(kv[q]), fmaf(bhi(qv[q]), bhi(kv[q]), sc[j])); } }
        float mx = sc[0];
#pragma unroll
        for (int j = 1; j < 8; ++j) mx = fmaxf(mx, sc[j]);
        mx = fmaxf(mx, __shfl_xor(mx, 1)); mx = fmaxf(mx, __shfl_xor(mx, 2)); mx = fmaxf(mx, __shfl_xor(mx, 4));
        const float mn = fmaxf(m, mx), al = exp2f(m - mn); float ps = 0.f;
#pragma unroll
        for (int j = 0; j < 8; ++j) { const float pv = exp2f(sc[j] - mn); ps += pv; Ss[t * 65 + g + 8 * j] = pv; }
        ps += __shfl_xor(ps, 1); ps += __shfl_xor(ps, 2); ps += __shfl_xor(ps, 4);
        lsum = lsum * al + ps; m = mn;
#pragma unroll
        for (int j = 0; j < EV; ++j) acc[j] *= al;
        __syncthreads();
        for (int kk = 0; kk < 64; ++kk) { const float pv = Ss[t * 65 + kk];
#pragma unroll
            for (int j8 = 0; j8 < EV / 8; ++j8) { const u32x4 vv = *(const u32x4*)(Vs + kk * LV + g * EV + j8 * 8);
#pragma unroll
                for (int q = 0; q < 4; ++q) { acc[j8 * 8 + 2 * q] = fmaf(pv, blo(vv[q]), acc[j8 * 8 + 2 * q]); acc[j8 * 8 + 2 * q + 1] = fmaf(pv, bhi(vv[q]), acc[j8 * 8 + 2 * q + 1]); } } }
    }
    const float inv = 1.f / lsum;
#pragma unroll
    for (int j8 = 0; j8 < EV / 8; ++j8) { u32x4 o; o.x = pk2(acc[j8 * 8] * inv, acc[j8 * 8 + 1] * inv); o.y = pk2(acc[j8 * 8 + 2] * inv, acc[j8 * 8 + 3] * inv);
        o.z = pk2(acc[j8 * 8 + 4] * inv, acc[j8 * 8 + 5] * inv); o.w = pk2(acc[j8 * 8 + 6] * inv, acc[j8 * 8 + 7] * inv);
        *(u32x4*)(O + (size_t)t * os + g * EV + j8 * 8) = o; }
}

template <int DQK, int DV, int QG>
__device__ __forceinline__ void attn_mfma_unit(unsigned char* smem, const bf16* Q, int qs, const bf16* K, int ks, const bf16* VT, int vts, int ntile_wave, int ntile_max, bf16* O, int os) {
    constexpr int LK = DQK + 8, LV = 72, KS = DQK / 32, NDV = DV / 16;
    constexpr int NKPIECE = 64 * DQK / 8, NVPIECE = DV * 8, NKP = (NKPIECE + 511) / 512, NVP = (NVPIECE + 511) / 512;
    bf16* Ks = (bf16*)smem; bf16* Vs = Ks + 64 * LK;
    const int tid = TID(), wave = tid >> 6, lane = tid & 63, q = lane & 15, g = lane >> 4;
    bf16x8 qf[QG][KS];
#pragma unroll
    for (int qg = 0; qg < QG; ++qg)
#pragma unroll
        for (int kk = 0; kk < KS; ++kk) qf[qg][kk] = *(const bf16x8*)(Q + (size_t)(wave * 16 * QG + qg * 16 + q) * qs + kk * 32 + g * 8);
    f32x4 o[QG][NDV]; float mrun[QG], lrun[QG];
#pragma unroll
    for (int qg = 0; qg < QG; ++qg) { mrun[qg] = -3.0e38f; lrun[qg] = 0.f;
#pragma unroll
        for (int d = 0; d < NDV; ++d) o[qg][d] = (f32x4){0.f, 0.f, 0.f, 0.f}; }
    u32x4 kr[NKP], vr[NVP];
#define AT_GLOAD(kt) do { _Pragma("unroll") for (int _i = 0; _i < NKP; ++_i) { const int _x = tid + 512 * _i; if (_x < NKPIECE) { const int _r = _x / (DQK / 8), _c = _x % (DQK / 8); kr[_i] = *(const u32x4*)(K + (size_t)((kt) * 64 + _r) * ks + _c * 8); } } \
        _Pragma("unroll") for (int _i = 0; _i < NVP; ++_i) { const int _x = tid + 512 * _i; if (_x < NVPIECE) { const int _r = _x >> 3, _c = _x & 7; vr[_i] = *(const u32x4*)(VT + (size_t)_r * vts + (kt) * 64 + _c * 8); } } } while (0)
#define AT_LSTORE() do { _Pragma("unroll") for (int _i = 0; _i < NKP; ++_i) { const int _x = tid + 512 * _i; if (_x < NKPIECE) { const int _r = _x / (DQK / 8), _c = _x % (DQK / 8); *(u32x4*)(Ks + _r * LK + _c * 8) = kr[_i]; } } \
        _Pragma("unroll") for (int _i = 0; _i < NVP; ++_i) { const int _x = tid + 512 * _i; if (_x < NVPIECE) { const int _r = _x >> 3, _c = _x & 7; *(u32x4*)(Vs + _r * LV + _c * 8) = vr[_i]; } } } while (0)
    AT_GLOAD(0);
    for (int kt = 0; kt < ntile_max; ++kt) {
        __syncthreads();
        AT_LSTORE();
        __syncthreads();
        if (kt + 1 < ntile_max) AT_GLOAD(kt + 1);
        if (kt < ntile_wave) {
            f32x4 sc[QG][4];
#pragma unroll
            for (int qg = 0; qg < QG; ++qg)
#pragma unroll
                for (int b = 0; b < 4; ++b) sc[qg][b] = (f32x4){0.f, 0.f, 0.f, 0.f};
#pragma unroll
            for (int b = 0; b < 4; ++b)
#pragma unroll
                for (int kk = 0; kk < KS; ++kk) { const bf16x8 kf = *(const bf16x8*)(Ks + (b * 16 + q) * LK + kk * 32 + g * 8);
#pragma unroll
                    for (int qg = 0; qg < QG; ++qg) sc[qg][b] = __builtin_amdgcn_mfma_f32_16x16x32_bf16(kf, qf[qg][kk], sc[qg][b], 0, 0, 0); }
            bf16x8 pf[QG][2];
#pragma unroll
            for (int qg = 0; qg < QG; ++qg) {
                float mx = sc[qg][0][0];
#pragma unroll
                for (int b = 0; b < 4; ++b)
#pragma unroll
                    for (int i = 0; i < 4; ++i) mx = fmaxf(mx, sc[qg][b][i]);
                mx = fmaxf(mx, __shfl_xor(mx, 16)); mx = fmaxf(mx, __shfl_xor(mx, 32));
                const float mn = fmaxf(mrun[qg], mx), al = exp2f(mrun[qg] - mn); float ps = 0.f;
#pragma unroll
                for (int b = 0; b < 4; ++b)
#pragma unroll
                    for (int i = 0; i < 4; ++i) { const float pv = exp2f(sc[qg][b][i] - mn); sc[qg][b][i] = pv; ps += pv; }
                lrun[qg] = lrun[qg] * al + ps; mrun[qg] = mn;
#pragma unroll
                for (int d = 0; d < NDV; ++d) o[qg][d] = o[qg][d] * al;
#pragma unroll
                for (int st = 0; st < 2; ++st) { u32x4 w; w.x = pk2(sc[qg][2 * st][0], sc[qg][2 * st][1]); w.y = pk2(sc[qg][2 * st][2], sc[qg][2 * st][3]);
                    w.z = pk2(sc[qg][2 * st + 1][0], sc[qg][2 * st + 1][1]); w.w = pk2(sc[qg][2 * st + 1][2], sc[qg][2 * st + 1][3]); pf[qg][st] = __builtin_bit_cast(bf16x8, w); }
            }
#pragma unroll
            for (int d = 0; d < NDV; ++d)
#pragma unroll
                for (int st = 0; st < 2; ++st) { const u32x2 v0 = *(const u32x2*)(Vs + (d * 16 + q) * LV + st * 32 + 4 * g), v1 = *(const u32x2*)(Vs + (d * 16 + q) * LV + st * 32 + 16 + 4 * g);
                    const u32x4 vv = {v0.x, v0.y, v1.x, v1.y}; const bf16x8 vf = __builtin_bit_cast(bf16x8, vv);
#pragma unroll
                    for (int qg = 0; qg < QG; ++qg) o[qg][d] = __builtin_amdgcn_mfma_f32_16x16x32_bf16(vf, pf[qg][st], o[qg][d], 0, 0, 0); }
        }
    }
#undef AT_GLOAD
#undef AT_LSTORE
#pragma unroll
    for (int qg = 0; qg < QG; ++qg) { float lt = lrun[qg]; lt += __shfl_xor(lt, 16); lt += __shfl_xor(lt, 32); const float inv = 1.f / lt;
        bf16* orow = O + (size_t)(wave * 16 * QG + qg * 16 + q) * os + 4 * g;
#pragma unroll
        for (int d = 0; d < NDV; ++d) st_bf4(orow + d * 16, o[qg][d] * inv); }
}

__device__ __forceinline__ void mix_linear_unit(const Params& p, int l, unsigned char* smem, int u) {
    const int tid = TID(); unsigned char* ws = p.ws; const bf16* Y = (const bf16*)(ws + WS_Y);
    float* A0 = (float*)smem; float* A1 = A0 + 64 * 65; float* A2 = A1 + 64 * 65; float* A3 = A2 + 64 * 65; float* A4 = A3 + 64 * 65; float* A5 = A4 + 64 * 65;
    float* fc = A5 + 64 * 65; float* aa = fc + 64; float* pm = aa + 64; float* nv = pm + 64;
    const float* ST = (const float*)(ws + WS_ST); const float* NV = (const float*)(ws + WS_NV); const float* MS = (const float*)(ws + WS_MS);
    bf16* MIX = (bf16*)(ws + WS_XB);
    const int type = u >> 10, r = u & 1023, bh = r >> 5, c = r & 31, b = bh >> 2, h = bh & 3, t0 = b * SEQ + c * 64;
    const int t = tid >> 3, g = tid & 7, e0 = g * 8;
    __syncthreads();
    for (int i = tid; i < 4096; i += 512) A3[(i >> 6) * 65 + (i & 63)] = ST[(size_t)u * 4096 + i];
    ld_blk(A2, Y + (size_t)t0 * YW + (type == 0 ? Y_GV : Y_MV) + h * 64, YW);
    float mst = 0.f;
    if (type == 0) {
        gla_cum(p, l, A0, t0, h);
        ld_blk(A4, Y + (size_t)t0 * YW + Y_GQ + h * 64, YW); ld_blk(A1, Y + (size_t)t0 * YW + Y_GK + h * 64, YW);
        __syncthreads();
        for (int i = tid; i < 4096; i += 512) { const int s = i >> 6, dd = i & 63; const float bb = A0[s * 65 + dd]; A4[s * 65 + dd] *= 0.125f * expf(bb); A1[s * 65 + dd] *= expf(-bb); }
    } else {
        ml_gates(p, l, fc, aa, pm, t0, h);
        ml_conv(p, l, A4, t0, c, Y_MQ, 0, h, 0.125f); ml_conv(p, l, A1, t0, c, Y_MK, 256, h, 1.f);
        if (tid < 64) nv[tid] = NV[(size_t)r * 64 + tid];
        mst = MS[r];
    }
    __syncthreads();
    const float mm = (type == 1) ? fmaxf(mst, pm[t]) : 0.f;
    {
        float sc[8];
#pragma unroll
        for (int j = 0; j < 8; ++j) sc[j] = 0.f;
        for (int d = 0; d < 64; ++d) { const float qv = A4[t * 65 + d];
#pragma unroll
            for (int j = 0; j < 8; ++j) sc[j] = fmaf(qv, A1[(g + 8 * j) * 65 + d], sc[j]); }
#pragma unroll
        for (int j = 0; j < 8; ++j) { const int s = g + 8 * j; float w = (s <= t) ? sc[j] : 0.f; if (type == 1) w = (s <= t) ? w * expf(aa[s] - mm) : 0.f; A5[t * 65 + s] = w; }
    }
    __syncthreads();
    float acc[8], inter[8];
#pragma unroll
    for (int j = 0; j < 8; ++j) { acc[j] = 0.f; inter[j] = 0.f; }
    for (int d = 0; d < 64; ++d) { const float qv = A4[t * 65 + d];
#pragma unroll
        for (int j = 0; j < 8; ++j) inter[j] = fmaf(qv, A3[d * 65 + e0 + j], inter[j]); }
    for (int s = 0; s < 64; ++s) { const float pv = A5[t * 65 + s];
#pragma unroll
        for (int j = 0; j < 8; ++j) acc[j] = fmaf(pv, A2[s * 65 + e0 + j], acc[j]); }
    float o[8];
    if (type == 0) {
#pragma unroll
        for (int j = 0; j < 8; ++j) o[j] = acc[j] + inter[j];
    } else {
        const float wi = expf(mst - mm);
        float dn = 0.f;
#pragma unroll
        for (int j = 0; j < 8; ++j) dn += wi * A4[t * 65 + e0 + j] * nv[e0 + j] + A5[t * 65 + e0 + j];
        dn += __shfl_xor(dn, 1); dn += __shfl_xor(dn, 2); dn += __shfl_xor(dn, 4);
        const float mt = fc[t] + mm; const float den = fmaxf(fabsf(dn), expf(-mt)); const float inv = 1.f / den;
#pragma unroll
        for (int j = 0; j < 8; ++j) o[j] = (wi * inter[j] + acc[j]) * inv;
    }
    float s1 = 0.f;
#pragma unroll
    for (int j = 0; j < 8; ++j) s1 += o[j];
    s1 += __shfl_xor(s1, 1); s1 += __shfl_xor(s1, 2); s1 += __shfl_xor(s1, 4);
    const float mu = s1 * (1.f / 64.f); float s2 = 0.f;
#pragma unroll
    for (int j = 0; j < 8; ++j) { o[j] -= mu; s2 += o[j] * o[j]; }
    s2 += __shfl_xor(s2, 1); s2 += __shfl_xor(s2, 2); s2 += __shfl_xor(s2, 4);
    const float rstd = 1.f / sqrtf(s2 * (1.f / 64.f) + LN_EPS);
    const float* gn = (type == 0 ? p.in[7] : p.in[11]) + l * 256 + h * 64 + e0;
    const u32x4 gv = *(const u32x4*)(Y + (size_t)(t0 + t) * YW + (type == 0 ? Y_GR : Y_MO) + h * 64 + e0);
    float gate[8];
#pragma unroll
    for (int j = 0; j < 4; ++j) { gate[2 * j] = blo(gv[j]); gate[2 * j + 1] = bhi(gv[j]); }
    float res[8];
#pragma unroll
    for (int j = 0; j < 8; ++j) res[j] = o[j] * rstd * gn[j] * (type == 0 ? siluf(gate[j]) : sigmoidf(gate[j]));
    u32x4 ov; ov.x = pk2(res[0], res[1]); ov.y = pk2(res[2], res[3]); ov.z = pk2(res[4], res[5]); ov.w = pk2(res[6], res[7]);
    *(u32x4*)(MIX + (size_t)(t0 + t) * DM + type * 256 + h * 64 + e0) = ov;
}

__device__ __forceinline__ void phase_mix(const Params& p, int l, unsigned char* smem) {
    unsigned char* ws = p.ws;
    const bf16* QP = (const bf16*)(ws + WS_QP); const bf16* KP = (const bf16*)(ws + WS_KP); const bf16* VPT = (const bf16*)(ws + WS_VP); bf16* MIX = (bf16*)(ws + WS_XB);
    for (int u = BID(); u < 512; u += GRD()) {
        const int bh = u & 63, Qb = u < 256 ? 7 - (u >> 6) : (u - 256) >> 6, b = bh >> 3, h = bh & 7;
        const int wave = TID() >> 6;
        attn_mfma_unit<96, 64, 2>(smem, QP + ((size_t)bh * SEQ + Qb * 256) * 96, 96, KP + (size_t)bh * SEQ * 96, 96, VPT + (size_t)bh * 64 * SEQ, SEQ,
                                  Qb * 4 + (wave >> 1) + 1, Qb * 4 + 4, MIX + (size_t)(b * SEQ + Qb * 256) * DM + 512 + h * 64, DM);
    }
    __syncthreads();
    { const int tid = TID(), lane = tid & 63, wave = __builtin_amdgcn_readfirstlane(tid >> 6); bf16* Vt = (bf16*)(smem + wave * WAVE_LDS);
      for (int u = BID() * 8 + wave; u < 2048; u += GRD() * 8) lin_mix_wave(p, l, Vt, u, lane); }
}

__device__ __forceinline__ void ln_row_store(f32x4 (&v)[4], const float* g, const float* bta, float* of, bf16* ob, int lane) {
    float s = 0.f;
#pragma unroll
    for (int j = 0; j < 4; ++j) s += (v[j][0] + v[j][1]) + (v[j][2] + v[j][3]);
    const float mean = wave_sum(s) * (1.f / DM); float s2 = 0.f;
#pragma unroll
    for (int j = 0; j < 4; ++j) { v[j] = v[j] - mean; s2 += (v[j][0] * v[j][0] + v[j][1] * v[j][1]) + (v[j][2] * v[j][2] + v[j][3] * v[j][3]); }
    const float rstd = 1.f / sqrtf(wave_sum(s2) * (1.f / DM) + LN_EPS);
#pragma unroll
    for (int j = 0; j < 4; ++j) { const f32x4 gg = *(const f32x4*)(g + lane * 4 + 256 * j), bb = *(const f32x4*)(bta + lane * 4 + 256 * j);
        v[j] = v[j] * rstd * gg + bb; *(f32x4*)(of + lane * 4 + 256 * j) = v[j]; st_bf4(ob + lane * 4 + 256 * j, v[j]); }
}

__device__ __forceinline__ void phase_ln(const Params& p, int l, int which  , int dummy = 0  ) {
    const int tid = TID(), lane = tid & 63, wave = tid >> 6; unsigned char* ws = p.ws;
    float* XR = p.out; bf16* XB = (bf16*)(ws + WS_XB);
    const float* g = p.in[26 + 2 * which] + l * DM; const float* bta = p.in[27 + 2 * which] + l * DM;
    const bf16* CT = (const bf16*)(ws + WS_CT);
    for (int row = BID() * 8 + wave; row < NTOK; row += GRD() * 8) {
        f32x4 v[4];
#pragma unroll
        for (int j = 0; j < 4; ++j) v[j] = *(const f32x4*)(XR + (size_t)row * DM + lane * 4 + 256 * j);
        if (which == 2) {
#pragma unroll
            for (int j = 0; j < 4; ++j) { const u32x2 c0 = *(const u32x2*)(CT + (size_t)row * DM + lane * 4 + 256 * j), c1 = *(const u32x2*)(CT + ((size_t)NTOK + row) * DM + lane * 4 + 256 * j);
                v[j] = v[j] * ALPHA + (f32x4){blo(c0.x), bhi(c0.x), blo(c0.y), bhi(c0.y)} + (f32x4){blo(c1.x), bhi(c1.x), blo(c1.y), bhi(c1.y)}; }
        }
        float* of = XR + (size_t)row * DM; bf16* ob = XB + (size_t)row * DM;
        if (dummy) { of = (float*)(ws + (which == 2 ? WS_Y : WS_CT)) + (size_t)row * DM; ob = (bf16*)(ws + (which == 2 ? WS_ST : WS_Y)) + (size_t)row * DM; }
        ln_row_store(v, g, bta, of, ob, lane);
        if (which == 1) {
            const float* wgp = p.in[19] + (size_t)l * DM * 4; const float* bg = p.in[20] + l * 4; const float* wr = p.in[21] + (size_t)l * DM * 32; const float* br = p.in[22] + l * 32;
            float gl[4] = {0.f, 0.f, 0.f, 0.f};
#pragma unroll
            for (int j = 0; j < 4; ++j)
#pragma unroll
                for (int q = 0; q < 4; ++q) { const f32x4 w4 = *(const f32x4*)(wgp + (size_t)(lane * 4 + 256 * j + q) * 4); const float xv = v[j][q];
                    gl[0] = fmaf(xv, w4[0], gl[0]); gl[1] = fmaf(xv, w4[1], gl[1]); gl[2] = fmaf(xv, w4[2], gl[2]); gl[3] = fmaf(xv, w4[3], gl[3]); }
#pragma unroll
            for (int q = 0; q < 4; ++q) gl[q] = wave_sum(gl[q]) + bg[q];
            int gi = 0; float gm = gl[0];
#pragma unroll
            for (int q = 1; q < 4; ++q) if (gl[q] > gm) { gm = gl[q]; gi = q; }
            float gs = 0.f;
#pragma unroll
            for (int q = 0; q < 4; ++q) gs += expf(gl[q] - gm);
            const float gp = 1.f / gs;
            float el[8] = {0.f, 0.f, 0.f, 0.f, 0.f, 0.f, 0.f, 0.f};
#pragma unroll
            for (int j = 0; j < 4; ++j)
#pragma unroll
                for (int q = 0; q < 4; ++q) { const float* wrow = wr + (size_t)(lane * 4 + 256 * j + q) * 32 + gi * 8; const f32x4 w0 = *(const f32x4*)wrow, w1 = *(const f32x4*)(wrow + 4); const float xv = v[j][q];
                    el[0] = fmaf(xv, w0[0], el[0]); el[1] = fmaf(xv, w0[1], el[1]); el[2] = fmaf(xv, w0[2], el[2]); el[3] = fmaf(xv, w0[3], el[3]);
                    el[4] = fmaf(xv, w1[0], el[4]); el[5] = fmaf(xv, w1[1], el[5]); el[6] = fmaf(xv, w1[2], el[6]); el[7] = fmaf(xv, w1[3], el[7]); }
#pragma unroll
            for (int q = 0; q < 8; ++q) el[q] = wave_sum(el[q]) + br[gi * 8 + q];
            int i0 = 0; float m0 = el[0];
#pragma unroll
            for (int q = 1; q < 8; ++q) if (el[q] > m0) { m0 = el[q]; i0 = q; }
            int i1 = -1; float m1 = -3.0e38f;
#pragma unroll
            for (int q = 0; q < 8; ++q) if (q != i0 && el[q] > m1) { m1 = el[q]; i1 = q; }
            const float p1 = expf(m1 - m0); const float w0 = gp / (1.f + p1), w1 = gp * p1 / (1.f + p1);
            if (lane == 0 && !dummy) {
                unsigned* cnt = (unsigned*)(ws + WS_CTL) + CW_CNT + l * 32; int* LT = (int*)(ws + WS_LISTT); float* LW = (float*)(ws + WS_LISTW);
                const int e0 = gi * 8 + i0, e1 = gi * 8 + i1;
                const unsigned p0 = atomicAdd(cnt + e0, 1u); LT[(size_t)e0 * NTOK + p0] = row * 2; LW[(size_t)e0 * NTOK + p0] = w0;
                const unsigned q1 = atomicAdd(cnt + e1, 1u); LT[(size_t)e1 * NTOK + q1] = row * 2 + 1; LW[(size_t)e1 * NTOK + q1] = w1;
            }
        }
    }
}

__device__ __forceinline__ void moe_table(const Params& p, int l, int* tstart, int* cntl) {
    __syncthreads();
    if (TID() == 0) { const unsigned* cnt = (const unsigned*)(p.ws + WS_CTL) + CW_CNT + l * 32; int s = 0;
        for (int e = 0; e < 32; ++e) { const int c = (int)__hip_atomic_load(cnt + e, __ATOMIC_RELAXED, __HIP_MEMORY_SCOPE_AGENT); cntl[e] = c; tstart[e] = s; s += (c + 255) >> 8; } tstart[32] = s; }
    __syncthreads();
}

__device__ __forceinline__ void phase_moe(const Params& p, int l, unsigned char* smem, int which  ) {
    unsigned char* ws = p.ws;
    int* tstart = (int*)(smem + LDS_BYTES - 1024); int* cntl = tstart + 40;
    moe_table(p, l, tstart, cntl);
    if (which == 0) { SchedMoe S{tstart, cntl, (const int*)(ws + WS_LISTT), (const float*)(ws + WS_LISTW), (const bf16*)(ws + WS_XB), (const bf16*)(ws + W_GU), 0};
        EpiMoe1 E{(bf16*)(ws + WS_H)}; gemm_run<true>(smem, S, 1024, 1024, 1024, E); }
    else { SchedMoe S{tstart, cntl, (const int*)(ws + WS_LISTT), (const float*)(ws + WS_LISTW), (const bf16*)(ws + WS_H), (const bf16*)(ws + W_DN), 1};
        EpiMoe2 E{(bf16*)(ws + WS_CT)}; gemm_run(smem, S, 256, 256, 256, E); }
}

constexpr int LDS_PARAMS = LDS_BYTES - 512;
#define GETP const Params& p = *(const Params*)(smem + LDS_PARAMS); unsigned char* ws = p.ws; (void)ws
#ifndef PROBE_REP
#define PROBE_REP 0
#endif
#ifndef FULL_MASK
#define FULL_MASK 0x3fffu
#endif
#ifndef PHASE_ATTR
#define PHASE_ATTR __forceinline__
#endif
__device__ PHASE_ATTR void ph_conv(unsigned char* smem, int l) { GETP; phase_conv(p, l, smem); }
__device__ PHASE_ATTR void ph_pre(unsigned char* smem) { GETP; phase_pre(p); }
__device__ PHASE_ATTR void ph_g1(unsigned char* smem, int l) { GETP;
    { SchedGrid S{(const bf16*)(ws + WS_XB), (const bf16*)(ws + W_IN), 1024, 10, 640, 0, 0}; EpiBf16Store E{(bf16*)(ws + WS_Y), YW, 1.f}; gemm_run(smem, S, 1024, 1024, 1024, E); }
    { SchedGrid S{(const bf16*)(ws + WS_MEMB), (const bf16*)(ws + W_XKV), 1024, 8, 64, 128, 0}; EpiKVX E{(bf16*)(ws + WS_KVX), (bf16*)(ws + WS_KVX + 4 * MiB)}; gemm_run(smem, S, 1024, 1024, 1024, E); }
}
__device__ PHASE_ATTR void ph_loc(unsigned char* smem, int l) { GETP; phase_loc(p, l, smem); }
__device__ PHASE_ATTR void ph_scan(unsigned char* smem, int l, int part = 3  ) { GETP;
    if (part & 1) {
    { SchedGrid S{(const bf16*)(ws + WS_Y), (const bf16*)(ws + W_Q), 256, 3, 192, 0, Y_CQ};
      EpiMlaQ E{(bf16*)(ws + WS_QP), (const float*)(ws + WS_RS), (const float*)(ws + WS_ROPE)}; gemm_run(smem, S, 256, YW, 256, E); }
    { SchedGrid S{(const bf16*)(ws + WS_Y), (const bf16*)(ws + W_KV), 256, 5, 320, 64, Y_T9};
      EpiMlaKV E{(bf16*)(ws + WS_KP), (bf16*)(ws + WS_VP), (const float*)(ws + WS_RS), (const float*)(ws + WS_ROPE)}; gemm_run(smem, S, 256, YW, 256, E); }
    }
    if (part & 2) phase_scan(p, l);
}
__device__ PHASE_ATTR void ph_mix(unsigned char* smem, int l) { GETP; phase_mix(p, l, smem); }
__device__ PHASE_ATTR void ph_g4(unsigned char* smem, int l, int dummy = 0) { GETP;
    SchedGrid S{(const bf16*)(ws + WS_XB), (const bf16*)(ws + W_OUT), 1024, 4, 256, 0, 0}; EpiResid E{l == 0 ? p.in[0] : p.out, dummy ? (float*)(ws + WS_CT) : p.out}; gemm_run(smem, S, 1024, 1024, 1024, E);
}
__device__ PHASE_ATTR void ph_ln(unsigned char* smem, int l, int which, int dummy = 0) { GETP; phase_ln(p, l, which, dummy); }
__device__ PHASE_ATTR void ph_g5(unsigned char* smem, int l) { GETP;
    SchedGrid S{(const bf16*)(ws + WS_XB), (const bf16*)(ws + W_XQ), 1024, 4, 256, 0, 0}; EpiBf16Store E{(bf16*)(ws + WS_QX), DM, XSCALE}; gemm_run(smem, S, 1024, 1024, 1024, E);
}
__device__ PHASE_ATTR void ph_xatt(unsigned char* smem, int l) { GETP;
    const bf16* QX = (const bf16*)(ws + WS_QX); const bf16* KX = (const bf16*)(ws + WS_KVX); const bf16* VXT = (const bf16*)(ws + WS_KVX + 4 * MiB); bf16* OX = (bf16*)(ws + WS_OX);
    for (int u = BID(); u < 512; u += GRD()) { const int b = u >> 6, h = (u >> 4) & 3, qt = u & 15;
        attn_mfma_unit<256, 256, 1>(smem, QX + (size_t)(b * SEQ + qt * 128) * DM + h * 256, DM, KX + (size_t)(b * 256) * 1024 + h * 256, 1024, VXT + (size_t)((b * 4 + h) * 256) * 256, 256, 4, 4,
                                    OX + (size_t)(b * SEQ + qt * 128) * DM + h * 256, DM); }
}
__device__ PHASE_ATTR void ph_g7(unsigned char* smem, int l, int dummy = 0) { GETP;
    SchedGrid S{(const bf16*)(ws + WS_OX), (const bf16*)(ws + W_XO), 1024, 4, 256, 0, 0}; EpiResid E{p.out, dummy ? (float*)(ws + WS_CT) : p.out}; gemm_run(smem, S, 1024, 1024, 1024, E);
}
__device__ PHASE_ATTR void ph_moe(unsigned char* smem, int l, int which) { GETP; phase_moe(p, l, smem, which); }

template <unsigned MASK>
__global__ void __launch_bounds__(512, 2) fwd(Params pk) {
    extern __shared__ __attribute__((aligned(16))) unsigned char smem[];
    { const unsigned* src = (const unsigned*)&pk; unsigned* dst = (unsigned*)(smem + LDS_PARAMS); for (int i = threadIdx.x; i < (int)(sizeof(Params) / 4); i += 512) dst[i] = src[i]; }
    unsigned char* ws = pk.ws;
    volatile LAS unsigned* barw = (volatile LAS unsigned*)((LAS unsigned char*)smem + LDS_BARW);
    if (threadIdx.x == 0) { barw[0] = 0u; barw[1] = 0u; }
    __syncthreads();
    XcdBarrier bar; bar.bar = (unsigned*)(ws + WS_CTL) + CW_BAR; bar.x = 0; bar.st = barw;
    const int lo = pk.ph_lo, hi = pk.ph_hi;
    const bool multi = (hi - lo) > 1;
    if (multi) bar = xcd_barrier_post((unsigned*)(ws + WS_CTL) + CW_BAR, barw);
    if (lo == 0) ph_pre(smem);
#pragma unroll 1
    for (int l = 0; l < 2; ++l) {
        const int base = l * NPH;
#define IN(k) (((MASK >> (k)) & 1u) != 0u && lo <= base + (k) && base + (k) < hi)
#define SEAM(k) do { if (base + (k) + 1 < hi) { xcd_barrier(bar); if ((PROBE_REP >> 20) & 1) xcd_barrier(bar); } } while (0)
#if PROBE_REP
#define REP(k) int _nr##k = ((PROBE_REP >> (k)) & 1) ? 2 : 1; asm volatile("" : "+s"(_nr##k)); for (int _r = 0; _r < _nr##k; ++_r)
#else
#define REP(k)
#endif
        if (IN(PH_CONV)) { REP(PH_CONV) { ph_conv(smem, l); } SEAM(PH_CONV); }
        if (IN(PH_G1)) { REP(PH_G1) { ph_g1(smem, l); } SEAM(PH_G1); }
        if (IN(PH_LOC)) { REP(PH_LOC) { ph_loc(smem, l); } SEAM(PH_LOC); }
        if (IN(PH_SCAN)) { ph_scan(smem, l);
#if PROBE_REP
            if ((PROBE_REP >> PH_SCAN) & 1) ph_scan(smem, l, 1);
#endif
            SEAM(PH_SCAN); }
        if (IN(PH_MIX)) { REP(PH_MIX) { ph_mix(smem, l); } SEAM(PH_MIX); }
        if (IN(PH_G4)) { ph_g4(smem, l);
#if PROBE_REP
            if ((PROBE_REP >> PH_G4) & 1) ph_g4(smem, l, 1);
#endif
            SEAM(PH_G4); }
        if (IN(PH_LN1)) { ph_ln(smem, l, 0);
#if PROBE_REP
            if ((PROBE_REP >> PH_LN1) & 1) { __syncthreads(); ph_ln(smem, l, 0, 1); }
#endif
            SEAM(PH_LN1); }
        if (IN(PH_G5)) { REP(PH_G5) { ph_g5(smem, l); } SEAM(PH_G5); }
        if (IN(PH_XATT)) { REP(PH_XATT) { ph_xatt(smem, l); } SEAM(PH_XATT); }
        if (IN(PH_G7)) { ph_g7(smem, l);
#if PROBE_REP
            if ((PROBE_REP >> PH_G7) & 1) ph_g7(smem, l, 1);
#endif
            SEAM(PH_G7); }
        if (IN(PH_LN2)) { ph_ln(smem, l, 1);
#if PROBE_REP
            if ((PROBE_REP >> PH_LN2) & 1) { __syncthreads(); ph_ln(smem, l, 1, 1); }
#endif
            SEAM(PH_LN2); }
        if (IN(PH_MOE1)) { REP(PH_MOE1) { ph_moe(smem, l, 0); } SEAM(PH_MOE1); }
        if (IN(PH_MOE2)) { REP(PH_MOE2) { ph_moe(smem, l, 1); } SEAM(PH_MOE2); }
        if (IN(PH_LN3)) { ph_ln(smem, l, 2);
#if PROBE_REP
            if ((PROBE_REP >> PH_LN3) & 1) { __syncthreads(); ph_ln(smem, l, 2, 1); }
#endif
            SEAM(PH_LN3); }
#undef IN
#undef SEAM
#undef REP
    }
}

extern "C" void kernel_launch(void* const* d_in, const int* in_sizes, int n_in, void* d_out, int out_size, void* d_ws, size_t ws_size, hipStream_t stream) {
    static int grid = 0;
    typedef void (*kfn_t)(Params);
#if N_LAUNCH_MODE == 1
    static const kfn_t kfn[NPH] = { fwd<1u << 0>, fwd<1u << 1>, fwd<1u << 2>, fwd<1u << 3>, fwd<1u << 4>, fwd<1u << 5>, fwd<1u << 6>, fwd<1u << 7>, fwd<1u << 8>, fwd<1u << 9>, fwd<1u << 10>, fwd<1u << 11>, fwd<1u << 12>, fwd<1u << 13> };
    constexpr int NK = NPH;
#else
    static const kfn_t kfn[1] = { fwd<FULL_MASK> };
    constexpr int NK = 1;
#endif
    if (grid == 0) {
        int dev = 0, cus = 0;
        if (n_in != 32 || out_size != NTOK * DM || ws_size < WS_TOTAL) { fprintf(stderr, "kernel_launch: unexpected shapes (n_in %d out %d ws %zu need %zu)\n", n_in, out_size, ws_size, (size_t)WS_TOTAL); }
        (void)hipGetDevice(&dev); (void)hipDeviceGetAttribute(&cus, hipDeviceAttributeMultiprocessorCount, dev);
        for (int i = 0; i < NK; ++i) (void)hipFuncSetAttribute((const void*)kfn[i], hipFuncAttributeMaxDynamicSharedMemorySize, LDS_BYTES);
        int per_cu = 0; (void)hipOccupancyMaxActiveBlocksPerMultiprocessor(&per_cu, (const void*)kfn[0], 512, LDS_BYTES);
        (void)hipGetLastError();
        grid = cus > 0 ? cus : 256;
    }
    (void)hipMemsetAsync((char*)d_ws + WS_CTL, 0, CTL_BYTES, stream);
    Params p{};
    for (int i = 0; i < 32; ++i) p.in[i] = (const float*)d_in[i];
    p.out = (float*)d_out; p.ws = (unsigned char*)d_ws;
#if N_LAUNCH_MODE == 1
    for (int ph = 0; ph < 2 * NPH; ++ph) { p.ph_lo = ph; p.ph_hi = ph + 1; hipLaunchKernelGGL(kfn[ph % NPH], dim3(grid), dim3(512), LDS_BYTES, stream, p); }
#else
    p.ph_lo = 0; p.ph_hi = 2 * NPH; hipLaunchKernelGGL(kfn[0], dim3(grid), dim3(512), LDS_BYTES, stream, p);
#endif
}
```

```cpp
#include <hip/hip_runtime.h>
#include <stdint.h>
#include <stdio.h>

#ifndef N_LAUNCH_MODE
#define N_LAUNCH_MODE 0
#endif

typedef unsigned short bf16;
typedef float f32x4 __attribute__((ext_vector_type(4)));
typedef unsigned u32x4 __attribute__((ext_vector_type(4)));
typedef unsigned u32x2 __attribute__((ext_vector_type(2)));
#define LAS __attribute__((address_space(3)))

constexpr int NTOK = 16384, DM = 1024, SEQ = 2048, NBATCH = 8, YW = 2560, NCH = 32;
constexpr int Y_GQ = 0, Y_GK = 256, Y_GV = 512, Y_GR = 768, Y_MQ = 1024, Y_MK = 1280, Y_MV = 1536, Y_MO = 1792, Y_CQ = 2048, Y_T9 = 2304,
              Y_A = 2304, Y_MI = 2320, Y_MF = 2324, Y_CKV = 2328, Y_KR = 2456;
constexpr float ALPHA = 1.41421356237309515f;
constexpr float LN_EPS = 1e-5f;
constexpr float LOG2E = 1.44269504088896341f;
constexpr float QSCALE = 0.10206207261596575f * LOG2E;
constexpr float XSCALE = 0.0625f * LOG2E;
constexpr int NPH = 14;
enum { PH_CONV = 0, PH_G1, PH_LOC, PH_SCAN, PH_MIX, PH_G4, PH_LN1, PH_G5, PH_XATT, PH_G7, PH_LN2, PH_MOE1, PH_MOE2, PH_LN3 };

constexpr size_t MiB = 1u << 20;
constexpr size_t WS_CTL = 0, CTL_BYTES = 1 * MiB;
constexpr size_t W_IN = 1 * MiB;
constexpr size_t W_Q = W_IN + (size_t)2560 * 1024 * 2;
constexpr size_t W_KV = W_Q + (size_t)768 * 256 * 2;
constexpr size_t W_OUT = W_KV + (size_t)1280 * 256 * 2;
constexpr size_t W_XQ = W_OUT + 2 * MiB;
constexpr size_t W_XKV = W_XQ + 2 * MiB;
constexpr size_t W_XO = W_XKV + 4 * MiB;
constexpr size_t W_GU = W_XO + 2 * MiB;
constexpr size_t W_DN = W_GU + 32 * MiB;
constexpr size_t W_END = W_DN + 16 * MiB;
constexpr size_t WS_XB = W_END;
constexpr size_t WS_MEMB = WS_XB + 32 * MiB;
constexpr size_t WS_KVX = WS_MEMB + 4 * MiB;
constexpr size_t WS_ROPE = WS_KVX + 8 * MiB;
constexpr size_t WS_RS = WS_ROPE + 2 * MiB;
constexpr size_t WS_LISTT = WS_RS + 128 * 1024;
constexpr size_t WS_LISTW = WS_LISTT + 2 * MiB;
constexpr size_t WS_NV = WS_LISTW + 2 * MiB;
constexpr size_t WS_DEC = WS_NV + 256 * 1024;
constexpr size_t WS_SC = WS_DEC + 256 * 1024;
constexpr size_t WS_MS = WS_SC + 8 * 1024;
constexpr size_t WS_BC = WS_MS + 8 * 1024;
constexpr size_t WS_QKC = WS_BC + 16 * MiB;
constexpr size_t WS_Y = WS_QKC + 16 * MiB;
constexpr size_t WS_QX = WS_Y, WS_OX = WS_Y + 32 * MiB, WS_H = WS_Y;
constexpr size_t WS_QP = WS_Y + 80 * MiB;
constexpr size_t WS_KP = WS_QP + 24 * MiB;
constexpr size_t WS_VP = WS_KP + 24 * MiB;
constexpr size_t WS_ST = WS_VP + 16 * MiB;
constexpr size_t WS_CT = WS_QP;
constexpr size_t WS_TOTAL = WS_ST + 32 * MiB;
static_assert(WS_TOTAL <= (size_t)342000000, "workspace budget");
constexpr int CW_BAR = 4096;
constexpr int CW_CNT = 16384;

constexpr int LDS_BYTES = 147456;
constexpr int LDS_BARW = LDS_BYTES - 16;

struct Params {
    const float* in[32];
    float* out;
    unsigned char* ws;
    int ph_lo, ph_hi;
};

__device__ __forceinline__ float bf2f(unsigned v) { return __uint_as_float(v << 16); }
__device__ __forceinline__ unsigned f2bf(float f) { unsigned u = __float_as_uint(f); return (u + 0x7fffu + ((u >> 16) & 1u)) >> 16; }
__device__ __forceinline__ unsigned pk2(float lo, float hi) { return f2bf(lo) | (f2bf(hi) << 16); }
__device__ __forceinline__ float blo(unsigned w) { return __uint_as_float(w << 16); }
__device__ __forceinline__ float bhi(unsigned w) { return __uint_as_float(w & 0xffff0000u); }
__device__ __forceinline__ float wave_sum(float v) {
#pragma unroll
    for (int o = 1; o < 64; o <<= 1) v += __shfl_xor(v, o);
    return v;
}
__device__ __forceinline__ float logsigmoid(float z) { return fminf(z, 0.f) - log1pf(expf(-fabsf(z))); }
__device__ __forceinline__ float fexp(float x) { return __builtin_amdgcn_exp2f(x * LOG2E); }
__device__ __forceinline__ float sigmoidf(float x) { return __builtin_amdgcn_rcpf(1.f + fexp(-x)); }
__device__ __forceinline__ float siluf(float x) { return x * __builtin_amdgcn_rcpf(1.f + fexp(-x)); }
__device__ __forceinline__ f32x4 up4q(u32x2 w) { return (f32x4){blo(w.x), bhi(w.x), blo(w.y), bhi(w.y)}; }
__device__ __forceinline__ void st_bf4(bf16* p, f32x4 v) { u32x2 w; w.x = pk2(v[0], v[1]); w.y = pk2(v[2], v[3]); *(u32x2*)p = w; }

#define XB_TMO      128
#define XB_XCNT(j)  (256  + 64 * (j))
#define XB_XSUB(j)  (1280 + 64 * (j))
#define XB_XGEN(j)  (2304 + 64 * (j))
#define XB_TOP      3328
#define XB_TOPGEN   3392
#define XCD_BAR_WORDS 3456
#define XB_SPIN_CAP (1u << 24)
__device__ __forceinline__ unsigned xb_ld(unsigned* p)              { return __hip_atomic_load(p, __ATOMIC_RELAXED, __HIP_MEMORY_SCOPE_AGENT); }
__device__ __forceinline__ unsigned xb_add(unsigned* p, unsigned v) { return __hip_atomic_fetch_add(p, v, __ATOMIC_RELAXED, __HIP_MEMORY_SCOPE_AGENT); }
__device__ __forceinline__ unsigned xb_xcc_id() { return (unsigned)__builtin_amdgcn_s_getreg((3 << 11) | 20) & 0xFu; }
#define XB_SPIN(cond, bar) do { unsigned _sp = 0; while (cond) { __builtin_amdgcn_s_sleep(1); \
    if ((++_sp & 255u) == 0u) { if (xb_ld(&(bar)[XB_TMO])) break; if (_sp > XB_SPIN_CAP) { atomicAdd(&(bar)[XB_TMO], 1u); break; } } } } while (0)
struct XcdBarrier { unsigned* bar; unsigned x; volatile LAS unsigned* st; };
__device__ __forceinline__ XcdBarrier xcd_barrier_post(unsigned* bar, volatile LAS unsigned* st) {
    XcdBarrier b; b.bar = bar; b.x = xb_xcc_id(); b.st = st;
    if (threadIdx.x == 0) (void)xb_add(&bar[XB_XCNT(b.x)], 1u);
    return b;
}
__device__ __forceinline__ void xcd_barrier_complete(unsigned* bar, unsigned x, unsigned& nloc, unsigned& nx) {
    const unsigned G = gridDim.x * gridDim.y * gridDim.z;
    unsigned sum, cnt, mine, sp = 0u;
    for (;;) {
        sum = 0u; cnt = 0u; mine = 0u;
#pragma unroll
        for (unsigned j = 0; j < 16; ++j) { const unsigned c = xb_ld(&bar[XB_XCNT(j)]); sum += c; cnt += (c > 0u) ? 1u : 0u; mine = (j == x) ? c : mine; }
        if (sum == G) break;
        __builtin_amdgcn_s_sleep(1);
        if ((++sp & 255u) == 0u) { if (xb_ld(&bar[XB_TMO])) break; if (sp > XB_SPIN_CAP) { atomicAdd(&bar[XB_TMO], 1u); break; } }
    }
    nloc = mine > 0u ? mine : 1u; nx = cnt > 0u ? cnt : 1u;
}
__device__ __forceinline__ void xcd_barrier(const XcdBarrier& b) {
    asm volatile("s_waitcnt vmcnt(0)" ::: "memory");
    __syncthreads();
    if (threadIdx.x == 0) {
        unsigned* bar = b.bar; asm volatile("" : "+s"(bar));
        __builtin_amdgcn_s_waitcnt(0);
        unsigned nloc = b.st[0], nx = b.st[1];
        if (nloc == 0u) { xcd_barrier_complete(bar, b.x, nloc, nx); b.st[0] = nloc; b.st[1] = nx; }
        const unsigned old = xb_add(&bar[XB_XSUB(b.x)], 1u);
        const unsigned gen = old / nloc;
        if (old + 1u == (gen + 1u) * nloc) {
            __builtin_amdgcn_fence(__ATOMIC_RELEASE, "agent");
            asm volatile("s_waitcnt vmcnt(0)" ::: "memory");
            const unsigned og = xb_add(&bar[XB_TOP], 1u);
            const unsigned tg = og / nx;
            if (og + 1u == (tg + 1u) * nx) xb_add(&bar[XB_TOPGEN], 1u);
            else XB_SPIN(xb_ld(&bar[XB_TOPGEN]) == tg, bar);
            __builtin_amdgcn_fence(__ATOMIC_ACQUIRE, "agent");
            xb_add(&bar[XB_XGEN(b.x)], 1u);
            asm volatile("s_waitcnt vmcnt(0)" ::: "memory");
        } else {
            XB_SPIN(xb_ld(&bar[XB_XGEN(b.x)]) == gen, bar);
            __builtin_amdgcn_fence(__ATOMIC_ACQUIRE, "agent");
            asm volatile("s_waitcnt vmcnt(0)" ::: "memory");
        }
    }
    __syncthreads();
}

__device__ __forceinline__ int TID() { int t = threadIdx.x; asm volatile("" : "+v"(t)); return t; }
__device__ __forceinline__ int BID() { int t = blockIdx.x; asm volatile("" : "+s"(t)); return t; }
__device__ __forceinline__ int GRD() { int t = gridDim.x; asm volatile("" : "+s"(t)); return t; }

struct UnitDesc {
    const bf16* A;
    const bf16* B;
    const int* ridx;
    const float* rw;
    int arow0, acol;
    int row0, col0;
    int nvalid;
    int gather;
};

template <class Epi>
__device__ __forceinline__ void gemm_unit_naive(unsigned char* smem, const UnitDesc& u, int K, int lda, int ldb, const Epi& E) {
    float* As = (float*)smem;
    float* Bs = As + 16 * 128;
    const int tid = TID(), ty = tid >> 4, tx = tid & 15;
    const int lr = tid >> 1, lk = (tid & 1) * 8;
    const bf16* brow = u.B + (size_t)lr * ldb;
    const int cb = (tx >> 2) * 32 + (tx & 3) * 4;
#pragma unroll 1
    for (int half = 0; half < 2; ++half) {
        float acc[4][16];
#pragma unroll
        for (int i = 0; i < 4; ++i)
#pragma unroll
            for (int j = 0; j < 16; ++j) acc[i][j] = 0.f;
        const int ar = half * 128 + (lr & 127);
        const bf16* arow;
        if (u.gather) { const int rr = ar < u.nvalid ? ar : 0; arow = u.A + (size_t)(u.ridx[rr] >> 1) * lda + u.acol; }
        else arow = u.A + (size_t)(u.arow0 + ar) * lda + u.acol;
#pragma unroll 1
        for (int k0 = 0; k0 < K; k0 += 16) {
            const u32x4 bv = *(const u32x4*)(brow + k0 + lk);
            u32x4 av = {0u, 0u, 0u, 0u};
            if (tid < 256) av = *(const u32x4*)(arow + k0 + lk);
            __syncthreads();
#pragma unroll
            for (int j = 0; j < 4; ++j) {
                if (tid < 256) { As[(lk + 2 * j) * 128 + lr] = blo(av[j]); As[(lk + 2 * j + 1) * 128 + lr] = bhi(av[j]); }
                Bs[(lk + 2 * j) * 256 + lr] = blo(bv[j]); Bs[(lk + 2 * j + 1) * 256 + lr] = bhi(bv[j]);
            }
            __syncthreads();
#pragma unroll 4
            for (int kk = 0; kk < 16; ++kk) {
                float b[16];
                const f32x4 a0 = *(const f32x4*)(As + kk * 128 + ty * 4);
#pragma unroll
                for (int g = 0; g < 2; ++g)
#pragma unroll
                    for (int h2 = 0; h2 < 2; ++h2) {
                        const f32x4 bq = *(const f32x4*)(Bs + kk * 256 + g * 128 + cb + h2 * 16);
                        b[g * 8 + h2 * 4 + 0] = bq[0]; b[g * 8 + h2 * 4 + 1] = bq[1]; b[g * 8 + h2 * 4 + 2] = bq[2]; b[g * 8 + h2 * 4 + 3] = bq[3];
                    }
#pragma unroll
                for (int i = 0; i < 4; ++i)
#pragma unroll
                    for (int j = 0; j < 16; ++j) acc[i][j] = fmaf(a0[i], b[j], acc[i][j]);
            }
        }
        __syncthreads();
        float* Ct = (float*)smem;
#pragma unroll
        for (int i = 0; i < 4; ++i)
#pragma unroll
            for (int g = 0; g < 2; ++g) {
                *(f32x4*)(Ct + (ty * 4 + i) * 260 + g * 128 + cb) = (f32x4){acc[i][g * 8 + 0], acc[i][g * 8 + 1], acc[i][g * 8 + 2], acc[i][g * 8 + 3]};
                *(f32x4*)(Ct + (ty * 4 + i) * 260 + g * 128 + cb + 16) = (f32x4){acc[i][g * 8 + 4], acc[i][g * 8 + 5], acc[i][g * 8 + 6], acc[i][g * 8 + 7]};
            }
        __syncthreads();
#pragma unroll 1
        for (int item = tid; item < 128 * 32; item += 512) {
            const int rr = item >> 5, cg = item & 31, c = (cg >> 4) * 128 + ((cg & 15) >> 2) * 32 + (cg & 3) * 4, r = half * 128 + rr;
            if (r < u.nvalid) { const f32x4 v0 = *(const f32x4*)(Ct + rr * 260 + c), v1 = *(const f32x4*)(Ct + rr * 260 + c + 16); E(u, r, c, v0, v1); }
        }
        __syncthreads();
    }
}

struct EpiBf16Store { bf16* O; int ldo; float scale;
    __device__ __forceinline__ void operator()(const UnitDesc& u, int r, int c, f32x4 v0, f32x4 v1) const {
        bf16* o = O + (size_t)(u.row0 + r) * ldo + u.col0 + c; st_bf4(o, v0 * scale); st_bf4(o + 16, v1 * scale); } };
struct EpiKVX { bf16* KX; bf16* VXT;
    __device__ __forceinline__ void grp(int row, int c, f32x4 v) const {
        if (c < 1024) st_bf4(KX + (size_t)row * 1024 + c, v);
        else { const int cc = c - 1024, b = row >> 8, key = row & 255; bf16* vt = VXT + ((size_t)(b * 1024 + cc)) * 256 + key;
            vt[0] = (bf16)f2bf(v[0]); vt[256] = (bf16)f2bf(v[1]); vt[512] = (bf16)f2bf(v[2]); vt[768] = (bf16)f2bf(v[3]); } }
    __device__ __forceinline__ void operator()(const UnitDesc& u, int r, int c, f32x4 v0, f32x4 v1) const {
        grp(u.row0 + r, u.col0 + c, v0); grp(u.row0 + r, u.col0 + c + 16, v1); } };
struct EpiResidB { const bf16* res; float* out;
    __device__ __forceinline__ void operator()(const UnitDesc& u, int r, int c, f32x4 v0, f32x4 v1) const {
        const size_t o = (size_t)(u.row0 + r) * DM + u.col0 + c;
        const f32x4 r0 = up4q(*(const u32x2*)(res + o)), r1 = up4q(*(const u32x2*)(res + o + 16));
        *(f32x4*)(out + o) = r0 * ALPHA + v0; *(f32x4*)(out + o + 16) = r1 * ALPHA + v1; } };
struct EpiResid { const float* res; float* out;
    __device__ __forceinline__ void operator()(const UnitDesc& u, int r, int c, f32x4 v0, f32x4 v1) const {
        const size_t o = (size_t)(u.row0 + r) * DM + u.col0 + c;
        const f32x4 r0 = *(const f32x4*)(res + o), r1 = *(const f32x4*)(res + o + 16);
        *(f32x4*)(out + o) = r0 * ALPHA + v0; *(f32x4*)(out + o + 16) = r1 * ALPHA + v1; } };
__device__ __forceinline__ f32x4 rope4(f32x4 v, const float* ROPE, int row, int i) {
    const f32x4 cs = *(const f32x4*)(ROPE + ((size_t)row * 16 + i) * 2);
    return (f32x4){v[0] * cs[0] - v[1] * cs[1], v[1] * cs[0] + v[0] * cs[1], v[2] * cs[2] - v[3] * cs[3], v[3] * cs[2] + v[2] * cs[3]}; }
struct EpiMlaQ { bf16* QP; const float* RS; const float* ROPE;
    __device__ __forceinline__ void grp(int row, int c, f32x4 v) const {
        asm volatile("" : "+v"(row), "+v"(c));
        const int b = row >> 11, s = row & 2047, h = c / 96, j = c - h * 96;
        v = v * (RS[row * 2] * QSCALE);
        if (j >= 64) v = rope4(v, ROPE, row, (j - 64) >> 1);
        st_bf4(QP + ((size_t)((b * 8 + h) * SEQ + s)) * 96 + j, v); }
    __device__ __forceinline__ void operator()(const UnitDesc& u, int r, int c, f32x4 v0, f32x4 v1) const {
        grp(u.row0 + r, u.col0 + c, v0); grp(u.row0 + r, u.col0 + c + 16, v1); } };
struct EpiMlaKV { bf16 *KP, *VP; const float* RS; const float* ROPE;
    __device__ __forceinline__ void grp(int row, int c, f32x4 v) const {
        asm volatile("" : "+v"(row), "+v"(c));
        const int b = row >> 11, s = row & 2047, h = c / 160, j = c - h * 160; const float rs = RS[row * 2 + 1];
        if (j < 64) st_bf4(KP + ((size_t)((b * 8 + h) * SEQ + s)) * 96 + j, v * rs);
        else if (j < 96) st_bf4(KP + ((size_t)((b * 8 + h) * SEQ + s)) * 96 + j, rope4(v, ROPE, row, (j - 64) >> 1));
        else { bf16* vt = VP + ((size_t)((b * 8 + h) * 64 + (j - 96))) * SEQ + s;
            vt[0] = (bf16)f2bf(v[0] * rs); vt[SEQ] = (bf16)f2bf(v[1] * rs); vt[2 * SEQ] = (bf16)f2bf(v[2] * rs); vt[3 * SEQ] = (bf16)f2bf(v[3] * rs); } }
    __device__ __forceinline__ void operator()(const UnitDesc& u, int r, int c, f32x4 v0, f32x4 v1) const {
        grp(u.row0 + r, u.col0 + c, v0); grp(u.row0 + r, u.col0 + c + 16, v1); } };
struct EpiMoe1 { bf16* H;
    __device__ __forceinline__ void operator()(const UnitDesc& u, int r, int c, f32x4 v0, f32x4 v1) const {
        f32x4 h;
#pragma unroll
        for (int j = 0; j < 4; ++j) h[j] = siluf(v0[j]) * v1[j];
        st_bf4(H + (size_t)(u.row0 + r) * 256 + u.col0 + (c >> 5) * 16 + (c & 15), h); } };
struct EpiMoe2 { bf16* CT;
    __device__ __forceinline__ void operator()(const UnitDesc& u, int r, int c, f32x4 v0, f32x4 v1) const {
        asm volatile("" : "+v"(r), "+v"(c));
        const int ent = u.ridx[r]; const float w = u.rw[r];
        bf16* o = CT + ((size_t)(ent & 1) * NTOK + (ent >> 1)) * DM + u.col0 + c; st_bf4(o, v0 * w); st_bf4(o + 16, v1 * w); } };

typedef short bf16x8 __attribute__((ext_vector_type(8)));
namespace mg {
constexpr int BK = 64, HALF = 128, HTB = HALF * BK * 2, STAGE_BYTES = 8 * HTB;
__device__ __forceinline__ int lds_byte(int r, int c) { const int st = (r >> 4) * 2 + (c >> 5), rr = r & 15, cc = c & 31, ob = rr * 64 + cc * 2; return st * 1024 + (ob ^ (((ob >> 9) & 1) << 5)); }
__device__ __forceinline__ void stage_rc(int b, int& R, int& C) { const int st = b / 1024, sb = b % 1024, swz = sb ^ (((sb >> 9) & 1) << 5); R = (st >> 1) * 16 + swz / 64; C = (st & 1) * 32 + (swz % 64) / 2; }

template <bool GATHER, class Sched, class Epi>
__device__ __forceinline__ void gemm_mfma(LAS unsigned char* lds, const Sched& S, const int K, const int lda, const int ldb, const Epi& E) {
    const int tid = TID(), wid = __builtin_amdgcn_readfirstlane(tid >> 6), lane = tid & 63, wr = wid >> 2, wc = wid & 3, fr = lane & 15, fq = lane >> 4;
    const int nt = K / BK;
    unsigned voffB[2], voffA[2];
    { int R0, C0, R1, C1; stage_rc(tid * 16, R0, C0); stage_rc(tid * 16 + 8192, R1, C1); voffB[0] = (unsigned)(R0 * ldb + C0) * 2u; voffB[1] = (unsigned)(R1 * ldb + C1) * 2u;
      voffA[0] = (unsigned)(R0 * lda + C0) * 2u; voffA[1] = (unsigned)(R1 * lda + C1) * 2u; }
    const size_t kstep = (size_t)(BK * 2);
    const size_t hstepB = (size_t)HALF * ldb * 2, hstepA = (size_t)HALF * lda * 2;
    const unsigned ldsw = (unsigned)wid * 1024u;
    const int aoff = lds_byte(wr * 64 + fr, fq * 8), boff = lds_byte(wc * 32 + fr, fq * 8);
#define MG_SA(b, h) (((b) * 2 + (h)) * HTB)
#define MG_SB(b, h) ((4 + (b) * 2 + (h)) * HTB)
#define MG_STAGE(bufoff, gbase, voff) do { _Pragma("unroll") for (int _i = 0; _i < 2; ++_i) \
        __builtin_amdgcn_global_load_lds((const unsigned*)((const char*)(gbase) + (voff)[_i]), (LAS unsigned*)(lds + (bufoff) + ldsw + _i * 8192), 16, 0, 0); } while (0)
#define MG_STA(bufoff, base, h, nx) do { if constexpr (GATHER) { MG_STAGE(bufoff, base, vc[h]); } else { MG_STAGE(bufoff, (base) + (h) * hstepA, voffA); } } while (0)
#define MG_LDA(dst, b, h) do { _Pragma("unroll") for (int m = 0; m < 4; ++m) _Pragma("unroll") for (int k = 0; k < 2; ++k) dst[m][k] = *(const LAS bf16x8*)(lds + MG_SA(b, h) + aoff + m * 2048 + k * 1024); } while (0)
#define MG_LDB(dst, b, h) do { _Pragma("unroll") for (int n = 0; n < 2; ++n) _Pragma("unroll") for (int k = 0; k < 2; ++k) dst[n][k] = *(const LAS bf16x8*)(lds + MG_SB(b, h) + boff + n * 2048 + k * 1024); } while (0)
#define MG_MMA(ai, bj, At, Bt) do { __builtin_amdgcn_s_setprio(1); _Pragma("unroll") for (int m = 0; m < 4; ++m) _Pragma("unroll") for (int n = 0; n < 2; ++n) _Pragma("unroll") for (int k = 0; k < 2; ++k) \
        acc[ai][bj][m][n] = __builtin_amdgcn_mfma_f32_16x16x32_bf16(Bt[n][k], At[m][k], acc[ai][bj][m][n], 0, 0, 0); __builtin_amdgcn_s_setprio(0); } while (0)
#define MG_WAIT_V(n) asm volatile("s_waitcnt vmcnt(" #n ")" ::: "memory")
#define MG_WAIT_L(n) asm volatile("s_waitcnt lgkmcnt(" #n ")" ::: "memory")
#define MG_BAR __builtin_amdgcn_s_barrier()
#define MG_SCHED __builtin_amdgcn_sched_barrier(0)
#define MG_MKOFF(u, v) do { if constexpr (GATHER) { int R0, C0, R1, C1; { const int _t = TID(); stage_rc(_t * 16, R0, C0); stage_rc(_t * 16 + 8192, R1, C1); } _Pragma("unroll") for (int _h = 0; _h < 2; ++_h) { \
        const int _r0 = R0 + 128 * _h, _r1 = R1 + 128 * _h; const int _l = (u).nvalid - 1; const int _a0 = (u).ridx[_r0 < _l ? _r0 : _l] >> 1, _a1 = (u).ridx[_r1 < _l ? _r1 : _l] >> 1; \
        v[_h][0] = ((unsigned)_a0 * (unsigned)lda + (unsigned)C0) * 2u; v[_h][1] = ((unsigned)_a1 * (unsigned)lda + (unsigned)C1) * 2u; } } } while (0)
#define MG_ABASE(u) (GATHER ? (const char*)((u).A + (u).acol) : (const char*)((u).A + (size_t)(u).arow0 * lda + (u).acol))
    UnitDesc cur, nxt; int ui = 0;
    if (!S.get(0, cur)) return;
    f32x4 acc[2][2][4][2];
#pragma unroll
    for (int a = 0; a < 2; ++a)
#pragma unroll
        for (int b = 0; b < 2; ++b)
#pragma unroll
            for (int m = 0; m < 4; ++m)
#pragma unroll
                for (int n = 0; n < 2; ++n) acc[a][b][m][n] = (f32x4){0.f, 0.f, 0.f, 0.f};
    bf16x8 At[4][2], B0[2][2], B1[2][2];
    unsigned vc[2][2];
    MG_MKOFF(cur, vc);
    const char* cA = MG_ABASE(cur); const char* cB = (const char*)cur.B;
    MG_STAGE(MG_SB(0, 0), cB, voffB); MG_STA(MG_SA(0, 0), cA, 0, false); MG_STAGE(MG_SB(0, 1), cB + hstepB, voffB); MG_STA(MG_SA(0, 1), cA, 1, false);
    if (wr == 1) MG_BAR;
    MG_WAIT_V(4); MG_BAR;
    MG_STAGE(MG_SB(1, 0), cB + kstep, voffB); MG_STA(MG_SA(1, 0), cA + kstep, 0, false); MG_STAGE(MG_SB(1, 1), cB + hstepB + kstep, voffB);
    MG_WAIT_V(6); MG_BAR;
    for (;;) {
        const bool has_next = S.get(ui + 1, nxt);
        const char* nA = has_next ? MG_ABASE(nxt) : cA; const char* nB = has_next ? (const char*)nxt.B : cB;
#pragma unroll 1
        for (int t = 0; t < nt; t += 2) {
            const bool last = (t == nt - 2);
            const char* a1 = cA + (size_t)(t + 1) * kstep;
            const char* a2 = last ? nA : cA + (size_t)(t + 2) * kstep; const char* b2 = last ? nB : cB + (size_t)(t + 2) * kstep;
            const char* a3 = a2 + kstep; const char* b3 = b2 + kstep;
            MG_LDB(B0, 0, 0); MG_SCHED; MG_LDA(At, 0, 0); MG_STA(MG_SA(1, 1), a1, 1, false);
            if constexpr (GATHER) { if (last && has_next) { MG_MKOFF(nxt, vc); } }
            MG_WAIT_L(8); MG_BAR; MG_WAIT_L(0); MG_MMA(0, 0, At, B0); MG_BAR; MG_SCHED;
            MG_LDB(B1, 0, 1); MG_STAGE(MG_SB(0, 0), b2, voffB);
            MG_BAR; MG_WAIT_L(0); MG_MMA(0, 1, At, B1); MG_BAR;
            MG_LDA(At, 0, 1); MG_STA(MG_SA(0, 0), a2, 0, last);
            MG_BAR; MG_WAIT_L(0); MG_MMA(1, 0, At, B0); MG_BAR; MG_SCHED;
            MG_STAGE(MG_SB(0, 1), b2 + hstepB, voffB);
            MG_WAIT_V(6); MG_BAR; MG_MMA(1, 1, At, B1); MG_BAR;
            MG_LDB(B0, 1, 0); MG_SCHED; MG_LDA(At, 1, 0); MG_STA(MG_SA(0, 1), a2, 1, last);
            MG_WAIT_L(8); MG_BAR; MG_WAIT_L(0); MG_MMA(0, 0, At, B0); MG_BAR; MG_SCHED;
            MG_LDB(B1, 1, 1); MG_STAGE(MG_SB(1, 0), b3, voffB);
            MG_BAR; MG_WAIT_L(0); MG_MMA(0, 1, At, B1); MG_BAR;
            MG_LDA(At, 1, 1); MG_STA(MG_SA(1, 0), a3, 0, last);
            MG_BAR; MG_WAIT_L(0); MG_MMA(1, 0, At, B0); MG_BAR; MG_SCHED;
            MG_STAGE(MG_SB(1, 1), b3 + hstepB, voffB);
            MG_WAIT_V(6); MG_BAR; MG_MMA(1, 1, At, B1); MG_BAR;
        }
#pragma unroll
        for (int ai = 0; ai < 2; ++ai)
#pragma unroll
            for (int m = 0; m < 4; ++m) { const int r = ai * HALF + wr * 64 + m * 16 + fr;
                if (r < cur.nvalid) {
#pragma unroll
                    for (int bj = 0; bj < 2; ++bj) E(cur, r, bj * HALF + wc * 32 + 4 * fq, acc[ai][bj][m][0], acc[ai][bj][m][1]); }
                asm volatile("" ::: "memory"); }
        if (!has_next) break;
#pragma unroll
        for (int a = 0; a < 2; ++a)
#pragma unroll
            for (int b = 0; b < 2; ++b)
#pragma unroll
                for (int m = 0; m < 4; ++m)
#pragma unroll
                    for (int n = 0; n < 2; ++n) acc[a][b][m][n] = (f32x4){0.f, 0.f, 0.f, 0.f};
        cur = nxt; cA = nA; cB = nB; ++ui;
    }
    MG_WAIT_V(0);
    if (wr == 0) MG_BAR;
    MG_BAR;
#undef MG_SA
#undef MG_SB
#undef MG_STAGE
#undef MG_LDA
#undef MG_LDB
#undef MG_MMA
#undef MG_WAIT_V
#undef MG_WAIT_L
#undef MG_BAR
#undef MG_SCHED
#undef MG_MKOFF
#undef MG_STA
#undef MG_ABASE
}
}

#ifndef USE_MFMA
#define USE_MFMA 1
#endif
template <bool GATHER = false, class Sched, class Epi>
__device__ __forceinline__ void gemm_run(unsigned char* smem, const Sched& S, int K, int lda, int ldb, const Epi& E) {
#if USE_MFMA
    __syncthreads();
    mg::gemm_mfma<GATHER>((LAS unsigned char*)smem, S, K, lda, ldb, E);
    __syncthreads();
#else
    UnitDesc u; for (int i = 0; S.get(i, u); ++i) gemm_unit_naive(smem, u, K, lda, ldb, E);
#endif
}
__device__ __forceinline__ int xcd_remap(int L, int n) { const int q = n >> 3, r = n & 7, x = L & 7, off = L >> 3; return (x < r ? x * (q + 1) : r * (q + 1) + (x - r) * q) + off; }
struct SchedGrid { const bf16* A; const bf16* B; int ldb, npn, nunits, rot, acol;
    __device__ __forceinline__ bool get(int i, UnitDesc& u) const {
        const int G = GRD(); const int L = (BID() + rot) % G + i * G; if (L >= nunits) return false;
        const int idx = xcd_remap(L, nunits), npm = nunits / npn, nig = 8 * npn, gid = idx / nig, fm = gid * 8, gsz = (npm - fm) < 8 ? (npm - fm) : 8, w = idx - gid * nig;
        const int pm = fm + w % gsz, pn = w / gsz;
        u.A = A; u.B = B + (size_t)pn * 256 * ldb; u.ridx = nullptr; u.rw = nullptr; u.arow0 = pm * 256; u.acol = acol; u.row0 = pm * 256; u.col0 = pn * 256; u.nvalid = 256; u.gather = 0; return true; } };
struct SchedMoe { const int* tstart; const int* cntl; const int* LT; const float* LW; const bf16* A; const bf16* W; int which;
    __device__ __forceinline__ bool get(int i, UnitDesc& u) const {
        const int ncol = which == 0 ? 2 : 4; const int L = BID() + i * GRD(), nun = __builtin_amdgcn_readfirstlane(tstart[32]) * ncol; if (L >= nun) return false;
        const int idx = xcd_remap(L, nun);
        const int rt = idx / ncol, pn = idx - rt * ncol; int e = 0;
        for (int q = 1; q < 32; ++q) if (__builtin_amdgcn_readfirstlane(tstart[q]) <= rt) e = q;
        const int pos0 = (rt - __builtin_amdgcn_readfirstlane(tstart[e])) * 256; int nv = __builtin_amdgcn_readfirstlane(cntl[e]) - pos0; nv = nv > 256 ? 256 : nv;
        u.ridx = LT + (size_t)e * NTOK + pos0; u.rw = LW + (size_t)e * NTOK + pos0; u.nvalid = nv; u.acol = 0; u.A = A;
        if (which == 0) { u.B = W + ((size_t)e * 512 + pn * 256) * 1024; u.arow0 = 0; u.row0 = rt * 256; u.col0 = pn * 128; u.gather = 1; }
        else { u.B = W + ((size_t)e * 1024 + pn * 256) * 256; u.arow0 = rt * 256; u.row0 = 0; u.col0 = pn * 256; u.gather = 0; }
        return true; } };

template <class F>
__device__ __forceinline__ void conv_item(const F& src, bf16* dst, int K, float* scr, int k0, int n0, int lane) {
#pragma unroll 8
    for (int i = 0; i < 32; ++i) { const int kk = 2 * i + (lane >> 5); scr[kk * 33 + (lane & 31)] = src(k0 + kk, n0 + (lane & 31)); }
    asm volatile("s_waitcnt lgkmcnt(0)" ::: "memory");
    const int c = lane & 7;
#pragma unroll
    for (int j = 0; j < 4; ++j) { const int n = (lane >> 3) + 8 * j; const float* s = scr + (8 * c) * 33 + n;
        u32x4 o; o.x = pk2(s[0 * 33], s[1 * 33]); o.y = pk2(s[2 * 33], s[3 * 33]); o.z = pk2(s[4 * 33], s[5 * 33]); o.w = pk2(s[6 * 33], s[7 * 33]);
        *(u32x4*)(dst + (size_t)(n0 + n) * K + k0 + 8 * c) = o; }
    asm volatile("s_waitcnt lgkmcnt(0)" ::: "memory");
}
__device__ __forceinline__ int yc_src(int n) {
    if (n < 1024) return n;
    if (n < 2048) return n + 16;
    if (n < 2304) return n + 24;
    if (n < 2320) return 1024 + (n - 2304);
    if (n < 2328) return 2064 + (n - 2320);
    if (n < 2488) return n;
    return -1;
}

__device__ __forceinline__ void phase_conv(const Params& p, int l, unsigned char* smem, size_t dshift = 0  ) {
    const int tid = TID(), lane = tid & 63, wave = tid >> 6;
    const int gw = BID() * 8 + wave, NGW = GRD() * 8;
    float* scr = (float*)smem + wave * (64 * 33 + 16);
    unsigned char* ws = p.ws + dshift;
    const float* w_in = p.in[3] + (size_t)l * 1024 * 2488;
    const float* w_out = p.in[4] + (size_t)l * 1024 * 1024;
    const float* gq = p.in[12] + l * 256; const float* w_uq = p.in[13] + (size_t)l * 256 * 768;
    const float* gkv = p.in[14] + l * 128; const float* w_ukv = p.in[15] + (size_t)l * 128 * 1024;
    const float* xwq = p.in[16] + (size_t)l * 1024 * 1024; const float* xwkv = p.in[17] + (size_t)l * 1024 * 2048; const float* xwo = p.in[18] + (size_t)l * 1024 * 1024;
    const float* wg = p.in[23] + (size_t)l * 32 * 1024 * 256; const float* wu = p.in[24] + (size_t)l * 32 * 1024 * 256; const float* wd = p.in[25] + (size_t)l * 32 * 256 * 1024;
    constexpr int I_IN = 16 * 80, I_Q = 4 * 24, I_KV = 4 * 40, I_SQ = 16 * 32, I_XKV = 16 * 64, I_GU = 32 * 16 * 16, I_DN = 32 * 4 * 32;
    constexpr int NIT = I_IN + I_Q + I_KV + 3 * I_SQ + I_XKV + I_GU + I_DN;
    for (int it = gw; it < NIT; it += NGW) {
        int r = it;
        if (r < I_IN) { const int kb = r / 80, nb = r % 80;
            conv_item([&](int k, int n) { const int s = yc_src(n); return s >= 0 ? w_in[(size_t)k * 2488 + s] : 0.f; }, (bf16*)(ws + W_IN), 1024, scr, kb * 64, nb * 32, lane); continue; }
        r -= I_IN;
        if (r < I_Q) { const int kb = r / 24, nb = r % 24;
            conv_item([&](int k, int n) { const int h = n / 96, j = n - h * 96; int sc = h * 96 + j; if (j >= 64) { const int jj = j - 64; sc = h * 96 + 64 + (jj >> 1) + 16 * (jj & 1); }
                return gq[k] * w_uq[(size_t)k * 768 + sc]; }, (bf16*)(ws + W_Q), 256, scr, kb * 64, nb * 32, lane); continue; }
        r -= I_Q;
        if (r < I_KV) { const int kb = r / 40, nb = r % 40;
            conv_item([&](int k, int n) { const int h = n / 160, j = n - h * 160;
                if (j >= 64 && j < 96) { const int jj = j - 64; return (k == 152 + (jj >> 1) + 16 * (jj & 1)) ? 1.f : 0.f; }
                const int col = (j < 64) ? h * 128 + j : h * 128 + 64 + (j - 96);
                return (k >= 24 && k < 152) ? gkv[k - 24] * w_ukv[(size_t)(k - 24) * 1024 + col] : 0.f; }, (bf16*)(ws + W_KV), 256, scr, kb * 64, nb * 32, lane); continue; }
        r -= I_KV;
        if (r < 3 * I_SQ) { const int m = r / I_SQ, q = r % I_SQ, kb = q / 32, nb = q % 32; const float* W = m == 0 ? w_out : (m == 1 ? xwq : xwo);
            bf16* D = (bf16*)(ws + (m == 0 ? W_OUT : (m == 1 ? W_XQ : W_XO)));
            conv_item([&](int k, int n) { return W[(size_t)k * 1024 + n]; }, D, 1024, scr, kb * 64, nb * 32, lane); continue; }
        r -= 3 * I_SQ;
        if (r < I_XKV) { const int kb = r / 64, nb = r % 64;
            conv_item([&](int k, int n) { return xwkv[(size_t)k * 2048 + n]; }, (bf16*)(ws + W_XKV), 1024, scr, kb * 64, nb * 32, lane); continue; }
        r -= I_XKV;
        if (r < I_GU) { const int e = r / 256, q = r % 256, kb = q / 16, nb = q % 16; const float* G = wg + (size_t)e * 1024 * 256; const float* U = wu + (size_t)e * 1024 * 256;
            conv_item([&](int k, int n) { const int j = (n >> 5) * 16 + (n & 15); return ((n >> 4) & 1) ? U[(size_t)k * 256 + j] : G[(size_t)k * 256 + j]; },
                      (bf16*)(ws + W_GU) + (size_t)e * 512 * 1024, 1024, scr, kb * 64, nb * 32, lane); continue; }
        r -= I_GU;
        { const int e = r / 128, q = r % 128, kb = q / 32, nb = q % 32; const float* Dn = wd + (size_t)e * 256 * 1024;
            conv_item([&](int k, int n) { return Dn[(size_t)k * 1024 + n]; }, (bf16*)(ws + W_DN) + (size_t)e * 1024 * 256, 256, scr, kb * 64, nb * 32, lane); }
    }
}

__device__ __forceinline__ void phase_pre(const Params& p) {
    const int tid = TID(); unsigned char* ws = p.ws;
    {
        const size_t gt = (size_t)BID() * 512 + tid, GT = (size_t)GRD() * 512;
        const float* x = p.in[0]; bf16* XB = (bf16*)(ws + WS_XB);
#pragma unroll 2
        for (size_t i = gt; i < (size_t)NTOK * DM / 8; i += GT) { const f32x4 a = *(const f32x4*)(x + i * 8), b = *(const f32x4*)(x + i * 8 + 4);
            u32x4 o; o.x = pk2(a[0], a[1]); o.y = pk2(a[2], a[3]); o.z = pk2(b[0], b[1]); o.w = pk2(b[2], b[3]); *(u32x4*)(XB + i * 8) = o; }
        const float* mem = p.in[1]; bf16* MB = (bf16*)(ws + WS_MEMB);
#pragma unroll 2
        for (size_t i = gt; i < (size_t)2048 * DM / 8; i += GT) { const f32x4 a = *(const f32x4*)(mem + i * 8), b = *(const f32x4*)(mem + i * 8 + 4);
            u32x4 o; o.x = pk2(a[0], a[1]); o.y = pk2(a[2], a[3]); o.z = pk2(b[0], b[1]); o.w = pk2(b[2], b[3]); *(u32x4*)(MB + i * 8) = o; }
        const int* pos = (const int*)p.in[2]; float* ROPE = (float*)(ws + WS_ROPE);
#pragma unroll 1
        for (size_t i = gt; i < (size_t)NTOK * 16; i += GT) { const int t = (int)(i >> 4), f = (int)(i & 15);
            double inv = 0.15915494309189535;
            for (int q = 0; q < f; ++q) inv *= 0.5623413251903491;
            const double rev = (double)pos[t] * inv; const float fr = (float)(rev - floor(rev));
            ROPE[i * 2] = __builtin_amdgcn_cosf(fr); ROPE[i * 2 + 1] = __builtin_amdgcn_sinf(fr); }
    }
}

__device__ __forceinline__ void gla_cum(const Params& p, int l, float* bs, int t0, int h) {
    const int tid = TID(), t = tid >> 3, dg = tid & 7;
    const bf16* Y = (const bf16*)(p.ws + WS_Y);
    const float* w_a2 = p.in[5] + l * 16 * 256; const float* b_a = p.in[6] + l * 256;
    float a[16];
    { const u32x4 a0 = *(const u32x4*)(Y + (size_t)(t0 + t) * YW + Y_A), a1 = *(const u32x4*)(Y + (size_t)(t0 + t) * YW + Y_A + 8);
#pragma unroll
      for (int j = 0; j < 4; ++j) { a[2 * j] = blo(a0[j]); a[2 * j + 1] = bhi(a0[j]); a[8 + 2 * j] = blo(a1[j]); a[8 + 2 * j + 1] = bhi(a1[j]); } }
#pragma unroll
    for (int j = 0; j < 8; ++j) { const int d = dg * 8 + j; float z = b_a[h * 64 + d];
#pragma unroll
        for (int q = 0; q < 16; ++q) z = fmaf(a[q], w_a2[q * 256 + h * 64 + d], z);
        bs[t * 65 + d] = logsigmoid(z) * (1.f / 16.f); }
    __syncthreads();
    if (tid < 64) { float s = 0.f; for (int tt = 0; tt < 64; ++tt) { s += bs[tt * 65 + tid]; bs[tt * 65 + tid] = s; } }
    __syncthreads();
}
__device__ __forceinline__ void ml_gates(const Params& p, int l, float* fc, float* aa, float* pm, int t0, int h) {
    const int tid = TID();
    const bf16* Y = (const bf16*)(p.ws + WS_Y);
    if (tid < 64) { const float fp = bf2f(Y[(size_t)(t0 + tid) * YW + Y_MF + h]) + p.in[10][l * 4 + h]; const float ig = bf2f(Y[(size_t)(t0 + tid) * YW + Y_MI + h]) + p.in[9][l * 4 + h];
        fc[tid] = logsigmoid(fp); aa[tid] = ig; }
    __syncthreads();
    if (tid == 0) { float s = 0.f, m = -3.0e38f; for (int i = 0; i < 64; ++i) { s += fc[i]; fc[i] = s; const float a = aa[i] - s; aa[i] = a; m = fmaxf(m, a); pm[i] = m; } }
    __syncthreads();
}
__device__ __forceinline__ void ml_conv(const Params& p, int l, float* dst, int t0, int c, int ycol, int wch, int h, float scale) {
    const int tid = TID(), s = tid >> 3, dg = tid & 7;
    const bf16* Y = (const bf16*)(p.ws + WS_Y); const float* w = p.in[8] + l * 4 * 512;
    float acc[8];
#pragma unroll
    for (int j = 0; j < 8; ++j) acc[j] = 0.f;
#pragma unroll
    for (int q = 0; q < 4; ++q) { const int ss = c * 64 + s - 3 + q;
        if (ss >= 0) { const u32x4 v = *(const u32x4*)(Y + (size_t)(t0 + s - 3 + q) * YW + ycol + h * 64 + dg * 8); const float* wr = w + q * 512 + wch + h * 64 + dg * 8;
#pragma unroll
            for (int j = 0; j < 4; ++j) { acc[2 * j] = fmaf(wr[2 * j], blo(v[j]), acc[2 * j]); acc[2 * j + 1] = fmaf(wr[2 * j + 1], bhi(v[j]), acc[2 * j + 1]); } } }
#pragma unroll
    for (int j = 0; j < 8; ++j) dst[s * 65 + dg * 8 + j] = siluf(acc[j]) * scale;
}
__device__ __forceinline__ void ld_blk(float* dst, const bf16* src, int ld) {
    const int tid = TID(), s = tid >> 3, dg = tid & 7; const u32x4 v = *(const u32x4*)(src + (size_t)s * ld + dg * 8);
#pragma unroll
    for (int j = 0; j < 4; ++j) { dst[s * 65 + dg * 8 + 2 * j] = blo(v[j]); dst[s * 65 + dg * 8 + 2 * j + 1] = bhi(v[j]); }
}

#define FENCE() do { asm volatile("" ::: "memory"); __builtin_amdgcn_sched_barrier(0); } while (0)
__device__ __forceinline__ f32x4 mfma16(bf16x8 a, bf16x8 b, f32x4 c) { return __builtin_amdgcn_mfma_f32_16x16x32_bf16(a, b, c, 0, 0, 0); }
__device__ __forceinline__ bf16x8 pack8(f32x4 a, f32x4 b) { u32x4 w; w.x = pk2(a[0], a[1]); w.y = pk2(a[2], a[3]); w.z = pk2(b[0], b[1]); w.w = pk2(b[2], b[3]); return __builtin_bit_cast(bf16x8, w); }
__device__ __forceinline__ f32x4 up4(u32x2 w) { return (f32x4){blo(w.x), bhi(w.x), blo(w.y), bhi(w.y)}; }
constexpr int LT = 68;
constexpr int WAVE_LDS = 18304;
__device__ __forceinline__ bf16x8 colfrag(const bf16* T, int col, int ra, int rb) {
    u32x4 w;
    w.x = (unsigned)T[(ra + 0) * LT + col] | ((unsigned)T[(ra + 1) * LT + col] << 16); w.y = (unsigned)T[(ra + 2) * LT + col] | ((unsigned)T[(ra + 3) * LT + col] << 16);
    w.z = (unsigned)T[(rb + 0) * LT + col] | ((unsigned)T[(rb + 1) * LT + col] << 16); w.w = (unsigned)T[(rb + 2) * LT + col] | ((unsigned)T[(rb + 3) * LT + col] << 16);
    return __builtin_bit_cast(bf16x8, w);
}
__device__ __forceinline__ void conv8(const bf16* Y, const float* cw  , int t0, int c, int rr, int ycol, float scale, f32x4& o0, f32x4& o1) {
    f32x4 a0 = {0.f, 0.f, 0.f, 0.f}, a1 = {0.f, 0.f, 0.f, 0.f};
#pragma unroll
    for (int tap = 0; tap < 4; ++tap) { const int ss = c * 64 + rr - 3 + tap;
        if (ss >= 0) { const u32x4 v = *(const u32x4*)(Y + (size_t)(t0 + rr - 3 + tap) * YW + ycol); const f32x4 w0 = *(const f32x4*)(cw + tap * 512), w1 = *(const f32x4*)(cw + tap * 512 + 4);
            a0 += w0 * (f32x4){blo(v.x), bhi(v.x), blo(v.y), bhi(v.y)}; a1 += w1 * (f32x4){blo(v.z), bhi(v.z), blo(v.w), bhi(v.w)}; } }
#pragma unroll
    for (int j = 0; j < 4; ++j) { o0[j] = siluf(a0[j]) * scale; o1[j] = siluf(a1[j]) * scale; }
}
__device__ __forceinline__ void v_to_lds(bf16* Vt, const bf16* vsrc, int lane) {
#pragma unroll
    for (int i = 0; i < 16; ++i) { const int x = lane + 64 * i, rr = x >> 4, cc = x & 15; *(u32x2*)(Vt + rr * LT + cc * 4) = *(const u32x2*)(vsrc + (size_t)rr * YW + cc * 4); }
}

__device__ __forceinline__ void lin_loc_wave(const Params& p, int l, bf16* Kt, bf16* Vt, int u, int lane) {
    asm volatile("" : "+v"(lane));
    unsigned char* ws = p.ws; const bf16* Y = (const bf16*)(ws + WS_Y);
    const int type = u >> 10, ur = u & 1023, bh = ur >> 5, c = ur & 31, b = bh >> 2, h = bh & 3, t0 = b * SEQ + c * 64;
    const int q = lane & 15, g = lane >> 4;
    float* ST = (float*)(ws + WS_ST) + (size_t)u * 4096;
    v_to_lds(Vt, Y + (size_t)t0 * YW + (type == 0 ? Y_GV : Y_MV) + h * 64, lane);
    if (type == 0) {
        const float* w_a2 = p.in[5] + l * 16 * 256 + h * 64; const float* b_a = p.in[6] + l * 256 + h * 64;
        const bf16x8 zero8 = {0, 0, 0, 0, 0, 0, 0, 0};
        bf16x8 wf[4], af[4];
#pragma unroll
        for (int db = 0; db < 4; ++db) { wf[db] = zero8;
            if (g < 2) { f32x4 w0, w1;
#pragma unroll
                for (int j = 0; j < 4; ++j) { w0[j] = w_a2[(8 * g + j) * 256 + 16 * db + q]; w1[j] = w_a2[(8 * g + 4 + j) * 256 + 16 * db + q]; }
                wf[db] = pack8(w0, w1); } }
#pragma unroll
        for (int tb = 0; tb < 4; ++tb) { af[tb] = zero8; if (g < 2) af[tb] = *(const bf16x8*)(Y + (size_t)(t0 + 16 * tb + q) * YW + Y_A + 8 * g); }
        float* BC = (float*)(ws + WS_BC); float* DEC = (float*)(ws + WS_DEC) + (size_t)ur * 64;
#pragma unroll
        for (int db = 0; db < 4; ++db) {
            const f32x4 ba = *(const f32x4*)(b_a + 16 * db + 4 * g);
            f32x4 bb[4]; f32x4 carry = {0.f, 0.f, 0.f, 0.f};
#pragma unroll
            for (int tb = 0; tb < 4; ++tb) { const f32x4 z = mfma16(wf[db], af[tb], (f32x4){0.f, 0.f, 0.f, 0.f});
#pragma unroll
                for (int r = 0; r < 4; ++r) { float x = logsigmoid(z[r] + ba[r]) * (1.f / 16.f);
#pragma unroll
                    for (int k = 1; k < 16; k <<= 1) { const float y = __shfl_up(x, k, 16); if (q >= k) x += y; }
                    x += carry[r]; bb[tb][r] = x; carry[r] = __shfl(x, (lane & 48) + 15); } }
#pragma unroll
            for (int sb = 0; sb < 4; ++sb) { const size_t row = (size_t)(t0 + 16 * sb + q);
                f32x4 kv = up4(*(const u32x2*)(Y + row * YW + Y_GK + h * 64 + 16 * db + 4 * g));
#pragma unroll
                for (int r = 0; r < 4; ++r) kv[r] *= fexp(carry[r] - bb[sb][r]);
                st_bf4(Kt + (16 * sb + q) * LT + 16 * db + 4 * g, kv);
                *(f32x4*)(BC + row * 256 + h * 64 + 16 * db + 4 * g) = bb[sb]; }
            if (q == 0) *(f32x4*)(DEC + 16 * db + 4 * g) = (f32x4){fexp(carry[0]), fexp(carry[1]), fexp(carry[2]), fexp(carry[3])};
            FENCE();
        }
    } else {
        const float fp = bf2f(Y[(size_t)(t0 + lane) * YW + Y_MF + h]) + p.in[10][l * 4 + h], ig = bf2f(Y[(size_t)(t0 + lane) * YW + Y_MI + h]) + p.in[9][l * 4 + h];
        float fc = logsigmoid(fp);
#pragma unroll
        for (int k = 1; k < 64; k <<= 1) { const float y = __shfl_up(fc, k); if (lane >= k) fc += y; }
        const float a = ig - fc; float M = a;
#pragma unroll
        for (int o = 1; o < 64; o <<= 1) M = fmaxf(M, __shfl_xor(M, o));
        const float F = __shfl(fc, 63), wl = fexp(a - M);
        const float* cw = p.in[8] + l * 4 * 512 + 256 + h * 64;
#pragma unroll
        for (int sb = 0; sb < 4; ++sb) { const float wrow = __shfl(wl, 16 * sb + q);
#pragma unroll
            for (int ks = 0; ks < 2; ++ks) { const int d0 = 32 * ks + 8 * g; f32x4 o0, o1; bf16* qk = (bf16*)(ws + WS_QKC) + (size_t)(t0 + 16 * sb + q) * 512 + h * 64 + d0;
                conv8(Y, cw + d0, t0, c, 16 * sb + q, Y_MK + h * 64 + d0, 1.f, o0, o1);
                st_bf4(qk + 256, o0); st_bf4(qk + 260, o1);
                st_bf4(Kt + (16 * sb + q) * LT + d0, o0 * wrow); st_bf4(Kt + (16 * sb + q) * LT + d0 + 4, o1 * wrow); FENCE();
                conv8(Y, cw - 256 + d0, t0, c, 16 * sb + q, Y_MQ + h * 64 + d0, 0.125f, o0, o1);
                st_bf4(qk, o0); st_bf4(qk + 4, o1); FENCE(); } }
        if (lane == 0) { float* SC = (float*)(ws + WS_SC); SC[ur * 2] = F; SC[ur * 2 + 1] = F + M; }
    }
    bf16x8 vf[4][2], kf[4][2];
#pragma unroll
    for (int eb = 0; eb < 4; ++eb)
#pragma unroll
        for (int ks = 0; ks < 2; ++ks) { vf[eb][ks] = colfrag(Vt, 16 * eb + q, 32 * ks + 8 * g, 32 * ks + 8 * g + 4); kf[eb][ks] = colfrag(Kt, 16 * eb + q, 32 * ks + 8 * g, 32 * ks + 8 * g + 4); FENCE(); }
#pragma unroll
    for (int eb = 0; eb < 4; ++eb)
#pragma unroll
        for (int db = 0; db < 4; ++db) { f32x4 acc = {0.f, 0.f, 0.f, 0.f};
#pragma unroll
            for (int ks = 0; ks < 2; ++ks) acc = mfma16(vf[eb][ks], kf[db][ks], acc);
#pragma unroll
            for (int r = 0; r < 4; ++r) ST[(16 * eb + 4 * g + r) * 64 + 16 * db + q] = acc[r]; }
    if (type == 1) { const u32x4 o1 = {0x3f803f80u, 0x3f803f80u, 0x3f803f80u, 0x3f803f80u}; const bf16x8 ones = __builtin_bit_cast(bf16x8, o1); float* NV = (float*)(ws + WS_NV) + (size_t)ur * 64;
#pragma unroll
        for (int db = 0; db < 4; ++db) { f32x4 acc = {0.f, 0.f, 0.f, 0.f};
#pragma unroll
            for (int ks = 0; ks < 2; ++ks) acc = mfma16(ones, kf[db][ks], acc);
            if (g == 0) NV[16 * db + q] = acc[0]; } }
}

template <int type>
__device__ __forceinline__ void lin_mix_wave(const Params& p, int l, bf16* Vt, int u, int lane) {
    asm volatile("" : "+v"(lane));
    unsigned char* ws = p.ws; const bf16* Y = (const bf16*)(ws + WS_Y);
    const int ur = u & 1023, bh = ur >> 5, c = ur & 31, b = bh >> 2, h = bh & 3, t0 = b * SEQ + c * 64;
    const int q = lane & 15, g = lane >> 4;
    const float* ST = (const float*)(ws + WS_ST) + (size_t)u * 4096;
    bf16* MIX = (bf16*)(ws + WS_XB);
    v_to_lds(Vt, Y + (size_t)t0 * YW + (type == 0 ? Y_GV : Y_MV) + h * 64, lane);
    bf16x8 kf[4][2];
    float fcl = 0.f, al = 0.f, pml = 0.f, mst = 0.f;
    const float* BC = (const float*)(ws + WS_BC);
    const bf16* QKC = (const bf16*)(ws + WS_QKC);
    if (type == 0) {
#pragma unroll
        for (int blk = 0; blk < 4; ++blk)
#pragma unroll
            for (int ks = 0; ks < 2; ++ks) { const size_t row = (size_t)(t0 + 16 * blk + q); const int d0 = 32 * ks + 8 * g;
                const f32x4 b0 = *(const f32x4*)(BC + row * 256 + h * 64 + d0), b1 = *(const f32x4*)(BC + row * 256 + h * 64 + d0 + 4);
                const u32x4 kk = *(const u32x4*)(Y + row * YW + Y_GK + h * 64 + d0);
                f32x4 k0 = {blo(kk.x), bhi(kk.x), blo(kk.y), bhi(kk.y)}, k1 = {blo(kk.z), bhi(kk.z), blo(kk.w), bhi(kk.w)};
#pragma unroll
                for (int j = 0; j < 4; ++j) { k0[j] *= fexp(-b0[j]); k1[j] *= fexp(-b1[j]); }
                kf[blk][ks] = pack8(k0, k1); FENCE(); }
    } else {
        const float fp = bf2f(Y[(size_t)(t0 + lane) * YW + Y_MF + h]) + p.in[10][l * 4 + h], ig = bf2f(Y[(size_t)(t0 + lane) * YW + Y_MI + h]) + p.in[9][l * 4 + h];
        float fc = logsigmoid(fp);
#pragma unroll
        for (int k = 1; k < 64; k <<= 1) { const float y = __shfl_up(fc, k); if (lane >= k) fc += y; }
        fcl = fc; al = ig - fc; pml = al;
#pragma unroll
        for (int k = 1; k < 64; k <<= 1) { const float y = __shfl_up(pml, k); if (lane >= k) pml = fmaxf(pml, y); }
        mst = ((const float*)(ws + WS_MS))[ur];
#pragma unroll
        for (int blk = 0; blk < 4; ++blk)
#pragma unroll
            for (int ks = 0; ks < 2; ++ks) kf[blk][ks] = *(const bf16x8*)(QKC + (size_t)(t0 + 16 * blk + q) * 512 + 256 + h * 64 + 32 * ks + 8 * g);
    }
    bf16x8 vf[4][2];
#pragma unroll
    for (int eb = 0; eb < 4; ++eb)
#pragma unroll
        for (int ks = 0; ks < 2; ++ks) { vf[eb][ks] = colfrag(Vt, 16 * eb + q, 32 * ks + 4 * g, 32 * ks + 16 + 4 * g); FENCE(); }
    const float* gn = (type == 0 ? p.in[7] : p.in[11]) + l * 256 + h * 64;
    f32x4 asv[4];
#pragma unroll
    for (int sb = 0; sb < 4; ++sb) { asv[sb] = (f32x4){0.f, 0.f, 0.f, 0.f};
        if (type == 1) {
#pragma unroll
            for (int r = 0; r < 4; ++r) asv[sb][r] = __shfl(al, 16 * sb + 4 * g + r); } }
    FENCE();
#pragma unroll
    for (int tb = 0; tb < 4; ++tb) {
        const int t = 16 * tb + q;
        bf16x8 qf[2];
#pragma unroll
        for (int ks = 0; ks < 2; ++ks) { const int d0 = 32 * ks + 8 * g;
            if (type == 0) { const size_t row = (size_t)(t0 + t);
                const f32x4 b0 = *(const f32x4*)(BC + row * 256 + h * 64 + d0), b1 = *(const f32x4*)(BC + row * 256 + h * 64 + d0 + 4);
                const u32x4 qq = *(const u32x4*)(Y + row * YW + Y_GQ + h * 64 + d0);
                f32x4 q0 = {blo(qq.x), bhi(qq.x), blo(qq.y), bhi(qq.y)}, q1 = {blo(qq.z), bhi(qq.z), blo(qq.w), bhi(qq.w)};
#pragma unroll
                for (int j = 0; j < 4; ++j) { q0[j] *= 0.125f * fexp(b0[j]); q1[j] *= 0.125f * fexp(b1[j]); }
                qf[ks] = pack8(q0, q1);
            } else qf[ks] = *(const bf16x8*)(QKC + (size_t)(t0 + t) * 512 + h * 64 + d0); }
        f32x4 pt[4];
#pragma unroll
        for (int sb = 0; sb < 4; ++sb) { pt[sb] = (f32x4){0.f, 0.f, 0.f, 0.f};
            if (sb <= tb) {
#pragma unroll
                for (int ks = 0; ks < 2; ++ks) pt[sb] = mfma16(kf[sb][ks], qf[ks], pt[sb]); } }
        float mm = 0.f, wi = 1.f;
        if (type == 1) { mm = fmaxf(mst, __shfl(pml, t)); wi = fexp(mst - mm); }
        float dsum = 0.f;
#pragma unroll
        for (int sb = 0; sb < 4; ++sb) if (sb <= tb) {
#pragma unroll
            for (int r = 0; r < 4; ++r) { const int sidx = 16 * sb + 4 * g + r; float w = pt[sb][r];
                if (type == 1) w *= fexp(asv[sb][r] - mm);
                w = (sidx <= t) ? w : 0.f; pt[sb][r] = w; dsum += w; } }
        bf16x8 pf[2]; pf[0] = pack8(pt[0], pt[1]); pf[1] = pack8(pt[2], pt[3]); FENCE();
        f32x4 ot[4];
#pragma unroll
        for (int eb = 0; eb < 4; ++eb) { f32x4 acc = {0.f, 0.f, 0.f, 0.f};
#pragma unroll
            for (int ks = 0; ks < 2; ++ks) { const float* sp = ST + (16 * eb + q) * 64 + 32 * ks + 8 * g;
                acc = mfma16(pack8(*(const f32x4*)sp, *(const f32x4*)(sp + 4)), qf[ks], acc); }
            acc = acc * wi;
            acc = mfma16(vf[eb][0], pf[0], acc);
            if (tb >= 2) acc = mfma16(vf[eb][1], pf[1], acc);
            ot[eb] = acc; }
        if (type == 1) {
            float qn = 0.f;
#pragma unroll
            for (int ks = 0; ks < 2; ++ks) { const u32x4 w = __builtin_bit_cast(u32x4, qf[ks]); const float* nvp = (const float*)(ws + WS_NV) + (size_t)ur * 64 + 32 * ks + 8 * g; const f32x4 n0 = *(const f32x4*)nvp, n1 = *(const f32x4*)(nvp + 4);
                qn += blo(w.x) * n0[0] + bhi(w.x) * n0[1] + blo(w.y) * n0[2] + bhi(w.y) * n0[3] + blo(w.z) * n1[0] + bhi(w.z) * n1[1] + blo(w.w) * n1[2] + bhi(w.w) * n1[3]; }
            qn += __shfl_xor(qn, 16); qn += __shfl_xor(qn, 32); dsum += __shfl_xor(dsum, 16); dsum += __shfl_xor(dsum, 32);
            const float den = wi * qn + dsum, mt = __shfl(fcl, t) + mm; const float inv = 1.f / fmaxf(fabsf(den), fexp(-mt));
#pragma unroll
            for (int eb = 0; eb < 4; ++eb) ot[eb] = ot[eb] * inv;
            FENCE();
        }
        float s1 = 0.f;
#pragma unroll
        for (int eb = 0; eb < 4; ++eb) s1 += (ot[eb][0] + ot[eb][1]) + (ot[eb][2] + ot[eb][3]);
        s1 += __shfl_xor(s1, 16); s1 += __shfl_xor(s1, 32);
        const float mu = s1 * (1.f / 64.f); float s2 = 0.f;
#pragma unroll
        for (int eb = 0; eb < 4; ++eb) { ot[eb] = ot[eb] - mu; s2 += (ot[eb][0] * ot[eb][0] + ot[eb][1] * ot[eb][1]) + (ot[eb][2] * ot[eb][2] + ot[eb][3] * ot[eb][3]); }
        s2 += __shfl_xor(s2, 16); s2 += __shfl_xor(s2, 32);
        const float rstd = 1.f / sqrtf(s2 * (1.f / 64.f) + LN_EPS);
#pragma unroll
        for (int eb = 0; eb < 4; ++eb) { const int e0 = 16 * eb + 4 * g;
            const f32x4 gate = up4(*(const u32x2*)(Y + (size_t)(t0 + t) * YW + (type == 0 ? Y_GR : Y_MO) + h * 64 + e0)); const f32x4 gg = *(const f32x4*)(gn + e0);
            f32x4 res;
#pragma unroll
            for (int r = 0; r < 4; ++r) res[r] = ot[eb][r] * rstd * gg[r] * (type == 0 ? siluf(gate[r]) : sigmoidf(gate[r]));
            st_bf4(MIX + (size_t)(t0 + t) * DM + type * 256 + h * 64 + e0, res); }
        FENCE();
    }
}

__device__ __forceinline__ void phase_loc(const Params& p, int l, unsigned char* smem) {
    const int tid = TID(), lane = tid & 63, wave = __builtin_amdgcn_readfirstlane(tid >> 6);
    unsigned char* ws = p.ws; const bf16* Y = (const bf16*)(ws + WS_Y);
    { bf16* Kt = (bf16*)(smem + wave * WAVE_LDS); bf16* Vt = Kt + 64 * LT;
      for (int u = BID() * 8 + wave; u < 2048; u += GRD() * 8) lin_loc_wave(p, l, Kt, Vt, u, lane); }
    float* RS = (float*)(ws + WS_RS);
    for (int row = BID() * 8 + wave; row < NTOK; row += GRD() * 8) {
        const u32x2 q = *(const u32x2*)(Y + (size_t)row * YW + Y_CQ + lane * 4); const unsigned kv = *(const unsigned*)(Y + (size_t)row * YW + Y_CKV + lane * 2);
        float sq = blo(q.x) * blo(q.x) + bhi(q.x) * bhi(q.x) + blo(q.y) * blo(q.y) + bhi(q.y) * bhi(q.y); float sk = blo(kv) * blo(kv) + bhi(kv) * bhi(kv);
        sq = wave_sum(sq); sk = wave_sum(sk);
        if (lane == 0) { RS[row * 2] = 1.f / sqrtf(sq * (1.f / 256.f) + LN_EPS); RS[row * 2 + 1] = 1.f / sqrtf(sk * (1.f / 128.f) + LN_EPS); }
    }
}

__device__ __forceinline__ void phase_scan(const Params& p, int l, int dummy = 0) {
    unsigned char* ws = p.ws;
    float* ST = (float*)(ws + WS_ST); float* STD = dummy ? (float*)(ws + WS_XB) : ST; float* NV = (float*)(ws + WS_NV); const float* DEC = (const float*)(ws + WS_DEC); const float* SC = (const float*)(ws + WS_SC); float* MS = (float*)(ws + WS_MS);
    const int gt = BID() * 512 + TID(), GT = GRD() * 512;
    for (int idx = gt; idx < 64 * 4096; idx += GT) {
        const int seq = idx >> 12, el = idx & 4095, d = el & 63;
        float* st = ST + (size_t)seq * 32 * 4096 + el;
        float tv[32];
#pragma unroll
        for (int c = 0; c < 32; ++c) tv[c] = st[(size_t)c * 4096];
        if (seq < 32) { const float* dc = DEC + (size_t)seq * 32 * 64 + d; float dv[32];
#pragma unroll
            for (int c = 0; c < 32; ++c) dv[c] = dc[c * 64];
            float S = 0.f;
#pragma unroll
            for (int c = 0; c < 32; ++c) { const float tmp = tv[c]; tv[c] = S; S = fmaf(dv[c], S, tmp); } }
        else { const float* sc = SC + (size_t)(seq - 32) * 32 * 2; float C = 0.f, m = 0.f;
#pragma unroll
            for (int c = 0; c < 32; ++c) { const float F = sc[c * 2], ml = sc[c * 2 + 1]; const float tmp = tv[c]; tv[c] = C;
                const float mn = fmaxf(F + m, ml); C = expf(F + m - mn) * C + expf(ml - mn) * tmp; m = mn; } }
        float* sd = STD + (size_t)seq * 32 * 4096 + el;
#pragma unroll
        for (int c = 0; c < 32; ++c) sd[(size_t)c * 4096] = tv[c];
    }
    if (dummy) return;
    for (int idx = gt; idx < 32 * 64; idx += GT) {
        const int sq = idx >> 6, d = idx & 63; float n = 0.f, m = 0.f; const float* sc = SC + (size_t)sq * 32 * 2; float* nv = NV + (size_t)sq * 32 * 64 + d;
#pragma unroll 4
        for (int c = 0; c < 32; ++c) { const float F = sc[c * 2], ml = sc[c * 2 + 1]; const float tmp = nv[c * 64]; nv[c * 64] = n; if (d == 0) MS[sq * 32 + c] = m;
            const float mn = fmaxf(F + m, ml); n = expf(F + m - mn) * n + expf(ml - mn) * tmp; m = mn; }
    }
}

template <int DQK, int DV>
__device__ __forceinline__ void attn_naive(unsigned char* smem, const bf16* Q, int qs, const bf16* K, int ks, const bf16* V, int vs, int nk, bf16* O, int os) {
    constexpr int LQ = DQK + 8, LV = DV + 8, EV = DV / 8;
    bf16* Qs = (bf16*)smem; bf16* Ks = Qs + 64 * LQ; bf16* Vs = Ks + 64 * LQ; float* Ss = (float*)(Vs + 64 * LV);
    const int tid = TID(), t = tid >> 3, g = tid & 7;
    __syncthreads();
    for (int i = tid; i < 64 * DQK / 8; i += 512) { const int r = i / (DQK / 8), c8 = i % (DQK / 8); *(u32x4*)(Qs + r * LQ + c8 * 8) = *(const u32x4*)(Q + (size_t)r * qs + c8 * 8); }
    float acc[EV]; float m = -3.0e38f, lsum = 0.f;
#pragma unroll
    for (int j = 0; j < EV; ++j) acc[j] = 0.f;
    for (int k0 = 0; k0 < nk; k0 += 64) {
        __syncthreads();
        for (int i = tid; i < 64 * DQK / 8; i += 512) { const int r = i / (DQK / 8), c8 = i % (DQK / 8); *(u32x4*)(Ks + r * LQ + c8 * 8) = *(const u32x4*)(K + (size_t)(k0 + r) * ks + c8 * 8); }
        for (int i = tid; i < 64 * DV / 8; i += 512) { const int r = i / (DV / 8), c8 = i % (DV / 8); *(u32x4*)(Vs + r * LV + c8 * 8) = *(const u32x4*)(V + (size_t)(k0 + r) * vs + c8 * 8); }
        __syncthreads();
        float sc[8];
#pragma unroll
        for (int j = 0; j < 8; ++j) sc[j] = 0.f;
        for (int d8 = 0; d8 < DQK / 8; ++d8) { const u32x4 qv = *(const u32x4*)(Qs + t * LQ + d8 * 8);
#pragma unroll
            for (int j = 0; j < 8; ++j) { const u32x4 kv = *(const u32x4*)(Ks + (g + 8 * j) * LQ + d8 * 8);
#pragma unroll
                for (int q = 0; q < 4; ++q) sc[j] = fmaf(blo(qv[q]), blo(kv[q]), fmaf(bhi(qv[q]), bhi(kv[q]), sc[j])); } }
        float mx = sc[0];
#pragma unroll
        for (int j = 1; j < 8; ++j) mx = fmaxf(mx, sc[j]);
        mx = fmaxf(mx, __shfl_xor(mx, 1)); mx = fmaxf(mx, __shfl_xor(mx, 2)); mx = fmaxf(mx, __shfl_xor(mx, 4));
        const float mn = fmaxf(m, mx), al = exp2f(m - mn); float ps = 0.f;
#pragma unroll
        for (int j = 0; j < 8; ++j) { const float pv = exp2f(sc[j] - mn); ps += pv; Ss[t * 65 + g + 8 * j] = pv; }
        ps += __shfl_xor(ps, 1); ps += __shfl_xor(ps, 2); ps += __shfl_xor(ps, 4);
        lsum = lsum * al + ps; m = mn;
#pragma unroll
        for (int j = 0; j < EV; ++j) acc[j] *= al;
        __syncthreads();
        for (int kk = 0; kk < 64; ++kk) { const float pv = Ss[t * 65 + kk];
#pragma unroll
            for (int j8 = 0; j8 < EV / 8; ++j8) { const u32x4 vv = *(const u32x4*)(Vs + kk * LV + g * EV + j8 * 8);
#pragma unroll
                for (int q = 0; q < 4; ++q) { acc[j8 * 8 + 2 * q] = fmaf(pv, blo(vv[q]), acc[j8 * 8 + 2 * q]); acc[j8 * 8 + 2 * q + 1] = fmaf(pv, bhi(vv[q]), acc[j8 * 8 + 2 * q + 1]); } } }
    }
    const float inv = 1.f / lsum;
#pragma unroll
    for (int j8 = 0; j8 < EV / 8; ++j8) { u32x4 o; o.x = pk2(acc[j8 * 8] * inv, acc[j8 * 8 + 1] * inv); o.y = pk2(acc[j8 * 8 + 2] * inv, acc[j8 * 8 + 3] * inv);
        o.z = pk2(acc[j8 * 8 + 4] * inv, acc[j8 * 8 + 5] * inv); o.w = pk2(acc[j8 * 8 + 6] * inv, acc[j8 * 8 + 7] * inv);
        *(u32x4*)(O + (size_t)t * os + g * EV + j8 * 8) = o; }
}

template <int DQK, int DV, int QG>
__device__ __forceinline__ void attn_mfma_unit(unsigned char* smem, const bf16* Q, int qs, const bf16* K, int ks, const bf16* VT, int vts, int ntile_wave, int ntile_max, bf16* O, int os) {
    constexpr int LK = DQK + 8, LV = 72, KS = DQK / 32, NDV = DV / 16;
    constexpr int NKPIECE = 64 * DQK / 8, NVPIECE = DV * 8, NKP = (NKPIECE + 511) / 512, NVP = (NVPIECE + 511) / 512;
    bf16* Ks = (bf16*)smem; bf16* Vs = Ks + 64 * LK;
    const int tid = TID(), wave = tid >> 6, lane = tid & 63, q = lane & 15, g = lane >> 4;
    bf16x8 qf[QG][KS];
#pragma unroll
    for (int qg = 0; qg < QG; ++qg)
#pragma unroll
        for (int kk = 0; kk < KS; ++kk) qf[qg][kk] = *(const bf16x8*)(Q + (size_t)(wave * 16 * QG + qg * 16 + q) * qs + kk * 32 + g * 8);
    f32x4 o[QG][NDV]; float mrun[QG], lrun[QG];
#pragma unroll
    for (int qg = 0; qg < QG; ++qg) { mrun[qg] = -3.0e38f; lrun[qg] = 0.f;
#pragma unroll
        for (int d = 0; d < NDV; ++d) o[qg][d] = (f32x4){0.f, 0.f, 0.f, 0.f}; }
    u32x4 kr[NKP], vr[NVP];
#define AT_GLOAD(kt) do { _Pragma("unroll") for (int _i = 0; _i < NKP; ++_i) { const int _x = tid + 512 * _i; if (_x < NKPIECE) { const int _r = _x / (DQK / 8), _c = _x % (DQK / 8); kr[_i] = *(const u32x4*)(K + (size_t)((kt) * 64 + _r) * ks + _c * 8); } } \
        _Pragma("unroll") for (int _i = 0; _i < NVP; ++_i) { const int _x = tid + 512 * _i; if (_x < NVPIECE) { const int _r = _x >> 3, _c = _x & 7; vr[_i] = *(const u32x4*)(VT + (size_t)_r * vts + (kt) * 64 + _c * 8); } } } while (0)
#define AT_LSTORE() do { _Pragma("unroll") for (int _i = 0; _i < NKP; ++_i) { const int _x = tid + 512 * _i; if (_x < NKPIECE) { const int _r = _x / (DQK / 8), _c = _x % (DQK / 8); *(u32x4*)(Ks + _r * LK + _c * 8) = kr[_i]; } } \
        _Pragma("unroll") for (int _i = 0; _i < NVP; ++_i) { const int _x = tid + 512 * _i; if (_x < NVPIECE) { const int _r = _x >> 3, _c = _x & 7; *(u32x4*)(Vs + _r * LV + _c * 8) = vr[_i]; } } } while (0)
    AT_GLOAD(0);
    for (int kt = 0; kt < ntile_max; ++kt) {
        __syncthreads();
        AT_LSTORE();
        __syncthreads();
        if (kt + 1 < ntile_max) AT_GLOAD(kt + 1);
        if (kt < ntile_wave) {
            f32x4 sc[QG][4];
#pragma unroll
            for (int qg = 0; qg < QG; ++qg)
#pragma unroll
                for (int b = 0; b < 4; ++b) sc[qg][b] = (f32x4){0.f, 0.f, 0.f, 0.f};
#pragma unroll
            for (int b = 0; b < 4; ++b)
#pragma unroll
                for (int kk = 0; kk < KS; ++kk) { const bf16x8 kf = *(const bf16x8*)(Ks + (b * 16 + q) * LK + kk * 32 + g * 8);
#pragma unroll
                    for (int qg = 0; qg < QG; ++qg) sc[qg][b] = __builtin_amdgcn_mfma_f32_16x16x32_bf16(kf, qf[qg][kk], sc[qg][b], 0, 0, 0); }
            bf16x8 pf[QG][2];
#pragma unroll
            for (int qg = 0; qg < QG; ++qg) {
                float mx = sc[qg][0][0];
#pragma unroll
                for (int b = 0; b < 4; ++b)
#pragma unroll
                    for (int i = 0; i < 4; ++i) mx = fmaxf(mx, sc[qg][b][i]);
                mx = fmaxf(mx, __shfl_xor(mx, 16)); mx = fmaxf(mx, __shfl_xor(mx, 32));
                const float mn = fmaxf(mrun[qg], mx), al = exp2f(mrun[qg] - mn); float ps = 0.f;
#pragma unroll
                for (int b = 0; b < 4; ++b)
#pragma unroll
                    for (int i = 0; i < 4; ++i) { const float pv = exp2f(sc[qg][b][i] - mn); sc[qg][b][i] = pv; ps += pv; }
                lrun[qg] = lrun[qg] * al + ps; mrun[qg] = mn;
#pragma unroll
                for (int d = 0; d < NDV; ++d) o[qg][d] = o[qg][d] * al;
#pragma unroll
                for (int st = 0; st < 2; ++st) { u32x4 w; w.x = pk2(sc[qg][2 * st][0], sc[qg][2 * st][1]); w.y = pk2(sc[qg][2 * st][2], sc[qg][2 * st][3]);
                    w.z = pk2(sc[qg][2 * st + 1][0], sc[qg][2 * st + 1][1]); w.w = pk2(sc[qg][2 * st + 1][2], sc[qg][2 * st + 1][3]); pf[qg][st] = __builtin_bit_cast(bf16x8, w); }
            }
#pragma unroll
            for (int d = 0; d < NDV; ++d)
#pragma unroll
                for (int st = 0; st < 2; ++st) { const u32x2 v0 = *(const u32x2*)(Vs + (d * 16 + q) * LV + st * 32 + 4 * g), v1 = *(const u32x2*)(Vs + (d * 16 + q) * LV + st * 32 + 16 + 4 * g);
                    const u32x4 vv = {v0.x, v0.y, v1.x, v1.y}; const bf16x8 vf = __builtin_bit_cast(bf16x8, vv);
#pragma unroll
                    for (int qg = 0; qg < QG; ++qg) o[qg][d] = __builtin_amdgcn_mfma_f32_16x16x32_bf16(vf, pf[qg][st], o[qg][d], 0, 0, 0); }
        }
    }
#undef AT_GLOAD
#undef AT_LSTORE
#pragma unroll
    for (int qg = 0; qg < QG; ++qg) { float lt = lrun[qg]; lt += __shfl_xor(lt, 16); lt += __shfl_xor(lt, 32); const float inv = 1.f / lt;
        bf16* orow = O + (size_t)(wave * 16 * QG + qg * 16 + q) * os + 4 * g;
#pragma unroll
        for (int d = 0; d < NDV; ++d) st_bf4(orow + d * 16, o[qg][d] * inv); }
}

__device__ __forceinline__ void mix_linear_unit(const Params& p, int l, unsigned char* smem, int u) {
    const int tid = TID(); unsigned char* ws = p.ws; const bf16* Y = (const bf16*)(ws + WS_Y);
    float* A0 = (float*)smem; float* A1 = A0 + 64 * 65; float* A2 = A1 + 64 * 65; float* A3 = A2 + 64 * 65; float* A4 = A3 + 64 * 65; float* A5 = A4 + 64 * 65;
    float* fc = A5 + 64 * 65; float* aa = fc + 64; float* pm = aa + 64; float* nv = pm + 64;
    const float* ST = (const float*)(ws + WS_ST); const float* NV = (const float*)(ws + WS_NV); const float* MS = (const float*)(ws + WS_MS);
    bf16* MIX = (bf16*)(ws + WS_XB);
    const int type = u >> 10, r = u & 1023, bh = r >> 5, c = r & 31, b = bh >> 2, h = bh & 3, t0 = b * SEQ + c * 64;
    const int t = tid >> 3, g = tid & 7, e0 = g * 8;
    __syncthreads();
    for (int i = tid; i < 4096; i += 512) A3[(i >> 6) * 65 + (i & 63)] = ST[(size_t)u * 4096 + i];
    ld_blk(A2, Y + (size_t)t0 * YW + (type == 0 ? Y_GV : Y_MV) + h * 64, YW);
    float mst = 0.f;
    if (type == 0) {
        gla_cum(p, l, A0, t0, h);
        ld_blk(A4, Y + (size_t)t0 * YW + Y_GQ + h * 64, YW); ld_blk(A1, Y + (size_t)t0 * YW + Y_GK + h * 64, YW);
        __syncthreads();
        for (int i = tid; i < 4096; i += 512) { const int s = i >> 6, dd = i & 63; const float bb = A0[s * 65 + dd]; A4[s * 65 + dd] *= 0.125f * expf(bb); A1[s * 65 + dd] *= expf(-bb); }
    } else {
        ml_gates(p, l, fc, aa, pm, t0, h);
        ml_conv(p, l, A4, t0, c, Y_MQ, 0, h, 0.125f); ml_conv(p, l, A1, t0, c, Y_MK, 256, h, 1.f);
        if (tid < 64) nv[tid] = NV[(size_t)r * 64 + tid];
        mst = MS[r];
    }
    __syncthreads();
    const float mm = (type == 1) ? fmaxf(mst, pm[t]) : 0.f;
    {
        float sc[8];
#pragma unroll
        for (int j = 0; j < 8; ++j) sc[j] = 0.f;
        for (int d = 0; d < 64; ++d) { const float qv = A4[t * 65 + d];
#pragma unroll
            for (int j = 0; j < 8; ++j) sc[j] = fmaf(qv, A1[(g + 8 * j) * 65 + d], sc[j]); }
#pragma unroll
        for (int j = 0; j < 8; ++j) { const int s = g + 8 * j; float w = (s <= t) ? sc[j] : 0.f; if (type == 1) w = (s <= t) ? w * expf(aa[s] - mm) : 0.f; A5[t * 65 + s] = w; }
    }
    __syncthreads();
    float acc[8], inter[8];
#pragma unroll
    for (int j = 0; j < 8; ++j) { acc[j] = 0.f; inter[j] = 0.f; }
    for (int d = 0; d < 64; ++d) { const float qv = A4[t * 65 + d];
#pragma unroll
        for (int j = 0; j < 8; ++j) inter[j] = fmaf(qv, A3[d * 65 + e0 + j], inter[j]); }
    for (int s = 0; s < 64; ++s) { const float pv = A5[t * 65 + s];
#pragma unroll
        for (int j = 0; j < 8; ++j) acc[j] = fmaf(pv, A2[s * 65 + e0 + j], acc[j]); }
    float o[8];
    if (type == 0) {
#pragma unroll
        for (int j = 0; j < 8; ++j) o[j] = acc[j] + inter[j];
    } else {
        const float wi = expf(mst - mm);
        float dn = 0.f;
#pragma unroll
        for (int j = 0; j < 8; ++j) dn += wi * A4[t * 65 + e0 + j] * nv[e0 + j] + A5[t * 65 + e0 + j];
        dn += __shfl_xor(dn, 1); dn += __shfl_xor(dn, 2); dn += __shfl_xor(dn, 4);
        const float mt = fc[t] + mm; const float den = fmaxf(fabsf(dn), expf(-mt)); const float inv = 1.f / den;
#pragma unroll
        for (int j = 0; j < 8; ++j) o[j] = (wi * inter[j] + acc[j]) * inv;
    }
    float s1 = 0.f;
#pragma unroll
    for (int j = 0; j < 8; ++j) s1 += o[j];
    s1 += __shfl_xor(s1, 1); s1 += __shfl_xor(s1, 2); s1 += __shfl_xor(s1, 4);
    const float mu = s1 * (1.f / 64.f); float s2 = 0.f;
#pragma unroll
    for (int j = 0; j < 8; ++j) { o[j] -= mu; s2 += o[j] * o[j]; }
    s2 += __shfl_xor(s2, 1); s2 += __shfl_xor(s2, 2); s2 += __shfl_xor(s2, 4);
    const float rstd = 1.f / sqrtf(s2 * (1.f / 64.f) + LN_EPS);
    const float* gn = (type == 0 ? p.in[7] : p.in[11]) + l * 256 + h * 64 + e0;
    const u32x4 gv = *(const u32x4*)(Y + (size_t)(t0 + t) * YW + (type == 0 ? Y_GR : Y_MO) + h * 64 + e0);
    float gate[8];
#pragma unroll
    for (int j = 0; j < 4; ++j) { gate[2 * j] = blo(gv[j]); gate[2 * j + 1] = bhi(gv[j]); }
    float res[8];
#pragma unroll
    for (int j = 0; j < 8; ++j) res[j] = o[j] * rstd * gn[j] * (type == 0 ? siluf(gate[j]) : sigmoidf(gate[j]));
    u32x4 ov; ov.x = pk2(res[0], res[1]); ov.y = pk2(res[2], res[3]); ov.z = pk2(res[4], res[5]); ov.w = pk2(res[6], res[7]);
    *(u32x4*)(MIX + (size_t)(t0 + t) * DM + type * 256 + h * 64 + e0) = ov;
}

__device__ __forceinline__ void phase_mix(const Params& p, int l, unsigned char* smem) {
    unsigned char* ws = p.ws;
    const bf16* QP = (const bf16*)(ws + WS_QP); const bf16* KP = (const bf16*)(ws + WS_KP); const bf16* VPT = (const bf16*)(ws + WS_VP); bf16* MIX = (bf16*)(ws + WS_XB);
    for (int u = BID(); u < 512; u += GRD()) {
        const int bh = u & 63, Qb = u < 256 ? 7 - (u >> 6) : (u - 256) >> 6, b = bh >> 3, h = bh & 7;
        const int wave = TID() >> 6;
        attn_mfma_unit<96, 64, 2>(smem, QP + ((size_t)bh * SEQ + Qb * 256) * 96, 96, KP + (size_t)bh * SEQ * 96, 96, VPT + (size_t)bh * 64 * SEQ, SEQ,
                                  Qb * 4 + (wave >> 1) + 1, Qb * 4 + 4, MIX + (size_t)(b * SEQ + Qb * 256) * DM + 512 + h * 64, DM);
    }
    __syncthreads();
    { const int tid = TID(), lane = tid & 63, wave = __builtin_amdgcn_readfirstlane(tid >> 6); bf16* Vt = (bf16*)(smem + wave * WAVE_LDS);
      for (int u = BID() * 8 + wave; u < 1024; u += GRD() * 8) lin_mix_wave<0>(p, l, Vt, u, lane);
      for (int u = 1024 + BID() * 8 + wave; u < 2048; u += GRD() * 8) lin_mix_wave<1>(p, l, Vt, u, lane); }
}

__device__ __forceinline__ void ln_row_store(f32x4 (&v)[4], const float* g, const float* bta, float* of, bf16* ob, int lane) {
    float s = 0.f;
#pragma unroll
    for (int j = 0; j < 4; ++j) s += (v[j][0] + v[j][1]) + (v[j][2] + v[j][3]);
    const float mean = wave_sum(s) * (1.f / DM); float s2 = 0.f;
#pragma unroll
    for (int j = 0; j < 4; ++j) { v[j] = v[j] - mean; s2 += (v[j][0] * v[j][0] + v[j][1] * v[j][1]) + (v[j][2] * v[j][2] + v[j][3] * v[j][3]); }
    const float rstd = 1.f / sqrtf(wave_sum(s2) * (1.f / DM) + LN_EPS);
#pragma unroll
    for (int j = 0; j < 4; ++j) { const f32x4 gg = *(const f32x4*)(g + lane * 4 + 256 * j), bb = *(const f32x4*)(bta + lane * 4 + 256 * j);
        v[j] = v[j] * rstd * gg + bb; if (of) *(f32x4*)(of + lane * 4 + 256 * j) = v[j]; st_bf4(ob + lane * 4 + 256 * j, v[j]); }
}

__device__ __forceinline__ void phase_ln(const Params& p, int l, int which  , int dummy = 0  ) {
    const int tid = TID(), lane = tid & 63, wave = tid >> 6; unsigned char* ws = p.ws;
    float* XR = p.out; bf16* XB = (bf16*)(ws + WS_XB);
    const float* g = p.in[26 + 2 * which] + l * DM; const float* bta = p.in[27 + 2 * which] + l * DM;
    const bf16* CT = (const bf16*)(ws + WS_CT);
    for (int row = BID() * 8 + wave; row < NTOK; row += GRD() * 8) {
        f32x4 v[4];
        if (which == 2) {
#pragma unroll
            for (int j = 0; j < 4; ++j) { const u32x2 c0 = *(const u32x2*)(CT + (size_t)row * DM + lane * 4 + 256 * j), c1 = *(const u32x2*)(CT + ((size_t)NTOK + row) * DM + lane * 4 + 256 * j);
                v[j] = up4q(*(const u32x2*)(XB + (size_t)row * DM + lane * 4 + 256 * j)) * ALPHA + up4q(c0) + up4q(c1); }
        } else {
#pragma unroll
            for (int j = 0; j < 4; ++j) v[j] = *(const f32x4*)(XR + (size_t)row * DM + lane * 4 + 256 * j);
        }
        float* of = which == 2 ? XR + (size_t)row * DM : nullptr; bf16* ob = XB + (size_t)row * DM;
        if (dummy) { of = (float*)(ws + (which == 2 ? WS_Y : WS_CT)) + (size_t)row * DM; ob = (bf16*)(ws + (which == 2 ? WS_ST : WS_Y)) + (size_t)row * DM; }
        ln_row_store(v, g, bta, of, ob, lane);
        if (which == 1) {
            const float* wgp = p.in[19] + (size_t)l * DM * 4; const float* bg = p.in[20] + l * 4; const float* wr = p.in[21] + (size_t)l * DM * 32; const float* br = p.in[22] + l * 32;
            float gl[4] = {0.f, 0.f, 0.f, 0.f};
#pragma unroll
            for (int j = 0; j < 4; ++j)
#pragma unroll
                for (int q = 0; q < 4; ++q) { const f32x4 w4 = *(const f32x4*)(wgp + (size_t)(lane * 4 + 256 * j + q) * 4); const float xv = v[j][q];
                    gl[0] = fmaf(xv, w4[0], gl[0]); gl[1] = fmaf(xv, w4[1], gl[1]); gl[2] = fmaf(xv, w4[2], gl[2]); gl[3] = fmaf(xv, w4[3], gl[3]); }
#pragma unroll
            for (int q = 0; q < 4; ++q) gl[q] = wave_sum(gl[q]) + bg[q];
            int gi = 0; float gm = gl[0];
#pragma unroll
            for (int q = 1; q < 4; ++q) if (gl[q] > gm) { gm = gl[q]; gi = q; }
            float gs = 0.f;
#pragma unroll
            for (int q = 0; q < 4; ++q) gs += expf(gl[q] - gm);
            const float gp = 1.f / gs;
            float el[8] = {0.f, 0.f, 0.f, 0.f, 0.f, 0.f, 0.f, 0.f};
#pragma unroll
            for (int j = 0; j < 4; ++j)
#pragma unroll
                for (int q = 0; q < 4; ++q) { const float* wrow = wr + (size_t)(lane * 4 + 256 * j + q) * 32 + gi * 8; const f32x4 w0 = *(const f32x4*)wrow, w1 = *(const f32x4*)(wrow + 4); const float xv = v[j][q];
                    el[0] = fmaf(xv, w0[0], el[0]); el[1] = fmaf(xv, w0[1], el[1]); el[2] = fmaf(xv, w0[2], el[2]); el[3] = fmaf(xv, w0[3], el[3]);
                    el[4] = fmaf(xv, w1[0], el[4]); el[5] = fmaf(xv, w1[1], el[5]); el[6] = fmaf(xv, w1[2], el[6]); el[7] = fmaf(xv, w1[3], el[7]); }
#pragma unroll
            for (int q = 0; q < 8; ++q) el[q] = wave_sum(el[q]) + br[gi * 8 + q];
            int i0 = 0; float m0 = el[0];
#pragma unroll
            for (int q = 1; q < 8; ++q) if (el[q] > m0) { m0 = el[q]; i0 = q; }
            int i1 = -1; float m1 = -3.0e38f;
#pragma unroll
            for (int q = 0; q < 8; ++q) if (q != i0 && el[q] > m1) { m1 = el[q]; i1 = q; }
            const float p1 = expf(m1 - m0); const float w0 = gp / (1.f + p1), w1 = gp * p1 / (1.f + p1);
            if (lane == 0 && !dummy) {
                unsigned* cnt = (unsigned*)(ws + WS_CTL) + CW_CNT + l * 32; int* LT = (int*)(ws + WS_LISTT); float* LW = (float*)(ws + WS_LISTW);
                const int e0 = gi * 8 + i0, e1 = gi * 8 + i1;
                const unsigned p0 = atomicAdd(cnt + e0, 1u); LT[(size_t)e0 * NTOK + p0] = row * 2; LW[(size_t)e0 * NTOK + p0] = w0;
                const unsigned q1 = atomicAdd(cnt + e1, 1u); LT[(size_t)e1 * NTOK + q1] = row * 2 + 1; LW[(size_t)e1 * NTOK + q1] = w1;
            }
        }
    }
}

__device__ __forceinline__ void moe_table(const Params& p, int l, int* tstart, int* cntl) {
    __syncthreads();
    if (TID() == 0) { const unsigned* cnt = (const unsigned*)(p.ws + WS_CTL) + CW_CNT + l * 32; int s = 0;
        for (int e = 0; e < 32; ++e) { const int c = (int)__hip_atomic_load(cnt + e, __ATOMIC_RELAXED, __HIP_MEMORY_SCOPE_AGENT); cntl[e] = c; tstart[e] = s; s += (c + 255) >> 8; } tstart[32] = s; }
    __syncthreads();
}

__device__ __forceinline__ void phase_moe(const Params& p, int l, unsigned char* smem, int which  ) {
    unsigned char* ws = p.ws;
    int* tstart = (int*)(smem + LDS_BYTES - 1024); int* cntl = tstart + 40;
    moe_table(p, l, tstart, cntl);
    if (which == 0) { SchedMoe S{tstart, cntl, (const int*)(ws + WS_LISTT), (const float*)(ws + WS_LISTW), (const bf16*)(ws + WS_XB), (const bf16*)(ws + W_GU), 0};
        EpiMoe1 E{(bf16*)(ws + WS_H)}; gemm_run<true>(smem, S, 1024, 1024, 1024, E); }
    else { SchedMoe S{tstart, cntl, (const int*)(ws + WS_LISTT), (const float*)(ws + WS_LISTW), (const bf16*)(ws + WS_H), (const bf16*)(ws + W_DN), 1};
        EpiMoe2 E{(bf16*)(ws + WS_CT)}; gemm_run(smem, S, 256, 256, 256, E); }
}

constexpr int LDS_PARAMS = LDS_BYTES - 512;
#define GETP const Params& p = *(const Params*)(smem + LDS_PARAMS); unsigned char* ws = p.ws; (void)ws
#ifndef PROBE_REP
#define PROBE_REP 0
#endif
#ifndef FULL_MASK
#define FULL_MASK 0x3fffu
#endif
#ifndef PHASE_ATTR
#define PHASE_ATTR __forceinline__
#endif
__device__ PHASE_ATTR void ph_conv(unsigned char* smem, int l, size_t dshift = 0) { GETP; phase_conv(p, l, smem, dshift); }
__device__ PHASE_ATTR void ph_pre(unsigned char* smem) { GETP; phase_pre(p); }
__device__ PHASE_ATTR void ph_g1(unsigned char* smem, int l) { GETP;
    { SchedGrid S{(const bf16*)(ws + WS_XB), (const bf16*)(ws + W_IN), 1024, 10, 640, 0, 0}; EpiBf16Store E{(bf16*)(ws + WS_Y), YW, 1.f}; gemm_run(smem, S, 1024, 1024, 1024, E); }
    { SchedGrid S{(const bf16*)(ws + WS_MEMB), (const bf16*)(ws + W_XKV), 1024, 8, 64, 128, 0}; EpiKVX E{(bf16*)(ws + WS_KVX), (bf16*)(ws + WS_KVX + 4 * MiB)}; gemm_run(smem, S, 1024, 1024, 1024, E); }
}
__device__ PHASE_ATTR void ph_loc(unsigned char* smem, int l) { GETP; phase_loc(p, l, smem); }
__device__ PHASE_ATTR void ph_scan(unsigned char* smem, int l, int part = 3  ) { GETP;
    if (part & 1) {
    { SchedGrid S{(const bf16*)(ws + WS_Y), (const bf16*)(ws + W_Q), 256, 3, 192, 0, Y_CQ};
      EpiMlaQ E{(bf16*)(ws + WS_QP), (const float*)(ws + WS_RS), (const float*)(ws + WS_ROPE)}; gemm_run(smem, S, 256, YW, 256, E); }
    { SchedGrid S{(const bf16*)(ws + WS_Y), (const bf16*)(ws + W_KV), 256, 5, 320, 64, Y_T9};
      EpiMlaKV E{(bf16*)(ws + WS_KP), (bf16*)(ws + WS_VP), (const float*)(ws + WS_RS), (const float*)(ws + WS_ROPE)}; gemm_run(smem, S, 256, YW, 256, E); }
    }
    if (part & 2) phase_scan(p, l);
    if (part & 4) phase_scan(p, l, 1);
}
__device__ PHASE_ATTR void ph_mix(unsigned char* smem, int l) { GETP; phase_mix(p, l, smem); }
__device__ PHASE_ATTR void ph_g4(unsigned char* smem, int l, int dummy = 0) { GETP;
    SchedGrid S{(const bf16*)(ws + WS_XB), (const bf16*)(ws + W_OUT), 1024, 4, 256, 0, 0}; EpiResid E{l == 0 ? p.in[0] : p.out, dummy ? (float*)(ws + WS_CT) : p.out}; gemm_run(smem, S, 1024, 1024, 1024, E);
}
__device__ PHASE_ATTR void ph_ln(unsigned char* smem, int l, int which, int dummy = 0) { GETP; phase_ln(p, l, which, dummy); }
__device__ PHASE_ATTR void ph_g5(unsigned char* smem, int l) { GETP;
    SchedGrid S{(const bf16*)(ws + WS_XB), (const bf16*)(ws + W_XQ), 1024, 4, 256, 0, 0}; EpiBf16Store E{(bf16*)(ws + WS_QX), DM, XSCALE}; gemm_run(smem, S, 1024, 1024, 1024, E);
}
__device__ PHASE_ATTR void ph_xatt(unsigned char* smem, int l) { GETP;
    const bf16* QX = (const bf16*)(ws + WS_QX); const bf16* KX = (const bf16*)(ws + WS_KVX); const bf16* VXT = (const bf16*)(ws + WS_KVX + 4 * MiB); bf16* OX = (bf16*)(ws + WS_OX);
    for (int L = BID(); L < 512; L += GRD()) { const int u = xcd_remap(L, 512), b = u >> 6, h = (u >> 4) & 3, qt = u & 15;
        attn_mfma_unit<256, 256, 1>(smem, QX + (size_t)(b * SEQ + qt * 128) * DM + h * 256, DM, KX + (size_t)(b * 256) * 1024 + h * 256, 1024, VXT + (size_t)((b * 4 + h) * 256) * 256, 256, 4, 4,
                                    OX + (size_t)(b * SEQ + qt * 128) * DM + h * 256, DM); }
}
__device__ PHASE_ATTR void ph_g7(unsigned char* smem, int l, int dummy = 0) { GETP;
    SchedGrid S{(const bf16*)(ws + WS_OX), (const bf16*)(ws + W_XO), 1024, 4, 256, 0, 0}; EpiResidB E{(const bf16*)(ws + WS_XB), dummy ? (float*)(ws + WS_CT) : p.out}; gemm_run(smem, S, 1024, 1024, 1024, E);
}
__device__ PHASE_ATTR void ph_moe(unsigned char* smem, int l, int which) { GETP; phase_moe(p, l, smem, which); }

template <unsigned MASK>
__global__ void __launch_bounds__(512, 2) fwd(Params pk) {
    extern __shared__ __attribute__((aligned(16))) unsigned char smem[];
    { const unsigned* src = (const unsigned*)&pk; unsigned* dst = (unsigned*)(smem + LDS_PARAMS); for (int i = threadIdx.x; i < (int)(sizeof(Params) / 4); i += 512) dst[i] = src[i]; }
    unsigned char* ws = pk.ws;
    volatile LAS unsigned* barw = (volatile LAS unsigned*)((LAS unsigned char*)smem + LDS_BARW);
    if (threadIdx.x == 0) { barw[0] = 0u; barw[1] = 0u; }
    __syncthreads();
    XcdBarrier bar; bar.bar = (unsigned*)(ws + WS_CTL) + CW_BAR; bar.x = 0; bar.st = barw;
    const int lo = pk.ph_lo, hi = pk.ph_hi;
    const bool multi = (hi - lo) > 1;
    if (multi) bar = xcd_barrier_post((unsigned*)(ws + WS_CTL) + CW_BAR, barw);
    if (lo == 0) ph_pre(smem);
#pragma unroll 1
    for (int l = 0; l < 2; ++l) {
        const int base = l * NPH;
#define IN(k) (((MASK >> (k)) & 1u) != 0u && lo <= base + (k) && base + (k) < hi)
#define SEAM(k) do { if (base + (k) + 1 < hi) { xcd_barrier(bar); if ((PROBE_REP >> 20) & 1) xcd_barrier(bar); } } while (0)
#if PROBE_REP
#define REP(k) int _nr##k = ((PROBE_REP >> (k)) & 1) ? 2 : 1; asm volatile("" : "+s"(_nr##k)); for (int _r = 0; _r < _nr##k; ++_r)
#else
#define REP(k)
#endif
        if (IN(PH_CONV)) { ph_conv(smem, l);
#if PROBE_REP
            if ((PROBE_REP >> PH_CONV) & 1) ph_conv(smem, 1 - l, WS_Y - W_IN);
            if ((PROBE_REP >> 21) & 1) ph_pre(smem);
#endif
            SEAM(PH_CONV); }
        if (IN(PH_G1)) { REP(PH_G1) { ph_g1(smem, l); } SEAM(PH_G1); }
        if (IN(PH_LOC)) { REP(PH_LOC) { ph_loc(smem, l); } SEAM(PH_LOC); }
        if (IN(PH_SCAN)) { ph_scan(smem, l);
#if PROBE_REP
            if ((PROBE_REP >> PH_SCAN) & 1) ph_scan(smem, l, 1);
            if ((PROBE_REP >> 22) & 1) { __syncthreads(); ph_scan(smem, l, 4); }
#endif
            SEAM(PH_SCAN); }
        if (IN(PH_MIX)) { REP(PH_MIX) { ph_mix(smem, l); } SEAM(PH_MIX); }
        if (IN(PH_G4)) { ph_g4(smem, l);
#if PROBE_REP
            if ((PROBE_REP >> PH_G4) & 1) ph_g4(smem, l, 1);
#endif
            SEAM(PH_G4); }
        if (IN(PH_LN1)) { ph_ln(smem, l, 0);
#if PROBE_REP
            if ((PROBE_REP >> PH_LN1) & 1) { __syncthreads(); ph_ln(smem, l, 0, 1); }
#endif
            SEAM(PH_LN1); }
        if (IN(PH_G5)) { REP(PH_G5) { ph_g5(smem, l); } SEAM(PH_G5); }
        if (IN(PH_XATT)) { REP(PH_XATT) { ph_xatt(smem, l); } SEAM(PH_XATT); }
        if (IN(PH_G7)) { ph_g7(smem, l);
#if PROBE_REP
            if ((PROBE_REP >> PH_G7) & 1) ph_g7(smem, l, 1);
#endif
            SEAM(PH_G7); }
        if (IN(PH_LN2)) { ph_ln(smem, l, 1);
#if PROBE_REP
            if ((PROBE_REP >> PH_LN2) & 1) { __syncthreads(); ph_ln(smem, l, 1, 1); }
#endif
            SEAM(PH_LN2); }
        if (IN(PH_MOE1)) { REP(PH_MOE1) { ph_moe(smem, l, 0); } SEAM(PH_MOE1); }
        if (IN(PH_MOE2)) { REP(PH_MOE2) { ph_moe(smem, l, 1); } SEAM(PH_MOE2); }
        if (IN(PH_LN3)) { ph_ln(smem, l, 2);
#if PROBE_REP
            if ((PROBE_REP >> PH_LN3) & 1) { __syncthreads(); ph_ln(smem, l, 2, 1); }
#endif
            SEAM(PH_LN3); }
#undef IN
#undef SEAM
#undef REP
    }
}

extern "C" void kernel_launch(void* const* d_in, const int* in_sizes, int n_in, void* d_out, int out_size, void* d_ws, size_t ws_size, hipStream_t stream) {
    static int grid = 0;
    typedef void (*kfn_t)(Params);
#if N_LAUNCH_MODE == 1
    static const kfn_t kfn[NPH] = { fwd<1u << 0>, fwd<1u << 1>, fwd<1u << 2>, fwd<1u << 3>, fwd<1u << 4>, fwd<1u << 5>, fwd<1u << 6>, fwd<1u << 7>, fwd<1u << 8>, fwd<1u << 9>, fwd<1u << 10>, fwd<1u << 11>, fwd<1u << 12>, fwd<1u << 13> };
    constexpr int NK = NPH;
#else
    static const kfn_t kfn[1] = { fwd<FULL_MASK> };
    constexpr int NK = 1;
#endif
    if (grid == 0) {
        int dev = 0, cus = 0;
        if (n_in != 32 || out_size != NTOK * DM || ws_size < WS_TOTAL) { fprintf(stderr, "kernel_launch: unexpected shapes (n_in %d out %d ws %zu need %zu)\n", n_in, out_size, ws_size, (size_t)WS_TOTAL); }
        (void)hipGetDevice(&dev); (void)hipDeviceGetAttribute(&cus, hipDeviceAttributeMultiprocessorCount, dev);
        for (int i = 0; i < NK; ++i) (void)hipFuncSetAttribute((const void*)kfn[i], hipFuncAttributeMaxDynamicSharedMemorySize, LDS_BYTES);
        int per_cu = 0; (void)hipOccupancyMaxActiveBlocksPerMultiprocessor(&per_cu, (const void*)kfn[0], 512, LDS_BYTES);
        (void)hipGetLastError();
        grid = cus > 0 ? cus : 256;
    }
    (void)hipMemsetAsync((char*)d_ws + WS_CTL, 0, CTL_BYTES, stream);
    Params p{};
    for (int i = 0; i < 32; ++i) p.in[i] = (const float*)d_in[i];
    p.out = (float*)d_out; p.ws = (unsigned char*)d_ws;
#if N_LAUNCH_MODE == 1
    for (int ph = 0; ph < 2 * NPH; ++ph) { p.ph_lo = ph; p.ph_hi = ph + 1; hipLaunchKernelGGL(kfn[ph % NPH], dim3(grid), dim3(512), LDS_BYTES, stream, p); }
#else
    p.ph_lo = 0; p.ph_hi = 2 * NPH; hipLaunchKernelGGL(kfn[0], dim3(grid), dim3(512), LDS_BYTES, stream, p);
#endif
}
```

```cpp
#include <hip/hip_runtime.h>
#include <stdint.h>
#include <stdio.h>

#ifndef N_LAUNCH_MODE
#define N_LAUNCH_MODE 0
#endif

typedef unsigned short bf16;
typedef float f32x4 __attribute__((ext_vector_type(4)));
typedef unsigned u32x4 __attribute__((ext_vector_type(4)));
typedef unsigned u32x2 __attribute__((ext_vector_type(2)));
#define LAS __attribute__((address_space(3)))

constexpr int NTOK = 16384, DM = 1024, SEQ = 2048, NBATCH = 8, YW = 2560, NCH = 32;
constexpr int Y_GQ = 0, Y_GK = 256, Y_GV = 512, Y_GR = 768, Y_MQ = 1024, Y_MK = 1280, Y_MV = 1536, Y_MO = 1792, Y_CQ = 2048, Y_T9 = 2304,
              Y_A = 2304, Y_MI = 2320, Y_MF = 2324, Y_CKV = 2328, Y_KR = 2456;
constexpr float ALPHA = 1.41421356237309515f;
constexpr float LN_EPS = 1e-5f;
constexpr float LOG2E = 1.44269504088896341f;
constexpr float QSCALE = 0.10206207261596575f * LOG2E;
constexpr float XSCALE = 0.0625f * LOG2E;
constexpr int NPH = 14;
enum { PH_CONV = 0, PH_G1, PH_LOC, PH_SCAN, PH_MIX, PH_G4, PH_LN1, PH_G5, PH_XATT, PH_G7, PH_LN2, PH_MOE1, PH_MOE2, PH_LN3 };

constexpr size_t MiB = 1u << 20;
constexpr size_t WS_CTL = 0, CTL_BYTES = 1 * MiB;
constexpr size_t W_IN = 1 * MiB;
constexpr size_t W_Q = W_IN + (size_t)2560 * 1024 * 2;
constexpr size_t W_KV = W_Q + (size_t)768 * 256 * 2;
constexpr size_t W_OUT = W_KV + (size_t)1280 * 256 * 2;
constexpr size_t W_XQ = W_OUT + 2 * MiB;
constexpr size_t W_XKV = W_XQ + 2 * MiB;
constexpr size_t W_XO = W_XKV + 4 * MiB;
constexpr size_t W_GU = W_XO + 2 * MiB;
constexpr size_t W_DN = W_GU + 32 * MiB;
constexpr size_t W_END = W_DN + 16 * MiB;
constexpr size_t WS_XB = W_END;
constexpr size_t WS_MEMB = WS_XB + 32 * MiB;
constexpr size_t WS_KVX = WS_MEMB + 4 * MiB;
constexpr size_t WS_ROPE = WS_KVX + 8 * MiB;
constexpr size_t WS_RS = WS_ROPE + 2 * MiB;
constexpr size_t WS_LISTT = WS_RS + 128 * 1024;
constexpr size_t WS_LISTW = WS_LISTT + 2 * MiB;
constexpr size_t WS_NV = WS_LISTW + 2 * MiB;
constexpr size_t WS_DEC = WS_NV + 256 * 1024;
constexpr size_t WS_SC = WS_DEC + 256 * 1024;
constexpr size_t WS_MS = WS_SC + 8 * 1024;
constexpr size_t WS_BC = WS_MS + 8 * 1024;
constexpr size_t WS_QKC = WS_BC + 16 * MiB;
constexpr size_t WS_Y = WS_QKC + 16 * MiB;
constexpr size_t WS_QX = WS_Y, WS_OX = WS_Y + 32 * MiB, WS_H = WS_Y;
constexpr size_t WS_QP = WS_Y + 80 * MiB;
constexpr size_t WS_KP = WS_QP + 24 * MiB;
constexpr size_t WS_VP = WS_KP + 24 * MiB;
constexpr size_t WS_ST = WS_VP + 16 * MiB;
constexpr size_t WS_CT = WS_QP;
constexpr size_t WS_TOTAL = WS_ST + 32 * MiB;
static_assert(WS_TOTAL <= (size_t)342000000, "workspace budget");
constexpr int CW_BAR = 4096;
constexpr int CW_CNT = 16384;

constexpr int LDS_BYTES = 147456;
constexpr int LDS_BARW = LDS_BYTES - 16;

struct Params {
    const float* in[32];
    float* out;
    unsigned char* ws;
    int ph_lo, ph_hi;
};

__device__ __forceinline__ float bf2f(unsigned v) { return __uint_as_float(v << 16); }
__device__ __forceinline__ unsigned f2bf(float f) { unsigned u = __float_as_uint(f); return (u + 0x7fffu + ((u >> 16) & 1u)) >> 16; }
typedef float f32x2_t __attribute__((ext_vector_type(2)));
typedef __bf16 bf16x2_t __attribute__((ext_vector_type(2)));
__device__ __forceinline__ unsigned pk2(float lo, float hi) { return __builtin_bit_cast(unsigned, __builtin_convertvector((f32x2_t){lo, hi}, bf16x2_t)); }
__device__ __forceinline__ float blo(unsigned w) { return __uint_as_float(w << 16); }
__device__ __forceinline__ float bhi(unsigned w) { return __uint_as_float(w & 0xffff0000u); }
__device__ __forceinline__ float wave_sum(float v) {
#pragma unroll
    for (int o = 1; o < 64; o <<= 1) v += __shfl_xor(v, o);
    return v;
}
__device__ __forceinline__ float logsigmoid(float z) { return fminf(z, 0.f) - log1pf(expf(-fabsf(z))); }
__device__ __forceinline__ float fexp(float x) { return __builtin_amdgcn_exp2f(x * LOG2E); }
__device__ __forceinline__ float sigmoidf(float x) { return __builtin_amdgcn_rcpf(1.f + fexp(-x)); }
__device__ __forceinline__ float siluf(float x) { return x * __builtin_amdgcn_rcpf(1.f + fexp(-x)); }
__device__ __forceinline__ f32x4 up4q(u32x2 w) { return (f32x4){blo(w.x), bhi(w.x), blo(w.y), bhi(w.y)}; }
__device__ __forceinline__ void st_bf4(bf16* p, f32x4 v) { u32x2 w; w.x = pk2(v[0], v[1]); w.y = pk2(v[2], v[3]); *(u32x2*)p = w; }

#define XB_TMO      128
#define XB_XCNT(j)  (256  + 64 * (j))
#define XB_XSUB(j)  (1280 + 64 * (j))
#define XB_XGEN(j)  (2304 + 64 * (j))
#define XB_TOP      3328
#define XB_TOPGEN   3392
#define XCD_BAR_WORDS 3456
#define XB_SPIN_CAP (1u << 24)
__device__ __forceinline__ unsigned xb_ld(unsigned* p)              { return __hip_atomic_load(p, __ATOMIC_RELAXED, __HIP_MEMORY_SCOPE_AGENT); }
__device__ __forceinline__ unsigned xb_add(unsigned* p, unsigned v) { return __hip_atomic_fetch_add(p, v, __ATOMIC_RELAXED, __HIP_MEMORY_SCOPE_AGENT); }
__device__ __forceinline__ unsigned xb_xcc_id() { return (unsigned)__builtin_amdgcn_s_getreg((3 << 11) | 20) & 0xFu; }
#define XB_SPIN(cond, bar) do { unsigned _sp = 0; while (cond) { __builtin_amdgcn_s_sleep(1); \
    if ((++_sp & 255u) == 0u) { if (xb_ld(&(bar)[XB_TMO])) break; if (_sp > XB_SPIN_CAP) { atomicAdd(&(bar)[XB_TMO], 1u); break; } } } } while (0)
struct XcdBarrier { unsigned* bar; unsigned x; volatile LAS unsigned* st; };
__device__ __forceinline__ XcdBarrier xcd_barrier_post(unsigned* bar, volatile LAS unsigned* st) {
    XcdBarrier b; b.bar = bar; b.x = xb_xcc_id(); b.st = st;
    if (threadIdx.x == 0) (void)xb_add(&bar[XB_XCNT(b.x)], 1u);
    return b;
}
__device__ __forceinline__ void xcd_barrier_complete(unsigned* bar, unsigned x, unsigned& nloc, unsigned& nx) {
    const unsigned G = gridDim.x * gridDim.y * gridDim.z;
    unsigned sum, cnt, mine, sp = 0u;
    for (;;) {
        sum = 0u; cnt = 0u; mine = 0u;
#pragma unroll
        for (unsigned j = 0; j < 16; ++j) { const unsigned c = xb_ld(&bar[XB_XCNT(j)]); sum += c; cnt += (c > 0u) ? 1u : 0u; mine = (j == x) ? c : mine; }
        if (sum == G) break;
        __builtin_amdgcn_s_sleep(1);
        if ((++sp & 255u) == 0u) { if (xb_ld(&bar[XB_TMO])) break; if (sp > XB_SPIN_CAP) { atomicAdd(&bar[XB_TMO], 1u); break; } }
    }
    nloc = mine > 0u ? mine : 1u; nx = cnt > 0u ? cnt : 1u;
}
__device__ __forceinline__ void xcd_barrier(const XcdBarrier& b) {
    asm volatile("s_waitcnt vmcnt(0)" ::: "memory");
    __syncthreads();
    if (threadIdx.x == 0) {
        unsigned* bar = b.bar; asm volatile("" : "+s"(bar));
        __builtin_amdgcn_s_waitcnt(0);
        unsigned nloc = b.st[0], nx = b.st[1];
        if (nloc == 0u) { xcd_barrier_complete(bar, b.x, nloc, nx); b.st[0] = nloc; b.st[1] = nx; }
        const unsigned old = xb_add(&bar[XB_XSUB(b.x)], 1u);
        const unsigned gen = old / nloc;
        if (old + 1u == (gen + 1u) * nloc) {
            __builtin_amdgcn_fence(__ATOMIC_RELEASE, "agent");
            asm volatile("s_waitcnt vmcnt(0)" ::: "memory");
            const unsigned og = xb_add(&bar[XB_TOP], 1u);
            const unsigned tg = og / nx;
            if (og + 1u == (tg + 1u) * nx) xb_add(&bar[XB_TOPGEN], 1u);
            else XB_SPIN(xb_ld(&bar[XB_TOPGEN]) == tg, bar);
            __builtin_amdgcn_fence(__ATOMIC_ACQUIRE, "agent");
            xb_add(&bar[XB_XGEN(b.x)], 1u);
            asm volatile("s_waitcnt vmcnt(0)" ::: "memory");
        } else {
            XB_SPIN(xb_ld(&bar[XB_XGEN(b.x)]) == gen, bar);
            __builtin_amdgcn_fence(__ATOMIC_ACQUIRE, "agent");
            asm volatile("s_waitcnt vmcnt(0)" ::: "memory");
        }
    }
    __syncthreads();
}

__device__ __forceinline__ int TID() { int t = threadIdx.x; asm volatile("" : "+v"(t)); return t; }
__device__ __forceinline__ int BID() { int t = blockIdx.x; asm volatile("" : "+s"(t)); return t; }
__device__ __forceinline__ int GRD() { int t = gridDim.x; asm volatile("" : "+s"(t)); return t; }

struct UnitDesc {
    const bf16* A;
    const bf16* B;
    const int* ridx;
    const float* rw;
    int arow0, acol;
    int row0, col0;
    int nvalid;
    int gather;
};

struct NoPre {};
struct EpiBf16Store { bf16* O; int ldo; float scale; typedef NoPre Pre;
    __device__ __forceinline__ Pre pre(const UnitDesc&, int, int) const { return Pre{}; }
    __device__ __forceinline__ void post(const UnitDesc& u, int r, int c, const Pre&, f32x4 v00, f32x4 v01, f32x4 v10, f32x4 v11) const {
        bf16* o = O + (size_t)(u.row0 + r) * ldo + u.col0 + c; st_bf4(o, v00 * scale); st_bf4(o + 16, v01 * scale); st_bf4(o + 128, v10 * scale); st_bf4(o + 144, v11 * scale); } };
struct EpiKVX { bf16* KX; bf16* VXT; typedef NoPre Pre;
    __device__ __forceinline__ Pre pre(const UnitDesc&, int, int) const { return Pre{}; }
    __device__ __forceinline__ void grp(int row, int c, f32x4 v) const {
        if (c < 1024) st_bf4(KX + (size_t)row * 1024 + c, v);
        else { const int cc = c - 1024, b = row >> 8, key = row & 255; bf16* vt = VXT + ((size_t)(b * 1024 + cc)) * 256 + key;
            vt[0] = (bf16)f2bf(v[0]); vt[256] = (bf16)f2bf(v[1]); vt[512] = (bf16)f2bf(v[2]); vt[768] = (bf16)f2bf(v[3]); } }
    __device__ __forceinline__ void post(const UnitDesc& u, int r, int c, const Pre&, f32x4 v00, f32x4 v01, f32x4 v10, f32x4 v11) const {
        const int row = u.row0 + r, cc = u.col0 + c; grp(row, cc, v00); grp(row, cc + 16, v01); grp(row, cc + 128, v10); grp(row, cc + 144, v11); } };
struct EpiResidB { const bf16* res; float* out;
    struct Pre { u32x2 a, b, c, d; };
    __device__ __forceinline__ Pre pre(const UnitDesc& u, int r, int c) const { const bf16* p = res + (size_t)(u.row0 + r) * DM + u.col0 + c;
        return Pre{*(const u32x2*)p, *(const u32x2*)(p + 16), *(const u32x2*)(p + 128), *(const u32x2*)(p + 144)}; }
    __device__ __forceinline__ void post(const UnitDesc& u, int r, int c, const Pre& pr, f32x4 v00, f32x4 v01, f32x4 v10, f32x4 v11) const {
        float* o = out + (size_t)(u.row0 + r) * DM + u.col0 + c;
        *(f32x4*)o = up4q(pr.a) * ALPHA + v00; *(f32x4*)(o + 16) = up4q(pr.b) * ALPHA + v01; *(f32x4*)(o + 128) = up4q(pr.c) * ALPHA + v10; *(f32x4*)(o + 144) = up4q(pr.d) * ALPHA + v11; } };
struct EpiResid { const float* res; float* out;
    struct Pre { f32x4 a, b, c, d; };
    __device__ __forceinline__ Pre pre(const UnitDesc& u, int r, int c) const { const float* p = res + (size_t)(u.row0 + r) * DM + u.col0 + c;
        return Pre{*(const f32x4*)p, *(const f32x4*)(p + 16), *(const f32x4*)(p + 128), *(const f32x4*)(p + 144)}; }
    __device__ __forceinline__ void post(const UnitDesc& u, int r, int c, const Pre& pr, f32x4 v00, f32x4 v01, f32x4 v10, f32x4 v11) const {
        float* o = out + (size_t)(u.row0 + r) * DM + u.col0 + c;
        *(f32x4*)o = pr.a * ALPHA + v00; *(f32x4*)(o + 16) = pr.b * ALPHA + v01; *(f32x4*)(o + 128) = pr.c * ALPHA + v10; *(f32x4*)(o + 144) = pr.d * ALPHA + v11; } };
__device__ __forceinline__ f32x4 rot4(f32x4 v, f32x4 cs) { return (f32x4){v[0] * cs[0] - v[1] * cs[1], v[1] * cs[0] + v[0] * cs[1], v[2] * cs[2] - v[3] * cs[3], v[3] * cs[2] + v[2] * cs[3]}; }
struct EpiMlaQ { bf16* QP; const float* RS; const float* ROPE;
    struct Pre { float rs; f32x4 cs[4]; };
    __device__ __forceinline__ Pre pre(const UnitDesc& u, int r, int c) const { const int row = u.row0 + r; Pre p; p.rs = RS[row * 2] * QSCALE;
#pragma unroll
        for (int k = 0; k < 4; ++k) { const int cc = u.col0 + c + (k >> 1) * 128 + (k & 1) * 16, j = cc % 96, i = (j >= 64 ? j - 64 : 0) >> 1; p.cs[k] = *(const f32x4*)(ROPE + ((size_t)row * 16 + i) * 2); }
        return p; }
    __device__ __forceinline__ void grp(int row, int c, f32x4 v, float rs, f32x4 cs) const {
        const int b = row >> 11, s = row & 2047, h = c / 96, j = c - h * 96;
        v = v * rs; if (j >= 64) v = rot4(v, cs);
        st_bf4(QP + ((size_t)((b * 8 + h) * SEQ + s)) * 96 + j, v); }
    __device__ __forceinline__ void post(const UnitDesc& u, int r, int c, const Pre& pr, f32x4 v00, f32x4 v01, f32x4 v10, f32x4 v11) const {
        const int row = u.row0 + r, cc = u.col0 + c; grp(row, cc, v00, pr.rs, pr.cs[0]); grp(row, cc + 16, v01, pr.rs, pr.cs[1]); grp(row, cc + 128, v10, pr.rs, pr.cs[2]); grp(row, cc + 144, v11, pr.rs, pr.cs[3]); } };
struct EpiMlaKV { bf16 *KP, *VP; const float* RS; const float* ROPE;
    struct Pre { float rs; f32x4 cs[4]; };
    __device__ __forceinline__ Pre pre(const UnitDesc& u, int r, int c) const { const int row = u.row0 + r; Pre p; p.rs = RS[row * 2 + 1];
#pragma unroll
        for (int k = 0; k < 4; ++k) { const int cc = u.col0 + c + (k >> 1) * 128 + (k & 1) * 16, j = cc % 160, i = ((j >= 64 && j < 96) ? j - 64 : 0) >> 1; p.cs[k] = *(const f32x4*)(ROPE + ((size_t)row * 16 + i) * 2); }
        return p; }
    __device__ __forceinline__ void grp(int row, int c, f32x4 v, float rs, f32x4 cs) const {
        const int b = row >> 11, s = row & 2047, h = c / 160, j = c - h * 160;
        if (j < 64) st_bf4(KP + ((size_t)((b * 8 + h) * SEQ + s)) * 96 + j, v * rs);
        else if (j < 96) st_bf4(KP + ((size_t)((b * 8 + h) * SEQ + s)) * 96 + j, rot4(v, cs));
        else { bf16* vt = VP + ((size_t)((b * 8 + h) * 64 + (j - 96))) * SEQ + s;
            vt[0] = (bf16)f2bf(v[0] * rs); vt[SEQ] = (bf16)f2bf(v[1] * rs); vt[2 * SEQ] = (bf16)f2bf(v[2] * rs); vt[3 * SEQ] = (bf16)f2bf(v[3] * rs); } }
    __device__ __forceinline__ void post(const UnitDesc& u, int r, int c, const Pre& pr, f32x4 v00, f32x4 v01, f32x4 v10, f32x4 v11) const {
        const int row = u.row0 + r, cc = u.col0 + c; grp(row, cc, v00, pr.rs, pr.cs[0]); grp(row, cc + 16, v01, pr.rs, pr.cs[1]); grp(row, cc + 128, v10, pr.rs, pr.cs[2]); grp(row, cc + 144, v11, pr.rs, pr.cs[3]); } };
struct EpiMoe1 { bf16* H; typedef NoPre Pre;
    __device__ __forceinline__ Pre pre(const UnitDesc&, int, int) const { return Pre{}; }
    __device__ __forceinline__ void post(const UnitDesc& u, int r, int c, const Pre&, f32x4 v00, f32x4 v01, f32x4 v10, f32x4 v11) const {
        f32x4 h0, h1;
#pragma unroll
        for (int j = 0; j < 4; ++j) { h0[j] = siluf(v00[j]) * v01[j]; h1[j] = siluf(v10[j]) * v11[j]; }
        bf16* o = H + (size_t)(u.row0 + r) * 256 + u.col0 + (c >> 5) * 16 + (c & 15); st_bf4(o, h0); st_bf4(o + 64, h1); } };
struct EpiMoe2 { bf16* CT;
    struct Pre { int ent; float w; };
    __device__ __forceinline__ Pre pre(const UnitDesc& u, int r, int) const { return Pre{u.ridx[r], u.rw[r]}; }
    __device__ __forceinline__ void post(const UnitDesc& u, int r, int c, const Pre& pr, f32x4 v00, f32x4 v01, f32x4 v10, f32x4 v11) const {
        bf16* o = CT + ((size_t)(pr.ent & 1) * NTOK + (pr.ent >> 1)) * DM + u.col0 + c; st_bf4(o, v00 * pr.w); st_bf4(o + 16, v01 * pr.w); st_bf4(o + 128, v10 * pr.w); st_bf4(o + 144, v11 * pr.w); } };

typedef short bf16x8 __attribute__((ext_vector_type(8)));
namespace mg {
constexpr int BK = 64, HALF = 128, HTB = HALF * BK * 2, STAGE_BYTES = 8 * HTB;
__device__ __forceinline__ int lds_byte(int r, int c) { const int st = (r >> 4) * 2 + (c >> 5), rr = r & 15, cc = c & 31, ob = rr * 64 + cc * 2; return st * 1024 + (ob ^ (((ob >> 9) & 1) << 5)); }
__device__ __forceinline__ void stage_rc(int b, int& R, int& C) { const int st = b / 1024, sb = b % 1024, swz = sb ^ (((sb >> 9) & 1) << 5); R = (st >> 1) * 16 + swz / 64; C = (st & 1) * 32 + (swz % 64) / 2; }

template <bool GATHER, class Sched, class Epi>
__device__ __forceinline__ void gemm_mfma(LAS unsigned char* lds, const Sched& S, const int K, const int lda, const int ldb, const Epi& E) {
    const int tid = TID(), wid = __builtin_amdgcn_readfirstlane(tid >> 6), lane = tid & 63, wr = wid >> 2, wc = wid & 3, fr = lane & 15, fq = lane >> 4;
    const int nt = K / BK;
    unsigned voffB[2], voffA[2];
    { int R0, C0, R1, C1; stage_rc(tid * 16, R0, C0); stage_rc(tid * 16 + 8192, R1, C1); voffB[0] = (unsigned)(R0 * ldb + C0) * 2u; voffB[1] = (unsigned)(R1 * ldb + C1) * 2u;
      voffA[0] = (unsigned)(R0 * lda + C0) * 2u; voffA[1] = (unsigned)(R1 * lda + C1) * 2u; }
    const size_t kstep = (size_t)(BK * 2);
    const size_t hstepB = (size_t)HALF * ldb * 2, hstepA = (size_t)HALF * lda * 2;
    const unsigned ldsw = (unsigned)wid * 1024u;
    const int aoff = lds_byte(wr * 64 + fr, fq * 8), boff = lds_byte(wc * 32 + fr, fq * 8);
#define MG_SA(b, h) (((b) * 2 + (h)) * HTB)
#define MG_SB(b, h) ((4 + (b) * 2 + (h)) * HTB)
#define MG_STAGE(bufoff, gbase, voff) do { _Pragma("unroll") for (int _i = 0; _i < 2; ++_i) \
        __builtin_amdgcn_global_load_lds((const unsigned*)((const char*)(gbase) + (voff)[_i]), (LAS unsigned*)(lds + (bufoff) + ldsw + _i * 8192), 16, 0, 0); } while (0)
#define MG_STA(bufoff, base, h, nx) do { if constexpr (GATHER) { MG_STAGE(bufoff, base, vc[h]); } else { MG_STAGE(bufoff, (base) + (h) * hstepA, voffA); } } while (0)
#define MG_LDA(dst, b, h) do { _Pragma("unroll") for (int m = 0; m < 4; ++m) _Pragma("unroll") for (int k = 0; k < 2; ++k) dst[m][k] = *(const LAS bf16x8*)(lds + MG_SA(b, h) + aoff + m * 2048 + k * 1024); } while (0)
#define MG_LDB(dst, b, h) do { _Pragma("unroll") for (int n = 0; n < 2; ++n) _Pragma("unroll") for (int k = 0; k < 2; ++k) dst[n][k] = *(const LAS bf16x8*)(lds + MG_SB(b, h) + boff + n * 2048 + k * 1024); } while (0)
#define MG_MMA(ai, bj, At, Bt) do { __builtin_amdgcn_s_setprio(1); _Pragma("unroll") for (int m = 0; m < 4; ++m) _Pragma("unroll") for (int n = 0; n < 2; ++n) _Pragma("unroll") for (int k = 0; k < 2; ++k) \
        acc[ai][bj][m][n] = __builtin_amdgcn_mfma_f32_16x16x32_bf16(Bt[n][k], At[m][k], acc[ai][bj][m][n], 0, 0, 0); __builtin_amdgcn_s_setprio(0); } while (0)
#define MG_WAIT_V(n) asm volatile("s_waitcnt vmcnt(" #n ")" ::: "memory")
#define MG_WAIT_L(n) asm volatile("s_waitcnt lgkmcnt(" #n ")" ::: "memory")
#define MG_BAR __builtin_amdgcn_s_barrier()
#define MG_SCHED __builtin_amdgcn_sched_barrier(0)
#define MG_MKOFF(u, v) do { if constexpr (GATHER) { int R0, C0, R1, C1; { const int _t = TID(); stage_rc(_t * 16, R0, C0); stage_rc(_t * 16 + 8192, R1, C1); } _Pragma("unroll") for (int _h = 0; _h < 2; ++_h) { \
        const int _r0 = R0 + 128 * _h, _r1 = R1 + 128 * _h; const int _l = (u).nvalid - 1; const int _a0 = (u).ridx[_r0 < _l ? _r0 : _l] >> 1, _a1 = (u).ridx[_r1 < _l ? _r1 : _l] >> 1; \
        v[_h][0] = ((unsigned)_a0 * (unsigned)lda + (unsigned)C0) * 2u; v[_h][1] = ((unsigned)_a1 * (unsigned)lda + (unsigned)C1) * 2u; } } } while (0)
#define MG_ABASE(u) (GATHER ? (const char*)((u).A + (u).acol) : (const char*)((u).A + (size_t)(u).arow0 * lda + (u).acol))
    UnitDesc cur, nxt; int ui = 0;
    if (!S.get(0, cur)) return;
    f32x4 acc[2][2][4][2];
#pragma unroll
    for (int a = 0; a < 2; ++a)
#pragma unroll
        for (int b = 0; b < 2; ++b)
#pragma unroll
            for (int m = 0; m < 4; ++m)
#pragma unroll
                for (int n = 0; n < 2; ++n) acc[a][b][m][n] = (f32x4){0.f, 0.f, 0.f, 0.f};
    bf16x8 At[4][2], B0[2][2], B1[2][2];
    unsigned vc[2][2];
    MG_MKOFF(cur, vc);
    const char* cA = MG_ABASE(cur); const char* cB = (const char*)cur.B;
    MG_STAGE(MG_SB(0, 0), cB, voffB); MG_STA(MG_SA(0, 0), cA, 0, false); MG_STAGE(MG_SB(0, 1), cB + hstepB, voffB); MG_STA(MG_SA(0, 1), cA, 1, false);
    if (wr == 1) MG_BAR;
    MG_WAIT_V(4); MG_BAR;
    MG_STAGE(MG_SB(1, 0), cB + kstep, voffB); MG_STA(MG_SA(1, 0), cA + kstep, 0, false); MG_STAGE(MG_SB(1, 1), cB + hstepB + kstep, voffB);
    MG_WAIT_V(6); MG_BAR;
    for (;;) {
        const bool has_next = S.get(ui + 1, nxt);
        const char* nA = has_next ? MG_ABASE(nxt) : cA; const char* nB = has_next ? (const char*)nxt.B : cB;
#pragma unroll 1
        for (int t = 0; t < nt; t += 2) {
            const bool last = (t == nt - 2);
            const char* a1 = cA + (size_t)(t + 1) * kstep;
            const char* a2 = last ? nA : cA + (size_t)(t + 2) * kstep; const char* b2 = last ? nB : cB + (size_t)(t + 2) * kstep;
            const char* a3 = a2 + kstep; const char* b3 = b2 + kstep;
            MG_LDB(B0, 0, 0); MG_SCHED; MG_LDA(At, 0, 0); MG_STA(MG_SA(1, 1), a1, 1, false);
            if constexpr (GATHER) { if (last && has_next) { MG_MKOFF(nxt, vc); } }
            MG_WAIT_L(8); MG_BAR; MG_WAIT_L(0); MG_MMA(0, 0, At, B0); MG_BAR; MG_SCHED;
            MG_LDB(B1, 0, 1); MG_STAGE(MG_SB(0, 0), b2, voffB);
            MG_BAR; MG_WAIT_L(0); MG_MMA(0, 1, At, B1); MG_BAR;
            MG_LDA(At, 0, 1); MG_STA(MG_SA(0, 0), a2, 0, last);
            MG_BAR; MG_WAIT_L(0); MG_MMA(1, 0, At, B0); MG_BAR; MG_SCHED;
            MG_STAGE(MG_SB(0, 1), b2 + hstepB, voffB);
            MG_WAIT_V(6); MG_BAR; MG_MMA(1, 1, At, B1); MG_BAR;
            MG_LDB(B0, 1, 0); MG_SCHED; MG_LDA(At, 1, 0); MG_STA(MG_SA(0, 1), a2, 1, last);
            MG_WAIT_L(8); MG_BAR; MG_WAIT_L(0); MG_MMA(0, 0, At, B0); MG_BAR; MG_SCHED;
            MG_LDB(B1, 1, 1); MG_STAGE(MG_SB(1, 0), b3, voffB);
            MG_BAR; MG_WAIT_L(0); MG_MMA(0, 1, At, B1); MG_BAR;
            MG_LDA(At, 1, 1); MG_STA(MG_SA(1, 0), a3, 0, last);
            MG_BAR; MG_WAIT_L(0); MG_MMA(1, 0, At, B0); MG_BAR; MG_SCHED;
            MG_STAGE(MG_SB(1, 1), b3 + hstepB, voffB);
            MG_WAIT_V(6); MG_BAR; MG_MMA(1, 1, At, B1); MG_BAR;
        }
        {
            const int rb = wr * 64 + fr, cb = wc * 32 + 4 * fq;
            typename Epi::Pre pr = E.pre(cur, rb, cb);
#pragma unroll
            for (int gi = 0; gi < 8; ++gi) { const int ai = gi >> 2, m = gi & 3, r = ai * HALF + m * 16 + rb;
                typename Epi::Pre nx = pr;
                if (gi < 7) nx = E.pre(cur, ((gi + 1) >> 2) * HALF + ((gi + 1) & 3) * 16 + rb, cb);
                if (r < cur.nvalid) E.post(cur, r, cb, pr, acc[ai][0][m][0], acc[ai][0][m][1], acc[ai][1][m][0], acc[ai][1][m][1]);
                pr = nx;
                asm volatile("" ::: "memory"); }
        }
        if (!has_next) break;
#pragma unroll
        for (int a = 0; a < 2; ++a)
#pragma unroll
            for (int b = 0; b < 2; ++b)
#pragma unroll
                for (int m = 0; m < 4; ++m)
#pragma unroll
                    for (int n = 0; n < 2; ++n) acc[a][b][m][n] = (f32x4){0.f, 0.f, 0.f, 0.f};
        cur = nxt; cA = nA; cB = nB; ++ui;
    }
    MG_WAIT_V(0);
    if (wr == 0) MG_BAR;
    MG_BAR;
#undef MG_SA
#undef MG_SB
#undef MG_STAGE
#undef MG_LDA
#undef MG_LDB
#undef MG_MMA
#undef MG_WAIT_V
#undef MG_WAIT_L
#undef MG_BAR
#undef MG_SCHED
#undef MG_MKOFF
#undef MG_STA
#undef MG_ABASE
}
}

#ifndef USE_MFMA
#define USE_MFMA 1
#endif
template <bool GATHER = false, class Sched, class Epi>
__device__ __forceinline__ void gemm_run(unsigned char* smem, const Sched& S, int K, int lda, int ldb, const Epi& E) {
#if USE_MFMA
    __syncthreads();
    mg::gemm_mfma<GATHER>((LAS unsigned char*)smem, S, K, lda, ldb, E);
    __syncthreads();
#endif
}
__device__ __forceinline__ int xcd_remap(int L, int n) { const int q = n >> 3, r = n & 7, x = L & 7, off = L >> 3; return (x < r ? x * (q + 1) : r * (q + 1) + (x - r) * q) + off; }
struct SchedGrid { const bf16* A; const bf16* B; int ldb, npn, nunits, rot, acol;
    __device__ __forceinline__ bool get(int i, UnitDesc& u) const {
        const int G = GRD(); const int L = (BID() + rot) % G + i * G; if (L >= nunits) return false;
        const int idx = xcd_remap(L, nunits), npm = nunits / npn, nig = 8 * npn, gid = idx / nig, fm = gid * 8, gsz = (npm - fm) < 8 ? (npm - fm) : 8, w = idx - gid * nig;
        const int pm = fm + w % gsz, pn = w / gsz;
        u.A = A; u.B = B + (size_t)pn * 256 * ldb; u.ridx = nullptr; u.rw = nullptr; u.arow0 = pm * 256; u.acol = acol; u.row0 = pm * 256; u.col0 = pn * 256; u.nvalid = 256; u.gather = 0; return true; } };
struct SchedMoe { const int* tstart; const int* cntl; const int* LT; const float* LW; const bf16* A; const bf16* W; int which;
    __device__ __forceinline__ bool get(int i, UnitDesc& u) const {
        const int ncol = which == 0 ? 2 : 4; const int L = BID() + i * GRD(), nun = __builtin_amdgcn_readfirstlane(tstart[32]) * ncol; if (L >= nun) return false;
        const int idx = xcd_remap(L, nun);
        const int rt = idx / ncol, pn = idx - rt * ncol; int e = 0;
        for (int q = 1; q < 32; ++q) if (__builtin_amdgcn_readfirstlane(tstart[q]) <= rt) e = q;
        const int pos0 = (rt - __builtin_amdgcn_readfirstlane(tstart[e])) * 256; int nv = __builtin_amdgcn_readfirstlane(cntl[e]) - pos0; nv = nv > 256 ? 256 : nv;
        u.ridx = LT + (size_t)e * NTOK + pos0; u.rw = LW + (size_t)e * NTOK + pos0; u.nvalid = nv; u.acol = 0; u.A = A;
        if (which == 0) { u.B = W + ((size_t)e * 512 + pn * 256) * 1024; u.arow0 = 0; u.row0 = rt * 256; u.col0 = pn * 128; u.gather = 1; }
        else { u.B = W + ((size_t)e * 1024 + pn * 256) * 256; u.arow0 = rt * 256; u.row0 = 0; u.col0 = pn * 256; u.gather = 0; }
        return true; } };

template <class F>
__device__ __forceinline__ void conv_item(const F& src, bf16* dst, int K, float* scr, int k0, int n0, int lane) {
#pragma unroll 8
    for (int i = 0; i < 32; ++i) { const int kk = 2 * i + (lane >> 5); scr[kk * 33 + (lane & 31)] = src(k0 + kk, n0 + (lane & 31)); }
    asm volatile("s_waitcnt lgkmcnt(0)" ::: "memory");
    const int c = lane & 7;
#pragma unroll
    for (int j = 0; j < 4; ++j) { const int n = (lane >> 3) + 8 * j; const float* s = scr + (8 * c) * 33 + n;
        u32x4 o; o.x = pk2(s[0 * 33], s[1 * 33]); o.y = pk2(s[2 * 33], s[3 * 33]); o.z = pk2(s[4 * 33], s[5 * 33]); o.w = pk2(s[6 * 33], s[7 * 33]);
        *(u32x4*)(dst + (size_t)(n0 + n) * K + k0 + 8 * c) = o; }
    asm volatile("s_waitcnt lgkmcnt(0)" ::: "memory");
}
template <class F4>
__device__ __forceinline__ void conv_item4(const F4& src4, bf16* dst, int K, float* scr, int k0, int n0, int lane) {
    f32x4 v[16];
#pragma unroll
    for (int i = 0; i < 16; ++i) v[i] = src4(k0 + i * 4 + (lane >> 4), n0 + (lane & 15) * 4);
#pragma unroll
    for (int i = 0; i < 16; ++i) { float* d = scr + (i * 4 + (lane >> 4)) * 65 + (lane & 15) * 4; d[0] = v[i][0]; d[1] = v[i][1]; d[2] = v[i][2]; d[3] = v[i][3]; }
    asm volatile("s_waitcnt lgkmcnt(0)" ::: "memory");
    const int c = lane & 7;
#pragma unroll
    for (int j = 0; j < 8; ++j) { const int n = j * 8 + (lane >> 3); const float* s = scr + (8 * c) * 65 + n;
        u32x4 o; o.x = pk2(s[0 * 65], s[1 * 65]); o.y = pk2(s[2 * 65], s[3 * 65]); o.z = pk2(s[4 * 65], s[5 * 65]); o.w = pk2(s[6 * 65], s[7 * 65]);
        *(u32x4*)(dst + (size_t)(n0 + n) * K + k0 + 8 * c) = o; }
    asm volatile("s_waitcnt lgkmcnt(0)" ::: "memory");
}
__device__ __forceinline__ int yc_src(int n) {
    if (n < 1024) return n;
    if (n < 2048) return n + 16;
    if (n < 2304) return n + 24;
    if (n < 2320) return 1024 + (n - 2304);
    if (n < 2328) return 2064 + (n - 2320);
    if (n < 2488) return n;
    return -1;
}

__device__ __forceinline__ void phase_conv(const Params& p, int l, unsigned char* smem, size_t dshift = 0  ) {
    const int tid = TID(), lane = tid & 63, wave = __builtin_amdgcn_readfirstlane(tid >> 6);
    const int gw = BID() * 8 + wave, NGW = GRD() * 8;
    float* scr = (float*)(smem + wave * 18304);
    unsigned char* ws = p.ws + dshift;
    const float* w_in = p.in[3] + (size_t)l * 1024 * 2488;
    const float* w_out = p.in[4] + (size_t)l * 1024 * 1024;
    const float* gq = p.in[12] + l * 256; const float* w_uq = p.in[13] + (size_t)l * 256 * 768;
    const float* gkv = p.in[14] + l * 128; const float* w_ukv = p.in[15] + (size_t)l * 128 * 1024;
    const float* xwq = p.in[16] + (size_t)l * 1024 * 1024; const float* xwkv = p.in[17] + (size_t)l * 1024 * 2048; const float* xwo = p.in[18] + (size_t)l * 1024 * 1024;
    const float* wg = p.in[23] + (size_t)l * 32 * 1024 * 256; const float* wu = p.in[24] + (size_t)l * 32 * 1024 * 256; const float* wd = p.in[25] + (size_t)l * 32 * 256 * 1024;
    constexpr int I_IN = 16 * 40, I_Q = 4 * 24, I_KV = 4 * 40, I_SQ = 16 * 16, I_XKV = 16 * 32, I_GU = 32 * 16 * 8, I_DN = 32 * 4 * 16;
    constexpr int NIT = I_GU + I_DN + I_IN + 3 * I_SQ + I_XKV + I_Q + I_KV;
    const f32x4 z4 = {0.f, 0.f, 0.f, 0.f};
    for (int it = gw; it < NIT; it += NGW) {
        int r = it;
        if (r < I_GU) { const int e = r >> 7, q = r & 127, kb = q >> 3, nb = q & 7; const float* G = wg + (size_t)e * 1024 * 256; const float* U = wu + (size_t)e * 1024 * 256;
            conv_item4([&](int k, int n) { const int j = (n >> 5) * 16 + (n & 15); return *(const f32x4*)((((n >> 4) & 1) ? U : G) + (size_t)k * 256 + j); },
                       (bf16*)(ws + W_GU) + (size_t)e * 512 * 1024, 1024, scr, kb * 64, nb * 64, lane); continue; }
        r -= I_GU;
        if (r < I_DN) { const int e = r >> 6, q = r & 63, kb = q >> 4, nb = q & 15; const float* Dn = wd + (size_t)e * 256 * 1024;
            conv_item4([&](int k, int n) { return *(const f32x4*)(Dn + (size_t)k * 1024 + n); }, (bf16*)(ws + W_DN) + (size_t)e * 1024 * 256, 256, scr, kb * 64, nb * 64, lane); continue; }
        r -= I_DN;
        if (r < I_IN) { const int kb = r / 40, nb = r % 40;
            conv_item4([&](int k, int n) { const int sc = yc_src(n); return sc >= 0 ? *(const f32x4*)(w_in + (size_t)k * 2488 + sc) : z4; }, (bf16*)(ws + W_IN), 1024, scr, kb * 64, nb * 64, lane); continue; }
        r -= I_IN;
        if (r < 3 * I_SQ) { const int m = r / I_SQ, q = r % I_SQ, kb = q >> 4, nb = q & 15; const float* W = m == 0 ? w_out : (m == 1 ? xwq : xwo);
            bf16* D = (bf16*)(ws + (m == 0 ? W_OUT : (m == 1 ? W_XQ : W_XO)));
            conv_item4([&](int k, int n) { return *(const f32x4*)(W + (size_t)k * 1024 + n); }, D, 1024, scr, kb * 64, nb * 64, lane); continue; }
        r -= 3 * I_SQ;
        if (r < I_XKV) { const int kb = r >> 5, nb = r & 31;
            conv_item4([&](int k, int n) { return *(const f32x4*)(xwkv + (size_t)k * 2048 + n); }, (bf16*)(ws + W_XKV), 1024, scr, kb * 64, nb * 64, lane); continue; }
        r -= I_XKV;
        if (r < I_Q) { const int kb = r / 24, nb = r % 24;
            conv_item([&](int k, int n) { const int h = n / 96, j = n - h * 96; int sc = h * 96 + j; if (j >= 64) { const int jj = j - 64; sc = h * 96 + 64 + (jj >> 1) + 16 * (jj & 1); }
                return gq[k] * w_uq[(size_t)k * 768 + sc]; }, (bf16*)(ws + W_Q), 256, scr, kb * 64, nb * 32, lane); continue; }
        r -= I_Q;
        { const int kb = r / 40, nb = r % 40;
            conv_item([&](int k, int n) { const int h = n / 160, j = n - h * 160;
                if (j >= 64 && j < 96) { const int jj = j - 64; return (k == 152 + (jj >> 1) + 16 * (jj & 1)) ? 1.f : 0.f; }
                const int col = (j < 64) ? h * 128 + j : h * 128 + 64 + (j - 96);
                return (k >= 24 && k < 152) ? gkv[k - 24] * w_ukv[(size_t)(k - 24) * 1024 + col] : 0.f; }, (bf16*)(ws + W_KV), 256, scr, kb * 64, nb * 32, lane); }
    }
}

__device__ __forceinline__ void phase_pre(const Params& p) {
    const int tid = TID(); unsigned char* ws = p.ws;
    {
        const size_t gt = (size_t)BID() * 512 + tid, GT = (size_t)GRD() * 512;
        const float* x = p.in[0]; bf16* XB = (bf16*)(ws + WS_XB);
#pragma unroll 2
        for (size_t i = gt; i < (size_t)NTOK * DM / 8; i += GT) { const f32x4 a = *(const f32x4*)(x + i * 8), b = *(const f32x4*)(x + i * 8 + 4);
            u32x4 o; o.x = pk2(a[0], a[1]); o.y = pk2(a[2], a[3]); o.z = pk2(b[0], b[1]); o.w = pk2(b[2], b[3]); *(u32x4*)(XB + i * 8) = o; }
        const float* mem = p.in[1]; bf16* MB = (bf16*)(ws + WS_MEMB);
#pragma unroll 2
        for (size_t i = gt; i < (size_t)2048 * DM / 8; i += GT) { const f32x4 a = *(const f32x4*)(mem + i * 8), b = *(const f32x4*)(mem + i * 8 + 4);
            u32x4 o; o.x = pk2(a[0], a[1]); o.y = pk2(a[2], a[3]); o.z = pk2(b[0], b[1]); o.w = pk2(b[2], b[3]); *(u32x4*)(MB + i * 8) = o; }
        const int* pos = (const int*)p.in[2]; float* ROPE = (float*)(ws + WS_ROPE);
#pragma unroll 1
        for (size_t i = gt; i < (size_t)NTOK * 16; i += GT) { const int t = (int)(i >> 4), f = (int)(i & 15);
            double inv = 0.15915494309189535;
            for (int q = 0; q < f; ++q) inv *= 0.5623413251903491;
            const double rev = (double)pos[t] * inv; const float fr = (float)(rev - floor(rev));
            ROPE[i * 2] = __builtin_amdgcn_cosf(fr); ROPE[i * 2 + 1] = __builtin_amdgcn_sinf(fr); }
    }
}

__device__ __forceinline__ void gla_cum(const Params& p, int l, float* bs, int t0, int h) {
    const int tid = TID(), t = tid >> 3, dg = tid & 7;
    const bf16* Y = (const bf16*)(p.ws + WS_Y);
    const float* w_a2 = p.in[5] + l * 16 * 256; const float* b_a = p.in[6] + l * 256;
    float a[16];
    { const u32x4 a0 = *(const u32x4*)(Y + (size_t)(t0 + t) * YW + Y_A), a1 = *(const u32x4*)(Y + (size_t)(t0 + t) * YW + Y_A + 8);
#pragma unroll
      for (int j = 0; j < 4; ++j) { a[2 * j] = blo(a0[j]); a[2 * j + 1] = bhi(a0[j]); a[8 + 2 * j] = blo(a1[j]); a[8 + 2 * j + 1] = bhi(a1[j]); } }
#pragma unroll
    for (int j = 0; j < 8; ++j) { const int d = dg * 8 + j; float z = b_a[h * 64 + d];
#pragma unroll
        for (int q = 0; q < 16; ++q) z = fmaf(a[q], w_a2[q * 256 + h * 64 + d], z);
        bs[t * 65 + d] = logsigmoid(z) * (1.f / 16.f); }
    __syncthreads();
    if (tid < 64) { float s = 0.f; for (int tt = 0; tt < 64; ++tt) { s += bs[tt * 65 + tid]; bs[tt * 65 + tid] = s; } }
    __syncthreads();
}
__device__ __forceinline__ void ml_gates(const Params& p, int l, float* fc, float* aa, float* pm, int t0, int h) {
    const int tid = TID();
    const bf16* Y = (const bf16*)(p.ws + WS_Y);
    if (tid < 64) { const float fp = bf2f(Y[(size_t)(t0 + tid) * YW + Y_MF + h]) + p.in[10][l * 4 + h]; const float ig = bf2f(Y[(size_t)(t0 + tid) * YW + Y_MI + h]) + p.in[9][l * 4 + h];
        fc[tid] = logsigmoid(fp); aa[tid] = ig; }
    __syncthreads();
    if (tid == 0) { float s = 0.f, m = -3.0e38f; for (int i = 0; i < 64; ++i) { s += fc[i]; fc[i] = s; const float a = aa[i] - s; aa[i] = a; m = fmaxf(m, a); pm[i] = m; } }
    __syncthreads();
}
__device__ __forceinline__ void ml_conv(const Params& p, int l, float* dst, int t0, int c, int ycol, int wch, int h, float scale) {
    const int tid = TID(), s = tid >> 3, dg = tid & 7;
    const bf16* Y = (const bf16*)(p.ws + WS_Y); const float* w = p.in[8] + l * 4 * 512;
    float acc[8];
#pragma unroll
    for (int j = 0; j < 8; ++j) acc[j] = 0.f;
#pragma unroll
    for (int q = 0; q < 4; ++q) { const int ss = c * 64 + s - 3 + q;
        if (ss >= 0) { const u32x4 v = *(const u32x4*)(Y + (size_t)(t0 + s - 3 + q) * YW + ycol + h * 64 + dg * 8); const float* wr = w + q * 512 + wch + h * 64 + dg * 8;
#pragma unroll
            for (int j = 0; j < 4; ++j) { acc[2 * j] = fmaf(wr[2 * j], blo(v[j]), acc[2 * j]); acc[2 * j + 1] = fmaf(wr[2 * j + 1], bhi(v[j]), acc[2 * j + 1]); } } }
#pragma unroll
    for (int j = 0; j < 8; ++j) dst[s * 65 + dg * 8 + j] = siluf(acc[j]) * scale;
}
__device__ __forceinline__ void ld_blk(float* dst, const bf16* src, int ld) {
    const int tid = TID(), s = tid >> 3, dg = tid & 7; const u32x4 v = *(const u32x4*)(src + (size_t)s * ld + dg * 8);
#pragma unroll
    for (int j = 0; j < 4; ++j) { dst[s * 65 + dg * 8 + 2 * j] = blo(v[j]); dst[s * 65 + dg * 8 + 2 * j + 1] = bhi(v[j]); }
}

#define FENCE() do { asm volatile("" ::: "memory"); __builtin_amdgcn_sched_barrier(0); } while (0)
__device__ __forceinline__ f32x4 mfma16(bf16x8 a, bf16x8 b, f32x4 c) { return __builtin_amdgcn_mfma_f32_16x16x32_bf16(a, b, c, 0, 0, 0); }
__device__ __forceinline__ bf16x8 pack8(f32x4 a, f32x4 b) { u32x4 w; w.x = pk2(a[0], a[1]); w.y = pk2(a[2], a[3]); w.z = pk2(b[0], b[1]); w.w = pk2(b[2], b[3]); return __builtin_bit_cast(bf16x8, w); }
__device__ __forceinline__ f32x4 up4(u32x2 w) { return (f32x4){blo(w.x), bhi(w.x), blo(w.y), bhi(w.y)}; }
constexpr int LT = 68;
constexpr int WAVE_LDS = 18304;
__device__ __forceinline__ bf16x8 colfrag(const bf16* T, int col, int ra, int rb) {
    u32x4 w;
    w.x = (unsigned)T[(ra + 0) * LT + col] | ((unsigned)T[(ra + 1) * LT + col] << 16); w.y = (unsigned)T[(ra + 2) * LT + col] | ((unsigned)T[(ra + 3) * LT + col] << 16);
    w.z = (unsigned)T[(rb + 0) * LT + col] | ((unsigned)T[(rb + 1) * LT + col] << 16); w.w = (unsigned)T[(rb + 2) * LT + col] | ((unsigned)T[(rb + 3) * LT + col] << 16);
    return __builtin_bit_cast(bf16x8, w);
}
__device__ __forceinline__ void conv8(const bf16* Y, const float* cw  , int t0, int c, int rr, int ycol, float scale, f32x4& o0, f32x4& o1) {
    f32x4 a0 = {0.f, 0.f, 0.f, 0.f}, a1 = {0.f, 0.f, 0.f, 0.f};
#pragma unroll
    for (int tap = 0; tap < 4; ++tap) { const int ss = c * 64 + rr - 3 + tap;
        if (ss >= 0) { const u32x4 v = *(const u32x4*)(Y + (size_t)(t0 + rr - 3 + tap) * YW + ycol); const f32x4 w0 = *(const f32x4*)(cw + tap * 512), w1 = *(const f32x4*)(cw + tap * 512 + 4);
            a0 += w0 * (f32x4){blo(v.x), bhi(v.x), blo(v.y), bhi(v.y)}; a1 += w1 * (f32x4){blo(v.z), bhi(v.z), blo(v.w), bhi(v.w)}; } }
#pragma unroll
    for (int j = 0; j < 4; ++j) { o0[j] = siluf(a0[j]) * scale; o1[j] = siluf(a1[j]) * scale; }
}
__device__ __forceinline__ void v_to_lds(bf16* Vt, const bf16* vsrc, int lane) {
#pragma unroll
    for (int i = 0; i < 16; ++i) { const int x = lane + 64 * i, rr = x >> 4, cc = x & 15; *(u32x2*)(Vt + rr * LT + cc * 4) = *(const u32x2*)(vsrc + (size_t)rr * YW + cc * 4); }
}

__device__ __forceinline__ void lin_loc_wave(const Params& p, int l, bf16* Kt, bf16* Vt, int u, int lane) {
    asm volatile("" : "+v"(lane));
    unsigned char* ws = p.ws; const bf16* Y = (const bf16*)(ws + WS_Y);
    const int type = u >> 10, ur = u & 1023, bh = ur >> 5, c = ur & 31, b = bh >> 2, h = bh & 3, t0 = b * SEQ + c * 64;
    const int q = lane & 15, g = lane >> 4;
    float* ST = (float*)(ws + WS_ST) + (size_t)u * 4096;
    v_to_lds(Vt, Y + (size_t)t0 * YW + (type == 0 ? Y_GV : Y_MV) + h * 64, lane);
    if (type == 0) {
        const float* w_a2 = p.in[5] + l * 16 * 256 + h * 64; const float* b_a = p.in[6] + l * 256 + h * 64;
        const bf16x8 zero8 = {0, 0, 0, 0, 0, 0, 0, 0};
        bf16x8 wf[4], af[4];
#pragma unroll
        for (int db = 0; db < 4; ++db) { wf[db] = zero8;
            if (g < 2) { f32x4 w0, w1;
#pragma unroll
                for (int j = 0; j < 4; ++j) { w0[j] = w_a2[(8 * g + j) * 256 + 16 * db + q]; w1[j] = w_a2[(8 * g + 4 + j) * 256 + 16 * db + q]; }
                wf[db] = pack8(w0, w1); } }
#pragma unroll
        for (int tb = 0; tb < 4; ++tb) { af[tb] = zero8; if (g < 2) af[tb] = *(const bf16x8*)(Y + (size_t)(t0 + 16 * tb + q) * YW + Y_A + 8 * g); }
        float* BC = (float*)(ws + WS_BC); float* DEC = (float*)(ws + WS_DEC) + (size_t)ur * 64;
#pragma unroll
        for (int db = 0; db < 4; ++db) {
            const f32x4 ba = *(const f32x4*)(b_a + 16 * db + 4 * g);
            f32x4 bb[4]; f32x4 carry = {0.f, 0.f, 0.f, 0.f};
#pragma unroll
            for (int tb = 0; tb < 4; ++tb) { const f32x4 z = mfma16(wf[db], af[tb], (f32x4){0.f, 0.f, 0.f, 0.f});
#pragma unroll
                for (int r = 0; r < 4; ++r) { float x = logsigmoid(z[r] + ba[r]) * (1.f / 16.f);
#pragma unroll
                    for (int k = 1; k < 16; k <<= 1) { const float y = __shfl_up(x, k, 16); if (q >= k) x += y; }
                    x += carry[r]; bb[tb][r] = x; carry[r] = __shfl(x, (lane & 48) + 15); } }
#pragma unroll
            for (int sb = 0; sb < 4; ++sb) { const size_t row = (size_t)(t0 + 16 * sb + q);
                f32x4 kv = up4(*(const u32x2*)(Y + row * YW + Y_GK + h * 64 + 16 * db + 4 * g));
#pragma unroll
                for (int r = 0; r < 4; ++r) kv[r] *= fexp(carry[r] - bb[sb][r]);
                st_bf4(Kt + (16 * sb + q) * LT + 16 * db + 4 * g, kv);
                *(f32x4*)(BC + row * 256 + h * 64 + 16 * db + 4 * g) = bb[sb]; }
            if (q == 0) *(f32x4*)(DEC + 16 * db + 4 * g) = (f32x4){fexp(carry[0]), fexp(carry[1]), fexp(carry[2]), fexp(carry[3])};
            FENCE();
        }
    } else {
        const float fp = bf2f(Y[(size_t)(t0 + lane) * YW + Y_MF + h]) + p.in[10][l * 4 + h], ig = bf2f(Y[(size_t)(t0 + lane) * YW + Y_MI + h]) + p.in[9][l * 4 + h];
        float fc = logsigmoid(fp);
#pragma unroll
        for (int k = 1; k < 64; k <<= 1) { const float y = __shfl_up(fc, k); if (lane >= k) fc += y; }
        const float a = ig - fc; float M = a;
#pragma unroll
        for (int o = 1; o < 64; o <<= 1) M = fmaxf(M, __shfl_xor(M, o));
        const float F = __shfl(fc, 63), wl = fexp(a - M);
        const float* cw = p.in[8] + l * 4 * 512 + 256 + h * 64;
#pragma unroll
        for (int sb = 0; sb < 4; ++sb) { const float wrow = __shfl(wl, 16 * sb + q);
#pragma unroll
            for (int ks = 0; ks < 2; ++ks) { const int d0 = 32 * ks + 8 * g; f32x4 o0, o1; bf16* qk = (bf16*)(ws + WS_QKC) + (size_t)(t0 + 16 * sb + q) * 512 + h * 64 + d0;
                conv8(Y, cw + d0, t0, c, 16 * sb + q, Y_MK + h * 64 + d0, 1.f, o0, o1);
                st_bf4(qk + 256, o0); st_bf4(qk + 260, o1);
                st_bf4(Kt + (16 * sb + q) * LT + d0, o0 * wrow); st_bf4(Kt + (16 * sb + q) * LT + d0 + 4, o1 * wrow); FENCE();
                conv8(Y, cw - 256 + d0, t0, c, 16 * sb + q, Y_MQ + h * 64 + d0, 0.125f, o0, o1);
                st_bf4(qk, o0); st_bf4(qk + 4, o1); FENCE(); } }
        if (lane == 0) { float* SC = (float*)(ws + WS_SC); SC[ur * 2] = F; SC[ur * 2 + 1] = F + M; }
    }
    bf16x8 vf[4][2], kf[4][2];
#pragma unroll
    for (int eb = 0; eb < 4; ++eb)
#pragma unroll
        for (int ks = 0; ks < 2; ++ks) { vf[eb][ks] = colfrag(Vt, 16 * eb + q, 32 * ks + 8 * g, 32 * ks + 8 * g + 4); kf[eb][ks] = colfrag(Kt, 16 * eb + q, 32 * ks + 8 * g, 32 * ks + 8 * g + 4); FENCE(); }
#pragma unroll
    for (int eb = 0; eb < 4; ++eb)
#pragma unroll
        for (int db = 0; db < 4; ++db) { f32x4 acc = {0.f, 0.f, 0.f, 0.f};
#pragma unroll
            for (int ks = 0; ks < 2; ++ks) acc = mfma16(vf[eb][ks], kf[db][ks], acc);
#pragma unroll
            for (int r = 0; r < 4; ++r) ST[(16 * eb + 4 * g + r) * 64 + 16 * db + q] = acc[r]; }
    if (type == 1) { const u32x4 o1 = {0x3f803f80u, 0x3f803f80u, 0x3f803f80u, 0x3f803f80u}; const bf16x8 ones = __builtin_bit_cast(bf16x8, o1); float* NV = (float*)(ws + WS_NV) + (size_t)ur * 64;
#pragma unroll
        for (int db = 0; db < 4; ++db) { f32x4 acc = {0.f, 0.f, 0.f, 0.f};
#pragma unroll
            for (int ks = 0; ks < 2; ++ks) acc = mfma16(ones, kf[db][ks], acc);
            if (g == 0) NV[16 * db + q] = acc[0]; } }
}

template <int type>
__device__ __forceinline__ void lin_mix_wave(const Params& p, int l, bf16* Vt, int u, int lane) {
    asm volatile("" : "+v"(lane));
    unsigned char* ws = p.ws; const bf16* Y = (const bf16*)(ws + WS_Y);
    const int ur = u & 1023, bh = ur >> 5, c = ur & 31, b = bh >> 2, h = bh & 3, t0 = b * SEQ + c * 64;
    const int q = lane & 15, g = lane >> 4;
    const float* ST = (const float*)(ws + WS_ST) + (size_t)u * 4096;
    bf16* MIX = (bf16*)(ws + WS_XB);
    v_to_lds(Vt, Y + (size_t)t0 * YW + (type == 0 ? Y_GV : Y_MV) + h * 64, lane);
    bf16x8 kf[4][2];
    float fcl = 0.f, al = 0.f, pml = 0.f, mst = 0.f;
    const float* BC = (const float*)(ws + WS_BC);
    const bf16* QKC = (const bf16*)(ws + WS_QKC);
    if (type == 0) {
#pragma unroll
        for (int blk = 0; blk < 4; ++blk)
#pragma unroll
            for (int ks = 0; ks < 2; ++ks) { const size_t row = (size_t)(t0 + 16 * blk + q); const int d0 = 32 * ks + 8 * g;
                const f32x4 b0 = *(const f32x4*)(BC + row * 256 + h * 64 + d0), b1 = *(const f32x4*)(BC + row * 256 + h * 64 + d0 + 4);
                const u32x4 kk = *(const u32x4*)(Y + row * YW + Y_GK + h * 64 + d0);
                f32x4 k0 = {blo(kk.x), bhi(kk.x), blo(kk.y), bhi(kk.y)}, k1 = {blo(kk.z), bhi(kk.z), blo(kk.w), bhi(kk.w)};
#pragma unroll
                for (int j = 0; j < 4; ++j) { k0[j] *= fexp(-b0[j]); k1[j] *= fexp(-b1[j]); }
                kf[blk][ks] = pack8(k0, k1); FENCE(); }
    } else {
        const float fp = bf2f(Y[(size_t)(t0 + lane) * YW + Y_MF + h]) + p.in[10][l * 4 + h], ig = bf2f(Y[(size_t)(t0 + lane) * YW + Y_MI + h]) + p.in[9][l * 4 + h];
        float fc = logsigmoid(fp);
#pragma unroll
        for (int k = 1; k < 64; k <<= 1) { const float y = __shfl_up(fc, k); if (lane >= k) fc += y; }
        fcl = fc; al = ig - fc; pml = al;
#pragma unroll
        for (int k = 1; k < 64; k <<= 1) { const float y = __shfl_up(pml, k); if (lane >= k) pml = fmaxf(pml, y); }
        mst = ((const float*)(ws + WS_MS))[ur];
#pragma unroll
        for (int blk = 0; blk < 4; ++blk)
#pragma unroll
            for (int ks = 0; ks < 2; ++ks) kf[blk][ks] = *(const bf16x8*)(QKC + (size_t)(t0 + 16 * blk + q) * 512 + 256 + h * 64 + 32 * ks + 8 * g);
    }
    bf16x8 vf[4][2];
#pragma unroll
    for (int eb = 0; eb < 4; ++eb)
#pragma unroll
        for (int ks = 0; ks < 2; ++ks) { vf[eb][ks] = colfrag(Vt, 16 * eb + q, 32 * ks + 4 * g, 32 * ks + 16 + 4 * g); FENCE(); }
    const float* gn = (type == 0 ? p.in[7] : p.in[11]) + l * 256 + h * 64;
    f32x4 asv[4];
#pragma unroll
    for (int sb = 0; sb < 4; ++sb) { asv[sb] = (f32x4){0.f, 0.f, 0.f, 0.f};
        if (type == 1) {
#pragma unroll
            for (int r = 0; r < 4; ++r) asv[sb][r] = __shfl(al, 16 * sb + 4 * g + r); } }
    FENCE();
#pragma unroll
    for (int tb = 0; tb < 4; ++tb) {
        const int t = 16 * tb + q;
        bf16x8 qf[2];
#pragma unroll
        for (int ks = 0; ks < 2; ++ks) { const int d0 = 32 * ks + 8 * g;
            if (type == 0) { const size_t row = (size_t)(t0 + t);
                const f32x4 b0 = *(const f32x4*)(BC + row * 256 + h * 64 + d0), b1 = *(const f32x4*)(BC + row * 256 + h * 64 + d0 + 4);
                const u32x4 qq = *(const u32x4*)(Y + row * YW + Y_GQ + h * 64 + d0);
                f32x4 q0 = {blo(qq.x), bhi(qq.x), blo(qq.y), bhi(qq.y)}, q1 = {blo(qq.z), bhi(qq.z), blo(qq.w), bhi(qq.w)};
#pragma unroll
                for (int j = 0; j < 4; ++j) { q0[j] *= 0.125f * fexp(b0[j]); q1[j] *= 0.125f * fexp(b1[j]); }
                qf[ks] = pack8(q0, q1);
            } else qf[ks] = *(const bf16x8*)(QKC + (size_t)(t0 + t) * 512 + h * 64 + d0); }
        f32x4 pt[4];
#pragma unroll
        for (int sb = 0; sb < 4; ++sb) { pt[sb] = (f32x4){0.f, 0.f, 0.f, 0.f};
            if (sb <= tb) {
#pragma unroll
                for (int ks = 0; ks < 2; ++ks) pt[sb] = mfma16(kf[sb][ks], qf[ks], pt[sb]); } }
        float mm = 0.f, wi = 1.f;
        if (type == 1) { mm = fmaxf(mst, __shfl(pml, t)); wi = fexp(mst - mm); }
        float dsum = 0.f;
#pragma unroll
        for (int sb = 0; sb < 4; ++sb) if (sb <= tb) {
#pragma unroll
            for (int r = 0; r < 4; ++r) { const int sidx = 16 * sb + 4 * g + r; float w = pt[sb][r];
                if (type == 1) w *= fexp(asv[sb][r] - mm);
                w = (sidx <= t) ? w : 0.f; pt[sb][r] = w; dsum += w; } }
        bf16x8 pf[2]; pf[0] = pack8(pt[0], pt[1]); pf[1] = pack8(pt[2], pt[3]); FENCE();
        f32x4 ot[4];
#pragma unroll
        for (int eb = 0; eb < 4; ++eb) { f32x4 acc = {0.f, 0.f, 0.f, 0.f};
#pragma unroll
            for (int ks = 0; ks < 2; ++ks) { const float* sp = ST + (16 * eb + q) * 64 + 32 * ks + 8 * g;
                acc = mfma16(pack8(*(const f32x4*)sp, *(const f32x4*)(sp + 4)), qf[ks], acc); }
            acc = acc * wi;
            acc = mfma16(vf[eb][0], pf[0], acc);
            if (tb >= 2) acc = mfma16(vf[eb][1], pf[1], acc);
            ot[eb] = acc; }
        if (type == 1) {
            float qn = 0.f;
#pragma unroll
            for (int ks = 0; ks < 2; ++ks) { const u32x4 w = __builtin_bit_cast(u32x4, qf[ks]); const float* nvp = (const float*)(ws + WS_NV) + (size_t)ur * 64 + 32 * ks + 8 * g; const f32x4 n0 = *(const f32x4*)nvp, n1 = *(const f32x4*)(nvp + 4);
                qn += blo(w.x) * n0[0] + bhi(w.x) * n0[1] + blo(w.y) * n0[2] + bhi(w.y) * n0[3] + blo(w.z) * n1[0] + bhi(w.z) * n1[1] + blo(w.w) * n1[2] + bhi(w.w) * n1[3]; }
            qn += __shfl_xor(qn, 16); qn += __shfl_xor(qn, 32); dsum += __shfl_xor(dsum, 16); dsum += __shfl_xor(dsum, 32);
            const float den = wi * qn + dsum, mt = __shfl(fcl, t) + mm; const float inv = 1.f / fmaxf(fabsf(den), fexp(-mt));
#pragma unroll
            for (int eb = 0; eb < 4; ++eb) ot[eb] = ot[eb] * inv;
            FENCE();
        }
        float s1 = 0.f;
#pragma unroll
        for (int eb = 0; eb < 4; ++eb) s1 += (ot[eb][0] + ot[eb][1]) + (ot[eb][2] + ot[eb][3]);
        s1 += __shfl_xor(s1, 16); s1 += __shfl_xor(s1, 32);
        const float mu = s1 * (1.f / 64.f); float s2 = 0.f;
#pragma unroll
        for (int eb = 0; eb < 4; ++eb) { ot[eb] = ot[eb] - mu; s2 += (ot[eb][0] * ot[eb][0] + ot[eb][1] * ot[eb][1]) + (ot[eb][2] * ot[eb][2] + ot[eb][3] * ot[eb][3]); }
        s2 += __shfl_xor(s2, 16); s2 += __shfl_xor(s2, 32);
        const float rstd = 1.f / sqrtf(s2 * (1.f / 64.f) + LN_EPS);
#pragma unroll
        for (int eb = 0; eb < 4; ++eb) { const int e0 = 16 * eb + 4 * g;
            const f32x4 gate = up4(*(const u32x2*)(Y + (size_t)(t0 + t) * YW + (type == 0 ? Y_GR : Y_MO) + h * 64 + e0)); const f32x4 gg = *(const f32x4*)(gn + e0);
            f32x4 res;
#pragma unroll
            for (int r = 0; r < 4; ++r) res[r] = ot[eb][r] * rstd * gg[r] * (type == 0 ? siluf(gate[r]) : sigmoidf(gate[r]));
            st_bf4(MIX + (size_t)(t0 + t) * DM + type * 256 + h * 64 + e0, res); }
        FENCE();
    }
}

__device__ __forceinline__ void phase_loc(const Params& p, int l, unsigned char* smem) {
    const int tid = TID(), lane = tid & 63, wave = __builtin_amdgcn_readfirstlane(tid >> 6);
    unsigned char* ws = p.ws; const bf16* Y = (const bf16*)(ws + WS_Y);
    { bf16* Kt = (bf16*)(smem + wave * WAVE_LDS); bf16* Vt = Kt + 64 * LT;
      for (int u = BID() * 8 + wave; u < 2048; u += GRD() * 8) lin_loc_wave(p, l, Kt, Vt, u, lane); }
    float* RS = (float*)(ws + WS_RS);
    for (int row = BID() * 8 + wave; row < NTOK; row += GRD() * 8) {
        const u32x2 q = *(const u32x2*)(Y + (size_t)row * YW + Y_CQ + lane * 4); const unsigned kv = *(const unsigned*)(Y + (size_t)row * YW + Y_CKV + lane * 2);
        float sq = blo(q.x) * blo(q.x) + bhi(q.x) * bhi(q.x) + blo(q.y) * blo(q.y) + bhi(q.y) * bhi(q.y); float sk = blo(kv) * blo(kv) + bhi(kv) * bhi(kv);
        sq = wave_sum(sq); sk = wave_sum(sk);
        if (lane == 0) { RS[row * 2] = 1.f / sqrtf(sq * (1.f / 256.f) + LN_EPS); RS[row * 2 + 1] = 1.f / sqrtf(sk * (1.f / 128.f) + LN_EPS); }
    }
}

__device__ __forceinline__ void phase_scan(const Params& p, int l, int dummy = 0) {
    unsigned char* ws = p.ws;
    float* ST = (float*)(ws + WS_ST); float* STD = dummy ? (float*)(ws + WS_XB) : ST; float* NV = (float*)(ws + WS_NV); const float* DEC = (const float*)(ws + WS_DEC); const float* SC = (const float*)(ws + WS_SC); float* MS = (float*)(ws + WS_MS);
    const int gt = BID() * 512 + TID(), GT = GRD() * 512;
    for (int idx = gt; idx < 64 * 4096; idx += GT) {
        const int seq = idx >> 12, el = idx & 4095, d = el & 63;
        float* st = ST + (size_t)seq * 32 * 4096 + el;
        float tv[32];
#pragma unroll
        for (int c = 0; c < 32; ++c) tv[c] = st[(size_t)c * 4096];
        if (seq < 32) { const float* dc = DEC + (size_t)seq * 32 * 64 + d; float dv[32];
#pragma unroll
            for (int c = 0; c < 32; ++c) dv[c] = dc[c * 64];
            float S = 0.f;
#pragma unroll
            for (int c = 0; c < 32; ++c) { const float tmp = tv[c]; tv[c] = S; S = fmaf(dv[c], S, tmp); } }
        else { const float* sc = SC + (size_t)(seq - 32) * 32 * 2; float C = 0.f, m = 0.f;
#pragma unroll
            for (int c = 0; c < 32; ++c) { const float F = sc[c * 2], ml = sc[c * 2 + 1]; const float tmp = tv[c]; tv[c] = C;
                const float mn = fmaxf(F + m, ml); C = expf(F + m - mn) * C + expf(ml - mn) * tmp; m = mn; } }
        float* sd = STD + (size_t)seq * 32 * 4096 + el;
#pragma unroll
        for (int c = 0; c < 32; ++c) sd[(size_t)c * 4096] = tv[c];
    }
    if (dummy) return;
    for (int idx = gt; idx < 32 * 64; idx += GT) {
        const int sq = idx >> 6, d = idx & 63; float n = 0.f, m = 0.f; const float* sc = SC + (size_t)sq * 32 * 2; float* nv = NV + (size_t)sq * 32 * 64 + d;
#pragma unroll 4
        for (int c = 0; c < 32; ++c) { const float F = sc[c * 2], ml = sc[c * 2 + 1]; const float tmp = nv[c * 64]; nv[c * 64] = n; if (d == 0) MS[sq * 32 + c] = m;
            const float mn = fmaxf(F + m, ml); n = expf(F + m - mn) * n + expf(ml - mn) * tmp; m = mn; }
    }
}

template <int DQK, int DV>
__device__ __forceinline__ void attn_naive(unsigned char* smem, const bf16* Q, int qs, const bf16* K, int ks, const bf16* V, int vs, int nk, bf16* O, int os) {
    constexpr int LQ = DQK + 8, LV = DV + 8, EV = DV / 8;
    bf16* Qs = (bf16*)smem; bf16* Ks = Qs + 64 * LQ; bf16* Vs = Ks + 64 * LQ; float* Ss = (float*)(Vs + 64 * LV);
    const int tid = TID(), t = tid >> 3, g = tid & 7;
    __syncthreads();
    for (int i = tid; i < 64 * DQK / 8; i += 512) { const int r = i / (DQK / 8), c8 = i % (DQK / 8); *(u32x4*)(Qs + r * LQ + c8 * 8) = *(const u32x4*)(Q + (size_t)r * qs + c8 * 8); }
    float acc[EV]; float m = -3.0e38f, lsum = 0.f;
#pragma unroll
    for (int j = 0; j < EV; ++j) acc[j] = 0.f;
    for (int k0 = 0; k0 < nk; k0 += 64) {
        __syncthreads();
        for (int i = tid; i < 64 * DQK / 8; i += 512) { const int r = i / (DQK / 8), c8 = i % (DQK / 8); *(u32x4*)(Ks + r * LQ + c8 * 8) = *(const u32x4*)(K + (size_t)(k0 + r) * ks + c8 * 8); }
        for (int i = tid; i < 64 * DV / 8; i += 512) { const int r = i / (DV / 8), c8 = i % (DV / 8); *(u32x4*)(Vs + r * LV + c8 * 8) = *(const u32x4*)(V + (size_t)(k0 + r) * vs + c8 * 8); }
        __syncthreads();
        float sc[8];
#pragma unroll
        for (int j = 0; j < 8; ++j) sc[j] = 0.f;
        for (int d8 = 0; d8 < DQK / 8; ++d8) { const u32x4 qv = *(const u32x4*)(Qs + t * LQ + d8 * 8);
#pragma unroll
            for (int j = 0; j < 8; ++j) { const u32x4 kv = *(const u32x4*)(Ks + (g + 8 * j) * LQ + d8 * 8);
#pragma unroll
                for (int q = 0; q < 4; ++q) sc[j] = fmaf(blo(qv[q]), blo(kv[q]), fmaf(bhi(qv[q]), bhi(kv[q]), sc[j])); } }
        float mx = sc[0];
#pragma unroll
        for (int j = 1; j < 8; ++j) mx = fmaxf(mx, sc[j]);
        mx = fmaxf(mx, __shfl_xor(mx, 1)); mx = fmaxf(mx, __shfl_xor(mx, 2)); mx = fmaxf(mx, __shfl_xor(mx, 4));
        const float mn = fmaxf(m, mx), al = exp2f(m - mn); float ps = 0.f;
#pragma unroll
        for (int j = 0; j < 8; ++j) { const float pv = exp2f(sc[j] - mn); ps += pv; Ss[t * 65 + g + 8 * j] = pv; }
        ps += __shfl_xor(ps, 1); ps += __shfl_xor(ps, 2); ps += __shfl_xor(ps, 4);
        lsum = lsum * al + ps; m = mn;
#pragma unroll
        for (int j = 0; j < EV; ++j) acc[j] *= al;
        __syncthreads();
        for (int kk = 0; kk < 64; ++kk) { const float pv = Ss[t * 65 + kk];
#pragma unroll
            for (int j8 = 0; j8 < EV / 8; ++j8) { const u32x4 vv = *(const u32x4*)(Vs + kk * LV + g * EV + j8 * 8);
#pragma unroll
                for (int q = 0; q < 4; ++q) { acc[j8 * 8 + 2 * q] = fmaf(pv, blo(vv[q]), acc[j8 * 8 + 2 * q]); acc[j8 * 8 + 2 * q + 1] = fmaf(pv, bhi(vv[q]), acc[j8 * 8 + 2 * q + 1]); } } }
    }
    const float inv = 1.f / lsum;
#pragma unroll
    for (int j8 = 0; j8 < EV / 8; ++j8) { u32x4 o; o.x = pk2(acc[j8 * 8] * inv, acc[j8 * 8 + 1] * inv); o.y = pk2(acc[j8 * 8 + 2] * inv, acc[j8 * 8 + 3] * inv);
        o.z = pk2(acc[j8 * 8 + 4] * inv, acc[j8 * 8 + 5] * inv); o.w = pk2(acc[j8 * 8 + 6] * inv, acc[j8 * 8 + 7] * inv);
        *(u32x4*)(O + (size_t)t * os + g * EV + j8 * 8) = o; }
}

template <int DQK, int DV, int QG>
__device__ __forceinline__ void attn_mfma_unit(unsigned char* smem, const bf16* Q, int qs, const bf16* K, int ks, const bf16* VT, int vts, int ntile_wave, int ntile_max, bf16* O, int os) {
    constexpr int LK = DQK + 8, LV = 72, KS = DQK / 32, NDV = DV / 16;
    constexpr int NKPIECE = 64 * DQK / 8, NVPIECE = DV * 8, NKP = (NKPIECE + 511) / 512, NVP = (NVPIECE + 511) / 512;
    bf16* Ks = (bf16*)smem; bf16* Vs = Ks + 64 * LK;
    const int tid = TID(), wave = tid >> 6, lane = tid & 63, q = lane & 15, g = lane >> 4;
    bf16x8 qf[QG][KS];
#pragma unroll
    for (int qg = 0; qg < QG; ++qg)
#pragma unroll
        for (int kk = 0; kk < KS; ++kk) qf[qg][kk] = *(const bf16x8*)(Q + (size_t)(wave * 16 * QG + qg * 16 + q) * qs + kk * 32 + g * 8);
    f32x4 o[QG][NDV]; float mrun[QG], lrun[QG];
#pragma unroll
    for (int qg = 0; qg < QG; ++qg) { mrun[qg] = -3.0e38f; lrun[qg] = 0.f;
#pragma unroll
        for (int d = 0; d < NDV; ++d) o[qg][d] = (f32x4){0.f, 0.f, 0.f, 0.f}; }
    u32x4 kr[NKP], vr[NVP];
#define AT_GLOAD(kt) do { _Pragma("unroll") for (int _i = 0; _i < NKP; ++_i) { const int _x = tid + 512 * _i; if (_x < NKPIECE) { const int _r = _x / (DQK / 8), _c = _x % (DQK / 8); kr[_i] = *(const u32x4*)(K + (size_t)((kt) * 64 + _r) * ks + _c * 8); } } \
        _Pragma("unroll") for (int _i = 0; _i < NVP; ++_i) { const int _x = tid + 512 * _i; if (_x < NVPIECE) { const int _r = _x >> 3, _c = _x & 7; vr[_i] = *(const u32x4*)(VT + (size_t)_r * vts + (kt) * 64 + _c * 8); } } } while (0)
#define AT_LSTORE() do { _Pragma("unroll") for (int _i = 0; _i < NKP; ++_i) { const int _x = tid + 512 * _i; if (_x < NKPIECE) { const int _r = _x / (DQK / 8), _c = _x % (DQK / 8); *(u32x4*)(Ks + _r * LK + _c * 8) = kr[_i]; } } \
        _Pragma("unroll") for (int _i = 0; _i < NVP; ++_i) { const int _x = tid + 512 * _i; if (_x < NVPIECE) { const int _r = _x >> 3, _c = _x & 7; *(u32x4*)(Vs + _r * LV + _c * 8) = vr[_i]; } } } while (0)
    AT_GLOAD(0);
    for (int kt = 0; kt < ntile_max; ++kt) {
        __syncthreads();
        AT_LSTORE();
        __syncthreads();
        if (kt + 1 < ntile_max) AT_GLOAD(kt + 1);
        if (kt < ntile_wave) {
            f32x4 sc[QG][4];
#pragma unroll
            for (int qg = 0; qg < QG; ++qg)
#pragma unroll
                for (int b = 0; b < 4; ++b) sc[qg][b] = (f32x4){0.f, 0.f, 0.f, 0.f};
#pragma unroll
            for (int b = 0; b < 4; ++b)
#pragma unroll
                for (int kk = 0; kk < KS; ++kk) { const bf16x8 kf = *(const bf16x8*)(Ks + (b * 16 + q) * LK + kk * 32 + g * 8);
#pragma unroll
                    for (int qg = 0; qg < QG; ++qg) sc[qg][b] = __builtin_amdgcn_mfma_f32_16x16x32_bf16(kf, qf[qg][kk], sc[qg][b], 0, 0, 0); }
            bf16x8 pf[QG][2];
#pragma unroll
            for (int qg = 0; qg < QG; ++qg) {
                float mx = sc[qg][0][0];
#pragma unroll
                for (int b = 0; b < 4; ++b)
#pragma unroll
                    for (int i = 0; i < 4; ++i) mx = fmaxf(mx, sc[qg][b][i]);
                mx = fmaxf(mx, __shfl_xor(mx, 16)); mx = fmaxf(mx, __shfl_xor(mx, 32));
                const float mn = fmaxf(mrun[qg], mx), al = __builtin_amdgcn_exp2f(mrun[qg] - mn); float ps = 0.f;
#pragma unroll
                for (int b = 0; b < 4; ++b)
#pragma unroll
                    for (int i = 0; i < 4; ++i) { const float pv = __builtin_amdgcn_exp2f(sc[qg][b][i] - mn); sc[qg][b][i] = pv; ps += pv; }
                lrun[qg] = lrun[qg] * al + ps; mrun[qg] = mn;
#pragma unroll
                for (int d = 0; d < NDV; ++d) o[qg][d] = o[qg][d] * al;
#pragma unroll
                for (int st = 0; st < 2; ++st) { u32x4 w; w.x = pk2(sc[qg][2 * st][0], sc[qg][2 * st][1]); w.y = pk2(sc[qg][2 * st][2], sc[qg][2 * st][3]);
                    w.z = pk2(sc[qg][2 * st + 1][0], sc[qg][2 * st + 1][1]); w.w = pk2(sc[qg][2 * st + 1][2], sc[qg][2 * st + 1][3]); pf[qg][st] = __builtin_bit_cast(bf16x8, w); }
            }
#pragma unroll
            for (int d = 0; d < NDV; ++d)
#pragma unroll
                for (int st = 0; st < 2; ++st) { const u32x2 v0 = *(const u32x2*)(Vs + (d * 16 + q) * LV + st * 32 + 4 * g), v1 = *(const u32x2*)(Vs + (d * 16 + q) * LV + st * 32 + 16 + 4 * g);
                    const u32x4 vv = {v0.x, v0.y, v1.x, v1.y}; const bf16x8 vf = __builtin_bit_cast(bf16x8, vv);
#pragma unroll
                    for (int qg = 0; qg < QG; ++qg) o[qg][d] = __builtin_amdgcn_mfma_f32_16x16x32_bf16(vf, pf[qg][st], o[qg][d], 0, 0, 0); }
        }
    }
#undef AT_GLOAD
#undef AT_LSTORE
#pragma unroll
    for (int qg = 0; qg < QG; ++qg) { float lt = lrun[qg]; lt += __shfl_xor(lt, 16); lt += __shfl_xor(lt, 32); const float inv = 1.f / lt;
        bf16* orow = O + (size_t)(wave * 16 * QG + qg * 16 + q) * os + 4 * g;
#pragma unroll
        for (int d = 0; d < NDV; ++d) st_bf4(orow + d * 16, o[qg][d] * inv); }
}

__device__ __forceinline__ void mix_linear_unit(const Params& p, int l, unsigned char* smem, int u) {
    const int tid = TID(); unsigned char* ws = p.ws; const bf16* Y = (const bf16*)(ws + WS_Y);
    float* A0 = (float*)smem; float* A1 = A0 + 64 * 65; float* A2 = A1 + 64 * 65; float* A3 = A2 + 64 * 65; float* A4 = A3 + 64 * 65; float* A5 = A4 + 64 * 65;
    float* fc = A5 + 64 * 65; float* aa = fc + 64; float* pm = aa + 64; float* nv = pm + 64;
    const float* ST = (const float*)(ws + WS_ST); const float* NV = (const float*)(ws + WS_NV); const float* MS = (const float*)(ws + WS_MS);
    bf16* MIX = (bf16*)(ws + WS_XB);
    const int type = u >> 10, r = u & 1023, bh = r >> 5, c = r & 31, b = bh >> 2, h = bh & 3, t0 = b * SEQ + c * 64;
    const int t = tid >> 3, g = tid & 7, e0 = g * 8;
    __syncthreads();
    for (int i = tid; i < 4096; i += 512) A3[(i >> 6) * 65 + (i & 63)] = ST[(size_t)u * 4096 + i];
    ld_blk(A2, Y + (size_t)t0 * YW + (type == 0 ? Y_GV : Y_MV) + h * 64, YW);
    float mst = 0.f;
    if (type == 0) {
        gla_cum(p, l, A0, t0, h);
        ld_blk(A4, Y + (size_t)t0 * YW + Y_GQ + h * 64, YW); ld_blk(A1, Y + (size_t)t0 * YW + Y_GK + h * 64, YW);
        __syncthreads();
        for (int i = tid; i < 4096; i += 512) { const int s = i >> 6, dd = i & 63; const float bb = A0[s * 65 + dd]; A4[s * 65 + dd] *= 0.125f * expf(bb); A1[s * 65 + dd] *= expf(-bb); }
    } else {
        ml_gates(p, l, fc, aa, pm, t0, h);
        ml_conv(p, l, A4, t0, c, Y_MQ, 0, h, 0.125f); ml_conv(p, l, A1, t0, c, Y_MK, 256, h, 1.f);
        if (tid < 64) nv[tid] = NV[(size_t)r * 64 + tid];
        mst = MS[r];
    }
    __syncthreads();
    const float mm = (type == 1) ? fmaxf(mst, pm[t]) : 0.f;
    {
        float sc[8];
#pragma unroll
        for (int j = 0; j < 8; ++j) sc[j] = 0.f;
        for (int d = 0; d < 64; ++d) { const float qv = A4[t * 65 + d];
#pragma unroll
            for (int j = 0; j < 8; ++j) sc[j] = fmaf(qv, A1[(g + 8 * j) * 65 + d], sc[j]); }
#pragma unroll
        for (int j = 0; j < 8; ++j) { const int s = g + 8 * j; float w = (s <= t) ? sc[j] : 0.f; if (type == 1) w = (s <= t) ? w * expf(aa[s] - mm) : 0.f; A5[t * 65 + s] = w; }
    }
    __syncthreads();
    float acc[8], inter[8];
#pragma unroll
    for (int j = 0; j < 8; ++j) { acc[j] = 0.f; inter[j] = 0.f; }
    for (int d = 0; d < 64; ++d) { const float qv = A4[t * 65 + d];
#pragma unroll
        for (int j = 0; j < 8; ++j) inter[j] = fmaf(qv, A3[d * 65 + e0 + j], inter[j]); }
    for (int s = 0; s < 64; ++s) { const float pv = A5[t * 65 + s];
#pragma unroll
        for (int j = 0; j < 8; ++j) acc[j] = fmaf(pv, A2[s * 65 + e0 + j], acc[j]); }
    float o[8];
    if (type == 0) {
#pragma unroll
        for (int j = 0; j < 8; ++j) o[j] = acc[j] + inter[j];
    } else {
        const float wi = expf(mst - mm);
        float dn = 0.f;
#pragma unroll
        for (int j = 0; j < 8; ++j) dn += wi * A4[t * 65 + e0 + j] * nv[e0 + j] + A5[t * 65 + e0 + j];
        dn += __shfl_xor(dn, 1); dn += __shfl_xor(dn, 2); dn += __shfl_xor(dn, 4);
        const float mt = fc[t] + mm; const float den = fmaxf(fabsf(dn), expf(-mt)); const float inv = 1.f / den;
#pragma unroll
        for (int j = 0; j < 8; ++j) o[j] = (wi * inter[j] + acc[j]) * inv;
    }
    float s1 = 0.f;
#pragma unroll
    for (int j = 0; j < 8; ++j) s1 += o[j];
    s1 += __shfl_xor(s1, 1); s1 += __shfl_xor(s1, 2); s1 += __shfl_xor(s1, 4);
    const float mu = s1 * (1.f / 64.f); float s2 = 0.f;
#pragma unroll
    for (int j = 0; j < 8; ++j) { o[j] -= mu; s2 += o[j] * o[j]; }
    s2 += __shfl_xor(s2, 1); s2 += __shfl_xor(s2, 2); s2 += __shfl_xor(s2, 4);
    const float rstd = 1.f / sqrtf(s2 * (1.f / 64.f) + LN_EPS);
    const float* gn = (type == 0 ? p.in[7] : p.in[11]) + l * 256 + h * 64 + e0;
    const u32x4 gv = *(const u32x4*)(Y + (size_t)(t0 + t) * YW + (type == 0 ? Y_GR : Y_MO) + h * 64 + e0);
    float gate[8];
#pragma unroll
    for (int j = 0; j < 4; ++j) { gate[2 * j] = blo(gv[j]); gate[2 * j + 1] = bhi(gv[j]); }
    float res[8];
#pragma unroll
    for (int j = 0; j < 8; ++j) res[j] = o[j] * rstd * gn[j] * (type == 0 ? siluf(gate[j]) : sigmoidf(gate[j]));
    u32x4 ov; ov.x = pk2(res[0], res[1]); ov.y = pk2(res[2], res[3]); ov.z = pk2(res[4], res[5]); ov.w = pk2(res[6], res[7]);
    *(u32x4*)(MIX + (size_t)(t0 + t) * DM + type * 256 + h * 64 + e0) = ov;
}

__device__ __forceinline__ void phase_mix(const Params& p, int l, unsigned char* smem) {
    unsigned char* ws = p.ws;
    const bf16* QP = (const bf16*)(ws + WS_QP); const bf16* KP = (const bf16*)(ws + WS_KP); const bf16* VPT = (const bf16*)(ws + WS_VP); bf16* MIX = (bf16*)(ws + WS_XB);
    for (int u = BID(); u < 512; u += GRD()) {
        const int bh = u & 63, Qb = u < 256 ? 7 - (u >> 6) : (u - 256) >> 6, b = bh >> 3, h = bh & 7;
        const int wave = TID() >> 6;
        attn_mfma_unit<96, 64, 2>(smem, QP + ((size_t)bh * SEQ + Qb * 256) * 96, 96, KP + (size_t)bh * SEQ * 96, 96, VPT + (size_t)bh * 64 * SEQ, SEQ,
                                  Qb * 4 + (wave >> 1) + 1, Qb * 4 + 4, MIX + (size_t)(b * SEQ + Qb * 256) * DM + 512 + h * 64, DM);
    }
    __syncthreads();
    { const int tid = TID(), lane = tid & 63, wave = __builtin_amdgcn_readfirstlane(tid >> 6); bf16* Vt = (bf16*)(smem + wave * WAVE_LDS);
      for (int u = BID() * 8 + wave; u < 1024; u += GRD() * 8) lin_mix_wave<0>(p, l, Vt, u, lane);
      for (int u = 1024 + BID() * 8 + wave; u < 2048; u += GRD() * 8) lin_mix_wave<1>(p, l, Vt, u, lane); }
}

__device__ __forceinline__ void ln_row_store(f32x4 (&v)[4], const float* g, const float* bta, float* of, bf16* ob, int lane) {
    float s = 0.f;
#pragma unroll
    for (int j = 0; j < 4; ++j) s += (v[j][0] + v[j][1]) + (v[j][2] + v[j][3]);
    const float mean = wave_sum(s) * (1.f / DM); float s2 = 0.f;
#pragma unroll
    for (int j = 0; j < 4; ++j) { v[j] = v[j] - mean; s2 += (v[j][0] * v[j][0] + v[j][1] * v[j][1]) + (v[j][2] * v[j][2] + v[j][3] * v[j][3]); }
    const float rstd = 1.f / sqrtf(wave_sum(s2) * (1.f / DM) + LN_EPS);
#pragma unroll
    for (int j = 0; j < 4; ++j) { const f32x4 gg = *(const f32x4*)(g + lane * 4 + 256 * j), bb = *(const f32x4*)(bta + lane * 4 + 256 * j);
        v[j] = v[j] * rstd * gg + bb; if (of) *(f32x4*)(of + lane * 4 + 256 * j) = v[j]; st_bf4(ob + lane * 4 + 256 * j, v[j]); }
}

__device__ __forceinline__ void phase_ln(const Params& p, int l, int which  , int dummy = 0  ) {
    const int tid = TID(), lane = tid & 63, wave = __builtin_amdgcn_readfirstlane(tid >> 6); unsigned char* ws = p.ws;
    float* XR = p.out; bf16* XB = (bf16*)(ws + WS_XB);
    const float* g = p.in[26 + 2 * which] + l * DM; const float* bta = p.in[27 + 2 * which] + l * DM;
    const bf16* CT = (const bf16*)(ws + WS_CT);
    for (int row = BID() * 8 + wave; row < NTOK; row += GRD() * 8) {
        f32x4 v[4];
        if (which == 2) {
#pragma unroll
            for (int j = 0; j < 4; ++j) { const u32x2 c0 = *(const u32x2*)(CT + (size_t)row * DM + lane * 4 + 256 * j), c1 = *(const u32x2*)(CT + ((size_t)NTOK + row) * DM + lane * 4 + 256 * j);
                v[j] = up4q(*(const u32x2*)(XB + (size_t)row * DM + lane * 4 + 256 * j)) * ALPHA + up4q(c0) + up4q(c1); }
        } else {
#pragma unroll
            for (int j = 0; j < 4; ++j) v[j] = *(const f32x4*)(XR + (size_t)row * DM + lane * 4 + 256 * j);
        }
        float* of = which == 2 ? XR + (size_t)row * DM : nullptr; bf16* ob = XB + (size_t)row * DM;
        if (dummy) { of = (float*)(ws + (which == 2 ? WS_Y : WS_CT)) + (size_t)row * DM; ob = (bf16*)(ws + (which == 2 ? WS_ST : WS_Y)) + (size_t)row * DM; }
        ln_row_store(v, g, bta, of, ob, lane);
        if (which == 1) {
            const float* wgp = p.in[19] + (size_t)l * DM * 4; const float* bg = p.in[20] + l * 4; const float* wr = p.in[21] + (size_t)l * DM * 32; const float* br = p.in[22] + l * 32;
            float gl[4] = {0.f, 0.f, 0.f, 0.f};
#pragma unroll
            for (int j = 0; j < 4; ++j)
#pragma unroll
                for (int q = 0; q < 4; ++q) { const f32x4 w4 = *(const f32x4*)(wgp + (size_t)(lane * 4 + 256 * j + q) * 4); const float xv = v[j][q];
                    gl[0] = fmaf(xv, w4[0], gl[0]); gl[1] = fmaf(xv, w4[1], gl[1]); gl[2] = fmaf(xv, w4[2], gl[2]); gl[3] = fmaf(xv, w4[3], gl[3]); }
#pragma unroll
            for (int q = 0; q < 4; ++q) gl[q] = wave_sum(gl[q]) + bg[q];
            int gi = 0; float gm = gl[0];
#pragma unroll
            for (int q = 1; q < 4; ++q) if (gl[q] > gm) { gm = gl[q]; gi = q; }
            float gs = 0.f;
#pragma unroll
            for (int q = 0; q < 4; ++q) gs += expf(gl[q] - gm);
            const float gp = 1.f / gs;
            float el[8] = {0.f, 0.f, 0.f, 0.f, 0.f, 0.f, 0.f, 0.f};
#pragma unroll
            for (int j = 0; j < 4; ++j)
#pragma unroll
                for (int q = 0; q < 4; ++q) { const float* wrow = wr + (size_t)(lane * 4 + 256 * j + q) * 32 + gi * 8; const f32x4 w0 = *(const f32x4*)wrow, w1 = *(const f32x4*)(wrow + 4); const float xv = v[j][q];
                    el[0] = fmaf(xv, w0[0], el[0]); el[1] = fmaf(xv, w0[1], el[1]); el[2] = fmaf(xv, w0[2], el[2]); el[3] = fmaf(xv, w0[3], el[3]);
                    el[4] = fmaf(xv, w1[0], el[4]); el[5] = fmaf(xv, w1[1], el[5]); el[6] = fmaf(xv, w1[2], el[6]); el[7] = fmaf(xv, w1[3], el[7]); }
#pragma unroll
            for (int q = 0; q < 8; ++q) el[q] = wave_sum(el[q]) + br[gi * 8 + q];
            int i0 = 0; float m0 = el[0];
#pragma unroll
            for (int q = 1; q < 8; ++q) if (el[q] > m0) { m0 = el[q]; i0 = q; }
            int i1 = -1; float m1 = -3.0e38f;
#pragma unroll
            for (int q = 0; q < 8; ++q) if (q != i0 && el[q] > m1) { m1 = el[q]; i1 = q; }
            const float p1 = expf(m1 - m0); const float w0 = gp / (1.f + p1), w1 = gp * p1 / (1.f + p1);
            if (lane == 0 && !dummy) {
                unsigned* cnt = (unsigned*)(ws + WS_CTL) + CW_CNT + l * 32; int* LT = (int*)(ws + WS_LISTT); float* LW = (float*)(ws + WS_LISTW);
                const int e0 = gi * 8 + i0, e1 = gi * 8 + i1;
                const unsigned p0 = atomicAdd(cnt + e0, 1u); LT[(size_t)e0 * NTOK + p0] = row * 2; LW[(size_t)e0 * NTOK + p0] = w0;
                const unsigned q1 = atomicAdd(cnt + e1, 1u); LT[(size_t)e1 * NTOK + q1] = row * 2 + 1; LW[(size_t)e1 * NTOK + q1] = w1;
            }
        }
    }
}

__device__ __forceinline__ void moe_table(const Params& p, int l, int* tstart, int* cntl) {
    __syncthreads();
    if (TID() == 0) { const unsigned* cnt = (const unsigned*)(p.ws + WS_CTL) + CW_CNT + l * 32; int s = 0;
        for (int e = 0; e < 32; ++e) { const int c = (int)__hip_atomic_load(cnt + e, __ATOMIC_RELAXED, __HIP_MEMORY_SCOPE_AGENT); cntl[e] = c; tstart[e] = s; s += (c + 255) >> 8; } tstart[32] = s; }
    __syncthreads();
}

__device__ __forceinline__ void phase_moe(const Params& p, int l, unsigned char* smem, int which  ) {
    unsigned char* ws = p.ws;
    int* tstart = (int*)(smem + LDS_BYTES - 1024); int* cntl = tstart + 40;
    moe_table(p, l, tstart, cntl);
    if (which == 0) { SchedMoe S{tstart, cntl, (const int*)(ws + WS_LISTT), (const float*)(ws + WS_LISTW), (const bf16*)(ws + WS_XB), (const bf16*)(ws + W_GU), 0};
        EpiMoe1 E{(bf16*)(ws + WS_H)}; gemm_run<true>(smem, S, 1024, 1024, 1024, E); }
    else { SchedMoe S{tstart, cntl, (const int*)(ws + WS_LISTT), (const float*)(ws + WS_LISTW), (const bf16*)(ws + WS_H), (const bf16*)(ws + W_DN), 1};
        EpiMoe2 E{(bf16*)(ws + WS_CT)}; gemm_run(smem, S, 256, 256, 256, E); }
}

constexpr int LDS_PARAMS = LDS_BYTES - 512;
#define GETP const Params& p = *(const Params*)(smem + LDS_PARAMS); unsigned char* ws = p.ws; (void)ws
#ifndef PROBE_REP
#define PROBE_REP 0
#endif
#ifndef FULL_MASK
#define FULL_MASK 0x3fffu
#endif
#ifndef PHASE_ATTR
#define PHASE_ATTR __forceinline__
#endif
__device__ PHASE_ATTR void ph_conv(unsigned char* smem, int l, size_t dshift = 0) { GETP; phase_conv(p, l, smem, dshift); }
__device__ PHASE_ATTR void ph_pre(unsigned char* smem) { GETP; phase_pre(p); }
__device__ PHASE_ATTR void ph_g1(unsigned char* smem, int l) { GETP;
    { SchedGrid S{(const bf16*)(ws + WS_XB), (const bf16*)(ws + W_IN), 1024, 10, 640, 0, 0}; EpiBf16Store E{(bf16*)(ws + WS_Y), YW, 1.f}; gemm_run(smem, S, 1024, 1024, 1024, E); }
    { SchedGrid S{(const bf16*)(ws + WS_MEMB), (const bf16*)(ws + W_XKV), 1024, 8, 64, 128, 0}; EpiKVX E{(bf16*)(ws + WS_KVX), (bf16*)(ws + WS_KVX + 4 * MiB)}; gemm_run(smem, S, 1024, 1024, 1024, E); }
}
__device__ PHASE_ATTR void ph_loc(unsigned char* smem, int l) { GETP; phase_loc(p, l, smem); }
__device__ PHASE_ATTR void ph_scan(unsigned char* smem, int l, int part = 3  ) { GETP;
    if (part & 1) {
    { SchedGrid S{(const bf16*)(ws + WS_Y), (const bf16*)(ws + W_Q), 256, 3, 192, 0, Y_CQ};
      EpiMlaQ E{(bf16*)(ws + WS_QP), (const float*)(ws + WS_RS), (const float*)(ws + WS_ROPE)}; gemm_run(smem, S, 256, YW, 256, E); }
    { SchedGrid S{(const bf16*)(ws + WS_Y), (const bf16*)(ws + W_KV), 256, 5, 320, 64, Y_T9};
      EpiMlaKV E{(bf16*)(ws + WS_KP), (bf16*)(ws + WS_VP), (const float*)(ws + WS_RS), (const float*)(ws + WS_ROPE)}; gemm_run(smem, S, 256, YW, 256, E); }
    }
    if (part & 2) phase_scan(p, l);
    if (part & 4) phase_scan(p, l, 1);
}
__device__ PHASE_ATTR void ph_mix(unsigned char* smem, int l) { GETP; phase_mix(p, l, smem); }
__device__ PHASE_ATTR void ph_g4(unsigned char* smem, int l, int dummy = 0) { GETP;
    SchedGrid S{(const bf16*)(ws + WS_XB), (const bf16*)(ws + W_OUT), 1024, 4, 256, 0, 0}; EpiResid E{l == 0 ? p.in[0] : p.out, dummy ? (float*)(ws + WS_CT) : p.out}; gemm_run(smem, S, 1024, 1024, 1024, E);
}
__device__ PHASE_ATTR void ph_ln(unsigned char* smem, int l, int which, int dummy = 0) { GETP; phase_ln(p, l, which, dummy); }
__device__ PHASE_ATTR void ph_g5(unsigned char* smem, int l) { GETP;
    SchedGrid S{(const bf16*)(ws + WS_XB), (const bf16*)(ws + W_XQ), 1024, 4, 256, 0, 0}; EpiBf16Store E{(bf16*)(ws + WS_QX), DM, XSCALE}; gemm_run(smem, S, 1024, 1024, 1024, E);
}
__device__ PHASE_ATTR void ph_xatt(unsigned char* smem, int l) { GETP;
    const bf16* QX = (const bf16*)(ws + WS_QX); const bf16* KX = (const bf16*)(ws + WS_KVX); const bf16* VXT = (const bf16*)(ws + WS_KVX + 4 * MiB); bf16* OX = (bf16*)(ws + WS_OX);
    for (int L = BID(); L < 512; L += GRD()) { const int u = xcd_remap(L, 512), b = u >> 6, h = (u >> 4) & 3, qt = u & 15;
        attn_mfma_unit<256, 256, 1>(smem, QX + (size_t)(b * SEQ + qt * 128) * DM + h * 256, DM, KX + (size_t)(b * 256) * 1024 + h * 256, 1024, VXT + (size_t)((b * 4 + h) * 256) * 256, 256, 4, 4,
                                    OX + (size_t)(b * SEQ + qt * 128) * DM + h * 256, DM); }
}
__device__ PHASE_ATTR void ph_g7(unsigned char* smem, int l, int dummy = 0) { GETP;
    SchedGrid S{(const bf16*)(ws + WS_OX), (const bf16*)(ws + W_XO), 1024, 4, 256, 0, 0}; EpiResidB E{(const bf16*)(ws + WS_XB), dummy ? (float*)(ws + WS_CT) : p.out}; gemm_run(smem, S, 1024, 1024, 1024, E);
}
__device__ PHASE_ATTR void ph_moe(unsigned char* smem, int l, int which) { GETP; phase_moe(p, l, smem, which); }

template <unsigned MASK>
__global__ void __launch_bounds__(512, 2) fwd(Params pk) {
    extern __shared__ __attribute__((aligned(16))) unsigned char smem[];
    { const unsigned* src = (const unsigned*)&pk; unsigned* dst = (unsigned*)(smem + LDS_PARAMS); for (int i = threadIdx.x; i < (int)(sizeof(Params) / 4); i += 512) dst[i] = src[i]; }
    unsigned char* ws = pk.ws;
    volatile LAS unsigned* barw = (volatile LAS unsigned*)((LAS unsigned char*)smem + LDS_BARW);
    if (threadIdx.x == 0) { barw[0] = 0u; barw[1] = 0u; }
    __syncthreads();
    XcdBarrier bar; bar.bar = (unsigned*)(ws + WS_CTL) + CW_BAR; bar.x = 0; bar.st = barw;
    const int lo = pk.ph_lo, hi = pk.ph_hi;
    const bool multi = (hi - lo) > 1;
    if (multi) bar = xcd_barrier_post((unsigned*)(ws + WS_CTL) + CW_BAR, barw);
    if (lo == 0) ph_pre(smem);
#pragma unroll 1
    for (int l = 0; l < 2; ++l) {
        const int base = l * NPH;
#define IN(k) (((MASK >> (k)) & 1u) != 0u && lo <= base + (k) && base + (k) < hi)
#define SEAM(k) do { if (base + (k) + 1 < hi) { xcd_barrier(bar); if ((PROBE_REP >> 20) & 1) xcd_barrier(bar); } } while (0)
#if PROBE_REP
#define REP(k) int _nr##k = ((PROBE_REP >> (k)) & 1) ? 2 : 1; asm volatile("" : "+s"(_nr##k)); for (int _r = 0; _r < _nr##k; ++_r)
#else
#define REP(k)
#endif
        if (IN(PH_CONV)) { ph_conv(smem, l);
#if PROBE_REP
            if ((PROBE_REP >> PH_CONV) & 1) ph_conv(smem, 1 - l, WS_Y - W_IN);
            if ((PROBE_REP >> 21) & 1) ph_pre(smem);
#endif
            SEAM(PH_CONV); }
        if (IN(PH_G1)) { REP(PH_G1) { ph_g1(smem, l); } SEAM(PH_G1); }
        if (IN(PH_LOC)) { REP(PH_LOC) { ph_loc(smem, l); } SEAM(PH_LOC); }
        if (IN(PH_SCAN)) { ph_scan(smem, l);
#if PROBE_REP
            if ((PROBE_REP >> PH_SCAN) & 1) ph_scan(smem, l, 1);
            if ((PROBE_REP >> 22) & 1) { __syncthreads(); ph_scan(smem, l, 4); }
#endif
            SEAM(PH_SCAN); }
        if (IN(PH_MIX)) { REP(PH_MIX) { ph_mix(smem, l); } SEAM(PH_MIX); }
        if (IN(PH_G4)) { ph_g4(smem, l);
#if PROBE_REP
            if ((PROBE_REP >> PH_G4) & 1) ph_g4(smem, l, 1);
#endif
            SEAM(PH_G4); }
        if (IN(PH_LN1)) { ph_ln(smem, l, 0);
#if PROBE_REP
            if ((PROBE_REP >> PH_LN1) & 1) { __syncthreads(); ph_ln(smem, l, 0, 1); }
#endif
            SEAM(PH_LN1); }
        if (IN(PH_G5)) { REP(PH_G5) { ph_g5(smem, l); } SEAM(PH_G5); }
        if (IN(PH_XATT)) { REP(PH_XATT) { ph_xatt(smem, l); } SEAM(PH_XATT); }
        if (IN(PH_G7)) { ph_g7(smem, l);
#if PROBE_REP
            if ((PROBE_REP >> PH_G7) & 1) ph_g7(smem, l, 1);
#endif
            SEAM(PH_G7); }
        if (IN(PH_LN2)) { ph_ln(smem, l, 1);
#if PROBE_REP
            if ((PROBE_REP >> PH_LN2) & 1) { __syncthreads(); ph_ln(smem, l, 1, 1); }
#endif
            SEAM(PH_LN2); }
        if (IN(PH_MOE1)) { REP(PH_MOE1) { ph_moe(smem, l, 0); } SEAM(PH_MOE1); }
        if (IN(PH_MOE2)) { REP(PH_MOE2) { ph_moe(smem, l, 1); } SEAM(PH_MOE2); }
        if (IN(PH_LN3)) { ph_ln(smem, l, 2);
#if PROBE_REP
            if ((PROBE_REP >> PH_LN3) & 1) { __syncthreads(); ph_ln(smem, l, 2, 1); }
#endif
            SEAM(PH_LN3); }
#undef IN
#undef SEAM
#undef REP
    }
}

extern "C" void kernel_launch(void* const* d_in, const int* in_sizes, int n_in, void* d_out, int out_size, void* d_ws, size_t ws_size, hipStream_t stream) {
    static int grid = 0;
    typedef void (*kfn_t)(Params);
#if N_LAUNCH_MODE == 1
    static const kfn_t kfn[NPH] = { fwd<1u << 0>, fwd<1u << 1>, fwd<1u << 2>, fwd<1u << 3>, fwd<1u << 4>, fwd<1u << 5>, fwd<1u << 6>, fwd<1u << 7>, fwd<1u << 8>, fwd<1u << 9>, fwd<1u << 10>, fwd<1u << 11>, fwd<1u << 12>, fwd<1u << 13> };
    constexpr int NK = NPH;
#else
    static const kfn_t kfn[1] = { fwd<FULL_MASK> };
    constexpr int NK = 1;
#endif
    if (grid == 0) {
        int dev = 0, cus = 0;
        if (n_in != 32 || out_size != NTOK * DM || ws_size < WS_TOTAL) { fprintf(stderr, "kernel_launch: unexpected shapes (n_in %d out %d ws %zu need %zu)\n", n_in, out_size, ws_size, (size_t)WS_TOTAL); }
        (void)hipGetDevice(&dev); (void)hipDeviceGetAttribute(&cus, hipDeviceAttributeMultiprocessorCount, dev);
        for (int i = 0; i < NK; ++i) (void)hipFuncSetAttribute((const void*)kfn[i], hipFuncAttributeMaxDynamicSharedMemorySize, LDS_BYTES);
        int per_cu = 0; (void)hipOccupancyMaxActiveBlocksPerMultiprocessor(&per_cu, (const void*)kfn[0], 512, LDS_BYTES);
        (void)hipGetLastError();
        grid = cus > 0 ? cus : 256;
    }
    (void)hipMemsetAsync((char*)d_ws + WS_CTL, 0, CTL_BYTES, stream);
    Params p{};
    for (int i = 0; i < 32; ++i) p.in[i] = (const float*)d_in[i];
    p.out = (float*)d_out; p.ws = (unsigned char*)d_ws;
#if N_LAUNCH_MODE == 1
    for (int ph = 0; ph < 2 * NPH; ++ph) { p.ph_lo = ph; p.ph_hi = ph + 1; hipLaunchKernelGGL(kfn[ph % NPH], dim3(grid), dim3(512), LDS_BYTES, stream, p); }
#else
    p.ph_lo = 0; p.ph_hi = 2 * NPH; hipLaunchKernelGGL(kfn[0], dim3(grid), dim3(512), LDS_BYTES, stream, p);
#endif
}
```

```cpp
#include <hip/hip_runtime.h>
#include <stdint.h>
#include <stdio.h>

#ifndef N_LAUNCH_MODE
#define N_LAUNCH_MODE 0
#endif

typedef unsigned short bf16;
typedef float f32x4 __attribute__((ext_vector_type(4)));
typedef unsigned u32x4 __attribute__((ext_vector_type(4)));
typedef unsigned u32x2 __attribute__((ext_vector_type(2)));
#define LAS __attribute__((address_space(3)))

constexpr int NTOK = 16384, DM = 1024, SEQ = 2048, NBATCH = 8, YW = 2560, NCH = 32;
constexpr int Y_GQ = 0, Y_GK = 256, Y_GV = 512, Y_GR = 768, Y_MQ = 1024, Y_MK = 1280, Y_MV = 1536, Y_MO = 1792, Y_CQ = 2048, Y_T9 = 2304,
              Y_A = 2304, Y_MI = 2320, Y_MF = 2324, Y_CKV = 2328, Y_KR = 2456;
constexpr float ALPHA = 1.41421356237309515f;
constexpr float LN_EPS = 1e-5f;
constexpr float LOG2E = 1.44269504088896341f;
constexpr float QSCALE = 0.10206207261596575f * LOG2E;
constexpr float XSCALE = 0.0625f * LOG2E;
constexpr int NPH = 14;
enum { PH_CONV = 0, PH_G1, PH_LOC, PH_SCAN, PH_MIX, PH_G4, PH_LN1, PH_G5, PH_XATT, PH_G7, PH_LN2, PH_MOE1, PH_MOE2, PH_LN3 };

constexpr size_t MiB = 1u << 20;
constexpr size_t WS_CTL = 0, CTL_BYTES = 1 * MiB;
constexpr size_t W_IN = 1 * MiB;
constexpr size_t W_Q = W_IN + (size_t)2560 * 1024 * 2;
constexpr size_t W_KV = W_Q + (size_t)768 * 256 * 2;
constexpr size_t W_OUT = W_KV + (size_t)1280 * 256 * 2;
constexpr size_t W_XQ = W_OUT + 2 * MiB;
constexpr size_t W_XKV = W_XQ + 2 * MiB;
constexpr size_t W_XO = W_XKV + 4 * MiB;
constexpr size_t W_GU = W_XO + 2 * MiB;
constexpr size_t W_DN = W_GU + 32 * MiB;
constexpr size_t W_END = W_DN + 16 * MiB;
constexpr size_t WS_XB = W_END;
constexpr size_t WS_MEMB = WS_XB + 32 * MiB;
constexpr size_t WS_KVX = WS_MEMB + 4 * MiB;
constexpr size_t WS_ROPE = WS_KVX + 8 * MiB;
constexpr size_t WS_RS = WS_ROPE + 2 * MiB;
constexpr size_t WS_LISTT = WS_RS + 128 * 1024;
constexpr size_t WS_LISTW = WS_LISTT + 2 * MiB;
constexpr size_t WS_NV = WS_LISTW + 2 * MiB;
constexpr size_t WS_DEC = WS_NV + 256 * 1024;
constexpr size_t WS_SC = WS_DEC + 256 * 1024;
constexpr size_t WS_MS = WS_SC + 8 * 1024;
constexpr size_t WS_BC = WS_MS + 8 * 1024;
constexpr size_t WS_QKC = WS_BC + 16 * MiB;
constexpr size_t WS_Y = WS_QKC + 16 * MiB;
constexpr size_t WS_QX = WS_Y, WS_OX = WS_Y + 32 * MiB, WS_H = WS_Y;
constexpr size_t WS_QP = WS_Y + 80 * MiB;
constexpr size_t WS_KP = WS_QP + 24 * MiB;
constexpr size_t WS_VP = WS_KP + 24 * MiB;
constexpr size_t WS_ST = WS_VP + 16 * MiB;
constexpr size_t WS_CT = WS_QP;
constexpr size_t WS_TOTAL = WS_ST + 32 * MiB;
static_assert(WS_TOTAL <= (size_t)342000000, "workspace budget");
constexpr int CW_BAR = 4096;
constexpr int CW_CNT = 16384;

constexpr int LDS_BYTES = 147456;
constexpr int LDS_BARW = LDS_BYTES - 16;

struct Params {
    const float* in[32];
    float* out;
    unsigned char* ws;
    int ph_lo, ph_hi;
};

__device__ __forceinline__ float bf2f(unsigned v) { return __uint_as_float(v << 16); }
__device__ __forceinline__ unsigned f2bf(float f) { unsigned u = __float_as_uint(f); return (u + 0x7fffu + ((u >> 16) & 1u)) >> 16; }
typedef float f32x2_t __attribute__((ext_vector_type(2)));
typedef __bf16 bf16x2_t __attribute__((ext_vector_type(2)));
__device__ __forceinline__ unsigned pk2(float lo, float hi) { return __builtin_bit_cast(unsigned, __builtin_convertvector((f32x2_t){lo, hi}, bf16x2_t)); }
__device__ __forceinline__ float blo(unsigned w) { return __uint_as_float(w << 16); }
__device__ __forceinline__ float bhi(unsigned w) { return __uint_as_float(w & 0xffff0000u); }
__device__ __forceinline__ float wave_sum(float v) {
#pragma unroll
    for (int o = 1; o < 64; o <<= 1) v += __shfl_xor(v, o);
    return v;
}
__device__ __forceinline__ float logsigmoid(float z) { return fminf(z, 0.f) - log1pf(expf(-fabsf(z))); }
__device__ __forceinline__ float fexp(float x) { return __builtin_amdgcn_exp2f(x * LOG2E); }
__device__ __forceinline__ float sigmoidf(float x) { return __builtin_amdgcn_rcpf(1.f + fexp(-x)); }
__device__ __forceinline__ float siluf(float x) { return x * __builtin_amdgcn_rcpf(1.f + fexp(-x)); }
__device__ __forceinline__ f32x4 up4q(u32x2 w) { return (f32x4){blo(w.x), bhi(w.x), blo(w.y), bhi(w.y)}; }
__device__ __forceinline__ void st_bf4(bf16* p, f32x4 v) { u32x2 w; w.x = pk2(v[0], v[1]); w.y = pk2(v[2], v[3]); *(u32x2*)p = w; }

#define XB_TMO      128
#define XB_XCNT(j)  (256  + 64 * (j))
#define XB_XSUB(j)  (1280 + 64 * (j))
#define XB_XGEN(j)  (2304 + 64 * (j))
#define XB_TOP      3328
#define XB_TOPGEN   3392
#define XCD_BAR_WORDS 3456
#define XB_SPIN_CAP (1u << 24)
__device__ __forceinline__ unsigned xb_ld(unsigned* p)              { return __hip_atomic_load(p, __ATOMIC_RELAXED, __HIP_MEMORY_SCOPE_AGENT); }
__device__ __forceinline__ unsigned xb_add(unsigned* p, unsigned v) { return __hip_atomic_fetch_add(p, v, __ATOMIC_RELAXED, __HIP_MEMORY_SCOPE_AGENT); }
__device__ __forceinline__ unsigned xb_xcc_id() { return (unsigned)__builtin_amdgcn_s_getreg((3 << 11) | 20) & 0xFu; }
#define XB_SPIN(cond, bar) do { unsigned _sp = 0; while (cond) { __builtin_amdgcn_s_sleep(1); \
    if ((++_sp & 255u) == 0u) { if (xb_ld(&(bar)[XB_TMO])) break; if (_sp > XB_SPIN_CAP) { atomicAdd(&(bar)[XB_TMO], 1u); break; } } } } while (0)
struct XcdBarrier { unsigned* bar; unsigned x; volatile LAS unsigned* st; };
__device__ __forceinline__ XcdBarrier xcd_barrier_post(unsigned* bar, volatile LAS unsigned* st) {
    XcdBarrier b; b.bar = bar; b.x = xb_xcc_id(); b.st = st;
    if (threadIdx.x == 0) (void)xb_add(&bar[XB_XCNT(b.x)], 1u);
    return b;
}
__device__ __forceinline__ void xcd_barrier_complete(unsigned* bar, unsigned x, unsigned& nloc, unsigned& nx) {
    const unsigned G = gridDim.x * gridDim.y * gridDim.z;
    unsigned sum, cnt, mine, sp = 0u;
    for (;;) {
        sum = 0u; cnt = 0u; mine = 0u;
#pragma unroll
        for (unsigned j = 0; j < 16; ++j) { const unsigned c = xb_ld(&bar[XB_XCNT(j)]); sum += c; cnt += (c > 0u) ? 1u : 0u; mine = (j == x) ? c : mine; }
        if (sum == G) break;
        __builtin_amdgcn_s_sleep(1);
        if ((++sp & 255u) == 0u) { if (xb_ld(&bar[XB_TMO])) break; if (sp > XB_SPIN_CAP) { atomicAdd(&bar[XB_TMO], 1u); break; } }
    }
    nloc = mine > 0u ? mine : 1u; nx = cnt > 0u ? cnt : 1u;
}
__device__ __forceinline__ void xcd_barrier(const XcdBarrier& b) {
    asm volatile("s_waitcnt vmcnt(0)" ::: "memory");
    __syncthreads();
    if (threadIdx.x == 0) {
        unsigned* bar = b.bar; asm volatile("" : "+s"(bar));
        __builtin_amdgcn_s_waitcnt(0);
        unsigned nloc = b.st[0], nx = b.st[1];
        if (nloc == 0u) { xcd_barrier_complete(bar, b.x, nloc, nx); b.st[0] = nloc; b.st[1] = nx; }
        const unsigned old = xb_add(&bar[XB_XSUB(b.x)], 1u);
        const unsigned gen = old / nloc;
        if (old + 1u == (gen + 1u) * nloc) {
            __builtin_amdgcn_fence(__ATOMIC_RELEASE, "agent");
            asm volatile("s_waitcnt vmcnt(0)" ::: "memory");
            const unsigned og = xb_add(&bar[XB_TOP], 1u);
            const unsigned tg = og / nx;
            if (og + 1u == (tg + 1u) * nx) xb_add(&bar[XB_TOPGEN], 1u);
            else XB_SPIN(xb_ld(&bar[XB_TOPGEN]) == tg, bar);
            __builtin_amdgcn_fence(__ATOMIC_ACQUIRE, "agent");
            xb_add(&bar[XB_XGEN(b.x)], 1u);
            asm volatile("s_waitcnt vmcnt(0)" ::: "memory");
        } else {
            XB_SPIN(xb_ld(&bar[XB_XGEN(b.x)]) == gen, bar);
            __builtin_amdgcn_fence(__ATOMIC_ACQUIRE, "agent");
            asm volatile("s_waitcnt vmcnt(0)" ::: "memory");
        }
    }
    __syncthreads();
}

__device__ __forceinline__ int TID() { int t = threadIdx.x; asm volatile("" : "+v"(t)); return t; }
__device__ __forceinline__ int BID() { int t = blockIdx.x; asm volatile("" : "+s"(t)); return t; }
__device__ __forceinline__ int GRD() { int t = gridDim.x; asm volatile("" : "+s"(t)); return t; }

struct UnitDesc {
    const bf16* A;
    const bf16* B;
    const int* ridx;
    const float* rw;
    int arow0, acol;
    int row0, col0;
    int nvalid;
    int gather;
};

struct NoPre {};
struct EpiBf16Store { bf16* O; int ldo; float scale; typedef NoPre Pre;
    __device__ __forceinline__ Pre pre(const UnitDesc&, int, int) const { return Pre{}; }
    __device__ __forceinline__ void post(const UnitDesc& u, int r, int c, const Pre&, f32x4 v00, f32x4 v01, f32x4 v10, f32x4 v11) const {
        bf16* o = O + (size_t)(u.row0 + r) * ldo + u.col0 + c; st_bf4(o, v00 * scale); st_bf4(o + 16, v01 * scale); st_bf4(o + 128, v10 * scale); st_bf4(o + 144, v11 * scale); } };
struct EpiKVX { bf16* KX; bf16* VXT; typedef NoPre Pre;
    __device__ __forceinline__ Pre pre(const UnitDesc&, int, int) const { return Pre{}; }
    __device__ __forceinline__ void grp(int row, int c, f32x4 v) const {
        if (c < 1024) st_bf4(KX + (size_t)row * 1024 + c, v);
        else { const int cc = c - 1024, b = row >> 8, key = row & 255; bf16* vt = VXT + ((size_t)(b * 1024 + cc)) * 256 + key;
            vt[0] = (bf16)f2bf(v[0]); vt[256] = (bf16)f2bf(v[1]); vt[512] = (bf16)f2bf(v[2]); vt[768] = (bf16)f2bf(v[3]); } }
    __device__ __forceinline__ void post(const UnitDesc& u, int r, int c, const Pre&, f32x4 v00, f32x4 v01, f32x4 v10, f32x4 v11) const {
        const int row = u.row0 + r, cc = u.col0 + c; grp(row, cc, v00); grp(row, cc + 16, v01); grp(row, cc + 128, v10); grp(row, cc + 144, v11); } };
struct EpiResidB { const bf16* res; float* out;
    struct Pre { u32x2 a, b, c, d; };
    __device__ __forceinline__ Pre pre(const UnitDesc& u, int r, int c) const { const bf16* p = res + (size_t)(u.row0 + r) * DM + u.col0 + c;
        return Pre{*(const u32x2*)p, *(const u32x2*)(p + 16), *(const u32x2*)(p + 128), *(const u32x2*)(p + 144)}; }
    __device__ __forceinline__ void post(const UnitDesc& u, int r, int c, const Pre& pr, f32x4 v00, f32x4 v01, f32x4 v10, f32x4 v11) const {
        float* o = out + (size_t)(u.row0 + r) * DM + u.col0 + c;
        *(f32x4*)o = up4q(pr.a) * ALPHA + v00; *(f32x4*)(o + 16) = up4q(pr.b) * ALPHA + v01; *(f32x4*)(o + 128) = up4q(pr.c) * ALPHA + v10; *(f32x4*)(o + 144) = up4q(pr.d) * ALPHA + v11; } };
struct EpiResid { const float* res; float* out;
    struct Pre { f32x4 a, b, c, d; };
    __device__ __forceinline__ Pre pre(const UnitDesc& u, int r, int c) const { const float* p = res + (size_t)(u.row0 + r) * DM + u.col0 + c;
        return Pre{*(const f32x4*)p, *(const f32x4*)(p + 16), *(const f32x4*)(p + 128), *(const f32x4*)(p + 144)}; }
    __device__ __forceinline__ void post(const UnitDesc& u, int r, int c, const Pre& pr, f32x4 v00, f32x4 v01, f32x4 v10, f32x4 v11) const {
        float* o = out + (size_t)(u.row0 + r) * DM + u.col0 + c;
        *(f32x4*)o = pr.a * ALPHA + v00; *(f32x4*)(o + 16) = pr.b * ALPHA + v01; *(f32x4*)(o + 128) = pr.c * ALPHA + v10; *(f32x4*)(o + 144) = pr.d * ALPHA + v11; } };
__device__ __forceinline__ f32x4 rot4(f32x4 v, f32x4 cs) { return (f32x4){v[0] * cs[0] - v[1] * cs[1], v[1] * cs[0] + v[0] * cs[1], v[2] * cs[2] - v[3] * cs[3], v[3] * cs[2] + v[2] * cs[3]}; }
struct EpiMlaQ { bf16* QP; const float* RS; const float* ROPE;
    struct Pre { float rs; f32x4 cs[4]; };
    __device__ __forceinline__ Pre pre(const UnitDesc& u, int r, int c) const { const int row = u.row0 + r; Pre p; p.rs = RS[row * 2] * QSCALE;
#pragma unroll
        for (int k = 0; k < 4; ++k) { const int cc = u.col0 + c + (k >> 1) * 128 + (k & 1) * 16, j = cc % 96, i = (j >= 64 ? j - 64 : 0) >> 1; p.cs[k] = *(const f32x4*)(ROPE + ((size_t)row * 16 + i) * 2); }
        return p; }
    __device__ __forceinline__ void grp(int row, int c, f32x4 v, float rs, f32x4 cs) const {
        const int b = row >> 11, s = row & 2047, h = c / 96, j = c - h * 96;
        v = v * rs; if (j >= 64) v = rot4(v, cs);
        st_bf4(QP + ((size_t)((b * 8 + h) * SEQ + s)) * 96 + j, v); }
    __device__ __forceinline__ void post(const UnitDesc& u, int r, int c, const Pre& pr, f32x4 v00, f32x4 v01, f32x4 v10, f32x4 v11) const {
        const int row = u.row0 + r, cc = u.col0 + c; grp(row, cc, v00, pr.rs, pr.cs[0]); grp(row, cc + 16, v01, pr.rs, pr.cs[1]); grp(row, cc + 128, v10, pr.rs, pr.cs[2]); grp(row, cc + 144, v11, pr.rs, pr.cs[3]); } };
struct EpiMlaKV { bf16 *KP, *VP; const float* RS; const float* ROPE;
    struct Pre { float rs; f32x4 cs[4]; };
    __device__ __forceinline__ Pre pre(const UnitDesc& u, int r, int c) const { const int row = u.row0 + r; Pre p; p.rs = RS[row * 2 + 1];
#pragma unroll
        for (int k = 0; k < 4; ++k) { const int cc = u.col0 + c + (k >> 1) * 128 + (k & 1) * 16, j = cc % 160, i = ((j >= 64 && j < 96) ? j - 64 : 0) >> 1; p.cs[k] = *(const f32x4*)(ROPE + ((size_t)row * 16 + i) * 2); }
        return p; }
    __device__ __forceinline__ void grp(int row, int c, f32x4 v, float rs, f32x4 cs) const {
        const int b = row >> 11, s = row & 2047, h = c / 160, j = c - h * 160;
        if (j < 64) st_bf4(KP + ((size_t)((b * 8 + h) * SEQ + s)) * 96 + j, v * rs);
        else if (j < 96) st_bf4(KP + ((size_t)((b * 8 + h) * SEQ + s)) * 96 + j, rot4(v, cs));
        else { bf16* vt = VP + ((size_t)((b * 8 + h) * 64 + (j - 96))) * SEQ + s;
            vt[0] = (bf16)f2bf(v[0] * rs); vt[SEQ] = (bf16)f2bf(v[1] * rs); vt[2 * SEQ] = (bf16)f2bf(v[2] * rs); vt[3 * SEQ] = (bf16)f2bf(v[3] * rs); } }
    __device__ __forceinline__ void post(const UnitDesc& u, int r, int c, const Pre& pr, f32x4 v00, f32x4 v01, f32x4 v10, f32x4 v11) const {
        const int row = u.row0 + r, cc = u.col0 + c; grp(row, cc, v00, pr.rs, pr.cs[0]); grp(row, cc + 16, v01, pr.rs, pr.cs[1]); grp(row, cc + 128, v10, pr.rs, pr.cs[2]); grp(row, cc + 144, v11, pr.rs, pr.cs[3]); } };
struct EpiMoe1 { bf16* H; typedef NoPre Pre;
    __device__ __forceinline__ Pre pre(const UnitDesc&, int, int) const { return Pre{}; }
    __device__ __forceinline__ void post(const UnitDesc& u, int r, int c, const Pre&, f32x4 v00, f32x4 v01, f32x4 v10, f32x4 v11) const {
        f32x4 h0, h1;
#pragma unroll
        for (int j = 0; j < 4; ++j) { h0[j] = siluf(v00[j]) * v01[j]; h1[j] = siluf(v10[j]) * v11[j]; }
        bf16* o = H + (size_t)(u.row0 + r) * 256 + u.col0 + (c >> 5) * 16 + (c & 15); st_bf4(o, h0); st_bf4(o + 64, h1); } };
struct EpiMoe2 { bf16* CT;
    struct Pre { int ent; float w; };
    __device__ __forceinline__ Pre pre(const UnitDesc& u, int r, int) const { return Pre{u.ridx[r], u.rw[r]}; }
    __device__ __forceinline__ void post(const UnitDesc& u, int r, int c, const Pre& pr, f32x4 v00, f32x4 v01, f32x4 v10, f32x4 v11) const {
        bf16* o = CT + ((size_t)(pr.ent & 1) * NTOK + (pr.ent >> 1)) * DM + u.col0 + c; st_bf4(o, v00 * pr.w); st_bf4(o + 16, v01 * pr.w); st_bf4(o + 128, v10 * pr.w); st_bf4(o + 144, v11 * pr.w); } };

typedef short bf16x8 __attribute__((ext_vector_type(8)));
namespace mg {
constexpr int BK = 64, HALF = 128, HTB = HALF * BK * 2, STAGE_BYTES = 8 * HTB;
__device__ __forceinline__ int lds_byte(int r, int c) { const int st = (r >> 4) * 2 + (c >> 5), rr = r & 15, cc = c & 31, ob = rr * 64 + cc * 2; return st * 1024 + (ob ^ (((ob >> 9) & 1) << 5)); }
__device__ __forceinline__ void stage_rc(int b, int& R, int& C) { const int st = b / 1024, sb = b % 1024, swz = sb ^ (((sb >> 9) & 1) << 5); R = (st >> 1) * 16 + swz / 64; C = (st & 1) * 32 + (swz % 64) / 2; }

template <bool GATHER, class Sched, class Epi>
__device__ __forceinline__ void gemm_mfma(LAS unsigned char* lds, const Sched& S, const int K, const int lda, const int ldb, const Epi& E) {
    const int tid = TID(), wid = __builtin_amdgcn_readfirstlane(tid >> 6), lane = tid & 63, wr = wid >> 2, wc = wid & 3, fr = lane & 15, fq = lane >> 4;
    const int nt = K / BK;
    unsigned voffB[2], voffA[2];
    { int R0, C0, R1, C1; stage_rc(tid * 16, R0, C0); stage_rc(tid * 16 + 8192, R1, C1); voffB[0] = (unsigned)(R0 * ldb + C0) * 2u; voffB[1] = (unsigned)(R1 * ldb + C1) * 2u;
      voffA[0] = (unsigned)(R0 * lda + C0) * 2u; voffA[1] = (unsigned)(R1 * lda + C1) * 2u; }
    const size_t kstep = (size_t)(BK * 2);
    const size_t hstepB = (size_t)HALF * ldb * 2, hstepA = (size_t)HALF * lda * 2;
    const unsigned ldsw = (unsigned)wid * 1024u;
    const int aoff = lds_byte(wr * 64 + fr, fq * 8), boff = lds_byte(wc * 32 + fr, fq * 8);
#define MG_SA(b, h) (((b) * 2 + (h)) * HTB)
#define MG_SB(b, h) ((4 + (b) * 2 + (h)) * HTB)
#define MG_STAGE(bufoff, gbase, voff) do { _Pragma("unroll") for (int _i = 0; _i < 2; ++_i) \
        __builtin_amdgcn_global_load_lds((const unsigned*)((const char*)(gbase) + (voff)[_i]), (LAS unsigned*)(lds + (bufoff) + ldsw + _i * 8192), 16, 0, 0); } while (0)
#define MG_STA(bufoff, base, h, nx) do { if constexpr (GATHER) { MG_STAGE(bufoff, base, vc[h]); } else { MG_STAGE(bufoff, (base) + (h) * hstepA, voffA); } } while (0)
#define MG_LDA(dst, b, h) do { _Pragma("unroll") for (int m = 0; m < 4; ++m) _Pragma("unroll") for (int k = 0; k < 2; ++k) dst[m][k] = *(const LAS bf16x8*)(lds + MG_SA(b, h) + aoff + m * 2048 + k * 1024); } while (0)
#define MG_LDB(dst, b, h) do { _Pragma("unroll") for (int n = 0; n < 2; ++n) _Pragma("unroll") for (int k = 0; k < 2; ++k) dst[n][k] = *(const LAS bf16x8*)(lds + MG_SB(b, h) + boff + n * 2048 + k * 1024); } while (0)
#define MG_MMA(ai, bj, At, Bt) do { __builtin_amdgcn_s_setprio(1); _Pragma("unroll") for (int m = 0; m < 4; ++m) _Pragma("unroll") for (int n = 0; n < 2; ++n) _Pragma("unroll") for (int k = 0; k < 2; ++k) \
        acc[ai][bj][m][n] = __builtin_amdgcn_mfma_f32_16x16x32_bf16(Bt[n][k], At[m][k], acc[ai][bj][m][n], 0, 0, 0); __builtin_amdgcn_s_setprio(0); } while (0)
#define MG_WAIT_V(n) asm volatile("s_waitcnt vmcnt(" #n ")" ::: "memory")
#define MG_WAIT_L(n) asm volatile("s_waitcnt lgkmcnt(" #n ")" ::: "memory")
#define MG_BAR __builtin_amdgcn_s_barrier()
#define MG_SCHED __builtin_amdgcn_sched_barrier(0)
#define MG_MKOFF(u, v) do { if constexpr (GATHER) { int R0, C0, R1, C1; { const int _t = TID(); stage_rc(_t * 16, R0, C0); stage_rc(_t * 16 + 8192, R1, C1); } _Pragma("unroll") for (int _h = 0; _h < 2; ++_h) { \
        const int _r0 = R0 + 128 * _h, _r1 = R1 + 128 * _h; const int _l = (u).nvalid - 1; const int _a0 = (u).ridx[_r0 < _l ? _r0 : _l] >> 1, _a1 = (u).ridx[_r1 < _l ? _r1 : _l] >> 1; \
        v[_h][0] = ((unsigned)_a0 * (unsigned)lda + (unsigned)C0) * 2u; v[_h][1] = ((unsigned)_a1 * (unsigned)lda + (unsigned)C1) * 2u; } } } while (0)
#define MG_ABASE(u) (GATHER ? (const char*)((u).A + (u).acol) : (const char*)((u).A + (size_t)(u).arow0 * lda + (u).acol))
    UnitDesc cur, nxt; int ui = 0;
    if (!S.get(0, cur)) return;
    f32x4 acc[2][2][4][2];
#pragma unroll
    for (int a = 0; a < 2; ++a)
#pragma unroll
        for (int b = 0; b < 2; ++b)
#pragma unroll
            for (int m = 0; m < 4; ++m)
#pragma unroll
                for (int n = 0; n < 2; ++n) acc[a][b][m][n] = (f32x4){0.f, 0.f, 0.f, 0.f};
    bf16x8 At[4][2], B0[2][2], B1[2][2];
    unsigned vc[2][2];
    MG_MKOFF(cur, vc);
    const char* cA = MG_ABASE(cur); const char* cB = (const char*)cur.B;
    MG_STAGE(MG_SB(0, 0), cB, voffB); MG_STA(MG_SA(0, 0), cA, 0, false); MG_STAGE(MG_SB(0, 1), cB + hstepB, voffB); MG_STA(MG_SA(0, 1), cA, 1, false);
    if (wr == 1) MG_BAR;
    MG_WAIT_V(4); MG_BAR;
    MG_STAGE(MG_SB(1, 0), cB + kstep, voffB); MG_STA(MG_SA(1, 0), cA + kstep, 0, false); MG_STAGE(MG_SB(1, 1), cB + hstepB + kstep, voffB);
    MG_WAIT_V(6); MG_BAR;
    for (;;) {
        const bool has_next = S.get(ui + 1, nxt);
        const char* nA = has_next ? MG_ABASE(nxt) : cA; const char* nB = has_next ? (const char*)nxt.B : cB;
#pragma unroll 1
        for (int t = 0; t < nt; t += 2) {
            const bool last = (t == nt - 2);
            const char* a1 = cA + (size_t)(t + 1) * kstep;
            const char* a2 = last ? nA : cA + (size_t)(t + 2) * kstep; const char* b2 = last ? nB : cB + (size_t)(t + 2) * kstep;
            const char* a3 = a2 + kstep; const char* b3 = b2 + kstep;
            MG_LDB(B0, 0, 0); MG_SCHED; MG_LDA(At, 0, 0); MG_STA(MG_SA(1, 1), a1, 1, false);
            if constexpr (GATHER) { if (last && has_next) { MG_MKOFF(nxt, vc); } }
            MG_WAIT_L(8); MG_BAR; MG_WAIT_L(0); MG_MMA(0, 0, At, B0); MG_BAR; MG_SCHED;
            MG_LDB(B1, 0, 1); MG_STAGE(MG_SB(0, 0), b2, voffB);
            MG_BAR; MG_WAIT_L(0); MG_MMA(0, 1, At, B1); MG_BAR;
            MG_LDA(At, 0, 1); MG_STA(MG_SA(0, 0), a2, 0, last);
            MG_BAR; MG_WAIT_L(0); MG_MMA(1, 0, At, B0); MG_BAR; MG_SCHED;
            MG_STAGE(MG_SB(0, 1), b2 + hstepB, voffB);
            MG_WAIT_V(6); MG_BAR; MG_MMA(1, 1, At, B1); MG_BAR;
            MG_LDB(B0, 1, 0); MG_SCHED; MG_LDA(At, 1, 0); MG_STA(MG_SA(0, 1), a2, 1, last);
            MG_WAIT_L(8); MG_BAR; MG_WAIT_L(0); MG_MMA(0, 0, At, B0); MG_BAR; MG_SCHED;
            MG_LDB(B1, 1, 1); MG_STAGE(MG_SB(1, 0), b3, voffB);
            MG_BAR; MG_WAIT_L(0); MG_MMA(0, 1, At, B1); MG_BAR;
            MG_LDA(At, 1, 1); MG_STA(MG_SA(1, 0), a3, 0, last);
            MG_BAR; MG_WAIT_L(0); MG_MMA(1, 0, At, B0); MG_BAR; MG_SCHED;
            MG_STAGE(MG_SB(1, 1), b3 + hstepB, voffB);
            MG_WAIT_V(6); MG_BAR; MG_MMA(1, 1, At, B1); MG_BAR;
        }
        {
            const int rb = wr * 64 + fr, cb = wc * 32 + 4 * fq;
            typename Epi::Pre pr = E.pre(cur, rb, cb);
#pragma unroll
            for (int gi = 0; gi < 8; ++gi) { const int ai = gi >> 2, m = gi & 3, r = ai * HALF + m * 16 + rb;
                typename Epi::Pre nx = pr;
                if (gi < 7) nx = E.pre(cur, ((gi + 1) >> 2) * HALF + ((gi + 1) & 3) * 16 + rb, cb);
                if (r < cur.nvalid) E.post(cur, r, cb, pr, acc[ai][0][m][0], acc[ai][0][m][1], acc[ai][1][m][0], acc[ai][1][m][1]);
                pr = nx;
                asm volatile("" ::: "memory"); }
        }
        if (!has_next) break;
#pragma unroll
        for (int a = 0; a < 2; ++a)
#pragma unroll
            for (int b = 0; b < 2; ++b)
#pragma unroll
                for (int m = 0; m < 4; ++m)
#pragma unroll
                    for (int n = 0; n < 2; ++n) acc[a][b][m][n] = (f32x4){0.f, 0.f, 0.f, 0.f};
        cur = nxt; cA = nA; cB = nB; ++ui;
    }
    MG_WAIT_V(0);
    if (wr == 0) MG_BAR;
    MG_BAR;
#undef MG_SA
#undef MG_SB
#undef MG_STAGE
#undef MG_LDA
#undef MG_LDB
#undef MG_MMA
#undef MG_WAIT_V
#undef MG_WAIT_L
#undef MG_BAR
#undef MG_SCHED
#undef MG_MKOFF
#undef MG_STA
#undef MG_ABASE
}
}

#ifndef USE_MFMA
#define USE_MFMA 1
#endif
template <bool GATHER = false, class Sched, class Epi>
__device__ __forceinline__ void gemm_run(unsigned char* smem, const Sched& S, int K, int lda, int ldb, const Epi& E) {
#if USE_MFMA
    __syncthreads();
    mg::gemm_mfma<GATHER>((LAS unsigned char*)smem, S, K, lda, ldb, E);
    __syncthreads();
#endif
}
__device__ __forceinline__ int xcd_remap(int L, int n) { const int q = n >> 3, r = n & 7, x = L & 7, off = L >> 3; return (x < r ? x * (q + 1) : r * (q + 1) + (x - r) * q) + off; }
struct SchedGrid { const bf16* A; const bf16* B; int ldb, npn, nunits, rot, acol;
    __device__ __forceinline__ bool get(int i, UnitDesc& u) const {
        const int G = GRD(); const int L = (BID() + rot) % G + i * G; if (L >= nunits) return false;
        const int idx = xcd_remap(L, nunits), npm = nunits / npn, nig = 8 * npn, gid = idx / nig, fm = gid * 8, gsz = (npm - fm) < 8 ? (npm - fm) : 8, w = idx - gid * nig;
        const int pm = fm + w % gsz, pn = w / gsz;
        u.A = A; u.B = B + (size_t)pn * 256 * ldb; u.ridx = nullptr; u.rw = nullptr; u.arow0 = pm * 256; u.acol = acol; u.row0 = pm * 256; u.col0 = pn * 256; u.nvalid = 256; u.gather = 0; return true; } };
struct SchedMoe { const int* tstart; const int* cntl; const int* LT; const float* LW; const bf16* A; const bf16* W; int which;
    __device__ __forceinline__ bool get(int i, UnitDesc& u) const {
        const int ncol = which == 0 ? 2 : 4; const int L = BID() + i * GRD(), nun = __builtin_amdgcn_readfirstlane(tstart[32]) * ncol; if (L >= nun) return false;
        const int idx = xcd_remap(L, nun);
        const int rt = idx / ncol, pn = idx - rt * ncol; int e = 0;
        for (int q = 1; q < 32; ++q) if (__builtin_amdgcn_readfirstlane(tstart[q]) <= rt) e = q;
        const int pos0 = (rt - __builtin_amdgcn_readfirstlane(tstart[e])) * 256; int nv = __builtin_amdgcn_readfirstlane(cntl[e]) - pos0; nv = nv > 256 ? 256 : nv;
        u.ridx = LT + (size_t)e * NTOK + pos0; u.rw = LW + (size_t)e * NTOK + pos0; u.nvalid = nv; u.acol = 0; u.A = A;
        if (which == 0) { u.B = W + ((size_t)e * 512 + pn * 256) * 1024; u.arow0 = 0; u.row0 = rt * 256; u.col0 = pn * 128; u.gather = 1; }
        else { u.B = W + ((size_t)e * 1024 + pn * 256) * 256; u.arow0 = rt * 256; u.row0 = 0; u.col0 = pn * 256; u.gather = 0; }
        return true; } };

template <class F>
__device__ __forceinline__ void conv_item(const F& src, bf16* dst, int K, float* scr, int k0, int n0, int lane) {
#pragma unroll 8
    for (int i = 0; i < 32; ++i) { const int kk = 2 * i + (lane >> 5); scr[kk * 33 + (lane & 31)] = src(k0 + kk, n0 + (lane & 31)); }
    asm volatile("s_waitcnt lgkmcnt(0)" ::: "memory");
    const int c = lane & 7;
#pragma unroll
    for (int j = 0; j < 4; ++j) { const int n = (lane >> 3) + 8 * j; const float* s = scr + (8 * c) * 33 + n;
        u32x4 o; o.x = pk2(s[0 * 33], s[1 * 33]); o.y = pk2(s[2 * 33], s[3 * 33]); o.z = pk2(s[4 * 33], s[5 * 33]); o.w = pk2(s[6 * 33], s[7 * 33]);
        *(u32x4*)(dst + (size_t)(n0 + n) * K + k0 + 8 * c) = o; }
    asm volatile("s_waitcnt lgkmcnt(0)" ::: "memory");
}
template <class F4>
__device__ __forceinline__ void conv_item4(const F4& src4, bf16* dst, int K, float* scr, int k0, int n0, int lane) {
    f32x4 v[16];
#pragma unroll
    for (int i = 0; i < 16; ++i) v[i] = src4(k0 + i * 4 + (lane >> 4), n0 + (lane & 15) * 4);
#pragma unroll
    for (int i = 0; i < 16; ++i) { float* d = scr + (i * 4 + (lane >> 4)) * 65 + (lane & 15) * 4; d[0] = v[i][0]; d[1] = v[i][1]; d[2] = v[i][2]; d[3] = v[i][3]; }
    asm volatile("s_waitcnt lgkmcnt(0)" ::: "memory");
    const int c = lane & 7;
#pragma unroll
    for (int j = 0; j < 8; ++j) { const int n = j * 8 + (lane >> 3); const float* s = scr + (8 * c) * 65 + n;
        u32x4 o; o.x = pk2(s[0 * 65], s[1 * 65]); o.y = pk2(s[2 * 65], s[3 * 65]); o.z = pk2(s[4 * 65], s[5 * 65]); o.w = pk2(s[6 * 65], s[7 * 65]);
        *(u32x4*)(dst + (size_t)(n0 + n) * K + k0 + 8 * c) = o; }
    asm volatile("s_waitcnt lgkmcnt(0)" ::: "memory");
}
__device__ __forceinline__ int yc_src(int n) {
    if (n < 1024) return n;
    if (n < 2048) return n + 16;
    if (n < 2304) return n + 24;
    if (n < 2320) return 1024 + (n - 2304);
    if (n < 2328) return 2064 + (n - 2320);
    if (n < 2488) return n;
    return -1;
}

__device__ __forceinline__ void phase_conv(const Params& p, int l, unsigned char* smem, size_t dshift = 0  ) {
    const int tid = TID(), lane = tid & 63, wave = __builtin_amdgcn_readfirstlane(tid >> 6);
    const int gw = BID() * 8 + wave, NGW = GRD() * 8;
    float* scr = (float*)(smem + wave * 18304);
    unsigned char* ws = p.ws + dshift;
    const float* w_in = p.in[3] + (size_t)l * 1024 * 2488;
    const float* w_out = p.in[4] + (size_t)l * 1024 * 1024;
    const float* gq = p.in[12] + l * 256; const float* w_uq = p.in[13] + (size_t)l * 256 * 768;
    const float* gkv = p.in[14] + l * 128; const float* w_ukv = p.in[15] + (size_t)l * 128 * 1024;
    const float* xwq = p.in[16] + (size_t)l * 1024 * 1024; const float* xwkv = p.in[17] + (size_t)l * 1024 * 2048; const float* xwo = p.in[18] + (size_t)l * 1024 * 1024;
    const float* wg = p.in[23] + (size_t)l * 32 * 1024 * 256; const float* wu = p.in[24] + (size_t)l * 32 * 1024 * 256; const float* wd = p.in[25] + (size_t)l * 32 * 256 * 1024;
    constexpr int I_IN = 16 * 40, I_Q = 4 * 24, I_KV = 4 * 40, I_SQ = 16 * 16, I_XKV = 16 * 32, I_GU = 32 * 16 * 8, I_DN = 32 * 4 * 16;
    constexpr int NIT = I_GU + I_DN + I_IN + 3 * I_SQ + I_XKV + I_Q + I_KV;
    const f32x4 z4 = {0.f, 0.f, 0.f, 0.f};
    for (int it = gw; it < NIT; it += NGW) {
        int r = it;
        if (r < I_GU) { const int e = r >> 7, q = r & 127, kb = q >> 3, nb = q & 7; const float* G = wg + (size_t)e * 1024 * 256; const float* U = wu + (size_t)e * 1024 * 256;
            conv_item4([&](int k, int n) { const int j = (n >> 5) * 16 + (n & 15); return *(const f32x4*)((((n >> 4) & 1) ? U : G) + (size_t)k * 256 + j); },
                       (bf16*)(ws + W_GU) + (size_t)e * 512 * 1024, 1024, scr, kb * 64, nb * 64, lane); continue; }
        r -= I_GU;
        if (r < I_DN) { const int e = r >> 6, q = r & 63, kb = q >> 4, nb = q & 15; const float* Dn = wd + (size_t)e * 256 * 1024;
            conv_item4([&](int k, int n) { return *(const f32x4*)(Dn + (size_t)k * 1024 + n); }, (bf16*)(ws + W_DN) + (size_t)e * 1024 * 256, 256, scr, kb * 64, nb * 64, lane); continue; }
        r -= I_DN;
        if (r < I_IN) { const int kb = r / 40, nb = r % 40;
            conv_item4([&](int k, int n) { const int sc = yc_src(n); return sc >= 0 ? *(const f32x4*)(w_in + (size_t)k * 2488 + sc) : z4; }, (bf16*)(ws + W_IN), 1024, scr, kb * 64, nb * 64, lane); continue; }
        r -= I_IN;
        if (r < 3 * I_SQ) { const int m = r / I_SQ, q = r % I_SQ, kb = q >> 4, nb = q & 15; const float* W = m == 0 ? w_out : (m == 1 ? xwq : xwo);
            bf16* D = (bf16*)(ws + (m == 0 ? W_OUT : (m == 1 ? W_XQ : W_XO)));
            conv_item4([&](int k, int n) { return *(const f32x4*)(W + (size_t)k * 1024 + n); }, D, 1024, scr, kb * 64, nb * 64, lane); continue; }
        r -= 3 * I_SQ;
        if (r < I_XKV) { const int kb = r >> 5, nb = r & 31;
            conv_item4([&](int k, int n) { return *(const f32x4*)(xwkv + (size_t)k * 2048 + n); }, (bf16*)(ws + W_XKV), 1024, scr, kb * 64, nb * 64, lane); continue; }
        r -= I_XKV;
        if (r < I_Q) { const int kb = r / 24, nb = r % 24;
            conv_item([&](int k, int n) { const int h = n / 96, j = n - h * 96; int sc = h * 96 + j; if (j >= 64) { const int jj = j - 64; sc = h * 96 + 64 + (jj >> 1) + 16 * (jj & 1); }
                return gq[k] * w_uq[(size_t)k * 768 + sc]; }, (bf16*)(ws + W_Q), 256, scr, kb * 64, nb * 32, lane); continue; }
        r -= I_Q;
        { const int kb = r / 40, nb = r % 40;
            conv_item([&](int k, int n) { const int h = n / 160, j = n - h * 160;
                if (j >= 64 && j < 96) { const int jj = j - 64; return (k == 152 + (jj >> 1) + 16 * (jj & 1)) ? 1.f : 0.f; }
                const int col = (j < 64) ? h * 128 + j : h * 128 + 64 + (j - 96);
                return (k >= 24 && k < 152) ? gkv[k - 24] * w_ukv[(size_t)(k - 24) * 1024 + col] : 0.f; }, (bf16*)(ws + W_KV), 256, scr, kb * 64, nb * 32, lane); }
    }
}

__device__ __forceinline__ void phase_pre(const Params& p) {
    const int tid = TID(); unsigned char* ws = p.ws;
    {
        const size_t gt = (size_t)BID() * 512 + tid, GT = (size_t)GRD() * 512;
        const float* x = p.in[0]; bf16* XB = (bf16*)(ws + WS_XB);
#pragma unroll 2
        for (size_t i = gt; i < (size_t)NTOK * DM / 8; i += GT) { const f32x4 a = *(const f32x4*)(x + i * 8), b = *(const f32x4*)(x + i * 8 + 4);
            u32x4 o; o.x = pk2(a[0], a[1]); o.y = pk2(a[2], a[3]); o.z = pk2(b[0], b[1]); o.w = pk2(b[2], b[3]); *(u32x4*)(XB + i * 8) = o; }
        const float* mem = p.in[1]; bf16* MB = (bf16*)(ws + WS_MEMB);
#pragma unroll 2
        for (size_t i = gt; i < (size_t)2048 * DM / 8; i += GT) { const f32x4 a = *(const f32x4*)(mem + i * 8), b = *(const f32x4*)(mem + i * 8 + 4);
            u32x4 o; o.x = pk2(a[0], a[1]); o.y = pk2(a[2], a[3]); o.z = pk2(b[0], b[1]); o.w = pk2(b[2], b[3]); *(u32x4*)(MB + i * 8) = o; }
        const int* pos = (const int*)p.in[2]; float* ROPE = (float*)(ws + WS_ROPE);
#pragma unroll 1
        for (size_t i = gt; i < (size_t)NTOK * 16; i += GT) { const int t = (int)(i >> 4), f = (int)(i & 15);
            double inv = 0.15915494309189535;
            for (int q = 0; q < f; ++q) inv *= 0.5623413251903491;
            const double rev = (double)pos[t] * inv; const float fr = (float)(rev - floor(rev));
            ROPE[i * 2] = __builtin_amdgcn_cosf(fr); ROPE[i * 2 + 1] = __builtin_amdgcn_sinf(fr); }
    }
}

__device__ __forceinline__ void gla_cum(const Params& p, int l, float* bs, int t0, int h) {
    const int tid = TID(), t = tid >> 3, dg = tid & 7;
    const bf16* Y = (const bf16*)(p.ws + WS_Y);
    const float* w_a2 = p.in[5] + l * 16 * 256; const float* b_a = p.in[6] + l * 256;
    float a[16];
    { const u32x4 a0 = *(const u32x4*)(Y + (size_t)(t0 + t) * YW + Y_A), a1 = *(const u32x4*)(Y + (size_t)(t0 + t) * YW + Y_A + 8);
#pragma unroll
      for (int j = 0; j < 4; ++j) { a[2 * j] = blo(a0[j]); a[2 * j + 1] = bhi(a0[j]); a[8 + 2 * j] = blo(a1[j]); a[8 + 2 * j + 1] = bhi(a1[j]); } }
#pragma unroll
    for (int j = 0; j < 8; ++j) { const int d = dg * 8 + j; float z = b_a[h * 64 + d];
#pragma unroll
        for (int q = 0; q < 16; ++q) z = fmaf(a[q], w_a2[q * 256 + h * 64 + d], z);
        bs[t * 65 + d] = logsigmoid(z) * (1.f / 16.f); }
    __syncthreads();
    if (tid < 64) { float s = 0.f; for (int tt = 0; tt < 64; ++tt) { s += bs[tt * 65 + tid]; bs[tt * 65 + tid] = s; } }
    __syncthreads();
}
__device__ __forceinline__ void ml_gates(const Params& p, int l, float* fc, float* aa, float* pm, int t0, int h) {
    const int tid = TID();
    const bf16* Y = (const bf16*)(p.ws + WS_Y);
    if (tid < 64) { const float fp = bf2f(Y[(size_t)(t0 + tid) * YW + Y_MF + h]) + p.in[10][l * 4 + h]; const float ig = bf2f(Y[(size_t)(t0 + tid) * YW + Y_MI + h]) + p.in[9][l * 4 + h];
        fc[tid] = logsigmoid(fp); aa[tid] = ig; }
    __syncthreads();
    if (tid == 0) { float s = 0.f, m = -3.0e38f; for (int i = 0; i < 64; ++i) { s += fc[i]; fc[i] = s; const float a = aa[i] - s; aa[i] = a; m = fmaxf(m, a); pm[i] = m; } }
    __syncthreads();
}
__device__ __forceinline__ void ml_conv(const Params& p, int l, float* dst, int t0, int c, int ycol, int wch, int h, float scale) {
    const int tid = TID(), s = tid >> 3, dg = tid & 7;
    const bf16* Y = (const bf16*)(p.ws + WS_Y); const float* w = p.in[8] + l * 4 * 512;
    float acc[8];
#pragma unroll
    for (int j = 0; j < 8; ++j) acc[j] = 0.f;
#pragma unroll
    for (int q = 0; q < 4; ++q) { const int ss = c * 64 + s - 3 + q;
        if (ss >= 0) { const u32x4 v = *(const u32x4*)(Y + (size_t)(t0 + s - 3 + q) * YW + ycol + h * 64 + dg * 8); const float* wr = w + q * 512 + wch + h * 64 + dg * 8;
#pragma unroll
            for (int j = 0; j < 4; ++j) { acc[2 * j] = fmaf(wr[2 * j], blo(v[j]), acc[2 * j]); acc[2 * j + 1] = fmaf(wr[2 * j + 1], bhi(v[j]), acc[2 * j + 1]); } } }
#pragma unroll
    for (int j = 0; j < 8; ++j) dst[s * 65 + dg * 8 + j] = siluf(acc[j]) * scale;
}
__device__ __forceinline__ void ld_blk(float* dst, const bf16* src, int ld) {
    const int tid = TID(), s = tid >> 3, dg = tid & 7; const u32x4 v = *(const u32x4*)(src + (size_t)s * ld + dg * 8);
#pragma unroll
    for (int j = 0; j < 4; ++j) { dst[s * 65 + dg * 8 + 2 * j] = blo(v[j]); dst[s * 65 + dg * 8 + 2 * j + 1] = bhi(v[j]); }
}

#define FENCE() do { asm volatile("" ::: "memory"); __builtin_amdgcn_sched_barrier(0); } while (0)
__device__ __forceinline__ f32x4 mfma16(bf16x8 a, bf16x8 b, f32x4 c) { return __builtin_amdgcn_mfma_f32_16x16x32_bf16(a, b, c, 0, 0, 0); }
__device__ __forceinline__ bf16x8 pack8(f32x4 a, f32x4 b) { u32x4 w; w.x = pk2(a[0], a[1]); w.y = pk2(a[2], a[3]); w.z = pk2(b[0], b[1]); w.w = pk2(b[2], b[3]); return __builtin_bit_cast(bf16x8, w); }
__device__ __forceinline__ f32x4 up4(u32x2 w) { return (f32x4){blo(w.x), bhi(w.x), blo(w.y), bhi(w.y)}; }
constexpr int LT = 68;
constexpr int WAVE_LDS = 18304;
__device__ __forceinline__ bf16x8 colfrag(const bf16* T, int col, int ra, int rb) {
    u32x4 w;
    w.x = (unsigned)T[(ra + 0) * LT + col] | ((unsigned)T[(ra + 1) * LT + col] << 16); w.y = (unsigned)T[(ra + 2) * LT + col] | ((unsigned)T[(ra + 3) * LT + col] << 16);
    w.z = (unsigned)T[(rb + 0) * LT + col] | ((unsigned)T[(rb + 1) * LT + col] << 16); w.w = (unsigned)T[(rb + 2) * LT + col] | ((unsigned)T[(rb + 3) * LT + col] << 16);
    return __builtin_bit_cast(bf16x8, w);
}
__device__ __forceinline__ void conv8(const bf16* Y, const float* cw  , int t0, int c, int rr, int ycol, float scale, f32x4& o0, f32x4& o1) {
    f32x4 a0 = {0.f, 0.f, 0.f, 0.f}, a1 = {0.f, 0.f, 0.f, 0.f};
#pragma unroll
    for (int tap = 0; tap < 4; ++tap) { const int ss = c * 64 + rr - 3 + tap;
        if (ss >= 0) { const u32x4 v = *(const u32x4*)(Y + (size_t)(t0 + rr - 3 + tap) * YW + ycol); const f32x4 w0 = *(const f32x4*)(cw + tap * 512), w1 = *(const f32x4*)(cw + tap * 512 + 4);
            a0 += w0 * (f32x4){blo(v.x), bhi(v.x), blo(v.y), bhi(v.y)}; a1 += w1 * (f32x4){blo(v.z), bhi(v.z), blo(v.w), bhi(v.w)}; } }
#pragma unroll
    for (int j = 0; j < 4; ++j) { o0[j] = siluf(a0[j]) * scale; o1[j] = siluf(a1[j]) * scale; }
}
__device__ __forceinline__ void v_to_lds(bf16* Vt, const bf16* vsrc, int lane) {
#pragma unroll
    for (int i = 0; i < 16; ++i) { const int x = lane + 64 * i, rr = x >> 4, cc = x & 15; *(u32x2*)(Vt + rr * LT + cc * 4) = *(const u32x2*)(vsrc + (size_t)rr * YW + cc * 4); }
}

__device__ __forceinline__ void lin_loc_wave(const Params& p, int l, bf16* Kt, bf16* Vt, int u, int lane) {
    asm volatile("" : "+v"(lane));
    unsigned char* ws = p.ws; const bf16* Y = (const bf16*)(ws + WS_Y);
    const int type = u >> 10, ur = u & 1023, bh = ur >> 5, c = ur & 31, b = bh >> 2, h = bh & 3, t0 = b * SEQ + c * 64;
    const int q = lane & 15, g = lane >> 4;
    float* ST = (float*)(ws + WS_ST) + (size_t)u * 4096;
    v_to_lds(Vt, Y + (size_t)t0 * YW + (type == 0 ? Y_GV : Y_MV) + h * 64, lane);
    if (type == 0) {
        const float* w_a2 = p.in[5] + l * 16 * 256 + h * 64; const float* b_a = p.in[6] + l * 256 + h * 64;
        const bf16x8 zero8 = {0, 0, 0, 0, 0, 0, 0, 0};
        bf16x8 wf[4], af[4];
#pragma unroll
        for (int db = 0; db < 4; ++db) { wf[db] = zero8;
            if (g < 2) { f32x4 w0, w1;
#pragma unroll
                for (int j = 0; j < 4; ++j) { w0[j] = w_a2[(8 * g + j) * 256 + 16 * db + q]; w1[j] = w_a2[(8 * g + 4 + j) * 256 + 16 * db + q]; }
                wf[db] = pack8(w0, w1); } }
#pragma unroll
        for (int tb = 0; tb < 4; ++tb) { af[tb] = zero8; if (g < 2) af[tb] = *(const bf16x8*)(Y + (size_t)(t0 + 16 * tb + q) * YW + Y_A + 8 * g); }
        float* BC = (float*)(ws + WS_BC); float* DEC = (float*)(ws + WS_DEC) + (size_t)ur * 64;
#pragma unroll
        for (int db = 0; db < 4; ++db) {
            const f32x4 ba = *(const f32x4*)(b_a + 16 * db + 4 * g);
            f32x4 bb[4]; f32x4 carry = {0.f, 0.f, 0.f, 0.f};
#pragma unroll
            for (int tb = 0; tb < 4; ++tb) { const f32x4 z = mfma16(wf[db], af[tb], (f32x4){0.f, 0.f, 0.f, 0.f});
#pragma unroll
                for (int r = 0; r < 4; ++r) { float x = logsigmoid(z[r] + ba[r]) * (1.f / 16.f);
#pragma unroll
                    for (int k = 1; k < 16; k <<= 1) { const float y = __shfl_up(x, k, 16); if (q >= k) x += y; }
                    x += carry[r]; bb[tb][r] = x; carry[r] = __shfl(x, (lane & 48) + 15); } }
#pragma unroll
            for (int sb = 0; sb < 4; ++sb) { const size_t row = (size_t)(t0 + 16 * sb + q);
                f32x4 kv = up4(*(const u32x2*)(Y + row * YW + Y_GK + h * 64 + 16 * db + 4 * g));
#pragma unroll
                for (int r = 0; r < 4; ++r) kv[r] *= fexp(carry[r] - bb[sb][r]);
                st_bf4(Kt + (16 * sb + q) * LT + 16 * db + 4 * g, kv);
                *(f32x4*)(BC + row * 256 + h * 64 + 16 * db + 4 * g) = bb[sb]; }
            if (q == 0) *(f32x4*)(DEC + 16 * db + 4 * g) = (f32x4){fexp(carry[0]), fexp(carry[1]), fexp(carry[2]), fexp(carry[3])};
            FENCE();
        }
    } else {
        const float fp = bf2f(Y[(size_t)(t0 + lane) * YW + Y_MF + h]) + p.in[10][l * 4 + h], ig = bf2f(Y[(size_t)(t0 + lane) * YW + Y_MI + h]) + p.in[9][l * 4 + h];
        float fc = logsigmoid(fp);
#pragma unroll
        for (int k = 1; k < 64; k <<= 1) { const float y = __shfl_up(fc, k); if (lane >= k) fc += y; }
        const float a = ig - fc; float M = a;
#pragma unroll
        for (int o = 1; o < 64; o <<= 1) M = fmaxf(M, __shfl_xor(M, o));
        const float F = __shfl(fc, 63), wl = fexp(a - M);
        const float* cw = p.in[8] + l * 4 * 512 + 256 + h * 64;
#pragma unroll
        for (int sb = 0; sb < 4; ++sb) { const float wrow = __shfl(wl, 16 * sb + q);
#pragma unroll
            for (int ks = 0; ks < 2; ++ks) { const int d0 = 32 * ks + 8 * g; f32x4 o0, o1; bf16* qk = (bf16*)(ws + WS_QKC) + (size_t)(t0 + 16 * sb + q) * 512 + h * 64 + d0;
                conv8(Y, cw + d0, t0, c, 16 * sb + q, Y_MK + h * 64 + d0, 1.f, o0, o1);
                st_bf4(qk + 256, o0); st_bf4(qk + 260, o1);
                st_bf4(Kt + (16 * sb + q) * LT + d0, o0 * wrow); st_bf4(Kt + (16 * sb + q) * LT + d0 + 4, o1 * wrow); FENCE();
                conv8(Y, cw - 256 + d0, t0, c, 16 * sb + q, Y_MQ + h * 64 + d0, 0.125f, o0, o1);
                st_bf4(qk, o0); st_bf4(qk + 4, o1); FENCE(); } }
        if (lane == 0) { float* SC = (float*)(ws + WS_SC); SC[ur * 2] = F; SC[ur * 2 + 1] = F + M; }
    }
    bf16x8 vf[4][2], kf[4][2];
#pragma unroll
    for (int eb = 0; eb < 4; ++eb)
#pragma unroll
        for (int ks = 0; ks < 2; ++ks) { vf[eb][ks] = colfrag(Vt, 16 * eb + q, 32 * ks + 8 * g, 32 * ks + 8 * g + 4); kf[eb][ks] = colfrag(Kt, 16 * eb + q, 32 * ks + 8 * g, 32 * ks + 8 * g + 4); FENCE(); }
#pragma unroll
    for (int eb = 0; eb < 4; ++eb)
#pragma unroll
        for (int db = 0; db < 4; ++db) { f32x4 acc = {0.f, 0.f, 0.f, 0.f};
#pragma unroll
            for (int ks = 0; ks < 2; ++ks) acc = mfma16(vf[eb][ks], kf[db][ks], acc);
#pragma unroll
            for (int r = 0; r < 4; ++r) ST[(16 * eb + 4 * g + r) * 64 + 16 * db + q] = acc[r]; }
    if (type == 1) { const u32x4 o1 = {0x3f803f80u, 0x3f803f80u, 0x3f803f80u, 0x3f803f80u}; const bf16x8 ones = __builtin_bit_cast(bf16x8, o1); float* NV = (float*)(ws + WS_NV) + (size_t)ur * 64;
#pragma unroll
        for (int db = 0; db < 4; ++db) { f32x4 acc = {0.f, 0.f, 0.f, 0.f};
#pragma unroll
            for (int ks = 0; ks < 2; ++ks) acc = mfma16(ones, kf[db][ks], acc);
            if (g == 0) NV[16 * db + q] = acc[0]; } }
}

template <int type>
__device__ __forceinline__ void lin_mix_wave(const Params& p, int l, bf16* Vt, int u, int lane) {
    asm volatile("" : "+v"(lane));
    unsigned char* ws = p.ws; const bf16* Y = (const bf16*)(ws + WS_Y);
    const int ur = u & 1023, bh = ur >> 5, c = ur & 31, b = bh >> 2, h = bh & 3, t0 = b * SEQ + c * 64;
    const int q = lane & 15, g = lane >> 4;
    const float* ST = (const float*)(ws + WS_ST) + (size_t)u * 4096;
    bf16* MIX = (bf16*)(ws + WS_XB);
    const float* BC = (const float*)(ws + WS_BC);
    const bf16* QKC = (const bf16*)(ws + WS_QKC);
    u32x2 vraw[16]; u32x4 kraw[4][2], qraw[4][2]; f32x4 braw[4][2][2];
    { const bf16* vsrc = Y + (size_t)t0 * YW + (type == 0 ? Y_GV : Y_MV) + h * 64;
#pragma unroll
      for (int i = 0; i < 16; ++i) { const int x = lane + 64 * i; vraw[i] = *(const u32x2*)(vsrc + (size_t)(x >> 4) * YW + (x & 15) * 4); } }
#pragma unroll
    for (int blk = 0; blk < 4; ++blk)
#pragma unroll
        for (int ks = 0; ks < 2; ++ks) { const size_t row = (size_t)(t0 + 16 * blk + q); const int d0 = 32 * ks + 8 * g;
            if (type == 0) { kraw[blk][ks] = *(const u32x4*)(Y + row * YW + Y_GK + h * 64 + d0); qraw[blk][ks] = *(const u32x4*)(Y + row * YW + Y_GQ + h * 64 + d0);
                braw[blk][ks][0] = *(const f32x4*)(BC + row * 256 + h * 64 + d0); braw[blk][ks][1] = *(const f32x4*)(BC + row * 256 + h * 64 + d0 + 4); }
            else { kraw[blk][ks] = *(const u32x4*)(QKC + row * 512 + 256 + h * 64 + d0); qraw[blk][ks] = *(const u32x4*)(QKC + row * 512 + h * 64 + d0); } }
    float fcl = 0.f, al = 0.f, pml = 0.f, mst = 0.f;
    if (type == 1) {
        const float fp = bf2f(Y[(size_t)(t0 + lane) * YW + Y_MF + h]) + p.in[10][l * 4 + h], ig = bf2f(Y[(size_t)(t0 + lane) * YW + Y_MI + h]) + p.in[9][l * 4 + h];
        mst = ((const float*)(ws + WS_MS))[ur];
        float fc = logsigmoid(fp);
#pragma unroll
        for (int k = 1; k < 64; k <<= 1) { const float y = __shfl_up(fc, k); if (lane >= k) fc += y; }
        fcl = fc; al = ig - fc; pml = al;
#pragma unroll
        for (int k = 1; k < 64; k <<= 1) { const float y = __shfl_up(pml, k); if (lane >= k) pml = fmaxf(pml, y); }
    }
    FENCE();
#pragma unroll
    for (int i = 0; i < 16; ++i) { const int x = lane + 64 * i; *(u32x2*)(Vt + (x >> 4) * LT + (x & 15) * 4) = vraw[i]; }
    bf16x8 kf[4][2], qfa[4][2];
#pragma unroll
    for (int blk = 0; blk < 4; ++blk)
#pragma unroll
        for (int ks = 0; ks < 2; ++ks) {
            if (type == 0) { const u32x4 kk = kraw[blk][ks], qq = qraw[blk][ks]; const f32x4 b0 = braw[blk][ks][0], b1 = braw[blk][ks][1];
                f32x4 k0 = {blo(kk.x), bhi(kk.x), blo(kk.y), bhi(kk.y)}, k1 = {blo(kk.z), bhi(kk.z), blo(kk.w), bhi(kk.w)};
                f32x4 q0 = {blo(qq.x), bhi(qq.x), blo(qq.y), bhi(qq.y)}, q1 = {blo(qq.z), bhi(qq.z), blo(qq.w), bhi(qq.w)};
#pragma unroll
                for (int j = 0; j < 4; ++j) { const float e0 = fexp(b0[j]), e1 = fexp(b1[j]); k0[j] *= __builtin_amdgcn_rcpf(e0); k1[j] *= __builtin_amdgcn_rcpf(e1); q0[j] *= 0.125f * e0; q1[j] *= 0.125f * e1; }
                kf[blk][ks] = pack8(k0, k1); qfa[blk][ks] = pack8(q0, q1);
            } else { kf[blk][ks] = __builtin_bit_cast(bf16x8, kraw[blk][ks]); qfa[blk][ks] = __builtin_bit_cast(bf16x8, qraw[blk][ks]); } }
    FENCE();
    bf16x8 sf[4][2], vf[4][2];
    { f32x4 sraw[4][2][2];
#pragma unroll
      for (int eb = 0; eb < 4; ++eb)
#pragma unroll
          for (int ks = 0; ks < 2; ++ks) { const float* sp = ST + (16 * eb + q) * 64 + 32 * ks + 8 * g; sraw[eb][ks][0] = *(const f32x4*)sp; sraw[eb][ks][1] = *(const f32x4*)(sp + 4); }
#pragma unroll
      for (int eb = 0; eb < 4; ++eb)
#pragma unroll
          for (int ks = 0; ks < 2; ++ks) { vf[eb][ks] = colfrag(Vt, 16 * eb + q, 32 * ks + 4 * g, 32 * ks + 16 + 4 * g); FENCE(); }
#pragma unroll
      for (int eb = 0; eb < 4; ++eb)
#pragma unroll
          for (int ks = 0; ks < 2; ++ks) sf[eb][ks] = pack8(sraw[eb][ks][0], sraw[eb][ks][1]); }
    f32x4 nvv[2][2];
#pragma unroll
    for (int ks = 0; ks < 2; ++ks) { nvv[ks][0] = (f32x4){0.f, 0.f, 0.f, 0.f}; nvv[ks][1] = nvv[ks][0];
        if (type == 1) { const float* nvp = (const float*)(ws + WS_NV) + (size_t)ur * 64 + 32 * ks + 8 * g; nvv[ks][0] = *(const f32x4*)nvp; nvv[ks][1] = *(const f32x4*)(nvp + 4); } }
    const float* gn = (type == 0 ? p.in[7] : p.in[11]) + l * 256 + h * 64;
    f32x4 asv[4];
#pragma unroll
    for (int sb = 0; sb < 4; ++sb) { asv[sb] = (f32x4){0.f, 0.f, 0.f, 0.f};
        if (type == 1) {
#pragma unroll
            for (int r = 0; r < 4; ++r) asv[sb][r] = __shfl(al, 16 * sb + 4 * g + r); } }
    FENCE();
#pragma unroll
    for (int tb = 0; tb < 4; ++tb) {
        const int t = 16 * tb + q;
        bf16x8 qf[2]; qf[0] = qfa[tb][0]; qf[1] = qfa[tb][1];
        u32x2 graw[4]; f32x4 gg4[4];
#pragma unroll
        for (int eb = 0; eb < 4; ++eb) { graw[eb] = *(const u32x2*)(Y + (size_t)(t0 + t) * YW + (type == 0 ? Y_GR : Y_MO) + h * 64 + 16 * eb + 4 * g); gg4[eb] = *(const f32x4*)(gn + 16 * eb + 4 * g); }
        f32x4 pt[4];
#pragma unroll
        for (int sb = 0; sb < 4; ++sb) { pt[sb] = (f32x4){0.f, 0.f, 0.f, 0.f};
            if (sb <= tb) {
#pragma unroll
                for (int ks = 0; ks < 2; ++ks) pt[sb] = mfma16(kf[sb][ks], qf[ks], pt[sb]); } }
        float mm = 0.f, wi = 1.f;
        if (type == 1) { mm = fmaxf(mst, __shfl(pml, t)); wi = fexp(mst - mm); }
        float dsum = 0.f;
#pragma unroll
        for (int sb = 0; sb < 4; ++sb) if (sb <= tb) {
#pragma unroll
            for (int r = 0; r < 4; ++r) { const int sidx = 16 * sb + 4 * g + r; float w = pt[sb][r];
                if (type == 1) w *= fexp(asv[sb][r] - mm);
                w = (sidx <= t) ? w : 0.f; pt[sb][r] = w; dsum += w; } }
        bf16x8 pf[2]; pf[0] = pack8(pt[0], pt[1]); pf[1] = pack8(pt[2], pt[3]); FENCE();
        f32x4 ot[4];
#pragma unroll
        for (int eb = 0; eb < 4; ++eb) { f32x4 acc = {0.f, 0.f, 0.f, 0.f};
#pragma unroll
            for (int ks = 0; ks < 2; ++ks) acc = mfma16(sf[eb][ks], qf[ks], acc);
            acc = acc * wi;
            acc = mfma16(vf[eb][0], pf[0], acc);
            if (tb >= 2) acc = mfma16(vf[eb][1], pf[1], acc);
            ot[eb] = acc; }
        if (type == 1) {
            float qn = 0.f;
#pragma unroll
            for (int ks = 0; ks < 2; ++ks) { const u32x4 w = __builtin_bit_cast(u32x4, qf[ks]); const f32x4 n0 = nvv[ks][0], n1 = nvv[ks][1];
                qn += blo(w.x) * n0[0] + bhi(w.x) * n0[1] + blo(w.y) * n0[2] + bhi(w.y) * n0[3] + blo(w.z) * n1[0] + bhi(w.z) * n1[1] + blo(w.w) * n1[2] + bhi(w.w) * n1[3]; }
            qn += __shfl_xor(qn, 16); qn += __shfl_xor(qn, 32); dsum += __shfl_xor(dsum, 16); dsum += __shfl_xor(dsum, 32);
            const float den = wi * qn + dsum, mt = __shfl(fcl, t) + mm; const float inv = 1.f / fmaxf(fabsf(den), fexp(-mt));
#pragma unroll
            for (int eb = 0; eb < 4; ++eb) ot[eb] = ot[eb] * inv;
            FENCE();
        }
        float s1 = 0.f;
#pragma unroll
        for (int eb = 0; eb < 4; ++eb) s1 += (ot[eb][0] + ot[eb][1]) + (ot[eb][2] + ot[eb][3]);
        s1 += __shfl_xor(s1, 16); s1 += __shfl_xor(s1, 32);
        const float mu = s1 * (1.f / 64.f); float s2 = 0.f;
#pragma unroll
        for (int eb = 0; eb < 4; ++eb) { ot[eb] = ot[eb] - mu; s2 += (ot[eb][0] * ot[eb][0] + ot[eb][1] * ot[eb][1]) + (ot[eb][2] * ot[eb][2] + ot[eb][3] * ot[eb][3]); }
        s2 += __shfl_xor(s2, 16); s2 += __shfl_xor(s2, 32);
        const float rstd = 1.f / sqrtf(s2 * (1.f / 64.f) + LN_EPS);
#pragma unroll
        for (int eb = 0; eb < 4; ++eb) { const int e0 = 16 * eb + 4 * g;
            const f32x4 gate = up4(graw[eb]); const f32x4 gg = gg4[eb];
            f32x4 res;
#pragma unroll
            for (int r = 0; r < 4; ++r) res[r] = ot[eb][r] * rstd * gg[r] * (type == 0 ? siluf(gate[r]) : sigmoidf(gate[r]));
            st_bf4(MIX + (size_t)(t0 + t) * DM + type * 256 + h * 64 + e0, res); }
        FENCE();
    }
}

__device__ __forceinline__ void phase_loc(const Params& p, int l, unsigned char* smem) {
    const int tid = TID(), lane = tid & 63, wave = __builtin_amdgcn_readfirstlane(tid >> 6);
    unsigned char* ws = p.ws; const bf16* Y = (const bf16*)(ws + WS_Y);
    { bf16* Kt = (bf16*)(smem + wave * WAVE_LDS); bf16* Vt = Kt + 64 * LT;
      for (int u = BID() * 8 + wave; u < 2048; u += GRD() * 8) lin_loc_wave(p, l, Kt, Vt, u, lane); }
    float* RS = (float*)(ws + WS_RS);
    for (int row = BID() * 8 + wave; row < NTOK; row += GRD() * 8) {
        const u32x2 q = *(const u32x2*)(Y + (size_t)row * YW + Y_CQ + lane * 4); const unsigned kv = *(const unsigned*)(Y + (size_t)row * YW + Y_CKV + lane * 2);
        float sq = blo(q.x) * blo(q.x) + bhi(q.x) * bhi(q.x) + blo(q.y) * blo(q.y) + bhi(q.y) * bhi(q.y); float sk = blo(kv) * blo(kv) + bhi(kv) * bhi(kv);
        sq = wave_sum(sq); sk = wave_sum(sk);
        if (lane == 0) { RS[row * 2] = 1.f / sqrtf(sq * (1.f / 256.f) + LN_EPS); RS[row * 2 + 1] = 1.f / sqrtf(sk * (1.f / 128.f) + LN_EPS); }
    }
}

__device__ __forceinline__ void phase_scan(const Params& p, int l, int dummy = 0) {
    unsigned char* ws = p.ws;
    float* ST = (float*)(ws + WS_ST); float* STD = dummy ? (float*)(ws + WS_XB) : ST; float* NV = (float*)(ws + WS_NV); const float* DEC = (const float*)(ws + WS_DEC); const float* SC = (const float*)(ws + WS_SC); float* MS = (float*)(ws + WS_MS);
    const int gt = BID() * 512 + TID(), GT = GRD() * 512;
    for (int idx = gt; idx < 64 * 4096; idx += GT) {
        const int seq = idx >> 12, el = idx & 4095, d = el & 63;
        float* st = ST + (size_t)seq * 32 * 4096 + el;
        float tv[32];
#pragma unroll
        for (int c = 0; c < 32; ++c) tv[c] = st[(size_t)c * 4096];
        if (seq < 32) { const float* dc = DEC + (size_t)seq * 32 * 64 + d; float dv[32];
#pragma unroll
            for (int c = 0; c < 32; ++c) dv[c] = dc[c * 64];
            float S = 0.f;
#pragma unroll
            for (int c = 0; c < 32; ++c) { const float tmp = tv[c]; tv[c] = S; S = fmaf(dv[c], S, tmp); } }
        else { const float* sc = SC + (size_t)(seq - 32) * 32 * 2; float C = 0.f, m = 0.f;
#pragma unroll
            for (int c = 0; c < 32; ++c) { const float F = sc[c * 2], ml = sc[c * 2 + 1]; const float tmp = tv[c]; tv[c] = C;
                const float mn = fmaxf(F + m, ml); C = expf(F + m - mn) * C + expf(ml - mn) * tmp; m = mn; } }
        float* sd = STD + (size_t)seq * 32 * 4096 + el;
#pragma unroll
        for (int c = 0; c < 32; ++c) sd[(size_t)c * 4096] = tv[c];
    }
    if (dummy) return;
    for (int idx = gt; idx < 32 * 64; idx += GT) {
        const int sq = idx >> 6, d = idx & 63; float n = 0.f, m = 0.f; const float* sc = SC + (size_t)sq * 32 * 2; float* nv = NV + (size_t)sq * 32 * 64 + d;
#pragma unroll 4
        for (int c = 0; c < 32; ++c) { const float F = sc[c * 2], ml = sc[c * 2 + 1]; const float tmp = nv[c * 64]; nv[c * 64] = n; if (d == 0) MS[sq * 32 + c] = m;
            const float mn = fmaxf(F + m, ml); n = expf(F + m - mn) * n + expf(ml - mn) * tmp; m = mn; }
    }
}

template <int DQK, int DV>
__device__ __forceinline__ void attn_naive(unsigned char* smem, const bf16* Q, int qs, const bf16* K, int ks, const bf16* V, int vs, int nk, bf16* O, int os) {
    constexpr int LQ = DQK + 8, LV = DV + 8, EV = DV / 8;
    bf16* Qs = (bf16*)smem; bf16* Ks = Qs + 64 * LQ; bf16* Vs = Ks + 64 * LQ; float* Ss = (float*)(Vs + 64 * LV);
    const int tid = TID(), t = tid >> 3, g = tid & 7;
    __syncthreads();
    for (int i = tid; i < 64 * DQK / 8; i += 512) { const int r = i / (DQK / 8), c8 = i % (DQK / 8); *(u32x4*)(Qs + r * LQ + c8 * 8) = *(const u32x4*)(Q + (size_t)r * qs + c8 * 8); }
    float acc[EV]; float m = -3.0e38f, lsum = 0.f;
#pragma unroll
    for (int j = 0; j < EV; ++j) acc[j] = 0.f;
    for (int k0 = 0; k0 < nk; k0 += 64) {
        __syncthreads();
        for (int i = tid; i < 64 * DQK / 8; i += 512) { const int r = i / (DQK / 8), c8 = i % (DQK / 8); *(u32x4*)(Ks + r * LQ + c8 * 8) = *(const u32x4*)(K + (size_t)(k0 + r) * ks + c8 * 8); }
        for (int i = tid; i < 64 * DV / 8; i += 512) { const int r = i / (DV / 8), c8 = i % (DV / 8); *(u32x4*)(Vs + r * LV + c8 * 8) = *(const u32x4*)(V + (size_t)(k0 + r) * vs + c8 * 8); }
        __syncthreads();
        float sc[8];
#pragma unroll
        for (int j = 0; j < 8; ++j) sc[j] = 0.f;
        for (int d8 = 0; d8 < DQK / 8; ++d8) { const u32x4 qv = *(const u32x4*)(Qs + t * LQ + d8 * 8);
#pragma unroll
            for (int j = 0; j < 8; ++j) { const u32x4 kv = *(const u32x4*)(Ks + (g + 8 * j) * LQ + d8 * 8);
#pragma unroll
                for (int q = 0; q < 4; ++q) sc[j] = fmaf(blo(qv[q]), blo(kv[q]), fmaf(bhi(qv[q]), bhi(kv[q]), sc[j])); } }
        float mx = sc[0];
#pragma unroll
        for (int j = 1; j < 8; ++j) mx = fmaxf(mx, sc[j]);
        mx = fmaxf(mx, __shfl_xor(mx, 1)); mx = fmaxf(mx, __shfl_xor(mx, 2)); mx = fmaxf(mx, __shfl_xor(mx, 4));
        const float mn = fmaxf(m, mx), al = exp2f(m - mn); float ps = 0.f;
#pragma unroll
        for (int j = 0; j < 8; ++j) { const float pv = exp2f(sc[j] - mn); ps += pv; Ss[t * 65 + g + 8 * j] = pv; }
        ps += __shfl_xor(ps, 1); ps += __shfl_xor(ps, 2); ps += __shfl_xor(ps, 4);
        lsum = lsum * al + ps; m = mn;
#pragma unroll
        for (int j = 0; j < EV; ++j) acc[j] *= al;
        __syncthreads();
        for (int kk = 0; kk < 64; ++kk) { const float pv = Ss[t * 65 + kk];
#pragma unroll
            for (int j8 = 0; j8 < EV / 8; ++j8) { const u32x4 vv = *(const u32x4*)(Vs + kk * LV + g * EV + j8 * 8);
#pragma unroll
                for (int q = 0; q < 4; ++q) { acc[j8 * 8 + 2 * q] = fmaf(pv, blo(vv[q]), acc[j8 * 8 + 2 * q]); acc[j8 * 8 + 2 * q + 1] = fmaf(pv, bhi(vv[q]), acc[j8 * 8 + 2 * q + 1]); } } }
    }
    const float inv = 1.f / lsum;
#pragma unroll
    for (int j8 = 0; j8 < EV / 8; ++j8) { u32x4 o; o.x = pk2(acc[j8 * 8] * inv, acc[j8 * 8 + 1] * inv); o.y = pk2(acc[j8 * 8 + 2] * inv, acc[j8 * 8 + 3] * inv);
        o.z = pk2(acc[j8 * 8 + 4] * inv, acc[j8 * 8 + 5] * inv); o.w = pk2(acc[j8 * 8 + 6] * inv, acc[j8 * 8 + 7] * inv);
        *(u32x4*)(O + (size_t)t * os + g * EV + j8 * 8) = o; }
}

template <int DQK, int DV, int QG>
__device__ __forceinline__ void attn_mfma_unit(unsigned char* smem, const bf16* Q, int qs, const bf16* K, int ks, const bf16* VT, int vts, int ntile_wave, int ntile_max, bf16* O, int os) {
    constexpr int LK = DQK + 8, LV = 72, KS = DQK / 32, NDV = DV / 16;
    constexpr int NKPIECE = 64 * DQK / 8, NVPIECE = DV * 8, NKP = (NKPIECE + 511) / 512, NVP = (NVPIECE + 511) / 512;
    bf16* Ks = (bf16*)smem; bf16* Vs = Ks + 64 * LK;
    const int tid = TID(), wave = tid >> 6, lane = tid & 63, q = lane & 15, g = lane >> 4;
    bf16x8 qf[QG][KS];
#pragma unroll
    for (int qg = 0; qg < QG; ++qg)
#pragma unroll
        for (int kk = 0; kk < KS; ++kk) qf[qg][kk] = *(const bf16x8*)(Q + (size_t)(wave * 16 * QG + qg * 16 + q) * qs + kk * 32 + g * 8);
    f32x4 o[QG][NDV]; float mrun[QG], lrun[QG];
#pragma unroll
    for (int qg = 0; qg < QG; ++qg) { mrun[qg] = -3.0e38f; lrun[qg] = 0.f;
#pragma unroll
        for (int d = 0; d < NDV; ++d) o[qg][d] = (f32x4){0.f, 0.f, 0.f, 0.f}; }
    u32x4 kr[NKP], vr[NVP];
#define AT_GLOAD(kt) do { _Pragma("unroll") for (int _i = 0; _i < NKP; ++_i) { const int _x = tid + 512 * _i; if (_x < NKPIECE) { const int _r = _x / (DQK / 8), _c = _x % (DQK / 8); kr[_i] = *(const u32x4*)(K + (size_t)((kt) * 64 + _r) * ks + _c * 8); } } \
        _Pragma("unroll") for (int _i = 0; _i < NVP; ++_i) { const int _x = tid + 512 * _i; if (_x < NVPIECE) { const int _r = _x >> 3, _c = _x & 7; vr[_i] = *(const u32x4*)(VT + (size_t)_r * vts + (kt) * 64 + _c * 8); } } } while (0)
#define AT_LSTORE() do { _Pragma("unroll") for (int _i = 0; _i < NKP; ++_i) { const int _x = tid + 512 * _i; if (_x < NKPIECE) { const int _r = _x / (DQK / 8), _c = _x % (DQK / 8); *(u32x4*)(Ks + _r * LK + _c * 8) = kr[_i]; } } \
        _Pragma("unroll") for (int _i = 0; _i < NVP; ++_i) { const int _x = tid + 512 * _i; if (_x < NVPIECE) { const int _r = _x >> 3, _c = _x & 7; *(u32x4*)(Vs + _r * LV + _c * 8) = vr[_i]; } } } while (0)
    AT_GLOAD(0);
    for (int kt = 0; kt < ntile_max; ++kt) {
        __syncthreads();
        AT_LSTORE();
        __syncthreads();
        if (kt + 1 < ntile_max) AT_GLOAD(kt + 1);
        if (kt < ntile_wave) {
            f32x4 sc[QG][4];
#pragma unroll
            for (int qg = 0; qg < QG; ++qg)
#pragma unroll
                for (int b = 0; b < 4; ++b) sc[qg][b] = (f32x4){0.f, 0.f, 0.f, 0.f};
#pragma unroll
            for (int b = 0; b < 4; ++b)
#pragma unroll
                for (int kk = 0; kk < KS; ++kk) { const bf16x8 kf = *(const bf16x8*)(Ks + (b * 16 + q) * LK + kk * 32 + g * 8);
#pragma unroll
                    for (int qg = 0; qg < QG; ++qg) sc[qg][b] = __builtin_amdgcn_mfma_f32_16x16x32_bf16(kf, qf[qg][kk], sc[qg][b], 0, 0, 0); }
            bf16x8 pf[QG][2];
#pragma unroll
            for (int qg = 0; qg < QG; ++qg) {
                float mx = sc[qg][0][0];
#pragma unroll
                for (int b = 0; b < 4; ++b)
#pragma unroll
                    for (int i = 0; i < 4; ++i) mx = fmaxf(mx, sc[qg][b][i]);
                mx = fmaxf(mx, __shfl_xor(mx, 16)); mx = fmaxf(mx, __shfl_xor(mx, 32));
                const float mn = fmaxf(mrun[qg], mx), al = __builtin_amdgcn_exp2f(mrun[qg] - mn); float ps = 0.f;
#pragma unroll
                for (int b = 0; b < 4; ++b)
#pragma unroll
                    for (int i = 0; i < 4; ++i) { const float pv = __builtin_amdgcn_exp2f(sc[qg][b][i] - mn); sc[qg][b][i] = pv; ps += pv; }
                lrun[qg] = lrun[qg] * al + ps; mrun[qg] = mn;
#pragma unroll
                for (int d = 0; d < NDV; ++d) o[qg][d] = o[qg][d] * al;
#pragma unroll
                for (int st = 0; st < 2; ++st) { u32x4 w; w.x = pk2(sc[qg][2 * st][0], sc[qg][2 * st][1]); w.y = pk2(sc[qg][2 * st][2], sc[qg][2 * st][3]);
                    w.z = pk2(sc[qg][2 * st + 1][0], sc[qg][2 * st + 1][1]); w.w = pk2(sc[qg][2 * st + 1][2], sc[qg][2 * st + 1][3]); pf[qg][st] = __builtin_bit_cast(bf16x8, w); }
            }
#pragma unroll
            for (int d = 0; d < NDV; ++d)
#pragma unroll
                for (int st = 0; st < 2; ++st) { const u32x2 v0 = *(const u32x2*)(Vs + (d * 16 + q) * LV + st * 32 + 4 * g), v1 = *(const u32x2*)(Vs + (d * 16 + q) * LV + st * 32 + 16 + 4 * g);
                    const u32x4 vv = {v0.x, v0.y, v1.x, v1.y}; const bf16x8 vf = __builtin_bit_cast(bf16x8, vv);
#pragma unroll
                    for (int qg = 0; qg < QG; ++qg) o[qg][d] = __builtin_amdgcn_mfma_f32_16x16x32_bf16(vf, pf[qg][st], o[qg][d], 0, 0, 0); }
        }
    }
#undef AT_GLOAD
#undef AT_LSTORE
#pragma unroll
    for (int qg = 0; qg < QG; ++qg) { float lt = lrun[qg]; lt += __shfl_xor(lt, 16); lt += __shfl_xor(lt, 32); const float inv = 1.f / lt;
        bf16* orow = O + (size_t)(wave * 16 * QG + qg * 16 + q) * os + 4 * g;
#pragma unroll
        for (int d = 0; d < NDV; ++d) st_bf4(orow + d * 16, o[qg][d] * inv); }
}

__device__ __forceinline__ void mix_linear_unit(const Params& p, int l, unsigned char* smem, int u) {
    const int tid = TID(); unsigned char* ws = p.ws; const bf16* Y = (const bf16*)(ws + WS_Y);
    float* A0 = (float*)smem; float* A1 = A0 + 64 * 65; float* A2 = A1 + 64 * 65; float* A3 = A2 + 64 * 65; float* A4 = A3 + 64 * 65; float* A5 = A4 + 64 * 65;
    float* fc = A5 + 64 * 65; float* aa = fc + 64; float* pm = aa + 64; float* nv = pm + 64;
    const float* ST = (const float*)(ws + WS_ST); const float* NV = (const float*)(ws + WS_NV); const float* MS = (const float*)(ws + WS_MS);
    bf16* MIX = (bf16*)(ws + WS_XB);
    const int type = u >> 10, r = u & 1023, bh = r >> 5, c = r & 31, b = bh >> 2, h = bh & 3, t0 = b * SEQ + c * 64;
    const int t = tid >> 3, g = tid & 7, e0 = g * 8;
    __syncthreads();
    for (int i = tid; i < 4096; i += 512) A3[(i >> 6) * 65 + (i & 63)] = ST[(size_t)u * 4096 + i];
    ld_blk(A2, Y + (size_t)t0 * YW + (type == 0 ? Y_GV : Y_MV) + h * 64, YW);
    float mst = 0.f;
    if (type == 0) {
        gla_cum(p, l, A0, t0, h);
        ld_blk(A4, Y + (size_t)t0 * YW + Y_GQ + h * 64, YW); ld_blk(A1, Y + (size_t)t0 * YW + Y_GK + h * 64, YW);
        __syncthreads();
        for (int i = tid; i < 4096; i += 512) { const int s = i >> 6, dd = i & 63; const float bb = A0[s * 65 + dd]; A4[s * 65 + dd] *= 0.125f * expf(bb); A1[s * 65 + dd] *= expf(-bb); }
    } else {
        ml_gates(p, l, fc, aa, pm, t0, h);
        ml_conv(p, l, A4, t0, c, Y_MQ, 0, h, 0.125f); ml_conv(p, l, A1, t0, c, Y_MK, 256, h, 1.f);
        if (tid < 64) nv[tid] = NV[(size_t)r * 64 + tid];
        mst = MS[r];
    }
    __syncthreads();
    const float mm = (type == 1) ? fmaxf(mst, pm[t]) : 0.f;
    {
        float sc[8];
#pragma unroll
        for (int j = 0; j < 8; ++j) sc[j] = 0.f;
        for (int d = 0; d < 64; ++d) { const float qv = A4[t * 65 + d];
#pragma unroll
            for (int j = 0; j < 8; ++j) sc[j] = fmaf(qv, A1[(g + 8 * j) * 65 + d], sc[j]); }
#pragma unroll
        for (int j = 0; j < 8; ++j) { const int s = g + 8 * j; float w = (s <= t) ? sc[j] : 0.f; if (type == 1) w = (s <= t) ? w * expf(aa[s] - mm) : 0.f; A5[t * 65 + s] = w; }
    }
    __syncthreads();
    float acc[8], inter[8];
#pragma unroll
    for (int j = 0; j < 8; ++j) { acc[j] = 0.f; inter[j] = 0.f; }
    for (int d = 0; d < 64; ++d) { const float qv = A4[t * 65 + d];
#pragma unroll
        for (int j = 0; j < 8; ++j) inter[j] = fmaf(qv, A3[d * 65 + e0 + j], inter[j]); }
    for (int s = 0; s < 64; ++s) { const float pv = A5[t * 65 + s];
#pragma unroll
        for (int j = 0; j < 8; ++j) acc[j] = fmaf(pv, A2[s * 65 + e0 + j], acc[j]); }
    float o[8];
    if (type == 0) {
#pragma unroll
        for (int j = 0; j < 8; ++j) o[j] = acc[j] + inter[j];
    } else {
        const float wi = expf(mst - mm);
        float dn = 0.f;
#pragma unroll
        for (int j = 0; j < 8; ++j) dn += wi * A4[t * 65 + e0 + j] * nv[e0 + j] + A5[t * 65 + e0 + j];
        dn += __shfl_xor(dn, 1); dn += __shfl_xor(dn, 2); dn += __shfl_xor(dn, 4);
        const float mt = fc[t] + mm; const float den = fmaxf(fabsf(dn), expf(-mt)); const float inv = 1.f / den;
#pragma unroll
        for (int j = 0; j < 8; ++j) o[j] = (wi * inter[j] + acc[j]) * inv;
    }
    float s1 = 0.f;
#pragma unroll
    for (int j = 0; j < 8; ++j) s1 += o[j];
    s1 += __shfl_xor(s1, 1); s1 += __shfl_xor(s1, 2); s1 += __shfl_xor(s1, 4);
    const float mu = s1 * (1.f / 64.f); float s2 = 0.f;
#pragma unroll
    for (int j = 0; j < 8; ++j) { o[j] -= mu; s2 += o[j] * o[j]; }
    s2 += __shfl_xor(s2, 1); s2 += __shfl_xor(s2, 2); s2 += __shfl_xor(s2, 4);
    const float rstd = 1.f / sqrtf(s2 * (1.f / 64.f) + LN_EPS);
    const float* gn = (type == 0 ? p.in[7] : p.in[11]) + l * 256 + h * 64 + e0;
    const u32x4 gv = *(const u32x4*)(Y + (size_t)(t0 + t) * YW + (type == 0 ? Y_GR : Y_MO) + h * 64 + e0);
    float gate[8];
#pragma unroll
    for (int j = 0; j < 4; ++j) { gate[2 * j] = blo(gv[j]); gate[2 * j + 1] = bhi(gv[j]); }
    float res[8];
#pragma unroll
    for (int j = 0; j < 8; ++j) res[j] = o[j] * rstd * gn[j] * (type == 0 ? siluf(gate[j]) : sigmoidf(gate[j]));
    u32x4 ov; ov.x = pk2(res[0], res[1]); ov.y = pk2(res[2], res[3]); ov.z = pk2(res[4], res[5]); ov.w = pk2(res[6], res[7]);
    *(u32x4*)(MIX + (size_t)(t0 + t) * DM + type * 256 + h * 64 + e0) = ov;
}

__device__ __forceinline__ void phase_mix(const Params& p, int l, unsigned char* smem, int part = 3  ) {
    unsigned char* ws = p.ws;
    const bf16* QP = (const bf16*)(ws + WS_QP); const bf16* KP = (const bf16*)(ws + WS_KP); const bf16* VPT = (const bf16*)(ws + WS_VP); bf16* MIX = (bf16*)(ws + WS_XB);
    if (part & 1)
    for (int u = BID(); u < 512; u += GRD()) {
        const int bh = u & 63, Qb = u < 256 ? 7 - (u >> 6) : (u - 256) >> 6, b = bh >> 3, h = bh & 7;
        const int wave = TID() >> 6;
        attn_mfma_unit<96, 64, 2>(smem, QP + ((size_t)bh * SEQ + Qb * 256) * 96, 96, KP + (size_t)bh * SEQ * 96, 96, VPT + (size_t)bh * 64 * SEQ, SEQ,
                                  Qb * 4 + (wave >> 1) + 1, Qb * 4 + 4, MIX + (size_t)(b * SEQ + Qb * 256) * DM + 512 + h * 64, DM);
    }
    __syncthreads();
    if (part & 2)
    { const int tid = TID(), lane = tid & 63, wave = __builtin_amdgcn_readfirstlane(tid >> 6); bf16* Vt = (bf16*)(smem + wave * WAVE_LDS);
      for (int u = BID() * 8 + wave; u < 1024; u += GRD() * 8) lin_mix_wave<0>(p, l, Vt, u, lane);
      for (int u = 1024 + BID() * 8 + wave; u < 2048; u += GRD() * 8) lin_mix_wave<1>(p, l, Vt, u, lane); }
}

__device__ __forceinline__ void ln_row_store(f32x4 (&v)[4], const float* g, const float* bta, float* of, bf16* ob, int lane) {
    float s = 0.f;
#pragma unroll
    for (int j = 0; j < 4; ++j) s += (v[j][0] + v[j][1]) + (v[j][2] + v[j][3]);
    const float mean = wave_sum(s) * (1.f / DM); float s2 = 0.f;
#pragma unroll
    for (int j = 0; j < 4; ++j) { v[j] = v[j] - mean; s2 += (v[j][0] * v[j][0] + v[j][1] * v[j][1]) + (v[j][2] * v[j][2] + v[j][3] * v[j][3]); }
    const float rstd = 1.f / sqrtf(wave_sum(s2) * (1.f / DM) + LN_EPS);
#pragma unroll
    for (int j = 0; j < 4; ++j) { const f32x4 gg = *(const f32x4*)(g + lane * 4 + 256 * j), bb = *(const f32x4*)(bta + lane * 4 + 256 * j);
        v[j] = v[j] * rstd * gg + bb; if (of) *(f32x4*)(of + lane * 4 + 256 * j) = v[j]; st_bf4(ob + lane * 4 + 256 * j, v[j]); }
}

__device__ __forceinline__ void phase_ln(const Params& p, int l, int which  , int dummy = 0  ) {
    const int tid = TID(), lane = tid & 63, wave = __builtin_amdgcn_readfirstlane(tid >> 6); unsigned char* ws = p.ws;
    float* XR = p.out; bf16* XB = (bf16*)(ws + WS_XB);
    const float* g = p.in[26 + 2 * which] + l * DM; const float* bta = p.in[27 + 2 * which] + l * DM;
    const bf16* CT = (const bf16*)(ws + WS_CT);
    f32x4 rf[4]; u32x2 rx[4], rc0[4], rc1[4];
#define LN_LOAD(rw) do { if (which == 2) { _Pragma("unroll") for (int j = 0; j < 4; ++j) { rx[j] = *(const u32x2*)(XB + (size_t)(rw) * DM + lane * 4 + 256 * j); \
            rc0[j] = *(const u32x2*)(CT + (size_t)(rw) * DM + lane * 4 + 256 * j); rc1[j] = *(const u32x2*)(CT + ((size_t)NTOK + (rw)) * DM + lane * 4 + 256 * j); } } \
        else { _Pragma("unroll") for (int j = 0; j < 4; ++j) rf[j] = *(const f32x4*)(XR + (size_t)(rw) * DM + lane * 4 + 256 * j); } } while (0)
    const int row_first = BID() * 8 + wave, row_step = GRD() * 8;
    if (row_first < NTOK) LN_LOAD(row_first);
    for (int row = row_first; row < NTOK; row += row_step) {
        f32x4 v[4];
        if (which == 2) {
#pragma unroll
            for (int j = 0; j < 4; ++j) v[j] = up4q(rx[j]) * ALPHA + up4q(rc0[j]) + up4q(rc1[j]);
        } else {
#pragma unroll
            for (int j = 0; j < 4; ++j) v[j] = rf[j];
        }
        if (row + row_step < NTOK) LN_LOAD(row + row_step);
        float* of = which == 2 ? XR + (size_t)row * DM : nullptr; bf16* ob = XB + (size_t)row * DM;
        if (dummy) { of = (float*)(ws + (which == 2 ? WS_Y : WS_CT)) + (size_t)row * DM; ob = (bf16*)(ws + (which == 2 ? WS_ST : WS_Y)) + (size_t)row * DM; }
        ln_row_store(v, g, bta, of, ob, lane);
        if (which == 1) {
            const float* wgp = p.in[19] + (size_t)l * DM * 4; const float* bg = p.in[20] + l * 4; const float* wr = p.in[21] + (size_t)l * DM * 32; const float* br = p.in[22] + l * 32;
            float gl[4] = {0.f, 0.f, 0.f, 0.f};
#pragma unroll
            for (int j = 0; j < 4; ++j)
#pragma unroll
                for (int q = 0; q < 4; ++q) { const f32x4 w4 = *(const f32x4*)(wgp + (size_t)(lane * 4 + 256 * j + q) * 4); const float xv = v[j][q];
                    gl[0] = fmaf(xv, w4[0], gl[0]); gl[1] = fmaf(xv, w4[1], gl[1]); gl[2] = fmaf(xv, w4[2], gl[2]); gl[3] = fmaf(xv, w4[3], gl[3]); }
#pragma unroll
            for (int q = 0; q < 4; ++q) gl[q] = wave_sum(gl[q]) + bg[q];
            int gi = 0; float gm = gl[0];
#pragma unroll
            for (int q = 1; q < 4; ++q) if (gl[q] > gm) { gm = gl[q]; gi = q; }
            float gs = 0.f;
#pragma unroll
            for (int q = 0; q < 4; ++q) gs += expf(gl[q] - gm);
            const float gp = 1.f / gs;
            float el[8] = {0.f, 0.f, 0.f, 0.f, 0.f, 0.f, 0.f, 0.f};
#pragma unroll
            for (int j = 0; j < 4; ++j)
#pragma unroll
                for (int q = 0; q < 4; ++q) { const float* wrow = wr + (size_t)(lane * 4 + 256 * j + q) * 32 + gi * 8; const f32x4 w0 = *(const f32x4*)wrow, w1 = *(const f32x4*)(wrow + 4); const float xv = v[j][q];
                    el[0] = fmaf(xv, w0[0], el[0]); el[1] = fmaf(xv, w0[1], el[1]); el[2] = fmaf(xv, w0[2], el[2]); el[3] = fmaf(xv, w0[3], el[3]);
                    el[4] = fmaf(xv, w1[0], el[4]); el[5] = fmaf(xv, w1[1], el[5]); el[6] = fmaf(xv, w1[2], el[6]); el[7] = fmaf(xv, w1[3], el[7]); }
#pragma unroll
            for (int q = 0; q < 8; ++q) el[q] = wave_sum(el[q]) + br[gi * 8 + q];
            int i0 = 0; float m0 = el[0];
#pragma unroll
            for (int q = 1; q < 8; ++q) if (el[q] > m0) { m0 = el[q]; i0 = q; }
            int i1 = -1; float m1 = -3.0e38f;
#pragma unroll
            for (int q = 0; q < 8; ++q) if (q != i0 && el[q] > m1) { m1 = el[q]; i1 = q; }
            const float p1 = expf(m1 - m0); const float w0 = gp / (1.f + p1), w1 = gp * p1 / (1.f + p1);
            if (lane == 0 && !dummy) {
                unsigned* cnt = (unsigned*)(ws + WS_CTL) + CW_CNT + l * 32; int* LT = (int*)(ws + WS_LISTT); float* LW = (float*)(ws + WS_LISTW);
                const int e0 = gi * 8 + i0, e1 = gi * 8 + i1;
                const unsigned p0 = atomicAdd(cnt + e0, 1u); LT[(size_t)e0 * NTOK + p0] = row * 2; LW[(size_t)e0 * NTOK + p0] = w0;
                const unsigned q1 = atomicAdd(cnt + e1, 1u); LT[(size_t)e1 * NTOK + q1] = row * 2 + 1; LW[(size_t)e1 * NTOK + q1] = w1;
            }
        }
    }
}

#undef LN_LOAD
__device__ __forceinline__ void moe_table(const Params& p, int l, int* tstart, int* cntl) {
    __syncthreads();
    const int tid = TID();
    if (tid < 64) {
        const unsigned* cnt = (const unsigned*)(p.ws + WS_CTL) + CW_CNT + l * 32;
        const int c = tid < 32 ? (int)__hip_atomic_load(cnt + (tid & 31), __ATOMIC_RELAXED, __HIP_MEMORY_SCOPE_AGENT) : 0;
        const int nt = (c + 255) >> 8; int incl = nt;
#pragma unroll
        for (int k = 1; k < 32; k <<= 1) { const int y = __shfl_up(incl, k); if (tid >= k) incl += y; }
        if (tid < 32) { cntl[tid] = c; tstart[tid] = incl - nt; }
        if (tid == 31) tstart[32] = incl;
    }
    __syncthreads();
}

__device__ __forceinline__ void phase_moe(const Params& p, int l, unsigned char* smem, int which  ) {
    unsigned char* ws = p.ws;
    int* tstart = (int*)(smem + LDS_BYTES - 1024); int* cntl = tstart + 40;
    moe_table(p, l, tstart, cntl);
    if (which == 0) { SchedMoe S{tstart, cntl, (const int*)(ws + WS_LISTT), (const float*)(ws + WS_LISTW), (const bf16*)(ws + WS_XB), (const bf16*)(ws + W_GU), 0};
        EpiMoe1 E{(bf16*)(ws + WS_H)}; gemm_run<true>(smem, S, 1024, 1024, 1024, E); }
    else { SchedMoe S{tstart, cntl, (const int*)(ws + WS_LISTT), (const float*)(ws + WS_LISTW), (const bf16*)(ws + WS_H), (const bf16*)(ws + W_DN), 1};
        EpiMoe2 E{(bf16*)(ws + WS_CT)}; gemm_run(smem, S, 256, 256, 256, E); }
}

constexpr int LDS_PARAMS = LDS_BYTES - 512;
#define GETP const Params& p = *(const Params*)(smem + LDS_PARAMS); unsigned char* ws = p.ws; (void)ws
#ifndef PROBE_REP
#define PROBE_REP 0
#endif
#ifndef FULL_MASK
#define FULL_MASK 0x3fffu
#endif
#ifndef PHASE_ATTR
#define PHASE_ATTR __forceinline__
#endif
__device__ PHASE_ATTR void ph_conv(unsigned char* smem, int l, size_t dshift = 0) { GETP; phase_conv(p, l, smem, dshift); }
__device__ PHASE_ATTR void ph_pre(unsigned char* smem) { GETP; phase_pre(p); }
__device__ PHASE_ATTR void ph_g1(unsigned char* smem, int l) { GETP;
    { SchedGrid S{(const bf16*)(ws + WS_XB), (const bf16*)(ws + W_IN), 1024, 10, 640, 0, 0}; EpiBf16Store E{(bf16*)(ws + WS_Y), YW, 1.f}; gemm_run(smem, S, 1024, 1024, 1024, E); }
    { SchedGrid S{(const bf16*)(ws + WS_MEMB), (const bf16*)(ws + W_XKV), 1024, 8, 64, 128, 0}; EpiKVX E{(bf16*)(ws + WS_KVX), (bf16*)(ws + WS_KVX + 4 * MiB)}; gemm_run(smem, S, 1024, 1024, 1024, E); }
}
__device__ PHASE_ATTR void ph_loc(unsigned char* smem, int l) { GETP; phase_loc(p, l, smem); }
__device__ PHASE_ATTR void ph_scan(unsigned char* smem, int l, int part = 3  ) { GETP;
    if (part & 1) {
    { SchedGrid S{(const bf16*)(ws + WS_Y), (const bf16*)(ws + W_Q), 256, 3, 192, 0, Y_CQ};
      EpiMlaQ E{(bf16*)(ws + WS_QP), (const float*)(ws + WS_RS), (const float*)(ws + WS_ROPE)}; gemm_run(smem, S, 256, YW, 256, E); }
    { SchedGrid S{(const bf16*)(ws + WS_Y), (const bf16*)(ws + W_KV), 256, 5, 320, 64, Y_T9};
      EpiMlaKV E{(bf16*)(ws + WS_KP), (bf16*)(ws + WS_VP), (const float*)(ws + WS_RS), (const float*)(ws + WS_ROPE)}; gemm_run(smem, S, 256, YW, 256, E); }
    }
    if (part & 2) phase_scan(p, l);
    if (part & 4) phase_scan(p, l, 1);
}
__device__ PHASE_ATTR void ph_mix(unsigned char* smem, int l, int part = 3) { GETP; phase_mix(p, l, smem, part); }
__device__ PHASE_ATTR void ph_g4(unsigned char* smem, int l, int dummy = 0) { GETP;
    SchedGrid S{(const bf16*)(ws + WS_XB), (const bf16*)(ws + W_OUT), 1024, 4, 256, 0, 0}; EpiResid E{l == 0 ? p.in[0] : p.out, dummy ? (float*)(ws + WS_CT) : p.out}; gemm_run(smem, S, 1024, 1024, 1024, E);
}
__device__ PHASE_ATTR void ph_ln(unsigned char* smem, int l, int which, int dummy = 0) { GETP; phase_ln(p, l, which, dummy); }
__device__ PHASE_ATTR void ph_g5(unsigned char* smem, int l) { GETP;
    SchedGrid S{(const bf16*)(ws + WS_XB), (const bf16*)(ws + W_XQ), 1024, 4, 256, 0, 0}; EpiBf16Store E{(bf16*)(ws + WS_QX), DM, XSCALE}; gemm_run(smem, S, 1024, 1024, 1024, E);
}
__device__ PHASE_ATTR void ph_xatt(unsigned char* smem, int l) { GETP;
    const bf16* QX = (const bf16*)(ws + WS_QX); const bf16* KX = (const bf16*)(ws + WS_KVX); const bf16* VXT = (const bf16*)(ws + WS_KVX + 4 * MiB); bf16* OX = (bf16*)(ws + WS_OX);
    for (int L = BID(); L < 512; L += GRD()) { const int u = xcd_remap(L, 512), b = u >> 6, h = (u >> 4) & 3, qt = u & 15;
        attn_mfma_unit<256, 256, 1>(smem, QX + (size_t)(b * SEQ + qt * 128) * DM + h * 256, DM, KX + (size_t)(b * 256) * 1024 + h * 256, 1024, VXT + (size_t)((b * 4 + h) * 256) * 256, 256, 4, 4,
                                    OX + (size_t)(b * SEQ + qt * 128) * DM + h * 256, DM); }
}
__device__ PHASE_ATTR void ph_g7(unsigned char* smem, int l, int dummy = 0) { GETP;
    SchedGrid S{(const bf16*)(ws + WS_OX), (const bf16*)(ws + W_XO), 1024, 4, 256, 0, 0}; EpiResidB E{(const bf16*)(ws + WS_XB), dummy ? (float*)(ws + WS_CT) : p.out}; gemm_run(smem, S, 1024, 1024, 1024, E);
}
__device__ PHASE_ATTR void ph_moe(unsigned char* smem, int l, int which) { GETP; phase_moe(p, l, smem, which); }

template <unsigned MASK>
__global__ void __launch_bounds__(512, 2) fwd(Params pk) {
    extern __shared__ __attribute__((aligned(16))) unsigned char smem[];
    { const unsigned* src = (const unsigned*)&pk; unsigned* dst = (unsigned*)(smem + LDS_PARAMS); for (int i = threadIdx.x; i < (int)(sizeof(Params) / 4); i += 512) dst[i] = src[i]; }
    unsigned char* ws = pk.ws;
    volatile LAS unsigned* barw = (volatile LAS unsigned*)((LAS unsigned char*)smem + LDS_BARW);
    if (threadIdx.x == 0) { barw[0] = 0u; barw[1] = 0u; }
    __syncthreads();
    XcdBarrier bar; bar.bar = (unsigned*)(ws + WS_CTL) + CW_BAR; bar.x = 0; bar.st = barw;
    const int lo = pk.ph_lo, hi = pk.ph_hi;
    const bool multi = (hi - lo) > 1;
    if (multi) bar = xcd_barrier_post((unsigned*)(ws + WS_CTL) + CW_BAR, barw);
    if (lo == 0) ph_pre(smem);
#pragma unroll 1
    for (int l = 0; l < 2; ++l) {
        const int base = l * NPH;
#define IN(k) (((MASK >> (k)) & 1u) != 0u && lo <= base + (k) && base + (k) < hi)
#define SEAM(k) do { if (base + (k) + 1 < hi) { xcd_barrier(bar); if ((PROBE_REP >> 20) & 1) xcd_barrier(bar); } } while (0)
#if PROBE_REP
#define REP(k) int _nr##k = ((PROBE_REP >> (k)) & 1) ? 2 : 1; asm volatile("" : "+s"(_nr##k)); for (int _r = 0; _r < _nr##k; ++_r)
#else
#define REP(k)
#endif
        if (IN(PH_CONV)) { ph_conv(smem, l);
#if PROBE_REP
            if ((PROBE_REP >> PH_CONV) & 1) ph_conv(smem, 1 - l, WS_Y - W_IN);
            if ((PROBE_REP >> 21) & 1) ph_pre(smem);
#endif
            SEAM(PH_CONV); }
        if (IN(PH_G1)) { REP(PH_G1) { ph_g1(smem, l); } SEAM(PH_G1); }
        if (IN(PH_LOC)) { REP(PH_LOC) { ph_loc(smem, l); } SEAM(PH_LOC); }
        if (IN(PH_SCAN)) { ph_scan(smem, l);
#if PROBE_REP
            if ((PROBE_REP >> PH_SCAN) & 1) ph_scan(smem, l, 1);
            if ((PROBE_REP >> 22) & 1) { __syncthreads(); ph_scan(smem, l, 4); }
#endif
            SEAM(PH_SCAN); }
        if (IN(PH_MIX)) { ph_mix(smem, l);
#if PROBE_REP
            if ((PROBE_REP >> PH_MIX) & 1) ph_mix(smem, l, 1);
            if ((PROBE_REP >> 23) & 1) ph_mix(smem, l, 2);
#endif
            SEAM(PH_MIX); }
        if (IN(PH_G4)) { ph_g4(smem, l);
#if PROBE_REP
            if ((PROBE_REP >> PH_G4) & 1) ph_g4(smem, l, 1);
#endif
            SEAM(PH_G4); }
        if (IN(PH_LN1)) { ph_ln(smem, l, 0);
#if PROBE_REP
            if ((PROBE_REP >> PH_LN1) & 1) { __syncthreads(); ph_ln(smem, l, 0, 1); }
#endif
            SEAM(PH_LN1); }
        if (IN(PH_G5)) { REP(PH_G5) { ph_g5(smem, l); } SEAM(PH_G5); }
        if (IN(PH_XATT)) { REP(PH_XATT) { ph_xatt(smem, l); } SEAM(PH_XATT); }
        if (IN(PH_G7)) { ph_g7(smem, l);
#if PROBE_REP
            if ((PROBE_REP >> PH_G7) & 1) ph_g7(smem, l, 1);
#endif
            SEAM(PH_G7); }
        if (IN(PH_LN2)) { ph_ln(smem, l, 1);
#if PROBE_REP
            if ((PROBE_REP >> PH_LN2) & 1) { __syncthreads(); ph_ln(smem, l, 1, 1); }
#endif
            SEAM(PH_LN2); }
        if (IN(PH_MOE1)) { REP(PH_MOE1) { ph_moe(smem, l, 0); } SEAM(PH_MOE1); }
        if (IN(PH_MOE2)) { REP(PH_MOE2) { ph_moe(smem, l, 1); } SEAM(PH_MOE2); }
        if (IN(PH_LN3)) { ph_ln(smem, l, 2);
#if PROBE_REP
            if ((PROBE_REP >> PH_LN3) & 1) { __syncthreads(); ph_ln(smem, l, 2, 1); }
#endif
            SEAM(PH_LN3); }
#undef IN
#undef SEAM
#undef REP
    }
}

extern "C" void kernel_launch(void* const* d_in, const int* in_sizes, int n_in, void* d_out, int out_size, void* d_ws, size_t ws_size, hipStream_t stream) {
    static int grid = 0;
    typedef void (*kfn_t)(Params);
#if N_LAUNCH_MODE == 1
    static const kfn_t kfn[NPH] = { fwd<1u << 0>, fwd<1u << 1>, fwd<1u << 2>, fwd<1u << 3>, fwd<1u << 4>, fwd<1u << 5>, fwd<1u << 6>, fwd<1u << 7>, fwd<1u << 8>, fwd<1u << 9>, fwd<1u << 10>, fwd<1u << 11>, fwd<1u << 12>, fwd<1u << 13> };
    constexpr int NK = NPH;
#else
    static const kfn_t kfn[1] = { fwd<FULL_MASK> };
    constexpr int NK = 1;
#endif
    if (grid == 0) {
        int dev = 0, cus = 0;
        if (n_in != 32 || out_size != NTOK * DM || ws_size < WS_TOTAL) { fprintf(stderr, "kernel_launch: unexpected shapes (n_in %d out %d ws %zu need %zu)\n", n_in, out_size, ws_size, (size_t)WS_TOTAL); }
        (void)hipGetDevice(&dev); (void)hipDeviceGetAttribute(&cus, hipDeviceAttributeMultiprocessorCount, dev);
        for (int i = 0; i < NK; ++i) (void)hipFuncSetAttribute((const void*)kfn[i], hipFuncAttributeMaxDynamicSharedMemorySize, LDS_BYTES);
        int per_cu = 0; (void)hipOccupancyMaxActiveBlocksPerMultiprocessor(&per_cu, (const void*)kfn[0], 512, LDS_BYTES);
        (void)hipGetLastError();
        grid = cus > 0 ? cus : 256;
    }
    (void)hipMemsetAsync((char*)d_ws + WS_CTL, 0, CTL_BYTES, stream);
    Params p{};
    for (int i = 0; i < 32; ++i) p.in[i] = (const float*)d_in[i];
    p.out = (float*)d_out; p.ws = (unsigned char*)d_ws;
#if N_LAUNCH_MODE == 1
    for (int ph = 0; ph < 2 * NPH; ++ph) { p.ph_lo = ph; p.ph_hi = ph + 1; hipLaunchKernelGGL(kfn[ph % NPH], dim3(grid), dim3(512), LDS_BYTES, stream, p); }
#else
    p.ph_lo = 0; p.ph_hi = 2 * NPH; hipLaunchKernelGGL(kfn[0], dim3(grid), dim3(512), LDS_BYTES, stream, p);
#endif
}
```
